# Optimizing an MI355X kernel written in HIP

```python
import math
import jax, jax.numpy as jnp
from jax import lax
import numpy as np


D_MODEL = 1024
BATCH = 4
SEQ = 4096
DEPTH = 2

D_FF = 2816
MLSTM_HEADS = 4
MLSTM_HEAD_DIM = 64
MLSTM_WIDTH = MLSTM_HEADS * MLSTM_HEAD_DIM
MLSTM_CHUNK = 64
SSM_HEADS = 8
SSM_HEAD_DIM = 64
SSM_WIDTH = SSM_HEADS * SSM_HEAD_DIM
SSM_STATE = 128
SSM_GROUPS = 2
SSM_CONV = 4
SSM_CONV_DIM = SSM_WIDTH + 2 * SSM_GROUPS * SSM_STATE
SSM_CHUNK = 128
DIFF_HEADS = 4
DIFF_QK_DIM = 32
DIFF_V_DIM = 64
DIFF_WIDTH = DIFF_HEADS * DIFF_V_DIM
Q_BLOCK = 128
REL_BUCKETS = 32
REL_MAX_DIST = 128
D_MIX = MLSTM_WIDTH + SSM_WIDTH + DIFF_WIDTH
IN_SPLIT_SIZES = (MLSTM_WIDTH, MLSTM_WIDTH, MLSTM_WIDTH, MLSTM_WIDTH, MLSTM_HEADS, MLSTM_HEADS,
                  SSM_WIDTH, SSM_CONV_DIM, SSM_HEADS,
                  2 * DIFF_HEADS * DIFF_QK_DIM, 2 * DIFF_HEADS * DIFF_QK_DIM, DIFF_WIDTH)
D_IN = sum(IN_SPLIT_SIZES)
NORM_EPS = 1e-6

kernel_name = 'hymba_style_mlstm_ssd_diffattn_macaron'


def rms_norm(x, w):
    xf = x.astype(jnp.float32)
    y = xf * lax.rsqrt(jnp.mean(xf * xf, axis=-1, keepdims=True) + NORM_EPS)
    return (y * w.astype(jnp.float32)).astype(x.dtype)


def swiglu_ffn(x, w_gate, w_up, w_down):
    return (jax.nn.silu(x @ w_gate) * (x @ w_up)) @ w_down


def t5_bucket(rel):
    n = jnp.maximum(rel, 0)
    max_exact = REL_BUCKETS // 2
    nf = jnp.maximum(n, 1).astype(jnp.float32)
    large = max_exact + (jnp.log(nf / max_exact) / math.log(REL_MAX_DIST / max_exact)
                         * (REL_BUCKETS - max_exact)).astype(jnp.int32)
    large = jnp.minimum(large, REL_BUCKETS - 1)
    return jnp.where(n < max_exact, n, large)


def causal_dwconv(x, w, b):
    K, C = w.shape
    y = lax.conv_general_dilated(x, w[:, None, :], window_strides=(1,), padding=((K - 1, 0),),
                                 dimension_numbers=('NWC', 'WIO', 'NWC'), feature_group_count=C)
    return y + b


def mlstm_chunkwise(q, k, v, i_pre, log_f):
    Bsz, H, S, DK = q.shape
    DV = v.shape[-1]
    L = MLSTM_CHUNK
    nc = S // L

    def to_chunks(a):
        return jnp.moveaxis(a.reshape(a.shape[:2] + (nc, L) + a.shape[3:]), 2, 0)

    causal = jnp.tril(jnp.ones((L, L), dtype=bool))

    def step(carry, inp):
        C, n, m = carry
        qc, kc, vc, ic, fc = inp
        b = jnp.cumsum(fc, axis=-1)
        log_d = jnp.where(causal, b[..., :, None] - b[..., None, :] + ic[..., None, :], -jnp.inf)
        m_inter = b + m[..., None]
        m_t = jnp.maximum(m_inter, jnp.max(log_d, axis=-1))
        d = jnp.exp(log_d - m_t[..., None])
        inter = jnp.exp(m_inter - m_t)
        s = jnp.einsum('bhtd,bhsd->bhts', qc, kc) * d
        num = jnp.einsum('bhts,bhsv->bhtv', s, vc) + inter[..., None] * jnp.einsum('bhtd,bhdv->bhtv', qc, C)
        den = jnp.sum(s, axis=-1) + inter * jnp.einsum('bhtd,bhd->bht', qc, n)
        h = num / jnp.maximum(jnp.abs(den), jnp.exp(-m_t))[..., None]
        b_last = b[..., -1]
        log_w = b_last[..., None] - b + ic
        m_new = jnp.maximum(b_last + m, jnp.max(log_w, axis=-1))
        w = jnp.exp(log_w - m_new[..., None])
        decay = jnp.exp(b_last + m - m_new)
        C_new = decay[..., None, None] * C + jnp.einsum('bhs,bhsd,bhsv->bhdv', w, kc, vc)
        n_new = decay[..., None] * n + jnp.einsum('bhs,bhsd->bhd', w, kc)
        return (C_new, n_new, m_new), h

    init = (jnp.zeros((Bsz, H, DK, DV), jnp.float32), jnp.zeros((Bsz, H, DK), jnp.float32),
            jnp.zeros((Bsz, H), jnp.float32))
    xs = (to_chunks(q), to_chunks(k), to_chunks(v), to_chunks(i_pre), to_chunks(log_f))
    _, h = lax.scan(step, init, xs)
    return jnp.moveaxis(h, 0, 2).reshape(Bsz, H, S, DV)


def ssd_chunked(x, dt, A, Bm, Cm):
    Bsz, S, H, P = x.shape
    N = Bm.shape[-1]
    L = SSM_CHUNK
    nc = S // L
    xc = (x * dt[..., None]).reshape(Bsz, nc, L, H, P)
    Bc = Bm.reshape(Bsz, nc, L, H, N)
    Cc = Cm.reshape(Bsz, nc, L, H, N)
    a_cs = jnp.cumsum((dt * A).reshape(Bsz, nc, L, H).transpose(0, 3, 1, 2), axis=-1)
    causal = jnp.tril(jnp.ones((L, L), dtype=bool))
    seg = jnp.exp(jnp.where(causal, a_cs[..., :, None] - a_cs[..., None, :], -jnp.inf))
    scores = jnp.einsum('bclhn,bcshn->bhcls', Cc, Bc) * seg
    y_diag = jnp.einsum('bhcls,bcshp->bclhp', scores, xc)
    decay_in = jnp.exp(a_cs[..., -1:] - a_cs)
    states = jnp.einsum('bcshn,bhcs,bcshp->bchpn', Bc, decay_in, xc)
    chunk_decay = jnp.exp(a_cs[..., -1])

    def step(s, inp):
        st, dec = inp
        return dec[..., None, None] * s + st, s

    _, prev = lax.scan(step, jnp.zeros((Bsz, H, P, N), jnp.float32),
                       (jnp.moveaxis(states, 1, 0), jnp.moveaxis(chunk_decay, 2, 0)))
    prev = jnp.moveaxis(prev, 0, 1)
    y_off = jnp.einsum('bclhn,bchpn,bhcl->bclhp', Cc, prev, jnp.exp(a_cs))
    return (y_diag + y_off).reshape(Bsz, S, H, P)


def diff_attention(q, k, v, rel_bias, lam):
    Bsz, H, S = q.shape[:3]
    DV = v.shape[-1]
    nb = S // Q_BLOCK
    scale = DIFF_QK_DIM ** -0.5
    k1 = k[..., 0, :]
    k2 = k[..., 1, :]
    qb = jnp.moveaxis(q.reshape(Bsz, H, nb, Q_BLOCK, 2, DIFF_QK_DIM), 2, 0)
    k_pos = jnp.arange(S)

    def block(args):
        qblk, bi = args
        q_pos = bi * Q_BLOCK + jnp.arange(Q_BLOCK)
        rel = q_pos[:, None] - k_pos[None, :]
        mask = rel >= 0
        bias = jnp.moveaxis(rel_bias[t5_bucket(rel)], -1, 0).astype(jnp.float32)

        def probs(qi, ki):
            logits = jnp.einsum('bhqd,bhkd->bhqk', qi, ki).astype(jnp.float32) * scale + bias
            return jax.nn.softmax(jnp.where(mask, logits, -jnp.inf), axis=-1)

        a = probs(qblk[..., 0, :], k1) - lam * probs(qblk[..., 1, :], k2)
        return jnp.einsum('bhqk,bhkv->bhqv', a.astype(v.dtype), v)

    out = lax.map(block, (qb, jnp.arange(nb)))
    return jnp.moveaxis(out, 0, 2).reshape(Bsz, H, S, DV)


def hybrid_mixer(h, layer_idx, w_in, w_out, mlstm_gate_bias, mlstm_norm_w, conv_w, conv_b,
                 dt_bias, A_log, D_skip, ssm_norm_w, q_norm_w, k_norm_w, lambdas, subln_w, rel_bias):
    Bsz, S, _ = h.shape
    f32 = jnp.float32
    proj = h @ w_in
    split_idx = np.cumsum(IN_SPLIT_SIZES)[:-1].tolist()
    mq, mk, mv, mo, mi, mf, z, xbc, dt_raw, dq, dk, dv = jnp.split(proj, split_idx, axis=-1)

    def heads(a, nh):
        return a.reshape(Bsz, S, nh, -1).transpose(0, 2, 1, 3)

    i_pre = (mi + mlstm_gate_bias[0]).astype(f32).transpose(0, 2, 1)
    log_f = jax.nn.log_sigmoid((mf + mlstm_gate_bias[1]).astype(f32)).transpose(0, 2, 1)
    hm = mlstm_chunkwise(heads(mq, MLSTM_HEADS).astype(f32),
                         heads(mk, MLSTM_HEADS).astype(f32) * (MLSTM_HEAD_DIM ** -0.5),
                         heads(mv, MLSTM_HEADS).astype(f32), i_pre, log_f)
    hm = rms_norm(hm.transpose(0, 2, 1, 3), mlstm_norm_w.reshape(MLSTM_HEADS, MLSTM_HEAD_DIM))
    y_mlstm = jax.nn.sigmoid(mo) * hm.reshape(Bsz, S, MLSTM_WIDTH).astype(h.dtype)

    xbc = jax.nn.silu(causal_dwconv(xbc, conv_w, conv_b))
    xs, Bm, Cm = jnp.split(xbc, [SSM_WIDTH, SSM_WIDTH + SSM_GROUPS * SSM_STATE], axis=-1)
    xs = xs.reshape(Bsz, S, SSM_HEADS, SSM_HEAD_DIM).astype(f32)
    rep = SSM_HEADS // SSM_GROUPS
    Bm = jnp.repeat(Bm.reshape(Bsz, S, SSM_GROUPS, SSM_STATE), rep, axis=2).astype(f32)
    Cm = jnp.repeat(Cm.reshape(Bsz, S, SSM_GROUPS, SSM_STATE), rep, axis=2).astype(f32)
    dt = jax.nn.softplus((dt_raw + dt_bias).astype(f32))
    A = -jnp.exp(A_log.astype(f32))
    y = ssd_chunked(xs, dt, A, Bm, Cm) + D_skip.astype(f32)[:, None] * xs
    y = y.reshape(Bsz, S, SSM_WIDTH).astype(h.dtype) * jax.nn.silu(z)
    y_ssm = rms_norm(y.reshape(Bsz, S, SSM_GROUPS, -1),
                     ssm_norm_w.reshape(SSM_GROUPS, -1)).reshape(Bsz, S, SSM_WIDTH)

    dq = rms_norm(dq.reshape(Bsz, S, DIFF_HEADS, 2, DIFF_QK_DIM), q_norm_w).transpose(0, 2, 1, 3, 4)
    dk = rms_norm(dk.reshape(Bsz, S, DIFF_HEADS, 2, DIFF_QK_DIM), k_norm_w).transpose(0, 2, 1, 3, 4)
    dv = heads(dv, DIFF_HEADS)
    lam_init = 0.8 - 0.6 * math.exp(-0.3 * layer_idx)
    lf = lambdas.astype(f32)
    lam = jnp.exp(jnp.sum(lf[0] * lf[1])) - jnp.exp(jnp.sum(lf[2] * lf[3])) + lam_init
    o = diff_attention(dq, dk, dv, rel_bias, lam)
    o = rms_norm(o.transpose(0, 2, 1, 3), subln_w) * (1.0 - lam_init)
    y_diff = o.reshape(Bsz, S, DIFF_WIDTH)

    return jnp.concatenate([y_mlstm, y_ssm, y_diff], axis=-1) @ w_out


def setup_inputs(seed: int = 0) -> dict:
    key = jax.random.key(seed)
    ks = jax.random.split(key, 32)
    L = DEPTH
    f32 = jnp.float32

    def nrm(i, shape, scale):
        return scale * jax.random.normal(ks[i], shape, f32)

    def gain(i, shape):
        return 1.0 + 0.1 * jax.random.normal(ks[i], shape, f32)

    x = jax.random.normal(ks[0], (BATCH, SEQ, D_MODEL), f32)
    ffn1_norm_w = gain(1, (L, D_MODEL))
    ffn1_w_gate = nrm(2, (L, D_MODEL, D_FF), D_MODEL ** -0.5)
    ffn1_w_up = nrm(3, (L, D_MODEL, D_FF), D_MODEL ** -0.5)
    ffn1_w_down = nrm(4, (L, D_FF, D_MODEL), D_FF ** -0.5)
    mix_norm_w = gain(5, (L, D_MODEL))
    w_in = nrm(6, (L, D_MODEL, D_IN), D_MODEL ** -0.5)
    mlstm_gate_bias = jnp.stack([nrm(7, (L, MLSTM_HEADS), 0.1),
                                 jnp.linspace(3.0, 6.0, MLSTM_HEADS)[None, :] + nrm(8, (L, MLSTM_HEADS), 0.1)],
                                axis=1)
    mlstm_norm_w = gain(9, (L, MLSTM_WIDTH))
    ssm_conv_w = nrm(10, (L, SSM_CONV, SSM_CONV_DIM), SSM_CONV ** -0.5)
    ssm_conv_b = nrm(11, (L, SSM_CONV_DIM), 0.01)
    dt0 = jnp.exp(jax.random.uniform(ks[12], (L, SSM_HEADS), f32, math.log(1e-3), math.log(1e-1)))
    ssm_dt_bias = dt0 + jnp.log(-jnp.expm1(-dt0))
    ssm_A_log = jnp.log(jax.random.uniform(ks[13], (L, SSM_HEADS), f32, 1.0, 16.0))
    ssm_D = gain(14, (L, SSM_HEADS))
    ssm_norm_w = gain(15, (L, SSM_WIDTH))
    diff_q_norm_w = gain(16, (L, 2, DIFF_QK_DIM))
    diff_k_norm_w = gain(17, (L, 2, DIFF_QK_DIM))
    diff_lambda = nrm(18, (L, 4, DIFF_QK_DIM), 0.1)
    diff_subln_w = gain(19, (L, DIFF_V_DIM))
    rel_bias = nrm(20, (REL_BUCKETS, DIFF_HEADS), 0.5)
    w_out = nrm(21, (L, D_MIX, D_MODEL), D_MIX ** -0.5)
    ffn2_norm_w = gain(22, (L, D_MODEL))
    ffn2_w_gate = nrm(23, (L, D_MODEL, D_FF), D_MODEL ** -0.5)
    ffn2_w_up = nrm(24, (L, D_MODEL, D_FF), D_MODEL ** -0.5)
    ffn2_w_down = nrm(25, (L, D_FF, D_MODEL), D_FF ** -0.5)
    return {'x': x, 'ffn1_norm_w': ffn1_norm_w, 'ffn1_w_gate': ffn1_w_gate, 'ffn1_w_up': ffn1_w_up,
            'ffn1_w_down': ffn1_w_down, 'mix_norm_w': mix_norm_w, 'w_in': w_in,
            'mlstm_gate_bias': mlstm_gate_bias, 'mlstm_norm_w': mlstm_norm_w,
            'ssm_conv_w': ssm_conv_w, 'ssm_conv_b': ssm_conv_b, 'ssm_dt_bias': ssm_dt_bias,
            'ssm_A_log': ssm_A_log, 'ssm_D': ssm_D, 'ssm_norm_w': ssm_norm_w,
            'diff_q_norm_w': diff_q_norm_w, 'diff_k_norm_w': diff_k_norm_w, 'diff_lambda': diff_lambda,
            'diff_subln_w': diff_subln_w, 'rel_bias': rel_bias, 'w_out': w_out,
            'ffn2_norm_w': ffn2_norm_w, 'ffn2_w_gate': ffn2_w_gate, 'ffn2_w_up': ffn2_w_up,
            'ffn2_w_down': ffn2_w_down}


def reference(x, ffn1_norm_w, ffn1_w_gate, ffn1_w_up, ffn1_w_down, mix_norm_w, w_in,
              mlstm_gate_bias, mlstm_norm_w, ssm_conv_w, ssm_conv_b, ssm_dt_bias, ssm_A_log, ssm_D,
              ssm_norm_w, diff_q_norm_w, diff_k_norm_w, diff_lambda, diff_subln_w, rel_bias, w_out,
              ffn2_norm_w, ffn2_w_gate, ffn2_w_up, ffn2_w_down):
    for l in range(DEPTH):
        x = x + 0.5 * swiglu_ffn(rms_norm(x, ffn1_norm_w[l]), ffn1_w_gate[l], ffn1_w_up[l], ffn1_w_down[l])
        x = x + hybrid_mixer(rms_norm(x, mix_norm_w[l]), l, w_in[l], w_out[l],
                             mlstm_gate_bias[l], mlstm_norm_w[l], ssm_conv_w[l], ssm_conv_b[l],
                             ssm_dt_bias[l], ssm_A_log[l], ssm_D[l], ssm_norm_w[l],
                             diff_q_norm_w[l], diff_k_norm_w[l], diff_lambda[l], diff_subln_w[l],
                             rel_bias)
        x = x + 0.5 * swiglu_ffn(rms_norm(x, ffn2_norm_w[l]), ffn2_w_gate[l], ffn2_w_up[l], ffn2_w_down[l])
    return x
```

```cpp
#include <hip/hip_runtime.h>
#include <cstdio>
#include <cstdint>

#define LAS __attribute__((address_space(3)))
#define GAS __attribute__((address_space(1)))
typedef unsigned short bf16_t;
typedef short bf16x8 __attribute__((ext_vector_type(8)));
typedef short bf16x4 __attribute__((ext_vector_type(4)));
typedef float f32x4 __attribute__((ext_vector_type(4)));
typedef float f32x2 __attribute__((ext_vector_type(2)));
typedef unsigned u32x4 __attribute__((ext_vector_type(4)));
typedef unsigned u32x2 __attribute__((ext_vector_type(2)));
typedef __bf16 bf16x2_t __attribute__((ext_vector_type(2)));

constexpr int M_TOK = 16384, SEQ = 4096, NBATCH = 4, DM = 1024, FF = 2816, NGU = 2 * FF, NIN = 3584, DEPTH = 2;
constexpr int PLD = 3328;
constexpr int PQ = 0, PK = 256, PV = 512, PO = 768, PZ = 1024, PX = 1536, PDQ = 2560, PDK = 2816, PDV = 3072;
constexpr float NORM_EPS = 1e-6f;
constexpr float LOG2E = 1.4426950408889634f;

__device__ __forceinline__ unsigned cvtpk(float lo, float hi) { f32x2 v = {lo, hi}; bf16x2_t b = __builtin_convertvector(v, bf16x2_t); return __builtin_bit_cast(unsigned, b); }
__device__ __forceinline__ bf16_t f2bf(float f) { return (bf16_t)(cvtpk(f, 0.f) & 0xffffu); }
__device__ __forceinline__ float bf2f(bf16_t h) { return __uint_as_float(((unsigned)h) << 16); }
__device__ __forceinline__ float bflo(unsigned w) { return __uint_as_float(w << 16); }
__device__ __forceinline__ float bfhi(unsigned w) { return __uint_as_float(w & 0xffff0000u); }
__device__ __forceinline__ float fast_exp(float x) { return __builtin_amdgcn_exp2f(x * LOG2E); }
__device__ __forceinline__ float fast_rcp(float x) { return __builtin_amdgcn_rcpf(x); }
__device__ __forceinline__ float sigmoidf_(float x) { return fast_rcp(1.f + fast_exp(-x)); }
__device__ __forceinline__ float siluf_(float x) { return x * sigmoidf_(x); }

namespace pg8 {
constexpr int BM = 256, BK = 64, HALF = 128, HTB = HALF * BK * 2, STAGE_BYTES = 8 * HTB, NXCD = 8, WGM = 8;
__host__ __device__ __forceinline__ int lds_byte(int r, int c) { const int st = (r >> 4) * 2 + (c >> 5), rr = r & 15, cc = c & 31, ob = rr * 64 + cc * 2; return st * 1024 + (ob ^ (((ob >> 9) & 1) << 5)); }
__host__ __device__ __forceinline__ void stage_rc(int b, int& R, int& C) { const int st = b / 1024, sb = b % 1024, swz = sb ^ (((sb >> 9) & 1) << 5); R = (st >> 1) * 16 + swz / 64; C = (st & 1) * 32 + (swz % 64) / 2; }
__host__ __device__ __forceinline__ int perm32(int rho) { const int n = rho >> 4, i = rho & 15; return 8 * (i >> 2) + 4 * n + (i & 3); }

struct Unit { int pm, pn; };
struct Gemm { const bf16_t* A; const bf16_t* Bt; int M, N, K, lda; };

struct StaticOrder {
    int nM, nN, nwg, G, c;
    __device__ void init(int M, int N, int G_, int c_) { nM = M / BM; nN = N / BM; nwg = nM * nN; G = G_; c = c_; }
    __device__ bool next(int i, Unit& u) const {
        const long L = (long)i * G + c; if (L >= nwg) return false;
        int wgid = (int)L; { const int q = nwg / NXCD, r = nwg % NXCD, xcd = wgid % NXCD, off = wgid / NXCD; wgid = (xcd < r ? xcd * (q + 1) : r * (q + 1) + (xcd - r) * q) + off; }
        const int nig = WGM * nN, gid = wgid / nig, fm = gid * WGM, gsz = (nM - fm) < WGM ? (nM - fm) : WGM;
        u.pm = fm + ((wgid % nig) % gsz); u.pn = (wgid % nig) / gsz; return true;
    }
};

template <class Epi, bool ALIGN_EPI, bool SP2>
__device__ __forceinline__ void gemm_phase(LAS unsigned char* lds, const Gemm g, const StaticOrder& S, const Epi& E, const int tid) {
    const int wid = __builtin_amdgcn_readfirstlane(tid >> 6), lane = tid & 63, wr = wid >> 2, wc = wid & 3, fr = lane & 15, fq = lane >> 4;
    const int K = g.K, nt = K / BK, lda = g.lda;
    unsigned voffA[2], voffB[2];
#pragma unroll
    for (int i = 0; i < 2; ++i) { int R, C; stage_rc(tid * 16 + i * 8192, R, C); const int Rb = (R & ~31) + perm32(R & 31);
        voffA[i] = (unsigned)(R * lda + C) * 2u; voffB[i] = (unsigned)(Rb * K + C) * 2u; }
    const size_t kstep = (size_t)(BK * 2);
    const size_t hstepA = (size_t)HALF * lda * 2, hstepB = (size_t)HALF * K * 2;
    const size_t tstepA = 2 * hstepA, tstepB = 2 * hstepB;
    const unsigned ldsw = (unsigned)wid * 1024u;
    const int aoff = lds_byte(wr * 64 + fr, fq * 8), boff = lds_byte(wc * 32 + fr, fq * 8);
#define PG8_SA(b, h) (((b) * 2 + (h)) * HTB)
#define PG8_SB(b, h) ((4 + (b) * 2 + (h)) * HTB)
#define PG8_STAGE(bufoff, gbase, voff) do { _Pragma("unroll") for (int _i = 0; _i < 2; ++_i) \
        __builtin_amdgcn_global_load_lds((const unsigned*)((const char*)(gbase) + (voff)[_i]), (LAS unsigned*)(lds + (bufoff) + ldsw + _i * 8192), 16, 0, 0); } while (0)
#define PG8_LDA(dst, b, h) do { _Pragma("unroll") for (int m = 0; m < 4; ++m) _Pragma("unroll") for (int k = 0; k < 2; ++k) dst[m][k] = *(const LAS bf16x8*)(lds + PG8_SA(b, h) + aoff + m * 2048 + k * 1024); } while (0)
#define PG8_LDB(dst, b, h) do { _Pragma("unroll") for (int n = 0; n < 2; ++n) _Pragma("unroll") for (int k = 0; k < 2; ++k) dst[n][k] = *(const LAS bf16x8*)(lds + PG8_SB(b, h) + boff + n * 2048 + k * 1024); } while (0)
#define PG8_MMA(ai, bj, At, Bt) do { __builtin_amdgcn_s_setprio(1); _Pragma("unroll") for (int m = 0; m < 4; ++m) _Pragma("unroll") for (int n = 0; n < 2; ++n) _Pragma("unroll") for (int k = 0; k < 2; ++k) \
        acc[ai][bj][m][n] = __builtin_amdgcn_mfma_f32_16x16x32_bf16(Bt[n][k], At[m][k], acc[ai][bj][m][n], 0, 0, 0); __builtin_amdgcn_s_setprio(0); } while (0)
#define PG8_WAIT_V(n) asm volatile("s_waitcnt vmcnt(" #n ")" ::: "memory")
#define PG8_WAIT_L(n) asm volatile("s_waitcnt lgkmcnt(" #n ")" ::: "memory")
#define PG8_BAR __builtin_amdgcn_s_barrier()
#define PG8_SCHED __builtin_amdgcn_sched_barrier(0)
    Unit cur, nxt; int ui = 0;
    if (!S.next(0, cur)) return;
    f32x4 acc[2][2][4][2];
#pragma unroll
    for (int a = 0; a < 2; ++a)
#pragma unroll
        for (int b = 0; b < 2; ++b)
#pragma unroll
            for (int m = 0; m < 4; ++m)
#pragma unroll
                for (int n = 0; n < 2; ++n) acc[a][b][m][n] = (f32x4){0.f, 0.f, 0.f, 0.f};
    bf16x8 At[4][2], B0[2][2], B1[2][2];
    const char* cA = (const char*)g.A + (size_t)cur.pm * tstepA; const char* cB = (const char*)g.Bt + (size_t)cur.pn * tstepB;
    if constexpr (SP2) {
        PG8_STAGE(PG8_SB(0, 0), cB, voffB); PG8_STAGE(PG8_SB(0, 1), cB + hstepB, voffB); PG8_STAGE(PG8_SA(0, 0), cA, voffA); PG8_STAGE(PG8_SA(0, 1), cA + hstepA, voffA);
        if (wr == 1) PG8_BAR;
        PG8_WAIT_V(2); PG8_BAR;
        PG8_STAGE(PG8_SB(1, 0), cB + kstep, voffB); PG8_STAGE(PG8_SA(1, 0), cA + kstep, voffA); PG8_STAGE(PG8_SB(1, 1), cB + hstepB + kstep, voffB);
        PG8_WAIT_V(6); PG8_BAR;
    } else {
        PG8_STAGE(PG8_SB(0, 0), cB, voffB); PG8_STAGE(PG8_SA(0, 0), cA, voffA); PG8_STAGE(PG8_SB(0, 1), cB + hstepB, voffB); PG8_STAGE(PG8_SA(0, 1), cA + hstepA, voffA);
        if (wr == 1) PG8_BAR;
        PG8_WAIT_V(4); PG8_BAR;
        PG8_STAGE(PG8_SB(1, 0), cB + kstep, voffB); PG8_STAGE(PG8_SA(1, 0), cA + kstep, voffA); PG8_STAGE(PG8_SB(1, 1), cB + hstepB + kstep, voffB);
        PG8_WAIT_V(6); PG8_BAR;
    }
    for (;;) {
        const bool has_next = S.next(ui + 1, nxt);
        const char* nA = has_next ? (const char*)g.A + (size_t)nxt.pm * tstepA : cA; const char* nB = has_next ? (const char*)g.Bt + (size_t)nxt.pn * tstepB : cB;
        for (int t = 0; t < nt; t += 2) {
            const bool last = (t == nt - 2);
            const char* a1 = cA + (size_t)(t + 1) * kstep;
            const char* a2 = last ? nA : cA + (size_t)(t + 2) * kstep; const char* b2 = last ? nB : cB + (size_t)(t + 2) * kstep;
            const char* a3 = a2 + kstep; const char* b3 = b2 + kstep;
            if constexpr (SP2) {
            PG8_LDB(B0, 0, 0); PG8_LDB(B1, 0, 1); PG8_SCHED; PG8_LDA(At, 0, 0); PG8_STAGE(PG8_SA(1, 1), a1 + hstepA, voffA);
            PG8_WAIT_V(8); PG8_WAIT_L(0); PG8_BAR; PG8_MMA(0, 0, At, B0); PG8_MMA(0, 1, At, B1); PG8_BAR; PG8_SCHED;
            PG8_LDA(At, 0, 1); PG8_STAGE(PG8_SB(0, 0), b2, voffB); PG8_STAGE(PG8_SB(0, 1), b2 + hstepB, voffB); PG8_STAGE(PG8_SA(0, 0), a2, voffA);
            PG8_WAIT_V(8); PG8_WAIT_L(0); PG8_BAR; PG8_MMA(1, 0, At, B0); PG8_MMA(1, 1, At, B1); PG8_BAR; PG8_SCHED;
            PG8_LDB(B0, 1, 0); PG8_LDB(B1, 1, 1); PG8_SCHED; PG8_LDA(At, 1, 0); PG8_STAGE(PG8_SA(0, 1), a2 + hstepA, voffA);
            PG8_WAIT_V(8); PG8_WAIT_L(0); PG8_BAR; PG8_MMA(0, 0, At, B0); PG8_MMA(0, 1, At, B1); PG8_BAR; PG8_SCHED;
            PG8_LDA(At, 1, 1); PG8_STAGE(PG8_SB(1, 0), b3, voffB); PG8_STAGE(PG8_SB(1, 1), b3 + hstepB, voffB); PG8_STAGE(PG8_SA(1, 0), a3, voffA);
            PG8_WAIT_V(8); PG8_WAIT_L(0); PG8_BAR; PG8_MMA(1, 0, At, B0); PG8_MMA(1, 1, At, B1); PG8_BAR; PG8_SCHED;
            } else {
            PG8_LDB(B0, 0, 0); PG8_SCHED; PG8_LDA(At, 0, 0); PG8_STAGE(PG8_SA(1, 1), a1 + hstepA, voffA);
            PG8_WAIT_L(8); PG8_BAR; PG8_WAIT_L(0); PG8_MMA(0, 0, At, B0); PG8_BAR; PG8_SCHED;
            PG8_LDB(B1, 0, 1); PG8_STAGE(PG8_SB(0, 0), b2, voffB);
            PG8_BAR; PG8_WAIT_L(0); PG8_MMA(0, 1, At, B1); PG8_BAR;
            PG8_LDA(At, 0, 1); PG8_STAGE(PG8_SA(0, 0), a2, voffA);
            PG8_BAR; PG8_WAIT_L(0); PG8_MMA(1, 0, At, B0); PG8_BAR; PG8_SCHED;
            PG8_STAGE(PG8_SB(0, 1), b2 + hstepB, voffB);
            PG8_WAIT_V(6); PG8_BAR; PG8_MMA(1, 1, At, B1); PG8_BAR;
            PG8_LDB(B0, 1, 0); PG8_SCHED; PG8_LDA(At, 1, 0); PG8_STAGE(PG8_SA(0, 1), a2 + hstepA, voffA);
            PG8_WAIT_L(8); PG8_BAR; PG8_WAIT_L(0); PG8_MMA(0, 0, At, B0); PG8_BAR; PG8_SCHED;
            PG8_LDB(B1, 1, 1); PG8_STAGE(PG8_SB(1, 0), b3, voffB);
            PG8_BAR; PG8_WAIT_L(0); PG8_MMA(0, 1, At, B1); PG8_BAR;
            PG8_LDA(At, 1, 1); PG8_STAGE(PG8_SA(1, 0), a3, voffA);
            PG8_BAR; PG8_WAIT_L(0); PG8_MMA(1, 0, At, B0); PG8_BAR; PG8_SCHED;
            PG8_STAGE(PG8_SB(1, 1), b3 + hstepB, voffB);
            PG8_WAIT_V(6); PG8_BAR; PG8_MMA(1, 1, At, B1); PG8_BAR;
            }
        }
        if constexpr (ALIGN_EPI) { if (wr == 0) PG8_BAR; }
        E(acc, cur, wr, wc, fr, fq);
        if (!has_next) break;
#pragma unroll
        for (int a = 0; a < 2; ++a)
#pragma unroll
            for (int b = 0; b < 2; ++b)
#pragma unroll
                for (int m = 0; m < 4; ++m)
#pragma unroll
                    for (int n = 0; n < 2; ++n) acc[a][b][m][n] = (f32x4){0.f, 0.f, 0.f, 0.f};
        cur = nxt; cA = nA; cB = nB; ++ui;
        if constexpr (ALIGN_EPI) { if (wr == 1) PG8_BAR; }
    }
    PG8_WAIT_V(0);
    if constexpr (!ALIGN_EPI) { if (wr == 0) PG8_BAR; }
    PG8_BAR;
#undef PG8_SA
#undef PG8_SB
#undef PG8_STAGE
#undef PG8_LDA
#undef PG8_LDB
#undef PG8_MMA
#undef PG8_WAIT_V
#undef PG8_WAIT_L
#undef PG8_BAR
#undef PG8_SCHED
}
}
constexpr size_t MiB = 1u << 20;
constexpr size_t WS_CTL = 0, CTL_ZERO_BYTES = 1 * MiB;
constexpr size_t WS_SSQ = 1 * MiB;
constexpr size_t WS_GATES = 2 * MiB;
constexpr size_t WS_NST = 3 * MiB;
constexpr size_t WS_W = 4 * MiB;
constexpr size_t W_GU1 = 0, W_D1 = 11 * MiB, W_IN = W_D1 + 11 * MiB / 2, W_OUT = W_IN + 7 * MiB, W_GU2 = W_OUT + 2 * MiB, W_D2 = W_GU2 + 11 * MiB, W_LAYER = 42 * MiB;
static_assert(W_D2 + 11 * MiB / 2 == W_LAYER, "weights map");
constexpr size_t WS_XB = 88 * MiB;
constexpr size_t WS_CST = 120 * MiB;
constexpr size_t WS_SST = 128 * MiB;
constexpr size_t WS_PROJ = 144 * MiB;
constexpr size_t WS_END = 248 * MiB;
static_assert(WS_PROJ + (size_t)M_TOK * PLD * 2 <= WS_END, "ws map");

constexpr int CW_BAR = 4096;
constexpr int CW_Q = 16384;

constexpr int RING_BYTES = 131072;
constexpr int LDSCTL_OFF = RING_BYTES, MISC_OFF = LDSCTL_OFF + 320;
constexpr int LDS_BYTES = 147456;
constexpr int NWAVES = 8, NTHREADS = 512;

typedef GAS unsigned gu32;
#define RLX_AGENT __ATOMIC_RELAXED, __HIP_MEMORY_SCOPE_AGENT
#define LDS_WAIT() asm volatile("s_waitcnt lgkmcnt(0)" ::: "memory")
#define VM_WAIT() asm volatile("s_waitcnt vmcnt(0)" ::: "memory")

#define XB_TMO      128
#define XB_XCNT(j)  (256  + 64 * (j))
#define XB_XSUB(j)  (1280 + 64 * (j))
#define XB_XGEN(j)  (2304 + 64 * (j))
#define XB_TOP      3328
#define XB_TOPGEN   3392
#define XCD_BAR_WORDS 3456
#define XB_SPIN_CAP (1u << 22)
__device__ __forceinline__ unsigned xb_ld(unsigned* p)              { return __hip_atomic_load(p, __ATOMIC_RELAXED, __HIP_MEMORY_SCOPE_AGENT); }
__device__ __forceinline__ unsigned xb_add(unsigned* p, unsigned v) { return __hip_atomic_fetch_add(p, v, __ATOMIC_RELAXED, __HIP_MEMORY_SCOPE_AGENT); }
__device__ __forceinline__ unsigned xb_xcc_id() { return (unsigned)__builtin_amdgcn_s_getreg((3 << 11) | 20) & 0xFu; }
#define XB_SPIN(cond, bar) do { unsigned _sp = 0; while (cond) { __builtin_amdgcn_s_sleep(1); \
    if ((++_sp & 255u) == 0u) { if (xb_ld(&(bar)[XB_TMO])) break; if (_sp > XB_SPIN_CAP) { atomicAdd(&(bar)[XB_TMO], 1u); break; } } } } while (0)
struct XcdBarrier { unsigned* bar; unsigned x; volatile LAS unsigned* st; };
__device__ __forceinline__ XcdBarrier xcd_barrier_post(unsigned* bar, volatile LAS unsigned* st) {
    XcdBarrier b; b.bar = bar; b.x = xb_xcc_id(); b.st = st;
    if (threadIdx.x == 0) (void)xb_add(&bar[XB_XCNT(b.x)], 1u);
    return b;
}
__device__ __forceinline__ void xcd_barrier_complete(unsigned* bar, unsigned x, unsigned& nloc, unsigned& nx) {
    const unsigned G = gridDim.x * gridDim.y * gridDim.z;
    unsigned sum, cnt, mine, sp = 0u;
    for (;;) {
        sum = 0u; cnt = 0u; mine = 0u;
#pragma unroll
        for (unsigned j = 0; j < 16; ++j) { const unsigned c = xb_ld(&bar[XB_XCNT(j)]); sum += c; cnt += (c > 0u) ? 1u : 0u; mine = (j == x) ? c : mine; }
        if (sum == G) break;
        __builtin_amdgcn_s_sleep(1);
        if ((++sp & 255u) == 0u) { if (xb_ld(&bar[XB_TMO])) break; if (sp > XB_SPIN_CAP) { atomicAdd(&bar[XB_TMO], 1u); break; } }
    }
    nloc = mine > 0u ? mine : 1u; nx = cnt > 0u ? cnt : 1u;
}
__device__ __forceinline__ void xcd_barrier(const XcdBarrier& b) {
    asm volatile("s_waitcnt vmcnt(0)" ::: "memory");
    __syncthreads();
    if (threadIdx.x == 0) {
        unsigned* bar = b.bar;
        __builtin_amdgcn_s_waitcnt(0);
        unsigned nloc = b.st[0], nx = b.st[1];
        if (nloc == 0u) { xcd_barrier_complete(bar, b.x, nloc, nx); b.st[0] = nloc; b.st[1] = nx; }
        const unsigned old = xb_add(&bar[XB_XSUB(b.x)], 1u);
        const unsigned gen = old / nloc;
        if (old + 1u == (gen + 1u) * nloc) {
            __builtin_amdgcn_fence(__ATOMIC_RELEASE, "agent");
            asm volatile("s_waitcnt vmcnt(0)" ::: "memory");
            const unsigned og = xb_add(&bar[XB_TOP], 1u);
            const unsigned tg = og / nx;
            if (og + 1u == (tg + 1u) * nx) xb_add(&bar[XB_TOPGEN], 1u);
            else XB_SPIN(xb_ld(&bar[XB_TOPGEN]) == tg, bar);
            __builtin_amdgcn_fence(__ATOMIC_ACQUIRE, "agent");
            xb_add(&bar[XB_XGEN(b.x)], 1u);
            asm volatile("s_waitcnt vmcnt(0)" ::: "memory");
        } else {
            XB_SPIN(xb_ld(&bar[XB_XGEN(b.x)]) == gen, bar);
            __builtin_amdgcn_fence(__ATOMIC_ACQUIRE, "agent");
            asm volatile("s_waitcnt vmcnt(0)" ::: "memory");
        }
    }
    __syncthreads();
}

struct Args { const float* in[25]; float* out; unsigned char* ws; int ph_lo, ph_hi; };
typedef const float* fptr_t; typedef __attribute__((address_space(4))) const fptr_t* kinptr_t;
struct ArgView { kinptr_t in; };
struct Frame {
    LAS unsigned char* lds;
    volatile LAS unsigned* MISC;
    unsigned* ctl;
    int tid, lane, wave, vcu, G;
    kinptr_t in;
    unsigned char* ws;
};
__device__ __forceinline__ float wave_sum(float v) {
#pragma unroll
    for (int o = 1; o < 64; o <<= 1) v += __shfl_xor(v, o);
    return v;
}
__device__ __forceinline__ int q_next(Frame& F, int q) {
    __syncthreads();
    if (F.tid == 0) F.MISC[16] = xb_add(F.ctl + CW_Q + 64 * q, 1u);
    __syncthreads();
    return (int)F.MISC[16];
}

struct MapPlain { __device__ __forceinline__ int row(int n) const { return n; } __device__ __forceinline__ float scale(int) const { return 1.f; } };
struct MapGU { int off; __device__ __forceinline__ int row(int n) const { return 256 * (n >> 7) + off + (n & 127); } __device__ __forceinline__ float scale(int) const { return 1.f; } };
struct MapIn {
    __device__ __forceinline__ int row(int n) const {
        if (n < 1024) return n;
        if (n < 1032) return 13 * 256 + (n - 1024);
        if (n < 1544) return 4 * 256 + (n - 1032);
        if (n < 2568) return 6 * 256 + (n - 1544);
        if (n < 2576) return 13 * 256 + 8 + (n - 2568);
        return 10 * 256 + (n - 2576);
    }
    __device__ __forceinline__ float scale(int n) const { return (n >= 256 && n < 512) ? 0.125f : 1.f; }
};
template <class Map>
__device__ __forceinline__ void p0_transpose_item(const float* W, int K, int N, bf16_t* WT, LAS float* scr, int item, int lane, const float* gain, const Map map) {
    const int nblk = (N + 31) / 32, kb = item / nblk, nb = item % nblk, k0 = 64 * kb, n0 = 32 * nb;
    const int nn = n0 + (lane & 31);
#pragma unroll 8
    for (int i = 0; i < 32; ++i) { const int kk = 2 * i + (lane >> 5); float v = 0.f; if (nn < N) { v = W[(size_t)(k0 + kk) * N + nn]; if (gain) v *= gain[k0 + kk]; } scr[kk * 33 + (lane & 31)] = v; }
    LDS_WAIT(); asm volatile("" ::: "memory");
    const int c = lane & 7;
#pragma unroll
    for (int j = 0; j < 4; ++j) { const int nl = (lane >> 3) + 8 * j; const int n = n0 + nl;
        if (n < N) { const LAS float* s = scr + (8 * c) * 33 + nl; const float sc = map.scale(n);
            u32x4 o; o.x = cvtpk(s[0 * 33] * sc, s[1 * 33] * sc); o.y = cvtpk(s[2 * 33] * sc, s[3 * 33] * sc); o.z = cvtpk(s[4 * 33] * sc, s[5 * 33] * sc); o.w = cvtpk(s[6 * 33] * sc, s[7 * 33] * sc);
            *(u32x4*)(WT + (size_t)map.row(n) * K + k0 + 8 * c) = o; } }
    LDS_WAIT(); asm volatile("" ::: "memory");
}
__device__ __forceinline__ void p0_prologue(Frame& F) {
    LAS float* scr = (LAS float*)(F.lds + F.wave * 16384);
    const int gw = F.vcu * NWAVES + F.wave, NGW = F.G * NWAVES;
    constexpr int I_G = (DM / 64) * (FF / 32), I_D = (FF / 64) * (DM / 32), I_IN = (DM / 64) * ((3344 + 31) / 32), I_OUT = (DM / 64) * (DM / 32);
    constexpr int I_LAYER = 4 * I_G + 2 * I_D + I_IN + I_OUT;
    for (int it = gw; it < DEPTH * I_LAYER; it += NGW) {
        const int l = it / I_LAYER; int r = it % I_LAYER;
        bf16_t* WL = (bf16_t*)(F.ws + WS_W + (size_t)l * W_LAYER);
        if (r < I_G) { p0_transpose_item(F.in[2] + (size_t)l * DM * FF, DM, FF, (bf16_t*)((char*)WL + W_GU1), scr, r, F.lane, F.in[1] + l * DM, MapGU{0}); continue; } r -= I_G;
        if (r < I_G) { p0_transpose_item(F.in[3] + (size_t)l * DM * FF, DM, FF, (bf16_t*)((char*)WL + W_GU1), scr, r, F.lane, F.in[1] + l * DM, MapGU{128}); continue; } r -= I_G;
        if (r < I_D) { p0_transpose_item(F.in[4] + (size_t)l * FF * DM, FF, DM, (bf16_t*)((char*)WL + W_D1), scr, r, F.lane, nullptr, MapPlain{}); continue; } r -= I_D;
        if (r < I_IN) { p0_transpose_item(F.in[6] + (size_t)l * DM * 3344, DM, 3344, (bf16_t*)((char*)WL + W_IN), scr, r, F.lane, F.in[5] + l * DM, MapIn{}); continue; } r -= I_IN;
        if (r < I_OUT) { p0_transpose_item(F.in[20] + (size_t)l * DM * DM, DM, DM, (bf16_t*)((char*)WL + W_OUT), scr, r, F.lane, nullptr, MapPlain{}); continue; } r -= I_OUT;
        if (r < I_G) { p0_transpose_item(F.in[22] + (size_t)l * DM * FF, DM, FF, (bf16_t*)((char*)WL + W_GU2), scr, r, F.lane, F.in[21] + l * DM, MapGU{0}); continue; } r -= I_G;
        if (r < I_G) { p0_transpose_item(F.in[23] + (size_t)l * DM * FF, DM, FF, (bf16_t*)((char*)WL + W_GU2), scr, r, F.lane, F.in[21] + l * DM, MapGU{128}); continue; } r -= I_G;
        p0_transpose_item(F.in[24] + (size_t)l * FF * DM, FF, DM, (bf16_t*)((char*)WL + W_D2), scr, r, F.lane, nullptr, MapPlain{});
    }
    for (int l = 0; l < DEPTH; ++l) {
        u32x4* z = (u32x4*)(F.ws + WS_W + (size_t)l * W_LAYER + W_IN + (size_t)(13 * 256 + 16) * DM * 2);
        const int n16 = 240 * DM * 2 / 16;
        for (int i = gw * 64 + F.lane; i < n16; i += NGW * 64) z[i] = (u32x4){0u, 0u, 0u, 0u};
    }
    const float* x = F.in[0]; bf16_t* XB = (bf16_t*)(F.ws + WS_XB); float* SSQ = (float*)(F.ws + WS_SSQ);
    for (int m = gw; m < M_TOK; m += NGW) {
        const f32x4* xr = (const f32x4*)(x + (size_t)m * DM) + F.lane; float s = 0.f; f32x4 v[4];
#pragma unroll
        for (int j = 0; j < 4; ++j) { v[j] = xr[64 * j]; s += (v[j].x * v[j].x + v[j].y * v[j].y) + (v[j].z * v[j].z + v[j].w * v[j].w); }
        s = wave_sum(s);
        u32x2* o8 = (u32x2*)(XB + (size_t)m * DM) + F.lane;
#pragma unroll
        for (int j = 0; j < 4; ++j) o8[64 * j] = (u32x2){cvtpk(v[j].x, v[j].y), cvtpk(v[j].z, v[j].w)};
        if (F.lane < 16) SSQ[(size_t)m * 16 + F.lane] = (F.lane == 0) ? s : 0.f;
    }
}

__device__ __forceinline__ void rows_rs(const float* ssq, int rowbase, int fr, int fq, float (&rs)[8]) {
    f32x4 p[8];
#pragma unroll
    for (int i = 0; i < 8; ++i) { const int row = rowbase + (i >> 2) * 128 + (i & 3) * 16 + fr; p[i] = *(const f32x4*)(ssq + (size_t)row * 16 + 4 * fq); }
#pragma unroll
    for (int i = 0; i < 8; ++i) { float s = (p[i].x + p[i].y) + (p[i].z + p[i].w); s += __shfl_xor(s, 16); s += __shfl_xor(s, 32); rs[i] = rsqrtf(s * (1.0f / DM) + NORM_EPS); }
}
struct EpiSwiglu {
    bf16_t* H; const float* ssq;
    __device__ __forceinline__ void operator()(const f32x4 (&acc)[2][2][4][2], const pg8::Unit& u, int wr, int wc, int fr, int fq) const {
        asm volatile("" : "+v"(fr), "+v"(fq));
        const int col0 = u.pn * 128 + wc * 32 + 8 * fq;
        float rs[8]; rows_rs(ssq, u.pm * 256 + wr * 64, fr, fq, rs);
#pragma unroll
        for (int ai = 0; ai < 2; ++ai)
#pragma unroll
            for (int m = 0; m < 4; ++m) {
                const int row = u.pm * 256 + ai * 128 + wr * 64 + m * 16 + fr; const float r = rs[ai * 4 + m];
                float hv[8];
#pragma unroll
                for (int n = 0; n < 2; ++n)
#pragma unroll
                    for (int j = 0; j < 4; ++j) { const float g = acc[ai][0][m][n][j] * r, up = acc[ai][1][m][n][j] * r; hv[4 * n + j] = siluf_(g) * up; }
                u32x4 w; w.x = cvtpk(hv[0], hv[1]); w.y = cvtpk(hv[2], hv[3]); w.z = cvtpk(hv[4], hv[5]); w.w = cvtpk(hv[6], hv[7]);
                *(u32x4*)(H + (size_t)row * FF + col0) = w;
                if (m & 1) asm volatile("" ::: "memory");
            }
    }
};
struct EpiResid {
    const float* xin; float* xout; bf16_t* XB; float* ssq; float alpha;
    __device__ __forceinline__ void operator()(const f32x4 (&acc)[2][2][4][2], const pg8::Unit& u, int wr, int wc, int fr, int fq) const {
        asm volatile("" : "+v"(fr), "+v"(fq));
        const int col0 = u.pn * 256 + wc * 32 + 8 * fq;
#pragma unroll
        for (int ai = 0; ai < 2; ++ai)
#pragma unroll
            for (int m = 0; m < 4; ++m) {
                const int row = u.pm * 256 + ai * 128 + wr * 64 + m * 16 + fr; float ss = 0.f;
#pragma unroll
                for (int bj = 0; bj < 2; ++bj) {
                    const size_t off = (size_t)row * DM + col0 + bj * 128;
                    const f32x4 x0 = *(const f32x4*)(xin + off), x1 = *(const f32x4*)(xin + off + 4);
                    const f32x4 y0 = x0 + acc[ai][bj][m][0] * alpha, y1 = x1 + acc[ai][bj][m][1] * alpha;
                    *(f32x4*)(xout + off) = y0; *(f32x4*)(xout + off + 4) = y1;
                    ss += (y0.x * y0.x + y0.y * y0.y) + (y0.z * y0.z + y0.w * y0.w) + (y1.x * y1.x + y1.y * y1.y) + (y1.z * y1.z + y1.w * y1.w);
                    u32x4 w; w.x = cvtpk(y0.x, y0.y); w.y = cvtpk(y0.z, y0.w); w.z = cvtpk(y1.x, y1.y); w.w = cvtpk(y1.z, y1.w);
                    *(u32x4*)(XB + off) = w;
                }
                ss += __shfl_xor(ss, 16); ss += __shfl_xor(ss, 32);
                if (fq == 0) ssq[(size_t)row * 16 + u.pn * 4 + wc] = ss;
            }
    }
};
struct EpiInProj {
    bf16_t* PROJ; float* GATES; const float* ssq; const float* qnw; const float* knw; const float* gbias; const float* dtb;
    template <int KIND>
    __device__ __forceinline__ void body(const f32x4 (&acc)[2][2][4][2], const pg8::Unit& u, int wr, int wc, int fr, int fq, const float (&rs)[8]) const {
        const int t = u.pn, colw = wc * 32 + 8 * fq;
        float nw[8];
        if (KIND == 3) { const float* w = (t == 10 ? qnw : knw) + (wc & 1) * 32 + 8 * fq; const float sc = (t == 10) ? (0.17677669529663687f * LOG2E) : 1.f;
#pragma unroll
            for (int i = 0; i < 8; ++i) nw[i] = w[i] * sc; }
#pragma unroll
        for (int ai = 0; ai < 2; ++ai)
#pragma unroll
            for (int m = 0; m < 4; ++m) {
                const int row = u.pm * 256 + ai * 128 + wr * 64 + m * 16 + fr; const float r = rs[ai * 4 + m];
#pragma unroll
                for (int bj = 0; bj < 2; ++bj) {
                    float v[8];
#pragma unroll
                    for (int n = 0; n < 2; ++n)
#pragma unroll
                        for (int j = 0; j < 4; ++j) v[4 * n + j] = acc[ai][bj][m][n][j] * r;
                    if (KIND == 1) {
#pragma unroll
                        for (int i = 0; i < 8; ++i) v[i] = sigmoidf_(v[i]);
                    } else if (KIND == 2) {
#pragma unroll
                        for (int i = 0; i < 8; ++i) v[i] = siluf_(v[i]);
                    } else if (KIND == 3) {
                        float ss = 0.f;
#pragma unroll
                        for (int i = 0; i < 8; ++i) ss += v[i] * v[i];
                        ss += __shfl_xor(ss, 16); ss += __shfl_xor(ss, 32);
                        const float q = rsqrtf(ss * (1.0f / 32.0f) + NORM_EPS);
#pragma unroll
                        for (int i = 0; i < 8; ++i) v[i] = v[i] * q * nw[i];
                    }
                    u32x4 w; w.x = cvtpk(v[0], v[1]); w.y = cvtpk(v[2], v[3]); w.z = cvtpk(v[4], v[5]); w.w = cvtpk(v[6], v[7]);
                    *(u32x4*)(PROJ + (size_t)row * PLD + t * 256 + bj * 128 + colw) = w;
                }
                if (m & 1) asm volatile("" ::: "memory");
            }
    }
    __device__ __forceinline__ void gates(const f32x4 (&acc)[2][2][4][2], const pg8::Unit& u, int wr, int wc, int fr, int fq, const float (&rs)[8]) const {
        if (wc != 0 || fq >= 2) return;
#pragma unroll
        for (int ai = 0; ai < 2; ++ai)
#pragma unroll
            for (int m = 0; m < 4; ++m) {
                const int row = u.pm * 256 + ai * 128 + wr * 64 + m * 16 + fr; const float r = rs[ai * 4 + m];
                float v[8], o[8];
#pragma unroll
                for (int n = 0; n < 2; ++n)
#pragma unroll
                    for (int j = 0; j < 4; ++j) v[4 * n + j] = acc[ai][0][m][n][j] * r;
                if (fq == 0) {
#pragma unroll
                    for (int j = 0; j < 4; ++j) { o[j] = v[j] + gbias[j]; const float z = v[4 + j] + gbias[4 + j]; o[4 + j] = fminf(z, 0.f) - log1pf(expf(-fabsf(z))); }
                } else {
#pragma unroll
                    for (int j = 0; j < 8; ++j) { const float z = v[j] + dtb[j]; o[j] = fmaxf(z, 0.f) + log1pf(expf(-fabsf(z))); }
                }
                float* gp = GATES + (size_t)row * 16 + 8 * fq;
                *(f32x4*)gp = (f32x4){o[0], o[1], o[2], o[3]}; *(f32x4*)(gp + 4) = (f32x4){o[4], o[5], o[6], o[7]};
                asm volatile("" ::: "memory");
            }
    }
    __device__ __forceinline__ void operator()(const f32x4 (&acc)[2][2][4][2], const pg8::Unit& u, int wr, int wc, int fr, int fq) const {
        asm volatile("" : "+v"(fr), "+v"(fq));
        float rs[8]; rows_rs(ssq, u.pm * 256 + wr * 64, fr, fq, rs);
        const int t = u.pn;
        if (t == 13) gates(acc, u, wr, wc, fr, fq, rs);
        else if (t == 3) body<1>(acc, u, wr, wc, fr, fq, rs);
        else if (t == 4 || t == 5) body<2>(acc, u, wr, wc, fr, fq, rs);
        else if (t == 10 || t == 11) body<3>(acc, u, wr, wc, fr, fq, rs);
        else body<0>(acc, u, wr, wc, fr, fq, rs);
    }
};
#define MFMA16(a, b, c) __builtin_amdgcn_mfma_f32_16x16x32_bf16((a), (b), (c), 0, 0, 0)
#define WAVE_SYNC() do { asm volatile("s_waitcnt lgkmcnt(0)" ::: "memory"); __builtin_amdgcn_wave_barrier(); } while (0)
__device__ __forceinline__ bf16x8 ld_g8(const bf16_t* p) { return *(const bf16x8*)p; }
__device__ __forceinline__ bf16x8 ld_l8(const LAS bf16_t* p) { return *(const LAS bf16x8*)p; }
__device__ __forceinline__ bf16x8 ld_l44(const LAS bf16_t* p0, const LAS bf16_t* p1) { const bf16x4 a = *(const LAS bf16x4*)p0, b = *(const LAS bf16x4*)p1; return (bf16x8){a[0], a[1], a[2], a[3], b[0], b[1], b[2], b[3]}; }
__device__ __forceinline__ bf16x8 pack8(const f32x4 a, const f32x4 b) { u32x4 w; w.x = cvtpk(a[0], a[1]); w.y = cvtpk(a[2], a[3]); w.z = cvtpk(b[0], b[1]); w.w = cvtpk(b[2], b[3]); return __builtin_bit_cast(bf16x8, w); }
__device__ __forceinline__ float wave_scan_incl(float v, int lane) {
#pragma unroll
    for (int o = 1; o < 64; o <<= 1) { const float t = __shfl_up(v, o); if (lane >= o) v += t; }
    return v;
}

__device__ __forceinline__ void conv_phase(Frame& F, int l) {
    const bf16_t* PROJ = (const bf16_t*)(F.ws + WS_PROJ); bf16_t* XACT = (bf16_t*)(F.ws + WS_XB);
    const float* cw = F.in[9] + (size_t)l * 4 * 1024; const float* cb = F.in[10] + (size_t)l * 1024;
    for (int g = F.vcu * NTHREADS + F.tid; g < 1024 * 128; g += F.G * NTHREADS) {
        const int cg = g & 127, rb = g >> 7, ch0 = cg * 8, row0 = rb * 16;
        float w[4][8], bs[8];
#pragma unroll
        for (int j = 0; j < 4; ++j) { const f32x4 a = *(const f32x4*)(cw + j * 1024 + ch0), b = *(const f32x4*)(cw + j * 1024 + ch0 + 4);
            w[j][0] = a.x; w[j][1] = a.y; w[j][2] = a.z; w[j][3] = a.w; w[j][4] = b.x; w[j][5] = b.y; w[j][6] = b.z; w[j][7] = b.w; }
        { const f32x4 a = *(const f32x4*)(cb + ch0), b = *(const f32x4*)(cb + ch0 + 4); bs[0] = a.x; bs[1] = a.y; bs[2] = a.z; bs[3] = a.w; bs[4] = b.x; bs[5] = b.y; bs[6] = b.z; bs[7] = b.w; }
        float h3[8], h2[8], h1[8];
        const bool first = (row0 % SEQ) == 0;
        const bf16_t* src = PROJ + (size_t)row0 * PLD + PX + ch0;
        if (first) {
#pragma unroll
            for (int e = 0; e < 8; ++e) { h3[e] = 0.f; h2[e] = 0.f; h1[e] = 0.f; }
        } else {
            const u32x4 a = *(const u32x4*)(src - 3 * (size_t)PLD), b = *(const u32x4*)(src - 2 * (size_t)PLD), c = *(const u32x4*)(src - (size_t)PLD);
#pragma unroll
            for (int e = 0; e < 4; ++e) { h3[2 * e] = bflo(a[e]); h3[2 * e + 1] = bfhi(a[e]); h2[2 * e] = bflo(b[e]); h2[2 * e + 1] = bfhi(b[e]); h1[2 * e] = bflo(c[e]); h1[2 * e + 1] = bfhi(c[e]); }
        }
#pragma unroll 4
        for (int i = 0; i < 16; ++i) {
            const u32x4 d = *(const u32x4*)(src + (size_t)i * PLD); float cur[8], o[8];
#pragma unroll
            for (int e = 0; e < 4; ++e) { cur[2 * e] = bflo(d[e]); cur[2 * e + 1] = bfhi(d[e]); }
#pragma unroll
            for (int e = 0; e < 8; ++e) { const float s = bs[e] + w[0][e] * h3[e] + w[1][e] * h2[e] + w[2][e] * h1[e] + w[3][e] * cur[e]; o[e] = siluf_(s); h3[e] = h2[e]; h2[e] = h1[e]; h1[e] = cur[e]; }
            u32x4 ow; ow.x = cvtpk(o[0], o[1]); ow.y = cvtpk(o[2], o[3]); ow.z = cvtpk(o[4], o[5]); ow.w = cvtpk(o[6], o[7]);
            *(u32x4*)(XACT + (size_t)(row0 + i) * 1024 + ch0) = ow;
        }
    }
}

__device__ __forceinline__ void mlstm_state_item(Frame& F, int bh) {
    const int b = bh >> 2, h = bh & 3, w = F.wave, vq = w & 3, dh = w >> 2, lane = F.lane, fr = lane & 15, fq = lane >> 4;
    LAS bf16_t* KT = (LAS bf16_t*)(F.lds + w * 8192); LAS bf16_t* VT = KT + 32 * 72; LAS bf16_t* WV = VT + 16 * 72;
    const bf16_t* PROJ = (const bf16_t*)(F.ws + WS_PROJ); const float* GATES = (const float*)(F.ws + WS_GATES);
    bf16_t* CST = (bf16_t*)(F.ws + WS_CST); float* NST = (float*)(F.ws + WS_NST);
    f32x4 acc[2], nacc[2];
    acc[0] = acc[1] = nacc[0] = nacc[1] = (f32x4){0.f, 0.f, 0.f, 0.f};
    for (int c = 0; c < 64; ++c) {
        const size_t row = (size_t)b * SEQ + 64 * c + lane;
        const bf16_t* kp = PROJ + row * PLD + PK + h * 64 + dh * 32; const bf16_t* vp = PROJ + row * PLD + PV + h * 64 + vq * 16;
        u32x4 kr[4], vr[2];
#pragma unroll
        for (int i = 0; i < 4; ++i) kr[i] = *(const u32x4*)(kp + 8 * i);
#pragma unroll
        for (int i = 0; i < 2; ++i) vr[i] = *(const u32x4*)(vp + 8 * i);
        const float ig = GATES[row * 16 + h], lf = GATES[row * 16 + 4 + h];
        const float bs = wave_scan_incl(lf, lane); const float bl = __shfl(bs, 63);
        const float wgt = fast_exp(bl - bs + ig), decay = fast_exp(bl);
#pragma unroll
        for (int i = 0; i < 4; ++i)
#pragma unroll
            for (int e = 0; e < 4; ++e) { KT[(8 * i + 2 * e) * 72 + lane] = (bf16_t)(kr[i][e] & 0xffffu); KT[(8 * i + 2 * e + 1) * 72 + lane] = (bf16_t)(kr[i][e] >> 16); }
#pragma unroll
        for (int i = 0; i < 2; ++i)
#pragma unroll
            for (int e = 0; e < 4; ++e) { VT[(8 * i + 2 * e) * 72 + lane] = f2bf(wgt * bflo(vr[i][e])); VT[(8 * i + 2 * e + 1) * 72 + lane] = f2bf(wgt * bfhi(vr[i][e])); }
        WV[lane] = f2bf(wgt);
        WAVE_SYNC();
        const size_t ci = (size_t)bh * 64 + c;
#pragma unroll
        for (int dt = 0; dt < 2; ++dt)
#pragma unroll
            for (int r = 0; r < 4; ++r) CST[ci * 4096 + (vq * 16 + 4 * fq + r) * 64 + dh * 32 + dt * 16 + fr] = f2bf(acc[dt][r]);
        if (vq == 0 && fq == 0) { NST[ci * 64 + dh * 32 + fr] = nacc[0][0]; NST[ci * 64 + dh * 32 + 16 + fr] = nacc[1][0]; }
#pragma unroll
        for (int dt = 0; dt < 2; ++dt) { acc[dt] = acc[dt] * decay; nacc[dt] = nacc[dt] * decay; }
#pragma unroll
        for (int ks = 0; ks < 2; ++ks) {
            const bf16x8 A = ld_l8(VT + fr * 72 + 32 * ks + 8 * fq);
            bf16x8 An = ld_l8(WV + 32 * ks + 8 * fq); if (fr != 0) An = (bf16x8){0, 0, 0, 0, 0, 0, 0, 0};
#pragma unroll
            for (int dt = 0; dt < 2; ++dt) { const bf16x8 B = ld_l8(KT + (dt * 16 + fr) * 72 + 32 * ks + 8 * fq);
                acc[dt] = MFMA16(A, B, acc[dt]); if (vq == 0) nacc[dt] = MFMA16(An, B, nacc[dt]); }
        }
        WAVE_SYNC();
    }
}

template <int TH>
__device__ __forceinline__ void mlstm_out_wave(Frame& F, int l, int bc, int h) {
    const int b = bc >> 6, c = bc & 63, w = F.wave, lane = F.lane, fr = lane & 15, fq = lane >> 4;
    LAS bf16_t* VT = (LAS bf16_t*)(F.lds + w * 12288); LAS float* BT_ = (LAS float*)(F.lds + w * 12288 + 9216); LAS float* GS = BT_ + 64;
    const bf16_t* PROJ = (const bf16_t*)(F.ws + WS_PROJ); const float* GATES = (const float*)(F.ws + WS_GATES);
    const bf16_t* CST = (const bf16_t*)(F.ws + WS_CST); const float* NST = (const float*)(F.ws + WS_NST);
    bf16_t* Y = (bf16_t*)(F.ws + WS_PROJ) + PX;
    const size_t row0 = (size_t)b * SEQ + 64 * c; const size_t ci = (size_t)(b * 4 + h) * 64 + c;
    constexpr int NST_ = 2 * TH + 2, NKK = TH + 1;
    {
        const size_t row = row0 + lane;
        const float ig = GATES[row * 16 + h], lf = GATES[row * 16 + 4 + h];
        const float bs = wave_scan_incl(lf, lane);
        BT_[lane] = bs; GS[lane] = ig - bs;
        const bf16_t* vp = PROJ + row * PLD + PV + h * 64;
#pragma unroll
        for (int i = 0; i < 8; ++i) { const u32x4 v = *(const u32x4*)(vp + 8 * i);
#pragma unroll
            for (int e = 0; e < 4; ++e) { VT[(8 * i + 2 * e) * 72 + lane] = (bf16_t)(v[e] & 0xffffu); VT[(8 * i + 2 * e + 1) * 72 + lane] = (bf16_t)(v[e] >> 16); } }
    }
    bf16x8 Qf[2][2];
#pragma unroll
    for (int tt = 0; tt < 2; ++tt)
#pragma unroll
        for (int ks = 0; ks < 2; ++ks) Qf[tt][ks] = ld_g8(PROJ + (row0 + 32 * TH + 16 * tt + fr) * PLD + PQ + h * 64 + 32 * ks + 8 * fq);
    WAVE_SYNC();
    f32x4 P[2][NST_]; float den[2];
#pragma unroll
    for (int tt = 0; tt < 2; ++tt) {
        const int t = 32 * TH + 16 * tt + fr; const float bt = BT_[t]; float d1 = 0.f;
#pragma unroll
        for (int st = 0; st < NST_; ++st) {
            f32x4 s = (f32x4){0.f, 0.f, 0.f, 0.f};
#pragma unroll
            for (int ks = 0; ks < 2; ++ks) { const bf16x8 Kf = ld_g8(PROJ + (row0 + 16 * st + fr) * PLD + PK + h * 64 + 32 * ks + 8 * fq); s = MFMA16(Kf, Qf[tt][ks], s); }
#pragma unroll
            for (int r = 0; r < 4; ++r) { const int sidx = 16 * st + 4 * fq + r; const float wv = (sidx <= t) ? s[r] * fast_exp(bt + GS[sidx]) : 0.f; s[r] = wv; d1 += wv; }
            P[tt][st] = s;
        }
        d1 += __shfl_xor(d1, 16); d1 += __shfl_xor(d1, 32);
        float d2 = 0.f;
#pragma unroll
        for (int ks = 0; ks < 2; ++ks) { const f32x4 n0 = *(const f32x4*)(NST + ci * 64 + 32 * ks + 8 * fq), n1 = *(const f32x4*)(NST + ci * 64 + 32 * ks + 8 * fq + 4);
            const u32x4 qw = __builtin_bit_cast(u32x4, Qf[tt][ks]);
            d2 += bflo(qw.x) * n0.x + bfhi(qw.x) * n0.y + bflo(qw.y) * n0.z + bfhi(qw.y) * n0.w + bflo(qw.z) * n1.x + bfhi(qw.z) * n1.y + bflo(qw.w) * n1.z + bfhi(qw.w) * n1.w; }
        d2 += __shfl_xor(d2, 16); d2 += __shfl_xor(d2, 32);
        den[tt] = d1 + fast_exp(bt) * d2;
    }
    const float* nw = F.in[8] + (size_t)l * 256 + h * 64;
#pragma unroll
    for (int tt = 0; tt < 2; ++tt) {
        f32x4 acc[4];
#pragma unroll
        for (int vt = 0; vt < 4; ++vt) { acc[vt] = (f32x4){0.f, 0.f, 0.f, 0.f};
#pragma unroll
            for (int ks = 0; ks < 2; ++ks) { const bf16x8 Cf = ld_g8(CST + ci * 4096 + (16 * vt + fr) * 64 + 32 * ks + 8 * fq); acc[vt] = MFMA16(Qf[tt][ks], Cf, acc[vt]); } }
        float eb[4], dr[4];
#pragma unroll
        for (int r = 0; r < 4; ++r) { eb[r] = fast_exp(BT_[32 * TH + 16 * tt + 4 * fq + r]); dr[r] = __shfl(den[tt], 4 * fq + r); }
#pragma unroll
        for (int vt = 0; vt < 4; ++vt)
#pragma unroll
            for (int r = 0; r < 4; ++r) acc[vt][r] *= eb[r];
#pragma unroll
        for (int kk = 0; kk < NKK; ++kk) { const bf16x8 PA = pack8(P[tt][2 * kk], P[tt][2 * kk + 1]);
#pragma unroll
            for (int vt = 0; vt < 4; ++vt) { const bf16x8 Bv = ld_l44(VT + (16 * vt + fr) * 72 + 32 * kk + 4 * fq, VT + (16 * vt + fr) * 72 + 32 * kk + 16 + 4 * fq); acc[vt] = MFMA16(PA, Bv, acc[vt]); } }
        float ss[4];
#pragma unroll
        for (int r = 0; r < 4; ++r) { const float inv = fast_rcp(fmaxf(fabsf(dr[r]), 1.0f)); float s = 0.f;
#pragma unroll
            for (int vt = 0; vt < 4; ++vt) { acc[vt][r] *= inv; s += acc[vt][r] * acc[vt][r]; }
            s += __shfl_xor(s, 1); s += __shfl_xor(s, 2); s += __shfl_xor(s, 4); s += __shfl_xor(s, 8); ss[r] = rsqrtf(s * (1.0f / 64.0f) + NORM_EPS); }
#pragma unroll
        for (int r = 0; r < 4; ++r) { const size_t row = row0 + 32 * TH + 16 * tt + 4 * fq + r;
#pragma unroll
            for (int vt = 0; vt < 4; ++vt) { const int col = h * 64 + 16 * vt + fr; const float og = bf2f(PROJ[row * PLD + PO + col]);
                Y[row * PLD + col] = f2bf(acc[vt][r] * ss[r] * nw[16 * vt + fr] * og); } }
    }
    WAVE_SYNC();
}
__device__ __forceinline__ void mlstm_out_item(Frame& F, int l, int bc) {
    const int h = F.wave >> 1;
    if (F.wave & 1) mlstm_out_wave<1>(F, l, bc, h); else mlstm_out_wave<0>(F, l, bc, h);
}
constexpr int ATT_KSTR = 72, ATT_BUF = 2 * 64 * ATT_KSTR * 2;
constexpr int ATT_TAB_OFF = 2 * ATT_BUF;
__device__ __forceinline__ int t5_bucket(int n) {
    if (n < 16) return n;
    int bk = 16;
    bk += (n >= 19); bk += (n >= 21); bk += (n >= 24); bk += (n >= 27); bk += (n >= 31); bk += (n >= 35); bk += (n >= 40); bk += (n >= 46);
    bk += (n >= 52); bk += (n >= 59); bk += (n >= 67); bk += (n >= 77); bk += (n >= 87); bk += (n >= 99); bk += (n >= 113);
    return bk;
}
__device__ __forceinline__ void attn_item(Frame& F, int l, int bh, int qi) {
    const int b = bh >> 2, h = bh & 3, w = F.wave, lane = F.lane, fr = lane & 15, fq = lane >> 4, tid = F.tid;
    const bf16_t* PROJ = (const bf16_t*)(F.ws + WS_PROJ); bf16_t* Y = (bf16_t*)(F.ws + WS_PROJ) + PX;
    LAS float* TAB = (LAS float*)(F.lds + ATT_TAB_OFF);
    const size_t row0 = (size_t)b * SEQ; const int q0 = qi * 128;
    const float* lm = F.in[17] + (size_t)l * 128;
    float d1 = (lane < 32) ? lm[lane] * lm[32 + lane] : 0.f, d2 = (lane < 32) ? lm[64 + lane] * lm[96 + lane] : 0.f;
    d1 = wave_sum(d1); d2 = wave_sum(d2);
    const float lam_init = 0.8f - 0.6f * expf(-0.3f * (float)l);
    const float lam = expf(d1) - expf(d2) + lam_init;
    if (tid < 256) TAB[tid] = F.in[19][t5_bucket(tid) * 4 + h] * LOG2E;
    const int ntiles = 2 * qi + 2;
    const int lk = tid >> 3, lc = tid & 7;
    const bf16_t* kg = PROJ + (row0 + lk) * PLD + PDK + h * 64 + 8 * lc; const bf16_t* vg = PROJ + (row0 + lk) * PLD + PDV + h * 64 + 8 * lc;
    u32x4 kreg = *(const u32x4*)kg, vreg = *(const u32x4*)vg;
#define ATT_WRITE(buf) do { LAS bf16_t* KL_ = (LAS bf16_t*)(F.lds + (buf) * ATT_BUF); LAS bf16_t* VT_ = KL_ + 64 * ATT_KSTR; \
        *(LAS u32x4*)(KL_ + lk * ATT_KSTR + 8 * lc) = kreg; \
        _Pragma("unroll") for (int e = 0; e < 4; ++e) { VT_[(8 * lc + 2 * e) * ATT_KSTR + lk] = (bf16_t)(vreg[e] & 0xffffu); VT_[(8 * lc + 2 * e + 1) * ATT_KSTR + lk] = (bf16_t)(vreg[e] >> 16); } } while (0)
    ATT_WRITE(0);
    if (ntiles > 1) { kreg = *(const u32x4*)(kg + (size_t)64 * PLD); vreg = *(const u32x4*)(vg + (size_t)64 * PLD); }
    const int qrow = q0 + 16 * w + fr;
    const bf16_t* qp = PROJ + (row0 + qrow) * PLD + PDQ + h * 64;
    const bf16x8 q1 = ld_g8(qp + 8 * fq), q2 = ld_g8(qp + 32 + 8 * fq);
    f32x4 O1[4], O2[4];
#pragma unroll
    for (int i = 0; i < 4; ++i) { O1[i] = (f32x4){0.f, 0.f, 0.f, 0.f}; O2[i] = (f32x4){0.f, 0.f, 0.f, 0.f}; }
    float l1 = 0.f, l2 = 0.f;
    __syncthreads();
    const float cfar = TAB[255];
    for (int j = 0; j < ntiles; ++j) {
        if (j + 1 < ntiles) { ATT_WRITE((j + 1) & 1); }
        if (j + 2 < ntiles) { kreg = *(const u32x4*)(kg + (size_t)(j + 2) * 64 * PLD); vreg = *(const u32x4*)(vg + (size_t)(j + 2) * 64 * PLD); }
        const int k0 = 64 * j;
        if (k0 <= q0 + 16 * w + 15) {
            const LAS bf16_t* KL = (const LAS bf16_t*)(F.lds + (j & 1) * ATT_BUF); const LAS bf16_t* VT = KL + 64 * ATT_KSTR;
            f32x4 S1[4], S2[4];
#pragma unroll
            for (int st = 0; st < 4; ++st) { const bf16x8 a1 = ld_l8(KL + (16 * st + fr) * ATT_KSTR + 8 * fq), a2 = ld_l8(KL + (16 * st + fr) * ATT_KSTR + 32 + 8 * fq);
                S1[st] = MFMA16(a1, q1, ((f32x4){0.f, 0.f, 0.f, 0.f})); S2[st] = MFMA16(a2, q2, ((f32x4){0.f, 0.f, 0.f, 0.f})); }
            if (j >= ntiles - 4) {
#pragma unroll
                for (int st = 0; st < 4; ++st)
#pragma unroll
                    for (int r = 0; r < 4; ++r) { const int rel = qrow - (k0 + 16 * st + 4 * fq + r); const float bv = TAB[rel < 0 ? 0 : rel];
                        const float p1 = __builtin_amdgcn_exp2f(S1[st][r] + bv), p2 = __builtin_amdgcn_exp2f(S2[st][r] + bv);
                        S1[st][r] = rel < 0 ? 0.f : p1; S2[st][r] = rel < 0 ? 0.f : p2; }
            } else {
#pragma unroll
                for (int st = 0; st < 4; ++st)
#pragma unroll
                    for (int r = 0; r < 4; ++r) { S1[st][r] = __builtin_amdgcn_exp2f(S1[st][r] + cfar); S2[st][r] = __builtin_amdgcn_exp2f(S2[st][r] + cfar); }
            }
#pragma unroll
            for (int st = 0; st < 4; ++st)
#pragma unroll
                for (int r = 0; r < 4; ++r) { l1 += S1[st][r]; l2 += S2[st][r]; }
#pragma unroll
            for (int ks = 0; ks < 2; ++ks) { const bf16x8 PA1 = pack8(S1[2 * ks], S1[2 * ks + 1]), PA2 = pack8(S2[2 * ks], S2[2 * ks + 1]);
#pragma unroll
                for (int vt = 0; vt < 4; ++vt) { const bf16x8 Bv = ld_l44(VT + (16 * vt + fr) * ATT_KSTR + 32 * ks + 4 * fq, VT + (16 * vt + fr) * ATT_KSTR + 32 * ks + 16 + 4 * fq);
                    O1[vt] = MFMA16(PA1, Bv, O1[vt]); O2[vt] = MFMA16(PA2, Bv, O2[vt]); } }
        }
        __syncthreads();
    }
#undef ATT_WRITE
    l1 += __shfl_xor(l1, 16); l1 += __shfl_xor(l1, 32); l2 += __shfl_xor(l2, 16); l2 += __shfl_xor(l2, 32);
    const float i1 = fast_rcp(l1), i2 = lam * fast_rcp(l2);
    const float* sw = F.in[18] + (size_t)l * 64; const float osc = 1.0f - lam_init;
#pragma unroll
    for (int r = 0; r < 4; ++r) {
        const float a1 = __shfl(i1, 4 * fq + r), a2 = __shfl(i2, 4 * fq + r); float o[4], s = 0.f;
#pragma unroll
        for (int vt = 0; vt < 4; ++vt) { o[vt] = O1[vt][r] * a1 - O2[vt][r] * a2; s += o[vt] * o[vt]; }
        s += __shfl_xor(s, 1); s += __shfl_xor(s, 2); s += __shfl_xor(s, 4); s += __shfl_xor(s, 8);
        const float rs = rsqrtf(s * (1.0f / 64.0f) + NORM_EPS) * osc;
        const size_t row = row0 + q0 + 16 * w + 4 * fq + r;
#pragma unroll
        for (int vt = 0; vt < 4; ++vt) Y[row * PLD + 768 + h * 64 + 16 * vt + fr] = f2bf(o[vt] * rs * sw[16 * vt + fr]);
    }
}

constexpr int SSD_STR = 136;
__device__ __forceinline__ void ssd_state_item(Frame& F, int l, int bhh) {
    const int b = bhh >> 3, hh = bhh & 7, g = hh >> 2, w = F.wave, lane = F.lane, fr = lane & 15, fq = lane >> 4, tid = F.tid;
    LAS bf16_t* XT = (LAS bf16_t*)F.lds; LAS bf16_t* BT = XT + 64 * SSD_STR; LAS float* XS = (LAS float*)(F.lds + 53248); LAS float* CD = XS + 4096;
    const bf16_t* XACT = (const bf16_t*)(F.ws + WS_XB); const float* GATES = (const float*)(F.ws + WS_GATES); bf16_t* SST = (bf16_t*)(F.ws + WS_SST);
    const float Ah = -expf(F.in[12][l * 8 + hh]);
    for (int c = w; c < 32; c += 8) {
        const size_t r0 = (size_t)b * SEQ + 128 * c;
        const float dt0 = GATES[(r0 + lane) * 16 + 8 + hh], dt1 = GATES[(r0 + 64 + lane) * 16 + 8 + hh];
        const float s0 = wave_scan_incl(dt0 * Ah, lane); const float t0 = __shfl(s0, 63);
        const float s1 = wave_scan_incl(dt1 * Ah, lane) + t0; const float last = __shfl(s1, 63);
        XS[128 * c + lane] = dt0 * fast_exp(last - s0); XS[128 * c + 64 + lane] = dt1 * fast_exp(last - s1);
        if (lane == 0) CD[c] = fast_exp(last);
    }
    const int pt = w & 3, nh = w >> 2;
    f32x4 acc[4];
#pragma unroll
    for (int j = 0; j < 4; ++j) acc[j] = (f32x4){0.f, 0.f, 0.f, 0.f};
    __syncthreads();
    for (int c = 0; c < 32; ++c) {
        const size_t r0 = (size_t)b * SEQ + 128 * c;
        u32x4 xr[2], br[4];
#pragma unroll
        for (int i = 0; i < 2; ++i) { const int q = tid + 512 * i; xr[i] = *(const u32x4*)(XACT + (r0 + (q >> 3)) * 1024 + hh * 64 + 8 * (q & 7)); }
#pragma unroll
        for (int i = 0; i < 4; ++i) { const int q = tid + 512 * i; br[i] = *(const u32x4*)(XACT + (r0 + (q >> 4)) * 1024 + 512 + g * 128 + 8 * (q & 15)); }
#pragma unroll
        for (int i = 0; i < 2; ++i) { const int q = tid + 512 * i, s = q >> 3, cc = q & 7; const float sc = XS[128 * c + s];
#pragma unroll
            for (int e = 0; e < 4; ++e) { XT[(8 * cc + 2 * e) * SSD_STR + s] = f2bf(sc * bflo(xr[i][e])); XT[(8 * cc + 2 * e + 1) * SSD_STR + s] = f2bf(sc * bfhi(xr[i][e])); } }
#pragma unroll
        for (int i = 0; i < 4; ++i) { const int q = tid + 512 * i, s = q >> 4, cc = q & 15;
#pragma unroll
            for (int e = 0; e < 4; ++e) { BT[(8 * cc + 2 * e) * SSD_STR + s] = (bf16_t)(br[i][e] & 0xffffu); BT[(8 * cc + 2 * e + 1) * SSD_STR + s] = (bf16_t)(br[i][e] >> 16); } }
        const size_t si = ((size_t)(b * 32 + c) * 8 + hh) * 8192;
#pragma unroll
        for (int j = 0; j < 4; ++j)
#pragma unroll
            for (int r = 0; r < 4; ++r) SST[si + (16 * pt + 4 * fq + r) * 128 + 16 * (4 * nh + j) + fr] = f2bf(acc[j][r]);
        const float cd = CD[c];
#pragma unroll
        for (int j = 0; j < 4; ++j) acc[j] = acc[j] * cd;
        __syncthreads();
#pragma unroll
        for (int ks = 0; ks < 4; ++ks) { const bf16x8 A = ld_l8(XT + (16 * pt + fr) * SSD_STR + 32 * ks + 8 * fq);
#pragma unroll
            for (int j = 0; j < 4; ++j) { const bf16x8 B = ld_l8(BT + (16 * (4 * nh + j) + fr) * SSD_STR + 32 * ks + 8 * fq); acc[j] = MFMA16(A, B, acc[j]); } }
        __syncthreads();
    }
}

__device__ __forceinline__ void ssd_out_item(Frame& F, int l, int it) {
    const int g = it & 1, c = (it >> 1) & 31, b = it >> 6, w = F.wave, lane = F.lane, fr = lane & 15, fq = lane >> 4, tid = F.tid;
    LAS bf16_t* XT = (LAS bf16_t*)F.lds;
    LAS float* ACS = (LAS float*)(F.lds + 256 * SSD_STR * 2); LAS float* DTS = ACS + 512;
    const bf16_t* XACT = (const bf16_t*)(F.ws + WS_XB); const float* GATES = (const float*)(F.ws + WS_GATES); const bf16_t* SST = (const bf16_t*)(F.ws + WS_SST);
    const bf16_t* PROJ = (const bf16_t*)(F.ws + WS_PROJ); bf16_t* Y = (bf16_t*)(F.ws + WS_PROJ) + PX;
    const size_t r0 = (size_t)b * SEQ + 128 * c;
    if (w < 4) {
        const int hh = g * 4 + w; const float Ah = -expf(F.in[12][l * 8 + hh]);
        const float dt0 = GATES[(r0 + lane) * 16 + 8 + hh], dt1 = GATES[(r0 + 64 + lane) * 16 + 8 + hh];
        const float s0 = wave_scan_incl(dt0 * Ah, lane); const float t0 = __shfl(s0, 63);
        const float s1 = wave_scan_incl(dt1 * Ah, lane) + t0;
        ACS[128 * w + lane] = s0; ACS[128 * w + 64 + lane] = s1; DTS[128 * w + lane] = dt0; DTS[128 * w + 64 + lane] = dt1;
    }
#pragma unroll
    for (int i = 0; i < 8; ++i) { const int q = tid + 512 * i, s = q >> 5, cc = q & 31; const u32x4 v = *(const u32x4*)(XACT + (r0 + s) * 1024 + g * 256 + 8 * cc);
#pragma unroll
        for (int e = 0; e < 4; ++e) { XT[(8 * cc + 2 * e) * SSD_STR + s] = (bf16_t)(v[e] & 0xffffu); XT[(8 * cc + 2 * e + 1) * SSD_STR + s] = (bf16_t)(v[e] >> 16); } }
    __syncthreads();
    const int lrow = 16 * w + fr;
    bf16x8 Cf[4];
#pragma unroll
    for (int ks = 0; ks < 4; ++ks) Cf[ks] = ld_g8(XACT + (r0 + lrow) * 1024 + 768 + g * 128 + 32 * ks + 8 * fq);
    f32x4 yacc[4][4];
#pragma unroll
    for (int hd = 0; hd < 4; ++hd) {
        const size_t si = ((size_t)(b * 32 + c) * 8 + g * 4 + hd) * 8192;
        float ea[4];
#pragma unroll
        for (int r = 0; r < 4; ++r) ea[r] = fast_exp(ACS[128 * hd + 16 * w + 4 * fq + r]);
#pragma unroll
        for (int pt = 0; pt < 4; ++pt) { f32x4 a = (f32x4){0.f, 0.f, 0.f, 0.f};
#pragma unroll
            for (int ks = 0; ks < 4; ++ks) { const bf16x8 Sf = ld_g8(SST + si + (16 * pt + fr) * 128 + 32 * ks + 8 * fq); a = MFMA16(Cf[ks], Sf, a); }
#pragma unroll
            for (int r = 0; r < 4; ++r) a[r] *= ea[r];
            yacc[hd][pt] = a; }
    }
    const int nkk = (w >> 1) + 1;
    for (int kk = 0; kk < nkk; ++kk) {
        f32x4 G0 = (f32x4){0.f, 0.f, 0.f, 0.f}, G1 = (f32x4){0.f, 0.f, 0.f, 0.f};
#pragma unroll
        for (int ks = 0; ks < 4; ++ks) {
            const bf16x8 b0 = ld_g8(XACT + (r0 + 32 * kk + fr) * 1024 + 512 + g * 128 + 32 * ks + 8 * fq), b1 = ld_g8(XACT + (r0 + 32 * kk + 16 + fr) * 1024 + 512 + g * 128 + 32 * ks + 8 * fq);
            G0 = MFMA16(b0, Cf[ks], G0); G1 = MFMA16(b1, Cf[ks], G1); }
#pragma unroll
        for (int hd = 0; hd < 4; ++hd) {
            const float al = ACS[128 * hd + lrow]; f32x4 P0, P1;
#pragma unroll
            for (int r = 0; r < 4; ++r) { const int s0 = 32 * kk + 4 * fq + r, s1 = s0 + 16;
                P0[r] = (s0 <= lrow) ? G0[r] * fast_exp(al - ACS[128 * hd + s0]) * DTS[128 * hd + s0] : 0.f;
                P1[r] = (s1 <= lrow) ? G1[r] * fast_exp(al - ACS[128 * hd + s1]) * DTS[128 * hd + s1] : 0.f; }
            const bf16x8 PA = pack8(P0, P1);
#pragma unroll
            for (int pt = 0; pt < 4; ++pt) { const LAS bf16_t* xp = XT + (64 * hd + 16 * pt + fr) * SSD_STR + 32 * kk + 4 * fq; const bf16x8 Bx = ld_l44(xp, xp + 16); yacc[hd][pt] = MFMA16(PA, Bx, yacc[hd][pt]); }
        }
    }
    const float* Dk = F.in[13] + l * 8 + g * 4; const float* nw = F.in[14] + (size_t)l * 512 + g * 256;
    float ss[4] = {0.f, 0.f, 0.f, 0.f};
#pragma unroll
    for (int hd = 0; hd < 4; ++hd) { const float dsk = Dk[hd];
#pragma unroll
        for (int pt = 0; pt < 4; ++pt)
#pragma unroll
            for (int r = 0; r < 4; ++r) { const size_t row = r0 + 16 * w + 4 * fq + r; const int ch = g * 256 + hd * 64 + 16 * pt + fr;
                const float xv = bf2f(XACT[row * 1024 + ch]), zv = bf2f(PROJ[row * PLD + PZ + ch]);
                const float yv = (yacc[hd][pt][r] + dsk * xv) * zv; yacc[hd][pt][r] = yv; ss[r] += yv * yv; } }
#pragma unroll
    for (int r = 0; r < 4; ++r) { float s = ss[r]; s += __shfl_xor(s, 1); s += __shfl_xor(s, 2); s += __shfl_xor(s, 4); s += __shfl_xor(s, 8); ss[r] = rsqrtf(s * (1.0f / 256.0f) + NORM_EPS); }
#pragma unroll
    for (int hd = 0; hd < 4; ++hd)
#pragma unroll
        for (int pt = 0; pt < 4; ++pt)
#pragma unroll
            for (int r = 0; r < 4; ++r) { const size_t row = r0 + 16 * w + 4 * fq + r; const int cl = hd * 64 + 16 * pt + fr;
                Y[row * PLD + 256 + g * 256 + cl] = f2bf(yacc[hd][pt][r] * ss[r] * nw[cl]); }
}
#ifndef PH_EN
#define PH_EN 1023
#endif
#ifndef MK_N_LAUNCHES
#define MK_N_LAUNCHES 1
#endif
constexpr int N_PHASES = 1 + 9 * DEPTH;
constexpr int NA1 = 320;

__global__ void __launch_bounds__(NTHREADS, 2) hyb_fwd(Args args) {
    extern __shared__ __attribute__((aligned(16))) unsigned char lds_raw[];
    {   const int t0 = threadIdx.x;
        for (int u = t0; u < (LDS_BYTES - LDSCTL_OFF) / 4; u += NTHREADS) ((LAS unsigned*)((LAS unsigned char*)lds_raw + LDSCTL_OFF))[u] = 0u; }
    __syncthreads();
    const int ph_lo = args.ph_lo, ph_hi = args.ph_hi;
    const bool one_launch = (ph_hi - ph_lo) > 1;
    if (one_launch) { XcdBarrier b0 = xcd_barrier_post((unsigned*)(args.ws + WS_CTL) + CW_BAR, (volatile LAS unsigned*)((LAS unsigned char*)lds_raw + MISC_OFF) + 8); (void)b0; }
    for (int ph = ph_lo; ph < ph_hi; ++ph) {
        int tid_ = threadIdx.x; asm volatile("" : "+v"(tid_));
        kinptr_t kin = (kinptr_t)__builtin_amdgcn_kernarg_segment_ptr(); asm volatile("" : "+s"(kin));
        Frame F;
        F.lds = (LAS unsigned char*)lds_raw; F.MISC = (volatile LAS unsigned*)(F.lds + MISC_OFF);
        F.tid = tid_; F.lane = tid_ & 63; F.wave = __builtin_amdgcn_readfirstlane(tid_ >> 6);
        F.G = gridDim.x; { const int bx = blockIdx.x; F.vcu = (F.G % 8 == 0) ? (bx % 8) * (F.G / 8) + bx / 8 : bx; }
        F.in = kin;
        float* const outp = (float*)kin[25]; unsigned char* ws = (unsigned char*)kin[26];
        F.ws = ws; F.ctl = (unsigned*)(ws + WS_CTL);
        bf16_t* XB = (bf16_t*)(ws + WS_XB); bf16_t* PROJ = (bf16_t*)(ws + WS_PROJ); float* SSQ = (float*)(ws + WS_SSQ); float* GATES = (float*)(ws + WS_GATES);
        if (ph == 0) { if (PH_EN & 1) p0_prologue(F); }
        else {
            const int l = (ph - 1) / 9, k = (ph - 1) % 9;
            const unsigned char* WL = ws + WS_W + (size_t)l * W_LAYER;
            if ((PH_EN & 2) && (k == 0 || k == 7)) {
                pg8::Gemm g{XB, (const bf16_t*)(WL + (k == 0 ? W_GU1 : W_GU2)), M_TOK, NGU, DM, DM}; pg8::StaticOrder S; S.init(M_TOK, NGU, F.G, (int)blockIdx.x);
                EpiSwiglu E{PROJ, SSQ};
                pg8::gemm_phase<EpiSwiglu, true, true>(F.lds, g, S, E, F.tid);
            } else if ((PH_EN & 4) && (k == 1 || k == 8 || k == 6)) {
                pg8::Gemm g; const float* xin = outp; float alpha = 0.5f;
                if (k == 6) { g = pg8::Gemm{PROJ + PX, (const bf16_t*)(WL + W_OUT), M_TOK, DM, DM, PLD}; alpha = 1.0f; }
                else { g = pg8::Gemm{PROJ, (const bf16_t*)(WL + (k == 1 ? W_D1 : W_D2)), M_TOK, DM, FF, FF}; if (l == 0 && k == 1) xin = kin[0]; }
                pg8::StaticOrder S; S.init(M_TOK, DM, F.G, (int)blockIdx.x);
                EpiResid E{xin, outp, XB, SSQ, alpha};
                pg8::gemm_phase<EpiResid, false, true>(F.lds, g, S, E, F.tid);
            } else if ((PH_EN & 8) && k == 2) {
                pg8::Gemm g{XB, (const bf16_t*)(WL + W_IN), M_TOK, NIN, DM, DM}; pg8::StaticOrder S; S.init(M_TOK, NIN, F.G, (int)blockIdx.x);
                EpiInProj E{PROJ, GATES, SSQ, kin[15] + l * 64, kin[16] + l * 64, kin[7] + l * 8, kin[11] + l * 8};
                pg8::gemm_phase<EpiInProj, true, true>(F.lds, g, S, E, F.tid);
            } else if ((PH_EN & 16) && k == 3) {
                conv_phase(F, l);
            } else if (k == 4) {
                for (;;) { const int it = q_next(F, 2 * l); if (it >= 48 + NA1) break;
                    { int t2 = threadIdx.x; asm volatile("" : "+v"(t2)); F.tid = t2; F.lane = t2 & 63; F.wave = __builtin_amdgcn_readfirstlane(t2 >> 6); }
                    if (it < 16) { if (PH_EN & 32) mlstm_state_item(F, it); }
                    else if (it < 48) { if (PH_EN & 64) ssd_state_item(F, l, it - 16); }
                    else { const int r = it - 48; if (PH_EN & 128) attn_item(F, l, r & 15, 31 - (r >> 4)); } }
            } else if (k == 5) {
                for (;;) { const int it = q_next(F, 2 * l + 1); if (it >= 512 + (512 - NA1)) break;
                    { int t2 = threadIdx.x; asm volatile("" : "+v"(t2)); F.tid = t2; F.lane = t2 & 63; F.wave = __builtin_amdgcn_readfirstlane(t2 >> 6); }
                    if (it < 256) { if (PH_EN & 256) ssd_out_item(F, l, it); }
                    else if (it < 512) { if (PH_EN & 512) mlstm_out_item(F, l, it - 256); }
                    else { const int r = NA1 + it - 512; if (PH_EN & 128) attn_item(F, l, r & 15, 31 - (r >> 4)); } }
            }
        }
        if (ph + 1 < ph_hi) { XcdBarrier bar; bar.bar = F.ctl + CW_BAR; bar.x = xb_xcc_id(); bar.st = F.MISC + 8; xcd_barrier(bar); }
    }
}

extern "C" void kernel_launch(void* const* d_in, const int* in_sizes, int n_in, void* d_out, int out_size, void* d_ws, size_t ws_size, hipStream_t stream) {
    static int grid = 0;
    if (grid == 0) {
        if (n_in != 25 || in_sizes[0] != M_TOK * DM || out_size != M_TOK * DM || ws_size < WS_END) { fprintf(stderr, "kernel_launch: unexpected shapes (n_in %d, in0 %d, out %d, ws %zu)\n", n_in, n_in > 0 ? in_sizes[0] : -1, out_size, ws_size); grid = -1; return; }
        int dev = 0, cus = 0, per_cu = 0;
        if (hipGetDevice(&dev) != hipSuccess || hipDeviceGetAttribute(&cus, hipDeviceAttributeMultiprocessorCount, dev) != hipSuccess) { grid = -1; return; }
        if (hipFuncSetAttribute((const void*)hyb_fwd, hipFuncAttributeMaxDynamicSharedMemorySize, LDS_BYTES) != hipSuccess) { fprintf(stderr, "kernel_launch: hipFuncSetAttribute failed\n"); grid = -1; return; }
        if (hipOccupancyMaxActiveBlocksPerMultiprocessor(&per_cu, (const void*)hyb_fwd, NTHREADS, LDS_BYTES) != hipSuccess || per_cu < 1)
            fprintf(stderr, "kernel_launch: note: occupancy query reports %d workgroups per CU\n", per_cu);
        (void)hipGetLastError();
        grid = cus;
    }
    if (grid < 0) return;
    if (hipMemsetAsync((char*)d_ws + WS_CTL, 0, CTL_ZERO_BYTES, stream) != hipSuccess) { fprintf(stderr, "kernel_launch: memset failed\n"); return; }
    Args a{};
    for (int i = 0; i < 25; ++i) a.in[i] = (const float*)d_in[i];
    a.out = (float*)d_out; a.ws = (unsigned char*)d_ws;
#if MK_N_LAUNCHES == 1
    a.ph_lo = 0; a.ph_hi = N_PHASES;
    hipLaunchKernelGGL(hyb_fwd, dim3(grid), dim3(NTHREADS), LDS_BYTES, stream, a);
#else
    for (int p = 0; p < N_PHASES; ++p) { a.ph_lo = p; a.ph_hi = p + 1; hipLaunchKernelGGL(hyb_fwd, dim3(grid), dim3(NTHREADS), LDS_BYTES, stream, a); }
#endif
    const hipError_t le = hipPeekAtLastError();
    if (le != hipSuccess) fprintf(stderr, "kernel_launch: launch failed: %s\n", hipGetErrorName(le));
}
```

```cpp
#include <hip/hip_runtime.h>
#include <cstdio>
#include <cstdint>

#define LAS __attribute__((address_space(3)))
#define GAS __attribute__((address_space(1)))
typedef unsigned short bf16_t;
typedef short bf16x8 __attribute__((ext_vector_type(8)));
typedef short bf16x4 __attribute__((ext_vector_type(4)));
typedef float f32x4 __attribute__((ext_vector_type(4)));
typedef float f32x2 __attribute__((ext_vector_type(2)));
typedef unsigned u32x4 __attribute__((ext_vector_type(4)));
typedef unsigned u32x2 __attribute__((ext_vector_type(2)));
typedef __bf16 bf16x2_t __attribute__((ext_vector_type(2)));

constexpr int M_TOK = 16384, SEQ = 4096, NBATCH = 4, DM = 1024, FF = 2816, NGU = 2 * FF, NIN = 3584, DEPTH = 2;
constexpr int PLD = 3328;
constexpr int PQ = 0, PK = 256, PV = 512, PO = 768, PZ = 1024, PX = 1536, PDQ = 2560, PDK = 2816, PDV = 3072;
constexpr float NORM_EPS = 1e-6f;
constexpr float LOG2E = 1.4426950408889634f;

__device__ __forceinline__ unsigned cvtpk(float lo, float hi) { f32x2 v = {lo, hi}; bf16x2_t b = __builtin_convertvector(v, bf16x2_t); return __builtin_bit_cast(unsigned, b); }
__device__ __forceinline__ bf16_t f2bf(float f) { return (bf16_t)(cvtpk(f, 0.f) & 0xffffu); }
__device__ __forceinline__ float bf2f(bf16_t h) { return __uint_as_float(((unsigned)h) << 16); }
__device__ __forceinline__ float bflo(unsigned w) { return __uint_as_float(w << 16); }
__device__ __forceinline__ float bfhi(unsigned w) { return __uint_as_float(w & 0xffff0000u); }
__device__ __forceinline__ float fast_exp(float x) { return __builtin_amdgcn_exp2f(x * LOG2E); }
__device__ __forceinline__ float fast_rcp(float x) { return __builtin_amdgcn_rcpf(x); }
__device__ __forceinline__ float fast_log1pexp(float x) { const float e = __builtin_amdgcn_exp2f(x * LOG2E); return __builtin_amdgcn_logf(1.0f + e) * 0.6931471805599453f; }
__device__ __forceinline__ float sigmoidf_(float x) { return fast_rcp(1.f + fast_exp(-x)); }
__device__ __forceinline__ float siluf_(float x) { return x * sigmoidf_(x); }

__device__ __forceinline__ void st16_wt(void* p, u32x4 v) { asm volatile("global_store_dwordx4 %0, %1, off sc1\n\ts_nop 1" :: "v"(p), "v"(v) : "memory"); }

namespace pg8 {
constexpr int BM = 256, BK = 64, HALF = 128, HTB = HALF * BK * 2, STAGE_BYTES = 8 * HTB, NXCD = 8, WGM = 8;
__host__ __device__ __forceinline__ int lds_byte(int r, int c) { const int st = (r >> 4) * 2 + (c >> 5), rr = r & 15, cc = c & 31, ob = rr * 64 + cc * 2; return st * 1024 + (ob ^ (((ob >> 9) & 1) << 5)); }
__host__ __device__ __forceinline__ void stage_rc(int b, int& R, int& C) { const int st = b / 1024, sb = b % 1024, swz = sb ^ (((sb >> 9) & 1) << 5); R = (st >> 1) * 16 + swz / 64; C = (st & 1) * 32 + (swz % 64) / 2; }
__host__ __device__ __forceinline__ int perm32(int rho) { const int n = rho >> 4, i = rho & 15; return 8 * (i >> 2) + 4 * n + (i & 3); }

struct Unit { int pm, pn; };
struct Gemm { const bf16_t* A; const bf16_t* Bt; int M, N, K, lda; };

struct StaticOrder {
    int nM, nN, nwg, G, c;
    __device__ void init(int M, int N, int G_, int c_) { nM = M / BM; nN = N / BM; nwg = nM * nN; G = G_; c = c_; }
    __device__ bool next(int i, Unit& u) const {
        const long L = (long)i * G + c; if (L >= nwg) return false;
        int wgid = (int)L; { const int q = nwg / NXCD, r = nwg % NXCD, xcd = wgid % NXCD, off = wgid / NXCD; wgid = (xcd < r ? xcd * (q + 1) : r * (q + 1) + (xcd - r) * q) + off; }
        const int nig = WGM * nN, gid = wgid / nig, fm = gid * WGM, gsz = (nM - fm) < WGM ? (nM - fm) : WGM;
        u.pm = fm + ((wgid % nig) % gsz); u.pn = (wgid % nig) / gsz; return true;
    }
};

template <class Epi, bool ALIGN_EPI, bool SP2>
__device__ __forceinline__ void gemm_phase(LAS unsigned char* lds, const Gemm g, const StaticOrder& S, const Epi& E, const int tid) {
    const int wid = __builtin_amdgcn_readfirstlane(tid >> 6), lane = tid & 63, wr = wid >> 2, wc = wid & 3, fr = lane & 15, fq = lane >> 4;
    const int K = g.K, nt = K / BK, lda = g.lda;
    unsigned voffA[2], voffB[2];
#pragma unroll
    for (int i = 0; i < 2; ++i) { int R, C; stage_rc(tid * 16 + i * 8192, R, C); const int Rb = (R & ~31) + perm32(R & 31);
        voffA[i] = (unsigned)(R * lda + C) * 2u; voffB[i] = (unsigned)(Rb * K + C) * 2u; }
    const size_t kstep = (size_t)(BK * 2);
    const size_t hstepA = (size_t)HALF * lda * 2, hstepB = (size_t)HALF * K * 2;
    const size_t tstepA = 2 * hstepA, tstepB = 2 * hstepB;
    const unsigned ldsw = (unsigned)wid * 1024u;
    const int aoff = lds_byte(wr * 64 + fr, fq * 8), boff = lds_byte(wc * 32 + fr, fq * 8);
#define PG8_SA(b, h) (((b) * 2 + (h)) * HTB)
#define PG8_SB(b, h) ((4 + (b) * 2 + (h)) * HTB)
#define PG8_STAGE(bufoff, gbase, voff) do { _Pragma("unroll") for (int _i = 0; _i < 2; ++_i) \
        __builtin_amdgcn_global_load_lds((const unsigned*)((const char*)(gbase) + (voff)[_i]), (LAS unsigned*)(lds + (bufoff) + ldsw + _i * 8192), 16, 0, 0); } while (0)
#define PG8_LDA(dst, b, h) do { _Pragma("unroll") for (int m = 0; m < 4; ++m) _Pragma("unroll") for (int k = 0; k < 2; ++k) dst[m][k] = *(const LAS bf16x8*)(lds + PG8_SA(b, h) + aoff + m * 2048 + k * 1024); } while (0)
#define PG8_LDB(dst, b, h) do { _Pragma("unroll") for (int n = 0; n < 2; ++n) _Pragma("unroll") for (int k = 0; k < 2; ++k) dst[n][k] = *(const LAS bf16x8*)(lds + PG8_SB(b, h) + boff + n * 2048 + k * 1024); } while (0)
#define PG8_MMA(ai, bj, At, Bt) do { __builtin_amdgcn_s_setprio(1); _Pragma("unroll") for (int m = 0; m < 4; ++m) _Pragma("unroll") for (int n = 0; n < 2; ++n) _Pragma("unroll") for (int k = 0; k < 2; ++k) \
        acc[ai][bj][m][n] = __builtin_amdgcn_mfma_f32_16x16x32_bf16(Bt[n][k], At[m][k], acc[ai][bj][m][n], 0, 0, 0); __builtin_amdgcn_s_setprio(0); } while (0)
#define PG8_WAIT_V(n) asm volatile("s_waitcnt vmcnt(" #n ")" ::: "memory")
#define PG8_WAIT_L(n) asm volatile("s_waitcnt lgkmcnt(" #n ")" ::: "memory")
#define PG8_BAR __builtin_amdgcn_s_barrier()
#define PG8_SCHED __builtin_amdgcn_sched_barrier(0)
    Unit cur, nxt; int ui = 0;
    if (!S.next(0, cur)) return;
    f32x4 acc[2][2][4][2];
    typename Epi::Raw raw; E.init_load(raw, cur, wr, wc, fr, fq);
    if constexpr (!Epi::HAS_INIT) {
#pragma unroll
    for (int a = 0; a < 2; ++a)
#pragma unroll
        for (int b = 0; b < 2; ++b)
#pragma unroll
            for (int m = 0; m < 4; ++m)
#pragma unroll
                for (int n = 0; n < 2; ++n) acc[a][b][m][n] = (f32x4){0.f, 0.f, 0.f, 0.f};
    }
    bf16x8 At[4][2], B0[2][2], B1[2][2];
    const char* cA = (const char*)g.A + (size_t)cur.pm * tstepA; const char* cB = (const char*)g.Bt + (size_t)cur.pn * tstepB;
    if constexpr (SP2) {
        PG8_STAGE(PG8_SB(0, 0), cB, voffB); PG8_STAGE(PG8_SB(0, 1), cB + hstepB, voffB); PG8_STAGE(PG8_SA(0, 0), cA, voffA); PG8_STAGE(PG8_SA(0, 1), cA + hstepA, voffA);
        if constexpr (Epi::HAS_INIT) E.init_finish(raw, acc);
        if (wr == 1) PG8_BAR;
        PG8_WAIT_V(2); PG8_BAR;
        PG8_STAGE(PG8_SB(1, 0), cB + kstep, voffB); PG8_STAGE(PG8_SA(1, 0), cA + kstep, voffA); PG8_STAGE(PG8_SB(1, 1), cB + hstepB + kstep, voffB);
        PG8_WAIT_V(6); PG8_BAR;
    } else {
        PG8_STAGE(PG8_SB(0, 0), cB, voffB); PG8_STAGE(PG8_SA(0, 0), cA, voffA); PG8_STAGE(PG8_SB(0, 1), cB + hstepB, voffB); PG8_STAGE(PG8_SA(0, 1), cA + hstepA, voffA);
        if (wr == 1) PG8_BAR;
        PG8_WAIT_V(4); PG8_BAR;
        PG8_STAGE(PG8_SB(1, 0), cB + kstep, voffB); PG8_STAGE(PG8_SA(1, 0), cA + kstep, voffA); PG8_STAGE(PG8_SB(1, 1), cB + hstepB + kstep, voffB);
        PG8_WAIT_V(6); PG8_BAR;
    }
    for (;;) {
        const bool has_next = S.next(ui + 1, nxt);
        const char* nA = has_next ? (const char*)g.A + (size_t)nxt.pm * tstepA : cA; const char* nB = has_next ? (const char*)g.Bt + (size_t)nxt.pn * tstepB : cB;
        for (int t = 0; t < nt; t += 2) {
            const bool last = (t == nt - 2);
            const char* a1 = cA + (size_t)(t + 1) * kstep;
            const char* a2 = last ? nA : cA + (size_t)(t + 2) * kstep; const char* b2 = last ? nB : cB + (size_t)(t + 2) * kstep;
            const char* a3 = a2 + kstep; const char* b3 = b2 + kstep;
            if constexpr (SP2) {
            PG8_LDB(B0, 0, 0); PG8_LDB(B1, 0, 1); PG8_SCHED; PG8_LDA(At, 0, 0); PG8_STAGE(PG8_SA(1, 1), a1 + hstepA, voffA);
            PG8_WAIT_V(8); PG8_WAIT_L(0); PG8_BAR; PG8_MMA(0, 0, At, B0); PG8_MMA(0, 1, At, B1); PG8_BAR; PG8_SCHED;
            PG8_LDA(At, 0, 1); PG8_STAGE(PG8_SB(0, 0), b2, voffB); PG8_STAGE(PG8_SB(0, 1), b2 + hstepB, voffB); PG8_STAGE(PG8_SA(0, 0), a2, voffA);
            PG8_WAIT_V(8); PG8_WAIT_L(0); PG8_BAR; PG8_MMA(1, 0, At, B0); PG8_MMA(1, 1, At, B1); PG8_BAR; PG8_SCHED;
            PG8_LDB(B0, 1, 0); PG8_LDB(B1, 1, 1); PG8_SCHED; PG8_LDA(At, 1, 0); PG8_STAGE(PG8_SA(0, 1), a2 + hstepA, voffA);
            PG8_WAIT_V(8); PG8_WAIT_L(0); PG8_BAR; PG8_MMA(0, 0, At, B0); PG8_MMA(0, 1, At, B1); PG8_BAR; PG8_SCHED;
            PG8_LDA(At, 1, 1); PG8_STAGE(PG8_SB(1, 0), b3, voffB); PG8_STAGE(PG8_SB(1, 1), b3 + hstepB, voffB); PG8_STAGE(PG8_SA(1, 0), a3, voffA);
            PG8_WAIT_V(8); PG8_WAIT_L(0); PG8_BAR; PG8_MMA(1, 0, At, B0); PG8_MMA(1, 1, At, B1); PG8_BAR; PG8_SCHED;
            } else {
            PG8_LDB(B0, 0, 0); PG8_SCHED; PG8_LDA(At, 0, 0); PG8_STAGE(PG8_SA(1, 1), a1 + hstepA, voffA);
            PG8_WAIT_L(8); PG8_BAR; PG8_WAIT_L(0); PG8_MMA(0, 0, At, B0); PG8_BAR; PG8_SCHED;
            PG8_LDB(B1, 0, 1); PG8_STAGE(PG8_SB(0, 0), b2, voffB);
            PG8_BAR; PG8_WAIT_L(0); PG8_MMA(0, 1, At, B1); PG8_BAR;
            PG8_LDA(At, 0, 1); PG8_STAGE(PG8_SA(0, 0), a2, voffA);
            PG8_BAR; PG8_WAIT_L(0); PG8_MMA(1, 0, At, B0); PG8_BAR; PG8_SCHED;
            PG8_STAGE(PG8_SB(0, 1), b2 + hstepB, voffB);
            PG8_WAIT_V(6); PG8_BAR; PG8_MMA(1, 1, At, B1); PG8_BAR;
            PG8_LDB(B0, 1, 0); PG8_SCHED; PG8_LDA(At, 1, 0); PG8_STAGE(PG8_SA(0, 1), a2 + hstepA, voffA);
            PG8_WAIT_L(8); PG8_BAR; PG8_WAIT_L(0); PG8_MMA(0, 0, At, B0); PG8_BAR; PG8_SCHED;
            PG8_LDB(B1, 1, 1); PG8_STAGE(PG8_SB(1, 0), b3, voffB);
            PG8_BAR; PG8_WAIT_L(0); PG8_MMA(0, 1, At, B1); PG8_BAR;
            PG8_LDA(At, 1, 1); PG8_STAGE(PG8_SA(1, 0), a3, voffA);
            PG8_BAR; PG8_WAIT_L(0); PG8_MMA(1, 0, At, B0); PG8_BAR; PG8_SCHED;
            PG8_STAGE(PG8_SB(1, 1), b3 + hstepB, voffB);
            PG8_WAIT_V(6); PG8_BAR; PG8_MMA(1, 1, At, B1); PG8_BAR;
            }
        }
        if constexpr (ALIGN_EPI) { if (wr == 0) PG8_BAR; }
        E(acc, cur, wr, wc, fr, fq);
        if (!has_next) break;
#pragma unroll
        for (int a = 0; a < 2; ++a)
#pragma unroll
            for (int b = 0; b < 2; ++b)
#pragma unroll
                for (int m = 0; m < 4; ++m)
#pragma unroll
                    for (int n = 0; n < 2; ++n) acc[a][b][m][n] = (f32x4){0.f, 0.f, 0.f, 0.f};
        cur = nxt; cA = nA; cB = nB; ++ui;
        if constexpr (ALIGN_EPI) { if (wr == 1) PG8_BAR; }
    }
    PG8_WAIT_V(0);
    if constexpr (!ALIGN_EPI) { if (wr == 0) PG8_BAR; }
    PG8_BAR;
#undef PG8_SA
#undef PG8_SB
#undef PG8_STAGE
#undef PG8_LDA
#undef PG8_LDB
#undef PG8_MMA
#undef PG8_WAIT_V
#undef PG8_WAIT_L
#undef PG8_BAR
#undef PG8_SCHED
}
}
constexpr size_t MiB = 1u << 20;
constexpr size_t WS_CTL = 0, CTL_ZERO_BYTES = 1 * MiB;
constexpr size_t WS_SSQ = 1 * MiB;
constexpr size_t WS_GATES = 2 * MiB;
constexpr size_t WS_NST = 3 * MiB;
constexpr size_t WS_W = 4 * MiB;
constexpr size_t W_GU1 = 0, W_D1 = 11 * MiB, W_IN = W_D1 + 11 * MiB / 2, W_OUT = W_IN + 7 * MiB, W_GU2 = W_OUT + 2 * MiB, W_D2 = W_GU2 + 11 * MiB, W_LAYER = 42 * MiB;
static_assert(W_D2 + 11 * MiB / 2 == W_LAYER, "weights map");
constexpr size_t WS_XB = 88 * MiB;
constexpr size_t WS_CST = 120 * MiB;
constexpr size_t WS_SST = 128 * MiB;
constexpr size_t WS_PROJ = 144 * MiB;
constexpr size_t WS_END = 248 * MiB;
static_assert(WS_PROJ + (size_t)M_TOK * PLD * 2 <= WS_END, "ws map");

constexpr int CW_BAR = 4096;
constexpr int CW_Q = 16384;

constexpr int RING_BYTES = 131072;
constexpr int LDSCTL_OFF = RING_BYTES, MISC_OFF = LDSCTL_OFF + 320;
constexpr int LDS_BYTES = 147456;
constexpr int NWAVES = 8, NTHREADS = 512;

typedef GAS unsigned gu32;
#define RLX_AGENT __ATOMIC_RELAXED, __HIP_MEMORY_SCOPE_AGENT
#define LDS_WAIT() asm volatile("s_waitcnt lgkmcnt(0)" ::: "memory")
#define VM_WAIT() asm volatile("s_waitcnt vmcnt(0)" ::: "memory")

#define XB_TMO      128
#define XB_XCNT(j)  (256  + 64 * (j))
#define XB_XSUB(j)  (1280 + 64 * (j))
#define XB_XGEN(j)  (2304 + 64 * (j))
#define XB_TOP      3328
#define XB_TOPGEN   3392
#define XCD_BAR_WORDS 3456
#define XB_SPIN_CAP (1u << 22)
__device__ __forceinline__ unsigned xb_ld(unsigned* p)              { return __hip_atomic_load(p, __ATOMIC_RELAXED, __HIP_MEMORY_SCOPE_AGENT); }
__device__ __forceinline__ unsigned xb_add(unsigned* p, unsigned v) { return __hip_atomic_fetch_add(p, v, __ATOMIC_RELAXED, __HIP_MEMORY_SCOPE_AGENT); }
__device__ __forceinline__ unsigned xb_xcc_id() { return (unsigned)__builtin_amdgcn_s_getreg((3 << 11) | 20) & 0xFu; }
#define XB_SPIN(cond, bar) do { unsigned _sp = 0; while (cond) { __builtin_amdgcn_s_sleep(1); \
    if ((++_sp & 255u) == 0u) { if (xb_ld(&(bar)[XB_TMO])) break; if (_sp > XB_SPIN_CAP) { atomicAdd(&(bar)[XB_TMO], 1u); break; } } } } while (0)
struct XcdBarrier { unsigned* bar; unsigned x; volatile LAS unsigned* st; };
__device__ __forceinline__ XcdBarrier xcd_barrier_post(unsigned* bar, volatile LAS unsigned* st) {
    XcdBarrier b; b.bar = bar; b.x = xb_xcc_id(); b.st = st;
    if (threadIdx.x == 0) (void)xb_add(&bar[XB_XCNT(b.x)], 1u);
    return b;
}
__device__ __forceinline__ void xcd_barrier_complete(unsigned* bar, unsigned x, unsigned& nloc, unsigned& nx) {
    const unsigned G = gridDim.x * gridDim.y * gridDim.z;
    unsigned sum, cnt, mine, sp = 0u;
    for (;;) {
        sum = 0u; cnt = 0u; mine = 0u;
#pragma unroll
        for (unsigned j = 0; j < 16; ++j) { const unsigned c = xb_ld(&bar[XB_XCNT(j)]); sum += c; cnt += (c > 0u) ? 1u : 0u; mine = (j == x) ? c : mine; }
        if (sum == G) break;
        __builtin_amdgcn_s_sleep(1);
        if ((++sp & 255u) == 0u) { if (xb_ld(&bar[XB_TMO])) break; if (sp > XB_SPIN_CAP) { atomicAdd(&bar[XB_TMO], 1u); break; } }
    }
    nloc = mine > 0u ? mine : 1u; nx = cnt > 0u ? cnt : 1u;
}
__device__ __forceinline__ void xcd_barrier(const XcdBarrier& b) {
    asm volatile("s_waitcnt vmcnt(0)" ::: "memory");
    __syncthreads();
    if (threadIdx.x == 0) {
        unsigned* bar = b.bar;
        __builtin_amdgcn_s_waitcnt(0);
        unsigned nloc = b.st[0], nx = b.st[1];
        if (nloc == 0u) { xcd_barrier_complete(bar, b.x, nloc, nx); b.st[0] = nloc; b.st[1] = nx; }
        const unsigned old = xb_add(&bar[XB_XSUB(b.x)], 1u);
        const unsigned gen = old / nloc;
        if (old + 1u == (gen + 1u) * nloc) {
            __builtin_amdgcn_fence(__ATOMIC_RELEASE, "agent");
            asm volatile("s_waitcnt vmcnt(0)" ::: "memory");
            const unsigned og = xb_add(&bar[XB_TOP], 1u);
            const unsigned tg = og / nx;
            if (og + 1u == (tg + 1u) * nx) xb_add(&bar[XB_TOPGEN], 1u);
            else XB_SPIN(xb_ld(&bar[XB_TOPGEN]) == tg, bar);
            __builtin_amdgcn_fence(__ATOMIC_ACQUIRE, "agent");
            xb_add(&bar[XB_XGEN(b.x)], 1u);
            asm volatile("s_waitcnt vmcnt(0)" ::: "memory");
        } else {
            XB_SPIN(xb_ld(&bar[XB_XGEN(b.x)]) == gen, bar);
            __builtin_amdgcn_fence(__ATOMIC_ACQUIRE, "agent");
            asm volatile("s_waitcnt vmcnt(0)" ::: "memory");
        }
    }
    __syncthreads();
}

struct Args { const float* in[25]; float* out; unsigned char* ws; int ph_lo, ph_hi; };
typedef const float* fptr_t; typedef __attribute__((address_space(4))) const fptr_t* kinptr_t;
struct ArgView { kinptr_t in; };
struct Frame {
    LAS unsigned char* lds;
    volatile LAS unsigned* MISC;
    unsigned* ctl;
    int tid, lane, wave, vcu, G;
    kinptr_t in;
    unsigned char* ws;
};
__device__ __forceinline__ float wave_sum(float v) {
#pragma unroll
    for (int o = 1; o < 64; o <<= 1) v += __shfl_xor(v, o);
    return v;
}
__device__ __forceinline__ int q_next(Frame& F, int q) {
    __syncthreads();
    if (F.tid == 0) F.MISC[16] = xb_add(F.ctl + CW_Q + 64 * q, 1u);
    __syncthreads();
    return (int)F.MISC[16];
}

struct MapPlain { __device__ __forceinline__ int row(int n) const { return n; } __device__ __forceinline__ float scale(int) const { return 1.f; } };
struct MapGU { int off; __device__ __forceinline__ int row(int n) const { return 256 * (n >> 7) + off + (n & 127); } __device__ __forceinline__ float scale(int) const { return 1.f; } };
struct MapIn {
    __device__ __forceinline__ int row(int n) const {
        if (n < 1024) return n;
        if (n < 1032) return 13 * 256 + (n - 1024);
        if (n < 1544) return 4 * 256 + (n - 1032);
        if (n < 2568) return 6 * 256 + (n - 1544);
        if (n < 2576) return 13 * 256 + 8 + (n - 2568);
        return 10 * 256 + (n - 2576);
    }
    __device__ __forceinline__ float scale(int n) const { return (n >= 256 && n < 512) ? 0.125f : 1.f; }
};
template <class Map>
__device__ __forceinline__ void p0_transpose_item(const float* W, int K, int N, bf16_t* WT, int item, int lane, const float* gain, const Map map) {
    const int nblk = (N + 63) / 64, kb = item / nblk, nb = item % nblk, k0 = 64 * kb, n = 64 * nb + lane;
    if (n >= N) return;
    const float* src = W + (size_t)k0 * N + n;
    float v[64];
#pragma unroll
    for (int i = 0; i < 64; ++i) v[i] = src[(size_t)i * N];
    const float sc = map.scale(n);
    if (gain) {
#pragma unroll
        for (int i = 0; i < 64; i += 4) { const f32x4 g = *(const f32x4*)(gain + k0 + i); v[i] *= g.x; v[i + 1] *= g.y; v[i + 2] *= g.z; v[i + 3] *= g.w; }
    }
    u32x4* dst = (u32x4*)(WT + (size_t)map.row(n) * K + k0);
#pragma unroll
    for (int c = 0; c < 8; ++c) { u32x4 o; o.x = cvtpk(v[8 * c] * sc, v[8 * c + 1] * sc); o.y = cvtpk(v[8 * c + 2] * sc, v[8 * c + 3] * sc); o.z = cvtpk(v[8 * c + 4] * sc, v[8 * c + 5] * sc); o.w = cvtpk(v[8 * c + 6] * sc, v[8 * c + 7] * sc); dst[c] = o; }
}
constexpr int I_G = (DM / 64) * (FF / 64), I_D = (FF / 64) * (DM / 64), I_IN = (DM / 64) * ((3344 + 63) / 64), I_OUT = (DM / 64) * (DM / 64);
constexpr int R_GU1 = 0, R_D1 = 2 * I_G, R_IN = R_D1 + I_D, R_OUT = R_IN + I_IN, R_GU2 = R_OUT + I_OUT, R_D2 = R_GU2 + 2 * I_G, R_END = R_D2 + I_D;
__device__ __forceinline__ void convert_items(Frame& F, int l, int r_lo, int r_hi, int gw, int NGW) {
    bf16_t* WL = (bf16_t*)(F.ws + WS_W + (size_t)l * W_LAYER);
    for (int it = r_lo + gw; it < r_hi; it += NGW) {
        int r = it;
        if (r < I_G) { p0_transpose_item(F.in[2] + (size_t)l * DM * FF, DM, FF, (bf16_t*)((char*)WL + W_GU1), r, F.lane, F.in[1] + l * DM, MapGU{0}); continue; } r -= I_G;
        if (r < I_G) { p0_transpose_item(F.in[3] + (size_t)l * DM * FF, DM, FF, (bf16_t*)((char*)WL + W_GU1), r, F.lane, F.in[1] + l * DM, MapGU{128}); continue; } r -= I_G;
        if (r < I_D) { p0_transpose_item(F.in[4] + (size_t)l * FF * DM, FF, DM, (bf16_t*)((char*)WL + W_D1), r, F.lane, nullptr, MapPlain{}); continue; } r -= I_D;
        if (r < I_IN) { p0_transpose_item(F.in[6] + (size_t)l * DM * 3344, DM, 3344, (bf16_t*)((char*)WL + W_IN), r, F.lane, F.in[5] + l * DM, MapIn{}); continue; } r -= I_IN;
        if (r < I_OUT) { p0_transpose_item(F.in[20] + (size_t)l * DM * DM, DM, DM, (bf16_t*)((char*)WL + W_OUT), r, F.lane, nullptr, MapPlain{}); continue; } r -= I_OUT;
        if (r < I_G) { p0_transpose_item(F.in[22] + (size_t)l * DM * FF, DM, FF, (bf16_t*)((char*)WL + W_GU2), r, F.lane, F.in[21] + l * DM, MapGU{0}); continue; } r -= I_G;
        if (r < I_G) { p0_transpose_item(F.in[23] + (size_t)l * DM * FF, DM, FF, (bf16_t*)((char*)WL + W_GU2), r, F.lane, F.in[21] + l * DM, MapGU{128}); continue; } r -= I_G;
        p0_transpose_item(F.in[24] + (size_t)l * FF * DM, FF, DM, (bf16_t*)((char*)WL + W_D2), r, F.lane, nullptr, MapPlain{});
    }
    if (r_lo <= R_IN && R_IN < r_hi) {
        u32x4* z = (u32x4*)(F.ws + WS_W + (size_t)l * W_LAYER + W_IN + (size_t)(13 * 256 + 16) * DM * 2);
        const int n16 = 240 * DM * 2 / 16;
        unsigned z0 = 0u; asm volatile("" : "+v"(z0));
        for (int i = gw * 64 + F.lane; i < n16; i += NGW * 64) z[i] = (u32x4){z0, z0, z0, z0};
    }
}
__device__ __forceinline__ void side_convert(Frame& F, int l, int k) {
    if ((int)blockIdx.x < 128 || F.G != 256) return;
    const int gw = ((int)blockIdx.x - 128) * NWAVES + F.wave, NGW = 128 * NWAVES;
    if (l == 0 && k == 0) convert_items(F, 0, R_D1, R_OUT, gw, NGW);
    else if (l == 0 && k == 2) convert_items(F, 0, R_OUT, R_END, gw, NGW);
    else if (l == 0 && k == 7) convert_items(F, 1, R_GU1, R_D1, gw, NGW);
    else if (l == 1 && k == 0) convert_items(F, 1, R_D1, R_GU2, gw, NGW);
    else if (l == 1 && k == 2) convert_items(F, 1, R_GU2, R_D2, gw, NGW);
    else if (l == 1 && k == 7) convert_items(F, 1, R_D2, R_END, gw, NGW);
}
__device__ __forceinline__ void p0_prologue(Frame& F) {
    const int gw = F.vcu * NWAVES + F.wave, NGW = F.G * NWAVES;
    if (F.G == 256) convert_items(F, 0, R_GU1, R_D1, gw, NGW);
    else { convert_items(F, 0, 0, R_END, gw, NGW); convert_items(F, 1, 0, R_END, gw, NGW); }
    const float* x = F.in[0]; bf16_t* XB = (bf16_t*)(F.ws + WS_XB); float* SSQ = (float*)(F.ws + WS_SSQ);
    for (int m = gw; m < M_TOK; m += NGW) {
        const f32x4* xr = (const f32x4*)(x + (size_t)m * DM) + F.lane; float s = 0.f; f32x4 v[4];
#pragma unroll
        for (int j = 0; j < 4; ++j) { v[j] = xr[64 * j]; s += (v[j].x * v[j].x + v[j].y * v[j].y) + (v[j].z * v[j].z + v[j].w * v[j].w); }
        s = wave_sum(s);
        u32x2* o8 = (u32x2*)(XB + (size_t)m * DM) + F.lane;
#pragma unroll
        for (int j = 0; j < 4; ++j) o8[64 * j] = (u32x2){cvtpk(v[j].x, v[j].y), cvtpk(v[j].z, v[j].w)};
        if (F.lane < 16) SSQ[(size_t)m * 16 + F.lane] = (F.lane == 0) ? s : 0.f;
    }
}

__device__ __forceinline__ void rows_rs(const float* ssq, int rowbase, int fr, int fq, float (&rs)[8]) {
    f32x4 p[8];
#pragma unroll
    for (int i = 0; i < 8; ++i) { const int row = rowbase + (i >> 2) * 128 + (i & 3) * 16 + fr; p[i] = *(const f32x4*)(ssq + (size_t)row * 16 + 4 * fq); }
#pragma unroll
    for (int i = 0; i < 8; ++i) { float s = (p[i].x + p[i].y) + (p[i].z + p[i].w); s += __shfl_xor(s, 16); s += __shfl_xor(s, 32); rs[i] = rsqrtf(s * (1.0f / DM) + NORM_EPS); }
}
struct EpiNoInit { struct Raw {}; static constexpr bool HAS_INIT = false; __device__ __forceinline__ void init_load(Raw&, const pg8::Unit&, int, int, int, int) const {} };
struct EpiSwiglu : EpiNoInit {
    bf16_t* H; const float* ssq;
    __device__ __forceinline__ void operator()(const f32x4 (&acc)[2][2][4][2], const pg8::Unit& u, int wr, int wc, int fr, int fq) const {
        asm volatile("" : "+v"(fr), "+v"(fq));
        const int col0 = u.pn * 128 + wc * 32 + 8 * fq;
        float rs[8]; rows_rs(ssq, u.pm * 256 + wr * 64, fr, fq, rs);
#pragma unroll
        for (int ai = 0; ai < 2; ++ai)
#pragma unroll
            for (int m = 0; m < 4; ++m) {
                const int row = u.pm * 256 + ai * 128 + wr * 64 + m * 16 + fr; const float r = rs[ai * 4 + m];
                float hv[8];
#pragma unroll
                for (int n = 0; n < 2; ++n)
#pragma unroll
                    for (int j = 0; j < 4; ++j) { const float g = acc[ai][0][m][n][j] * r, up = acc[ai][1][m][n][j] * r; hv[4 * n + j] = siluf_(g) * up; }
                u32x4 w; w.x = cvtpk(hv[0], hv[1]); w.y = cvtpk(hv[2], hv[3]); w.z = cvtpk(hv[4], hv[5]); w.w = cvtpk(hv[6], hv[7]);
                st16_wt(H + (size_t)row * FF + col0, w);
                if (m & 1) asm volatile("" ::: "memory");
            }
    }
};
template <bool FINAL>
struct EpiResid {
    struct Raw { u32x4 r[2][4][2]; };
    static constexpr bool HAS_INIT = true;
    float* xout; bf16_t* XB; float* ssq; float alpha, ralpha;
    __device__ __forceinline__ void init_load(Raw& raw, const pg8::Unit& u, int wr, int wc, int fr, int fq) const {
        const int col0 = u.pn * 256 + wc * 32 + 8 * fq;
#pragma unroll
        for (int ai = 0; ai < 2; ++ai)
#pragma unroll
            for (int m = 0; m < 4; ++m) { const int row = u.pm * 256 + ai * 128 + wr * 64 + m * 16 + fr;
#pragma unroll
                for (int bj = 0; bj < 2; ++bj) raw.r[ai][m][bj] = *(const u32x4*)(XB + (size_t)row * DM + col0 + bj * 128); }
    }
    __device__ __forceinline__ void init_finish(const Raw& raw, f32x4 (&acc)[2][2][4][2]) const {
#pragma unroll
        for (int ai = 0; ai < 2; ++ai)
#pragma unroll
            for (int m = 0; m < 4; ++m)
#pragma unroll
                for (int bj = 0; bj < 2; ++bj) { const u32x4 w = raw.r[ai][m][bj];
                    acc[ai][bj][m][0] = (f32x4){bflo(w.x), bfhi(w.x), bflo(w.y), bfhi(w.y)} * ralpha; acc[ai][bj][m][1] = (f32x4){bflo(w.z), bfhi(w.z), bflo(w.w), bfhi(w.w)} * ralpha; }
    }
    __device__ __forceinline__ void operator()(const f32x4 (&acc)[2][2][4][2], const pg8::Unit& u, int wr, int wc, int fr, int fq) const {
        asm volatile("" : "+v"(fr), "+v"(fq));
        const int col0 = u.pn * 256 + wc * 32 + 8 * fq;
#pragma unroll
        for (int ai = 0; ai < 2; ++ai)
#pragma unroll
            for (int m = 0; m < 4; ++m) {
                const int row = u.pm * 256 + ai * 128 + wr * 64 + m * 16 + fr; float ss = 0.f;
#pragma unroll
                for (int bj = 0; bj < 2; ++bj) {
                    const size_t off = (size_t)row * DM + col0 + bj * 128;
                    const f32x4 y0 = acc[ai][bj][m][0] * alpha, y1 = acc[ai][bj][m][1] * alpha;
                    if (FINAL) { *(f32x4*)(xout + off) = y0; *(f32x4*)(xout + off + 4) = y1; }
                    else {
                        ss += (y0.x * y0.x + y0.y * y0.y) + (y0.z * y0.z + y0.w * y0.w) + (y1.x * y1.x + y1.y * y1.y) + (y1.z * y1.z + y1.w * y1.w);
                        u32x4 w; w.x = cvtpk(y0.x, y0.y); w.y = cvtpk(y0.z, y0.w); w.z = cvtpk(y1.x, y1.y); w.w = cvtpk(y1.z, y1.w);
                        st16_wt(XB + off, w); }
                }
                if (!FINAL) { ss += __shfl_xor(ss, 16); ss += __shfl_xor(ss, 32);
                    if (fq == 0) ssq[(size_t)row * 16 + u.pn * 4 + wc] = ss; }
                if (m & 1) asm volatile("" ::: "memory");
            }
    }
};
struct EpiInProj : EpiNoInit {
    bf16_t* PROJ; float* GATES; const float* ssq; const float* qnw; const float* knw; const float* gbias; const float* dtb;
    template <int KIND>
    __device__ __forceinline__ void body(const f32x4 (&acc)[2][2][4][2], const pg8::Unit& u, int wr, int wc, int fr, int fq, const float (&rs)[8]) const {
        const int t = u.pn, colw = wc * 32 + 8 * fq;
        float nw[8];
        if (KIND == 3) { const float* w = (t == 10 ? qnw : knw) + (wc & 1) * 32 + 8 * fq; const float sc = (t == 10) ? (0.17677669529663687f * LOG2E) : 1.f;
#pragma unroll
            for (int i = 0; i < 8; ++i) nw[i] = w[i] * sc; }
#pragma unroll
        for (int ai = 0; ai < 2; ++ai)
#pragma unroll
            for (int m = 0; m < 4; ++m) {
                const int row = u.pm * 256 + ai * 128 + wr * 64 + m * 16 + fr; const float r = rs[ai * 4 + m];
#pragma unroll
                for (int bj = 0; bj < 2; ++bj) {
                    float v[8];
#pragma unroll
                    for (int n = 0; n < 2; ++n)
#pragma unroll
                        for (int j = 0; j < 4; ++j) v[4 * n + j] = acc[ai][bj][m][n][j] * r;
                    if (KIND == 1) {
#pragma unroll
                        for (int i = 0; i < 8; ++i) v[i] = sigmoidf_(v[i]);
                    } else if (KIND == 2) {
#pragma unroll
                        for (int i = 0; i < 8; ++i) v[i] = siluf_(v[i]);
                    } else if (KIND == 3) {
                        float ss = 0.f;
#pragma unroll
                        for (int i = 0; i < 8; ++i) ss += v[i] * v[i];
                        ss += __shfl_xor(ss, 16); ss += __shfl_xor(ss, 32);
                        const float q = rsqrtf(ss * (1.0f / 32.0f) + NORM_EPS);
#pragma unroll
                        for (int i = 0; i < 8; ++i) v[i] = v[i] * q * nw[i];
                    }
                    u32x4 w; w.x = cvtpk(v[0], v[1]); w.y = cvtpk(v[2], v[3]); w.z = cvtpk(v[4], v[5]); w.w = cvtpk(v[6], v[7]);
                    st16_wt(PROJ + (size_t)row * PLD + t * 256 + bj * 128 + colw, w);
                }
                if (m & 1) asm volatile("" ::: "memory");
            }
    }
    __device__ __forceinline__ void gates(const f32x4 (&acc)[2][2][4][2], const pg8::Unit& u, int wr, int wc, int fr, int fq, const float (&rs)[8]) const {
        if (wc != 0 || fq >= 2) return;
#pragma unroll
        for (int ai = 0; ai < 2; ++ai)
#pragma unroll
            for (int m = 0; m < 4; ++m) {
                const int row = u.pm * 256 + ai * 128 + wr * 64 + m * 16 + fr; const float r = rs[ai * 4 + m];
                float v[8], o[8];
#pragma unroll
                for (int n = 0; n < 2; ++n)
#pragma unroll
                    for (int j = 0; j < 4; ++j) v[4 * n + j] = acc[ai][0][m][n][j] * r;
                if (fq == 0) {
#pragma unroll
                    for (int j = 0; j < 4; ++j) { o[j] = v[j] + gbias[j]; const float z = v[4 + j] + gbias[4 + j]; o[4 + j] = fminf(z, 0.f) - fast_log1pexp(-fabsf(z)); }
                } else {
#pragma unroll
                    for (int j = 0; j < 8; ++j) { const float z = v[j] + dtb[j]; o[j] = fmaxf(z, 0.f) + fast_log1pexp(-fabsf(z)); }
                }
                float* gp = GATES + (size_t)row * 16 + 8 * fq;
                *(f32x4*)gp = (f32x4){o[0], o[1], o[2], o[3]}; *(f32x4*)(gp + 4) = (f32x4){o[4], o[5], o[6], o[7]};
                asm volatile("" ::: "memory");
            }
    }
    __device__ __forceinline__ void operator()(const f32x4 (&acc)[2][2][4][2], const pg8::Unit& u, int wr, int wc, int fr, int fq) const {
        asm volatile("" : "+v"(fr), "+v"(fq));
        float rs[8]; rows_rs(ssq, u.pm * 256 + wr * 64, fr, fq, rs);
        const int t = u.pn;
        if (t == 13) gates(acc, u, wr, wc, fr, fq, rs);
        else if (t == 3) body<1>(acc, u, wr, wc, fr, fq, rs);
        else if (t == 4 || t == 5) body<2>(acc, u, wr, wc, fr, fq, rs);
        else if (t == 10 || t == 11) body<3>(acc, u, wr, wc, fr, fq, rs);
        else body<0>(acc, u, wr, wc, fr, fq, rs);
    }
};
#define MFMA16(a, b, c) __builtin_amdgcn_mfma_f32_16x16x32_bf16((a), (b), (c), 0, 0, 0)
#define WAVE_SYNC() do { asm volatile("s_waitcnt lgkmcnt(0)" ::: "memory"); __builtin_amdgcn_wave_barrier(); } while (0)
#define LDS_BARRIER() do { asm volatile("s_waitcnt lgkmcnt(0)" ::: "memory"); __builtin_amdgcn_s_barrier(); asm volatile("" ::: "memory"); } while (0)
__device__ __forceinline__ bf16x8 ld_g8(const bf16_t* p) { return *(const bf16x8*)p; }
__device__ __forceinline__ bf16x8 ld_l8(const LAS bf16_t* p) { return *(const LAS bf16x8*)p; }
__device__ __forceinline__ bf16x8 ld_l44(const LAS bf16_t* p0, const LAS bf16_t* p1) { const bf16x4 a = *(const LAS bf16x4*)p0, b = *(const LAS bf16x4*)p1; return (bf16x8){a[0], a[1], a[2], a[3], b[0], b[1], b[2], b[3]}; }
__device__ __forceinline__ bf16x8 pack8(const f32x4 a, const f32x4 b) { u32x4 w; w.x = cvtpk(a[0], a[1]); w.y = cvtpk(a[2], a[3]); w.z = cvtpk(b[0], b[1]); w.w = cvtpk(b[2], b[3]); return __builtin_bit_cast(bf16x8, w); }
__device__ __forceinline__ float wave_scan_incl(float v, int lane) {
#pragma unroll
    for (int o = 1; o < 64; o <<= 1) { const float t = __shfl_up(v, o); if (lane >= o) v += t; }
    return v;
}

typedef short v4i16_t __attribute__((ext_vector_type(4)));
__device__ __forceinline__ bf16x8 ld_tr8(const LAS bf16_t* T, int pitch, int k0, int c0, int lane) {
    const int i = lane & 15, fq = lane >> 4;
    const LAS bf16_t* p = T + (k0 + 8 * fq + (i >> 2)) * pitch + c0 + 4 * (i & 3);
    const v4i16_t lo = __builtin_amdgcn_ds_read_tr16_b64_v4i16((LAS v4i16_t*)p), hi = __builtin_amdgcn_ds_read_tr16_b64_v4i16((LAS v4i16_t*)(p + 4 * pitch));
    return (bf16x8){lo[0], lo[1], lo[2], lo[3], hi[0], hi[1], hi[2], hi[3]};
}
__device__ __forceinline__ bf16x8 ld_tr8p(const LAS bf16_t* T, int pitch, int k0, int c0, int lane) {
    const int i = lane & 15, fq = lane >> 4;
    const LAS bf16_t* p = T + (k0 + 4 * fq + (i >> 2)) * pitch + c0 + 4 * (i & 3);
    const v4i16_t lo = __builtin_amdgcn_ds_read_tr16_b64_v4i16((LAS v4i16_t*)p), hi = __builtin_amdgcn_ds_read_tr16_b64_v4i16((LAS v4i16_t*)(p + 16 * pitch));
    return (bf16x8){lo[0], lo[1], lo[2], lo[3], hi[0], hi[1], hi[2], hi[3]};
}

__device__ __forceinline__ void conv_phase(Frame& F, int l) {
    const bf16_t* PROJ = (const bf16_t*)(F.ws + WS_PROJ); bf16_t* XACT = (bf16_t*)F.in[25];
    const float* cw = F.in[9] + (size_t)l * 4 * 1024; const float* cb = F.in[10] + (size_t)l * 1024;
    for (int g = F.vcu * NTHREADS + F.tid; g < 1024 * 128; g += F.G * NTHREADS) {
        const int cg = g & 127, rb = g >> 7, ch0 = cg * 8, row0 = rb * 16;
        float w[4][8], bs[8];
#pragma unroll
        for (int j = 0; j < 4; ++j) { const f32x4 a = *(const f32x4*)(cw + j * 1024 + ch0), b = *(const f32x4*)(cw + j * 1024 + ch0 + 4);
            w[j][0] = a.x; w[j][1] = a.y; w[j][2] = a.z; w[j][3] = a.w; w[j][4] = b.x; w[j][5] = b.y; w[j][6] = b.z; w[j][7] = b.w; }
        { const f32x4 a = *(const f32x4*)(cb + ch0), b = *(const f32x4*)(cb + ch0 + 4); bs[0] = a.x; bs[1] = a.y; bs[2] = a.z; bs[3] = a.w; bs[4] = b.x; bs[5] = b.y; bs[6] = b.z; bs[7] = b.w; }
        float h3[8], h2[8], h1[8];
        const bool first = (row0 % SEQ) == 0;
        const bf16_t* src = PROJ + (size_t)row0 * PLD + PX + ch0;
        if (first) {
#pragma unroll
            for (int e = 0; e < 8; ++e) { h3[e] = 0.f; h2[e] = 0.f; h1[e] = 0.f; }
        } else {
            const u32x4 a = *(const u32x4*)(src - 3 * (size_t)PLD), b = *(const u32x4*)(src - 2 * (size_t)PLD), c = *(const u32x4*)(src - (size_t)PLD);
#pragma unroll
            for (int e = 0; e < 4; ++e) { h3[2 * e] = bflo(a[e]); h3[2 * e + 1] = bfhi(a[e]); h2[2 * e] = bflo(b[e]); h2[2 * e + 1] = bfhi(b[e]); h1[2 * e] = bflo(c[e]); h1[2 * e + 1] = bfhi(c[e]); }
        }
        u32x4 dr[16];
#pragma unroll
        for (int i = 0; i < 16; ++i) dr[i] = *(const u32x4*)(src + (size_t)i * PLD);
#pragma unroll
        for (int i = 0; i < 16; ++i) {
            const u32x4 d = dr[i]; float cur[8], o[8];
#pragma unroll
            for (int e = 0; e < 4; ++e) { cur[2 * e] = bflo(d[e]); cur[2 * e + 1] = bfhi(d[e]); }
#pragma unroll
            for (int e = 0; e < 8; ++e) { const float s = bs[e] + w[0][e] * h3[e] + w[1][e] * h2[e] + w[2][e] * h1[e] + w[3][e] * cur[e]; o[e] = siluf_(s); h3[e] = h2[e]; h2[e] = h1[e]; h1[e] = cur[e]; }
            u32x4 ow; ow.x = cvtpk(o[0], o[1]); ow.y = cvtpk(o[2], o[3]); ow.z = cvtpk(o[4], o[5]); ow.w = cvtpk(o[6], o[7]);
            *(u32x4*)(XACT + (size_t)(row0 + i) * 1024 + ch0) = ow;
        }
    }
}

__device__ __forceinline__ void mlstm_state_item(Frame& F, int bh) {
    const int b = bh >> 2, h = bh & 3, w = F.wave, vq = w & 3, dh = w >> 2, lane = F.lane, fr = lane & 15, fq = lane >> 4, tid = F.tid;
    constexpr int MP = 72, MBUF = 2 * 64 * MP * 2 + 128;
    LAS float* WG = (LAS float*)(F.lds + 2 * MBUF); LAS float* DEC = WG + 4096;
    const bf16_t* PROJ = (const bf16_t*)(F.ws + WS_PROJ); const float* GATES = (const float*)(F.ws + WS_GATES);
    bf16_t* CST = (bf16_t*)(F.ws + WS_CST); float* NST = (float*)(F.ws + WS_NST);
    const size_t rowb = (size_t)b * SEQ;
    for (int c = w; c < 64; c += 8) {
        const float* gq = GATES + (rowb + 64 * c + lane) * 16 + h; const float ig = gq[0], lf = gq[4];
        const float bs = wave_scan_incl(lf, lane); const float bl = __shfl(bs, 63);
        WG[64 * c + lane] = fast_exp(bl - bs + ig); if (lane == 0) DEC[c] = fast_exp(bl);
    }
    f32x4 acc[2], nacc[2];
    acc[0] = acc[1] = nacc[0] = nacc[1] = (f32x4){0.f, 0.f, 0.f, 0.f};
    const int ls = tid >> 3, lc = tid & 7;
    const bf16_t* kp = PROJ + (rowb + ls) * PLD + PK + h * 64 + 8 * lc; const bf16_t* vp = PROJ + (rowb + ls) * PLD + PV + h * 64 + 8 * lc;
    u32x4 k0, v0, k1, v1, k2, v2;
#define ML_LOAD(kr_, vr_, c_) do { const size_t o_ = (size_t)(c_) * 64 * PLD; kr_ = *(const u32x4*)(kp + o_); vr_ = *(const u32x4*)(vp + o_); } while (0)
#define ML_WRITE(kr_, vr_, c_) do { LAS bf16_t* KL_ = (LAS bf16_t*)(F.lds + ((c_) & 1) * MBUF); LAS bf16_t* VL_ = KL_ + 64 * MP; const float wg_ = WG[64 * (c_) + ls]; \
        *(LAS u32x4*)(KL_ + ls * MP + 8 * lc) = kr_; u32x4 o_; _Pragma("unroll") for (int e_ = 0; e_ < 4; ++e_) o_[e_] = cvtpk(wg_ * bflo(vr_[e_]), wg_ * bfhi(vr_[e_])); \
        *(LAS u32x4*)(VL_ + ls * MP + 8 * lc) = o_; if (lc == 0) (VL_ + 64 * MP)[ls] = f2bf(wg_); } while (0)
    LAS bf16_t* STG = (LAS bf16_t*)(F.lds + 2 * MBUF + 16384 + 256); LAS float* NSTG = (LAS float*)(STG + 2 * 4096);
#define ML_STAGE(c_) do { LAS bf16_t* sg_ = STG + ((c_) & 1) * 4096; \
        _Pragma("unroll") for (int dt = 0; dt < 2; ++dt) _Pragma("unroll") for (int r = 0; r < 4; ++r) sg_[(vq * 16 + 4 * fq + r) * 64 + dh * 32 + dt * 16 + fr] = f2bf(acc[dt][r]); \
        if (vq == 0 && fq == 0) { NSTG[((c_) & 1) * 64 + dh * 32 + fr] = nacc[0][0]; NSTG[((c_) & 1) * 64 + dh * 32 + 16 + fr] = nacc[1][0]; } } while (0)
    ML_LOAD(k0, v0, 0); ML_LOAD(k1, v1, 1); ML_LOAD(k2, v2, 2);
    __syncthreads();
    ML_WRITE(k0, v0, 0);
    ML_STAGE(0);
    LDS_BARRIER();
#define ML_STEP(KW, VW, KN, VN, c_) do { const int cc_ = (c_); const size_t ci = (size_t)bh * 64 + cc_; \
          \
        { const u32x4 st_ = *(const LAS u32x4*)(STG + ((cc_) & 1) * 4096 + tid * 8); *(u32x4*)(CST + ci * 4096 + tid * 8) = st_; \
          NST[ci * 64 + (tid & 63)] = NSTG[((cc_) & 1) * 64 + (tid & 63)]; }     \
        asm volatile("" ::: "memory"); \
        if (cc_ + 1 < 64) ML_WRITE(KW, VW, cc_ + 1); \
        asm volatile("" ::: "memory"); \
        ML_LOAD(KN, VN, (cc_ + 3 < 64 ? cc_ + 3 : 63)); \
        asm volatile("" ::: "memory"); \
        const float decay = DEC[cc_]; \
        const LAS bf16_t* KL = (const LAS bf16_t*)(F.lds + (cc_ & 1) * MBUF); const LAS bf16_t* VL = KL + 64 * MP; const LAS bf16_t* WV = VL + 64 * MP; \
        _Pragma("unroll") for (int dt = 0; dt < 2; ++dt) { acc[dt] = acc[dt] * decay; nacc[dt] = nacc[dt] * decay; } \
        _Pragma("unroll") for (int ks = 0; ks < 2; ++ks) { \
            const bf16x8 A = ld_tr8(VL, MP, 32 * ks, 16 * vq, lane); \
            bf16x8 An = ld_l8(WV + 32 * ks + 8 * fq); if (fr != 0) An = (bf16x8){0, 0, 0, 0, 0, 0, 0, 0}; \
            _Pragma("unroll") for (int dt = 0; dt < 2; ++dt) { const bf16x8 B = ld_tr8(KL, MP, 32 * ks, 32 * dh + 16 * dt, lane); \
                acc[dt] = MFMA16(A, B, acc[dt]); if (vq == 0) nacc[dt] = MFMA16(An, B, nacc[dt]); } } \
        ML_STAGE(cc_ + 1); \
        LDS_BARRIER(); } while (0)
    for (int c = 0; c < 63; c += 3) { ML_STEP(k1, v1, k0, v0, c); ML_STEP(k2, v2, k1, v1, c + 1); ML_STEP(k0, v0, k2, v2, c + 2); }
    ML_STEP(k1, v1, k0, v0, 63);
#undef ML_STEP
#undef ML_LOAD
#undef ML_WRITE
#undef ML_STAGE
}

template <int TH>
__device__ __forceinline__ void mlstm_out_wave(Frame& F, int l, int bc, int h) {
    const int b = bc >> 6, c = bc & 63, w = F.wave, lane = F.lane, fr = lane & 15, fq = lane >> 4;
    constexpr int VP = 72;
    LAS bf16_t* VL = (LAS bf16_t*)(F.lds + w * 12288); LAS float* BT_ = (LAS float*)(F.lds + w * 12288 + 9216); LAS float* GS = BT_ + 64;
    LAS bf16_t* YS = VL;
    const bf16_t* PROJ = (const bf16_t*)(F.ws + WS_PROJ); const float* GATES = (const float*)(F.ws + WS_GATES);
    const bf16_t* CST = (const bf16_t*)(F.ws + WS_CST); const float* NST = (const float*)(F.ws + WS_NST);
    bf16_t* Y = (bf16_t*)(F.ws + WS_PROJ) + PX;
    const size_t row0 = (size_t)b * SEQ + 64 * c; const size_t ci = (size_t)(b * 4 + h) * 64 + c;
    constexpr int NST_ = 2 * TH + 2, NKK = TH + 1;
    {
        const size_t row = row0 + lane;
        const float ig = GATES[row * 16 + h], lf = GATES[row * 16 + 4 + h];
        const bf16_t* vp = PROJ + row * PLD + PV + h * 64;
        u32x4 vr[8];
#pragma unroll
        for (int i = 0; i < 8; ++i) vr[i] = *(const u32x4*)(vp + 8 * i);
        const float bs = wave_scan_incl(lf, lane);
        BT_[lane] = bs; GS[lane] = ig - bs;
#pragma unroll
        for (int i = 0; i < 8; ++i) *(LAS u32x4*)(VL + lane * VP + 8 * i) = vr[i];
    }
    bf16x8 Qf[2][2], Kf[NST_][2];
#pragma unroll
    for (int tt = 0; tt < 2; ++tt)
#pragma unroll
        for (int ks = 0; ks < 2; ++ks) Qf[tt][ks] = ld_g8(PROJ + (row0 + 32 * TH + 16 * tt + fr) * PLD + PQ + h * 64 + 32 * ks + 8 * fq);
#pragma unroll
    for (int st = 0; st < NST_; ++st)
#pragma unroll
        for (int ks = 0; ks < 2; ++ks) Kf[st][ks] = ld_g8(PROJ + (row0 + 16 * st + fr) * PLD + PK + h * 64 + 32 * ks + 8 * fq);
    WAVE_SYNC();
    f32x4 P[2][NST_]; float den[2];
#pragma unroll
    for (int tt = 0; tt < 2; ++tt) {
        const int t = 32 * TH + 16 * tt + fr; const float bt = BT_[t]; float d1 = 0.f;
#pragma unroll
        for (int st = 0; st < NST_; ++st) {
            f32x4 s = (f32x4){0.f, 0.f, 0.f, 0.f};
#pragma unroll
            for (int ks = 0; ks < 2; ++ks) s = MFMA16(Kf[st][ks], Qf[tt][ks], s);
#pragma unroll
            for (int r = 0; r < 4; ++r) { const int sidx = 16 * st + 4 * fq + r; const float wv = (sidx <= t) ? s[r] * fast_exp(bt + GS[sidx]) : 0.f; s[r] = wv; d1 += wv; }
            P[tt][st] = s;
        }
        d1 += __shfl_xor(d1, 16); d1 += __shfl_xor(d1, 32);
        float d2 = 0.f;
#pragma unroll
        for (int ks = 0; ks < 2; ++ks) { const f32x4 n0 = *(const f32x4*)(NST + ci * 64 + 32 * ks + 8 * fq), n1 = *(const f32x4*)(NST + ci * 64 + 32 * ks + 8 * fq + 4);
            const u32x4 qw = __builtin_bit_cast(u32x4, Qf[tt][ks]);
            d2 += bflo(qw.x) * n0.x + bfhi(qw.x) * n0.y + bflo(qw.y) * n0.z + bfhi(qw.y) * n0.w + bflo(qw.z) * n1.x + bfhi(qw.z) * n1.y + bflo(qw.w) * n1.z + bfhi(qw.w) * n1.w; }
        d2 += __shfl_xor(d2, 16); d2 += __shfl_xor(d2, 32);
        den[tt] = d1 + fast_exp(bt) * d2;
    }
    const float* nw = F.in[8] + (size_t)l * 256 + h * 64;
    f32x4 acc[2][4];
#pragma unroll
    for (int tt = 0; tt < 2; ++tt) {
        bf16x8 Cf[4][2];
#pragma unroll
        for (int vt = 0; vt < 4; ++vt)
#pragma unroll
            for (int ks = 0; ks < 2; ++ks) Cf[vt][ks] = ld_g8(CST + ci * 4096 + (16 * vt + fr) * 64 + 32 * ks + 8 * fq);
#pragma unroll
        for (int vt = 0; vt < 4; ++vt) { acc[tt][vt] = (f32x4){0.f, 0.f, 0.f, 0.f};
#pragma unroll
            for (int ks = 0; ks < 2; ++ks) acc[tt][vt] = MFMA16(Qf[tt][ks], Cf[vt][ks], acc[tt][vt]); }
        float eb[4], dr[4];
#pragma unroll
        for (int r = 0; r < 4; ++r) { eb[r] = fast_exp(BT_[32 * TH + 16 * tt + 4 * fq + r]); dr[r] = __shfl(den[tt], 4 * fq + r); }
#pragma unroll
        for (int vt = 0; vt < 4; ++vt)
#pragma unroll
            for (int r = 0; r < 4; ++r) acc[tt][vt][r] *= eb[r];
#pragma unroll
        for (int kk = 0; kk < NKK; ++kk) { const bf16x8 PA = pack8(P[tt][2 * kk], P[tt][2 * kk + 1]);
            bf16x8 Bv[4];
#pragma unroll
            for (int vt = 0; vt < 4; ++vt) Bv[vt] = ld_tr8p(VL, VP, 32 * kk, 16 * vt, lane);
#pragma unroll
            for (int vt = 0; vt < 4; ++vt) acc[tt][vt] = MFMA16(PA, Bv[vt], acc[tt][vt]); }
#pragma unroll
        for (int r = 0; r < 4; ++r) { const float inv = fast_rcp(fmaxf(fabsf(dr[r]), 1.0f)); float s = 0.f;
#pragma unroll
            for (int vt = 0; vt < 4; ++vt) { acc[tt][vt][r] *= inv; s += acc[tt][vt][r] * acc[tt][vt][r]; }
            s += __shfl_xor(s, 1); s += __shfl_xor(s, 2); s += __shfl_xor(s, 4); s += __shfl_xor(s, 8); const float rs = rsqrtf(s * (1.0f / 64.0f) + NORM_EPS);
#pragma unroll
            for (int vt = 0; vt < 4; ++vt) acc[tt][vt][r] *= rs * nw[16 * vt + fr]; }
    }
    WAVE_SYNC();
#pragma unroll
    for (int tt = 0; tt < 2; ++tt)
#pragma unroll
        for (int vt = 0; vt < 4; ++vt)
#pragma unroll
            for (int r = 0; r < 4; ++r) YS[(16 * tt + 4 * fq + r) * VP + 16 * vt + fr] = f2bf(acc[tt][vt][r]);
    WAVE_SYNC();
#pragma unroll
    for (int i = 0; i < 4; ++i) { const int tr_ = (lane >> 3) + 8 * i, ch = lane & 7; const size_t row = row0 + 32 * TH + tr_;
        const u32x4 yv = *(const LAS u32x4*)(YS + tr_ * VP + 8 * ch); const u32x4 gv = *(const u32x4*)(PROJ + row * PLD + PO + h * 64 + 8 * ch); u32x4 o;
#pragma unroll
        for (int e = 0; e < 4; ++e) o[e] = cvtpk(bflo(yv[e]) * bflo(gv[e]), bfhi(yv[e]) * bfhi(gv[e]));
        *(u32x4*)(Y + row * PLD + h * 64 + 8 * ch) = o; }
    WAVE_SYNC();
}
__device__ __forceinline__ void mlstm_out_item(Frame& F, int l, int bc) {
    const int h = F.wave >> 1;
    if (F.wave & 1) mlstm_out_wave<1>(F, l, bc, h); else mlstm_out_wave<0>(F, l, bc, h);
}
typedef float f32x16 __attribute__((ext_vector_type(16)));
#define MFMA32(a, b, c) __builtin_amdgcn_mfma_f32_32x32x16_bf16((a), (b), (c), 0, 0, 0)
constexpr int AK_STR = 72, AV_STR = 96;
constexpr int ATT_KB = 128 * AK_STR * 2, ATT_VB = 128 * AV_STR * 2, ATT_BUF = ATT_KB + ATT_VB;
constexpr int ATT_TAB_OFF = 2 * ATT_BUF;
__device__ __forceinline__ int t5_bucket(int n) {
    if (n < 16) return n;
    int bk = 16;
    bk += (n >= 19); bk += (n >= 21); bk += (n >= 24); bk += (n >= 27); bk += (n >= 31); bk += (n >= 35); bk += (n >= 40); bk += (n >= 46);
    bk += (n >= 52); bk += (n >= 59); bk += (n >= 67); bk += (n >= 77); bk += (n >= 87); bk += (n >= 99); bk += (n >= 113);
    return bk;
}
__device__ __forceinline__ int crow16(int reg, int hi) { return (reg & 3) + 8 * (reg >> 2) + 4 * hi; }
__device__ __forceinline__ bf16x8 pack8r(const f32x16& p, const int s) { u32x4 w; w.x = cvtpk(p[8 * s], p[8 * s + 1]); w.y = cvtpk(p[8 * s + 2], p[8 * s + 3]); w.z = cvtpk(p[8 * s + 4], p[8 * s + 5]); w.w = cvtpk(p[8 * s + 6], p[8 * s + 7]); return __builtin_bit_cast(bf16x8, w); }
__device__ __forceinline__ void epilogue_attn(Frame& F, int l, int bh, int qi, f32x16 (&O1)[2], f32x16 (&O2)[2], float l1, float l2);
__device__ __forceinline__ void attn_item(Frame& F, int l, int bh, int qi) {
    const int b = bh >> 2, h = bh & 3, w = F.wave, lane = F.lane, tid = F.tid, r32 = lane & 31, hi = lane >> 5, qq = w & 3, kh = w >> 2;
#ifdef PROBE_A
    const unsigned long long tp0_ = __builtin_amdgcn_s_memrealtime();
#endif
    const bf16_t* PROJ = (const bf16_t*)(F.ws + WS_PROJ); bf16_t* Y = (bf16_t*)(F.ws + WS_PROJ) + PX;
    LAS float* TAB = (LAS float*)(F.lds + ATT_TAB_OFF);
    LAS bf16_t* QL = (LAS bf16_t*)(F.lds + ATT_TAB_OFF + 1024);
    const size_t row0 = (size_t)b * SEQ; const int q0 = qi * 128;
    if (tid < 256) TAB[tid] = F.in[19][t5_bucket(tid) * 4 + h] * LOG2E;
    const int npairs = qi + 1;
    const int lk = tid >> 3, lc = tid & 7;
    const bf16_t* kg = PROJ + (row0 + lk) * PLD + PDK + h * 64 + 8 * lc; const bf16_t* vg = PROJ + (row0 + lk) * PLD + PDV + h * 64 + 8 * lc;
    u32x4 ka0, ka1, va0, va1;
#define ATT_WRITE(k0_, k1_, v0_, v1_, buf) do { LAS bf16_t* KL_ = (LAS bf16_t*)(F.lds + (buf) * ATT_BUF); LAS bf16_t* VL_ = (LAS bf16_t*)(F.lds + (buf) * ATT_BUF + ATT_KB); \
        *(LAS u32x4*)(KL_ + lk * AK_STR + 8 * lc) = k0_; *(LAS u32x4*)(KL_ + (lk + 64) * AK_STR + 8 * lc) = k1_; \
        *(LAS u32x4*)(VL_ + lk * AV_STR + 8 * lc) = v0_; *(LAS u32x4*)(VL_ + (lk + 64) * AV_STR + 8 * lc) = v1_; } while (0)
#define ATT_LOAD(k0_, k1_, v0_, v1_, p) do { const size_t o_ = (size_t)(p) * 128 * PLD; k0_ = *(const u32x4*)(kg + o_); k1_ = *(const u32x4*)(kg + o_ + (size_t)64 * PLD); v0_ = *(const u32x4*)(vg + o_); v1_ = *(const u32x4*)(vg + o_ + (size_t)64 * PLD); } while (0)
    ATT_LOAD(ka0, ka1, va0, va1, 0);
    {
        const bf16_t* qg = PROJ + (row0 + q0 + lk) * PLD + PDQ + h * 64 + 8 * lc;
        const u32x4 q0r = *(const u32x4*)qg, q1r = *(const u32x4*)(qg + (size_t)64 * PLD);
        *(LAS u32x4*)(QL + lk * AK_STR + 8 * lc) = q0r; *(LAS u32x4*)(QL + (lk + 64) * AK_STR + 8 * lc) = q1r; }
    ATT_WRITE(ka0, ka1, va0, va1, 0);
    if (npairs > 1) ATT_LOAD(ka0, ka1, va0, va1, 1);
    const int qrow = q0 + 32 * qq + r32;
    f32x16 O1[2], O2[2];
#pragma unroll
    for (int i = 0; i < 16; ++i) { O1[0][i] = 0.f; O1[1][i] = 0.f; O2[0][i] = 0.f; O2[1][i] = 0.f; }
    f32x4 L1 = {0.f, 0.f, 0.f, 0.f}, L2 = {0.f, 0.f, 0.f, 0.f};
    __syncthreads();
    const float cfar = TAB[255];
    const f32x16 cinit = {0.f, 0.f, 0.f, 0.f, 0.f, 0.f, 0.f, 0.f, 0.f, 0.f, 0.f, 0.f, 0.f, 0.f, 0.f, 0.f};
    const int vlane = (4 * hi + ((lane & 15) >> 2)) * AV_STR + 16 * ((lane >> 4) & 1) + 4 * (lane & 3);
    const LAS bf16_t* qlp = QL + (32 * qq + r32) * AK_STR + 8 * hi;
#ifdef PROBE_SECTIONS
    unsigned long long dA_ = 0, dB_ = 0, dC_ = 0;
#define ATT_T(x_) const unsigned long long x_ = __builtin_amdgcn_s_memtime()
#define ATT_TW(x_) asm volatile("s_waitcnt lgkmcnt(0)" ::: "memory"); const unsigned long long x_ = __builtin_amdgcn_s_memtime()
#define ATT_TACC() do { dA_ += tb_ - ta_; dB_ += tc_ - tb_; dC_ += td_ - tc_; } while (0)
#else
#define ATT_T(x_) do {} while (0)
#define ATT_TW(x_) do {} while (0)
#define ATT_TACC() do {} while (0)
#endif
#define ATT_EXP(S1_, S2_, sub_, NEAR_) do { \
        if (NEAR_) { \
            _Pragma("unroll") for (int r = 0; r < 16; ++r) { const int rel = qrow - (k0 + 32 * (sub_) + crow16(r, hi)); const float bv = TAB[rel < 0 ? 0 : rel] - cfar; \
                const float p1 = __builtin_amdgcn_exp2f(S1_[r] + bv), p2 = __builtin_amdgcn_exp2f(S2_[r] + bv); \
                S1_[r] = rel < 0 ? 0.f : p1; S2_[r] = rel < 0 ? 0.f : p2; } \
        } else { \
            _Pragma("unroll") for (int r = 0; r < 16; ++r) { S1_[r] = __builtin_amdgcn_exp2f(S1_[r]); S2_[r] = __builtin_amdgcn_exp2f(S2_[r]); } \
        } \
        _Pragma("unroll") for (int r = 0; r < 16; r += 4) { L1 += (f32x4){S1_[r], S1_[r + 1], S1_[r + 2], S1_[r + 3]}; L2 += (f32x4){S2_[r], S2_[r + 1], S2_[r + 2], S2_[r + 3]}; } } while (0)
#define ATT_VLOAD(Vf_, sub_) do { _Pragma("unroll") for (int s = 0; s < 2; ++s) _Pragma("unroll") for (int vt = 0; vt < 2; ++vt) { const LAS bf16_t* vp = VL + (32 * (sub_) + 16 * s) * AV_STR + 32 * vt + vlane; \
            const v4i16_t lo = __builtin_amdgcn_ds_read_tr16_b64_v4i16((LAS v4i16_t*)vp), hi4 = __builtin_amdgcn_ds_read_tr16_b64_v4i16((LAS v4i16_t*)(vp + 8 * AV_STR)); \
            Vf_[s][vt] = (bf16x8){lo[0], lo[1], lo[2], lo[3], hi4[0], hi4[1], hi4[2], hi4[3]}; } } while (0)
#define ATT_PV(S1_, S2_, Vf_) do { _Pragma("unroll") for (int s = 0; s < 2; ++s) { const bf16x8 PA1 = pack8r(S1_, s), PA2 = pack8r(S2_, s); \
            _Pragma("unroll") for (int vt = 0; vt < 2; ++vt) { O1[vt] = MFMA32(PA1, Vf_[s][vt], O1[vt]); O2[vt] = MFMA32(PA2, Vf_[s][vt], O2[vt]); } } } while (0)
#define ATT_ITER(k0_, k1_, v0_, v1_, p_, NEAR_) do { const int p = (p_); ATT_T(ta_); \
        if (p + 1 < npairs) { ATT_WRITE(k0_, k1_, v0_, v1_, (p + 1) & 1); } \
        if (p + 2 < npairs) { ATT_LOAD(k0_, k1_, v0_, v1_, p + 2); } \
        ATT_TW(tb_); \
        const int k0 = 128 * p + 64 * kh; \
        if (!(NEAR_) || k0 <= q0 + 32 * qq + 31) { \
            const LAS bf16_t* KL = (const LAS bf16_t*)(F.lds + (p & 1) * ATT_BUF) + 64 * kh * AK_STR; const LAS bf16_t* VL = (const LAS bf16_t*)(F.lds + (p & 1) * ATT_BUF + ATT_KB) + 64 * kh * AV_STR; \
            f32x16 SA1, SA2, SB1, SB2; \
            {   const bf16x8 Q00 = ld_l8(qlp), Q01 = ld_l8(qlp + 16), Q10 = ld_l8(qlp + 32), Q11 = ld_l8(qlp + 48); \
                const LAS bf16_t* kp = KL + r32 * AK_STR + 8 * hi; \
                const bf16x8 a10 = ld_l8(kp), a11 = ld_l8(kp + 16), a20 = ld_l8(kp + 32), a21 = ld_l8(kp + 48); \
                const bf16x8 b10 = ld_l8(kp + 32 * AK_STR), b11 = ld_l8(kp + 32 * AK_STR + 16), b20 = ld_l8(kp + 32 * AK_STR + 32), b21 = ld_l8(kp + 32 * AK_STR + 48); \
                SA1 = MFMA32(a10, Q00, cinit); SA2 = MFMA32(a20, Q10, cinit); SA1 = MFMA32(a11, Q01, SA1); SA2 = MFMA32(a21, Q11, SA2); \
                SB1 = MFMA32(b10, Q00, cinit); SB2 = MFMA32(b20, Q10, cinit); SB1 = MFMA32(b11, Q01, SB1); SB2 = MFMA32(b21, Q11, SB2); } \
            bf16x8 Vf[2][2], Vg[2][2]; \
            ATT_VLOAD(Vf, 0); ATT_VLOAD(Vg, 1); \
            ATT_EXP(SA1, SA2, 0, NEAR_); \
            ATT_PV(SA1, SA2, Vf); \
            ATT_EXP(SB1, SB2, 1, NEAR_); \
            ATT_PV(SB1, SB2, Vg); \
            if (!(NEAR_)) {   \
                __builtin_amdgcn_sched_group_barrier(0x8, 4, 0); \
                _Pragma("unroll") for (int g_ = 0; g_ < 4; ++g_) { __builtin_amdgcn_sched_group_barrier(0x8, 1, 0); __builtin_amdgcn_sched_group_barrier(0x400, 8, 0); } \
                __builtin_amdgcn_sched_group_barrier(0x2, 24, 0); \
                _Pragma("unroll") for (int g_ = 0; g_ < 8; ++g_) { __builtin_amdgcn_sched_group_barrier(0x8, 1, 0); __builtin_amdgcn_sched_group_barrier(0x400, 4, 0); __builtin_amdgcn_sched_group_barrier(0x2, 2, 0); } } \
        } \
        ATT_T(tc_); \
        LDS_BARRIER(); ATT_T(td_); ATT_TACC(); } while (0)
#ifdef PROBE_A
    if (lane == 0) atomicMax(F.ctl + 32768 + 64 * (11 + 16 * l), (unsigned)(__builtin_amdgcn_s_memrealtime() - tp0_));
#endif
    int pp = 0;
    for (; pp + 1 < qi; ++pp) ATT_ITER(ka0, ka1, va0, va1, pp, 0);
    for (; pp < npairs; ++pp) ATT_ITER(ka0, ka1, va0, va1, pp, 1);
#undef ATT_EXP
#undef ATT_VLOAD
#undef ATT_PV
#undef ATT_ITER
#ifdef PROBE_SECTIONS
    if (qi == 31 && lane == 0) { atomicMax(F.ctl + 32768 + 64 * (8 + 16 * l), (unsigned)(dA_ / 32) * 10u); atomicMax(F.ctl + 32768 + 64 * (9 + 16 * l), (unsigned)(dB_ / 32) * 10u); atomicMax(F.ctl + 32768 + 64 * (10 + 16 * l), (unsigned)(dC_ / 32) * 10u); }
#endif
#undef ATT_WRITE
#undef ATT_LOAD
    float l1 = (L1.x + L1.y) + (L1.z + L1.w), l2 = (L2.x + L2.y) + (L2.z + L2.w);
    epilogue_attn(F, l, bh, qi, O1, O2, l1, l2);
}
__device__ __forceinline__ void epilogue_attn(Frame& F, int l, int bh, int qi, f32x16 (&O1)[2], f32x16 (&O2)[2], float l1, float l2) {
    int t3 = threadIdx.x; asm volatile("" : "+v"(t3));
    const int lane = t3 & 63, w = __builtin_amdgcn_readfirstlane(t3 >> 6), r32 = lane & 31, hi = lane >> 5, qq = w & 3, kh = w >> 2, b = bh >> 2, h = bh & 3;
    bf16_t* Y = (bf16_t*)(F.ws + WS_PROJ) + PX;
    const size_t row0 = (size_t)b * SEQ; const int q0 = qi * 128;
    LAS float* XCH = (LAS float*)F.lds + (size_t)qq * 66 * 64 + lane;
    if (kh == 1) {
#pragma unroll
        for (int vt = 0; vt < 2; ++vt)
#pragma unroll
            for (int r = 0; r < 16; ++r) { XCH[(vt * 16 + r) * 64] = O1[vt][r]; XCH[(32 + vt * 16 + r) * 64] = O2[vt][r]; }
        XCH[64 * 64] = l1; XCH[65 * 64] = l2;
    }
    __syncthreads();
    if (kh == 0) {
        const float* lm = F.in[17] + (size_t)l * 128;
        float d1 = (lane < 32) ? lm[lane] * lm[32 + lane] : 0.f, d2 = (lane < 32) ? lm[64 + lane] * lm[96 + lane] : 0.f;
        d1 = wave_sum(d1); d2 = wave_sum(d2);
        int lq = l; asm volatile("" : "+s"(lq));
        const float lam_init = (lq == 0) ? 0.2f : 0.35550906759f;
        const float lam = __int_as_float(__builtin_amdgcn_readfirstlane(__float_as_int(fast_exp(d1) - fast_exp(d2) + lam_init)));
#pragma unroll
        for (int vt = 0; vt < 2; ++vt)
#pragma unroll
            for (int r = 0; r < 16; ++r) { O1[vt][r] += XCH[(vt * 16 + r) * 64]; O2[vt][r] += XCH[(32 + vt * 16 + r) * 64]; }
        l1 += XCH[64 * 64]; l2 += XCH[65 * 64];
        l1 += __shfl_xor(l1, 32); l2 += __shfl_xor(l2, 32);
        const float i1 = fast_rcp(l1), i2 = lam * fast_rcp(l2);
        const float* sw = F.in[18] + (size_t)l * 64; const float osc = 1.0f - lam_init;
        const float sw0 = sw[r32], sw1 = sw[32 + r32];
#pragma unroll
        for (int r = 0; r < 16; ++r) {
            const int qr = crow16(r, hi);
            const float a1 = __shfl(i1, qr), a2 = __shfl(i2, qr);
            const float o0 = O1[0][r] * a1 - O2[0][r] * a2, o1 = O1[1][r] * a1 - O2[1][r] * a2;
            float s = o0 * o0 + o1 * o1;
            s += __shfl_xor(s, 1); s += __shfl_xor(s, 2); s += __shfl_xor(s, 4); s += __shfl_xor(s, 8); s += __shfl_xor(s, 16);
            const float rs = rsqrtf(s * (1.0f / 64.0f) + NORM_EPS) * osc;
            const size_t row = row0 + q0 + 32 * qq + qr;
            Y[row * PLD + 768 + h * 64 + r32] = f2bf(o0 * rs * sw0); Y[row * PLD + 768 + h * 64 + 32 + r32] = f2bf(o1 * rs * sw1);
        }
    }
}

constexpr int SSD_STR = 136;
constexpr int SX_P = 72, SB_P = 136, SS_BUF = 128 * SX_P * 2 + 128 * SB_P * 2;
__device__ __forceinline__ void ssd_state_item(Frame& F, int l, int bhh) {
    const int b = bhh >> 3, hh = bhh & 7, g = hh >> 2, w = F.wave, lane = F.lane, fr = lane & 15, fq = lane >> 4, tid = F.tid;
    LAS float* XS = (LAS float*)(F.lds + 2 * SS_BUF); LAS float* CD = XS + 4096;
    const bf16_t* XACT = (const bf16_t*)F.in[25]; const float* GATES = (const float*)(F.ws + WS_GATES); bf16_t* SST = (bf16_t*)(F.ws + WS_SST);
    const float Ah = -expf(F.in[12][l * 8 + hh]);
    for (int c = w; c < 32; c += 8) {
        const size_t r0 = (size_t)b * SEQ + 128 * c;
        const float dt0 = GATES[(r0 + lane) * 16 + 8 + hh], dt1 = GATES[(r0 + 64 + lane) * 16 + 8 + hh];
        const float s0 = wave_scan_incl(dt0 * Ah, lane); const float t0 = __shfl(s0, 63);
        const float s1 = wave_scan_incl(dt1 * Ah, lane) + t0; const float last = __shfl(s1, 63);
        XS[128 * c + lane] = dt0 * fast_exp(last - s0); XS[128 * c + 64 + lane] = dt1 * fast_exp(last - s1);
        if (lane == 0) CD[c] = fast_exp(last);
    }
    const int pt = w & 3, nh = w >> 2;
    f32x4 acc[4];
#pragma unroll
    for (int j = 0; j < 4; ++j) acc[j] = (f32x4){0.f, 0.f, 0.f, 0.f};
    const bf16_t* xg = XACT + ((size_t)b * SEQ + (tid >> 3)) * 1024 + hh * 64 + 8 * (tid & 7);
    const bf16_t* bg = XACT + ((size_t)b * SEQ + (tid >> 4)) * 1024 + 512 + g * 128 + 8 * (tid & 15);
    u32x4 xa[2], ba[4], xb[2], bb[4], xc[2], bc[4];
#define SS_LOAD(xr, br, c_) do { const size_t o_ = (size_t)(c_) * 128 * 1024; xr[0] = *(const u32x4*)(xg + o_); xr[1] = *(const u32x4*)(xg + o_ + 64 * 1024); \
        _Pragma("unroll") for (int i_ = 0; i_ < 4; ++i_) br[i_] = *(const u32x4*)(bg + o_ + (size_t)i_ * 32 * 1024); } while (0)
#define SS_WRITE(xr, br, c_) do { LAS bf16_t* XL_ = (LAS bf16_t*)(F.lds + ((c_) & 1) * SS_BUF); LAS bf16_t* BL_ = XL_ + 128 * SX_P; \
        _Pragma("unroll") for (int i_ = 0; i_ < 2; ++i_) { const int s_ = (tid >> 3) + 64 * i_; const float sc_ = XS[128 * (c_) + s_]; u32x4 o_; \
            _Pragma("unroll") for (int e_ = 0; e_ < 4; ++e_) o_[e_] = cvtpk(sc_ * bflo(xr[i_][e_]), sc_ * bfhi(xr[i_][e_])); \
            *(LAS u32x4*)(XL_ + s_ * SX_P + 8 * (tid & 7)) = o_; } \
        _Pragma("unroll") for (int i_ = 0; i_ < 4; ++i_) *(LAS u32x4*)(BL_ + ((tid >> 4) + 32 * i_) * SB_P + 8 * (tid & 15)) = br[i_]; } while (0)
    LAS bf16_t* SSTG = (LAS bf16_t*)(F.lds + 2 * SS_BUF + 16384 + 128);
#define SS_STAGE(c_) do { LAS bf16_t* sg_ = SSTG + ((c_) & 1) * 8192; \
        _Pragma("unroll") for (int j = 0; j < 4; ++j) _Pragma("unroll") for (int r = 0; r < 4; ++r) sg_[(16 * pt + 4 * fq + r) * 128 + 16 * (4 * nh + j) + fr] = f2bf(acc[j][r]); } while (0)
    SS_LOAD(xa, ba, 0); SS_LOAD(xb, bb, 1); SS_LOAD(xc, bc, 2);
    __syncthreads();
    SS_WRITE(xa, ba, 0);
    SS_LOAD(xa, ba, 3);
    LDS_BARRIER();
#define SS_STEP(XW, BW, c_) do { const int cc_ = (c_); const size_t si = ((size_t)(b * 32 + cc_) * 8 + hh) * 8192; \
        _Pragma("unroll") for (int j = 0; j < 4; ++j) _Pragma("unroll") for (int r = 0; r < 4; ++r) SST[si + (16 * pt + 4 * fq + r) * 128 + 16 * (4 * nh + j) + fr] = f2bf(acc[j][r]); \
        asm volatile("" ::: "memory"); \
        if (cc_ + 1 < 32) { SS_WRITE(XW, BW, cc_ + 1); } \
        asm volatile("" ::: "memory"); \
        SS_LOAD(XW, BW, (cc_ + 4 < 32 ? cc_ + 4 : 31)); \
        asm volatile("" ::: "memory"); \
        const float cd = CD[cc_]; \
        _Pragma("unroll") for (int j = 0; j < 4; ++j) acc[j] = acc[j] * cd; \
        const LAS bf16_t* XL = (const LAS bf16_t*)(F.lds + (cc_ & 1) * SS_BUF); const LAS bf16_t* BL = XL + 128 * SX_P; \
        bf16x8 Af[4], Bf[4][4]; \
        _Pragma("unroll") for (int ks = 0; ks < 4; ++ks) { Af[ks] = ld_tr8(XL, SX_P, 32 * ks, 16 * pt, lane); \
            _Pragma("unroll") for (int j = 0; j < 4; ++j) Bf[ks][j] = ld_tr8(BL, SB_P, 32 * ks, 16 * (4 * nh + j), lane); } \
        asm volatile("s_waitcnt lgkmcnt(0)" ::: "memory"); __builtin_amdgcn_sched_barrier(0); \
        _Pragma("unroll") for (int ks = 0; ks < 4; ++ks) _Pragma("unroll") for (int j = 0; j < 4; ++j) acc[j] = MFMA16(Af[ks], Bf[ks][j], acc[j]); \
        LDS_BARRIER(); } while (0)
    for (int c = 0; c < 30; c += 3) { SS_STEP(xb, bb, c); SS_STEP(xc, bc, c + 1); SS_STEP(xa, ba, c + 2); }
    SS_STEP(xb, bb, 30); SS_STEP(xc, bc, 31);
#undef SS_STEP
#undef SS_STAGE
#undef SS_LOAD
#undef SS_WRITE
}

constexpr int SO_BP = 136, SO_XP = 72, SO_SP = 136, SO_YP = 264;
constexpr int SO_B_BYTES = 128 * SO_BP * 2, SO_H_BYTES = 128 * SO_XP * 2 + 64 * SO_SP * 2, SO_ACS_OFF = SO_B_BYTES + 2 * SO_H_BYTES;
__device__ __forceinline__ void ssd_out_item(Frame& F, int l, int it) {
    const int g = it & 1, c = (it >> 1) & 31, b = it >> 6, w = F.wave, lane = F.lane, fr = lane & 15, fq = lane >> 4, tid = F.tid;
    LAS bf16_t* BL = (LAS bf16_t*)F.lds;
    LAS float* ACS = (LAS float*)(F.lds + SO_ACS_OFF); LAS float* DTS = ACS + 512;
    const bf16_t* XACT = (const bf16_t*)F.in[25]; const float* GATES = (const float*)(F.ws + WS_GATES); const bf16_t* SST = (const bf16_t*)(F.ws + WS_SST);
    const bf16_t* PROJ = (const bf16_t*)(F.ws + WS_PROJ); bf16_t* Y = (bf16_t*)(F.ws + WS_PROJ) + PX;
    const size_t r0 = (size_t)b * SEQ + 128 * c;
    const bf16_t* bgp = XACT + (r0 + (tid >> 4)) * 1024 + 512 + g * 128 + 8 * (tid & 15);
    const bf16_t* xgp = XACT + (r0 + (tid >> 3)) * 1024 + g * 256 + 8 * (tid & 7);
    const bf16_t* sgp = SST + ((size_t)(b * 32 + c) * 8 + g * 4) * 8192 + (tid >> 4) * 128 + 8 * (tid & 15);
    u32x4 xr[2], sr[2];
#define SO_LOADH(hd_) do { xr[0] = *(const u32x4*)(xgp + (hd_) * 64); xr[1] = *(const u32x4*)(xgp + (hd_) * 64 + 64 * 1024); \
        sr[0] = *(const u32x4*)(sgp + (size_t)(hd_) * 8192); sr[1] = *(const u32x4*)(sgp + (size_t)(hd_) * 8192 + 32 * 128); } while (0)
#define SO_WRITEH(hd_) do { LAS bf16_t* XL_ = (LAS bf16_t*)(F.lds + SO_B_BYTES + ((hd_) & 1) * SO_H_BYTES); LAS bf16_t* SL_ = XL_ + 128 * SO_XP; \
        *(LAS u32x4*)(XL_ + (tid >> 3) * SO_XP + 8 * (tid & 7)) = xr[0]; *(LAS u32x4*)(XL_ + ((tid >> 3) + 64) * SO_XP + 8 * (tid & 7)) = xr[1]; \
        *(LAS u32x4*)(SL_ + (tid >> 4) * SO_SP + 8 * (tid & 15)) = sr[0]; *(LAS u32x4*)(SL_ + ((tid >> 4) + 32) * SO_SP + 8 * (tid & 15)) = sr[1]; } while (0)
    {   u32x4 br[4];
#pragma unroll
        for (int i = 0; i < 4; ++i) br[i] = *(const u32x4*)(bgp + (size_t)i * 32 * 1024);
        SO_LOADH(0);
#pragma unroll
        for (int i = 0; i < 4; ++i) *(LAS u32x4*)(BL + ((tid >> 4) + 32 * i) * SO_BP + 8 * (tid & 15)) = br[i];
        SO_WRITEH(0);
    }
    if (w < 4) {
        const int hh = g * 4 + w; const float Ah = -expf(F.in[12][l * 8 + hh]);
        const float dt0 = GATES[(r0 + lane) * 16 + 8 + hh], dt1 = GATES[(r0 + 64 + lane) * 16 + 8 + hh];
        const float s0 = wave_scan_incl(dt0 * Ah, lane); const float t0 = __shfl(s0, 63);
        const float s1 = wave_scan_incl(dt1 * Ah, lane) + t0;
        ACS[128 * w + lane] = s0; ACS[128 * w + 64 + lane] = s1; DTS[128 * w + lane] = dt0; DTS[128 * w + 64 + lane] = dt1;
    }
    SO_LOADH(1);
    const int lrow = 16 * w + fr, nkk = (w >> 1) + 1;
    bf16x8 Cf[4];
#pragma unroll
    for (int ks = 0; ks < 4; ++ks) Cf[ks] = ld_g8(XACT + (r0 + lrow) * 1024 + 768 + g * 128 + 32 * ks + 8 * fq);
    asm volatile("" : "+v"(Cf[0]), "+v"(Cf[1]), "+v"(Cf[2]), "+v"(Cf[3]));
    LDS_BARRIER();
    f32x4 G[4][2];
#pragma unroll
    for (int kk = 0; kk < 4; ++kk) { G[kk][0] = (f32x4){0.f, 0.f, 0.f, 0.f}; G[kk][1] = (f32x4){0.f, 0.f, 0.f, 0.f};
        if (kk < nkk) {
            bf16x8 b0[4], b1[4];
#pragma unroll
            for (int ks = 0; ks < 4; ++ks) { b0[ks] = ld_l8(BL + (32 * kk + fr) * SO_BP + 32 * ks + 8 * fq); b1[ks] = ld_l8(BL + (32 * kk + 16 + fr) * SO_BP + 32 * ks + 8 * fq); }
#pragma unroll
            for (int ks = 0; ks < 4; ++ks) { G[kk][0] = MFMA16(b0[ks], Cf[ks], G[kk][0]); G[kk][1] = MFMA16(b1[ks], Cf[ks], G[kk][1]); } } }
    const float* Dk = F.in[13] + l * 8 + g * 4;
    f32x4 yacc[4][4];
#pragma unroll
    for (int hd = 0; hd < 4; ++hd) {
        const LAS bf16_t* XL = (const LAS bf16_t*)(F.lds + SO_B_BYTES + (hd & 1) * SO_H_BYTES); const LAS bf16_t* SL = XL + 128 * SO_XP;
        bf16x8 Sf[4][4];
#pragma unroll
        for (int pt = 0; pt < 4; ++pt)
#pragma unroll
            for (int ks = 0; ks < 4; ++ks) Sf[pt][ks] = ld_l8(SL + (16 * pt + fr) * SO_SP + 32 * ks + 8 * fq);
        float ea[4], xv[4][4];
#pragma unroll
        for (int r = 0; r < 4; ++r) ea[r] = fast_exp(ACS[128 * hd + 16 * w + 4 * fq + r]);
#pragma unroll
        for (int pt = 0; pt < 4; ++pt)
#pragma unroll
            for (int r = 0; r < 4; ++r) xv[pt][r] = bf2f(XL[(16 * w + 4 * fq + r) * SO_XP + 16 * pt + fr]);
        const float dsk = Dk[hd];
#pragma unroll
        for (int pt = 0; pt < 4; ++pt) { f32x4 a = (f32x4){0.f, 0.f, 0.f, 0.f};
#pragma unroll
            for (int ks = 0; ks < 4; ++ks) a = MFMA16(Cf[ks], Sf[pt][ks], a);
#pragma unroll
            for (int r = 0; r < 4; ++r) a[r] = a[r] * ea[r] + dsk * xv[pt][r];
            yacc[hd][pt] = a; }
        const float al = ACS[128 * hd + lrow];
#pragma unroll
        for (int kk = 0; kk < 4; ++kk) if (kk < nkk) {
            f32x4 P0, P1;
#pragma unroll
            for (int r = 0; r < 4; ++r) { const int s0 = 32 * kk + 4 * fq + r, s1 = s0 + 16;
                P0[r] = (s0 <= lrow) ? G[kk][0][r] * fast_exp(al - ACS[128 * hd + s0]) * DTS[128 * hd + s0] : 0.f;
                P1[r] = (s1 <= lrow) ? G[kk][1][r] * fast_exp(al - ACS[128 * hd + s1]) * DTS[128 * hd + s1] : 0.f; }
            const bf16x8 PA = pack8(P0, P1);
            bf16x8 Bx[4];
#pragma unroll
            for (int pt = 0; pt < 4; ++pt) Bx[pt] = ld_tr8p(XL, SO_XP, 32 * kk, 16 * pt, lane);
#pragma unroll
            for (int pt = 0; pt < 4; ++pt) yacc[hd][pt] = MFMA16(PA, Bx[pt], yacc[hd][pt]);
        }
        if (hd + 1 < 4) { SO_WRITEH(hd + 1); if (hd + 2 < 4) SO_LOADH(hd + 2); }
        LDS_BARRIER();
    }
#undef SO_LOADH
#undef SO_WRITEH
    LAS bf16_t* YL = (LAS bf16_t*)F.lds;
#pragma unroll
    for (int hd = 0; hd < 4; ++hd)
#pragma unroll
        for (int pt = 0; pt < 4; ++pt)
#pragma unroll
            for (int r = 0; r < 4; ++r) YL[(16 * w + 4 * fq + r) * SO_YP + hd * 64 + 16 * pt + fr] = f2bf(yacc[hd][pt][r]);
    LDS_BARRIER();
    const float* nw = F.in[14] + (size_t)l * 512 + g * 256; const int ch8 = 8 * (tid & 31);
    const f32x4 nw0 = *(const f32x4*)(nw + ch8), nw1 = *(const f32x4*)(nw + ch8 + 4);
#pragma unroll 2
    for (int i = 0; i < 8; ++i) {
        const int lr = (tid >> 5) + 16 * i; const size_t row = r0 + lr;
        const u32x4 yv = *(const LAS u32x4*)(YL + lr * SO_YP + ch8); const u32x4 zv = *(const u32x4*)(PROJ + row * PLD + PZ + g * 256 + ch8);
        float v[8]; float ss = 0.f;
#pragma unroll
        for (int e = 0; e < 4; ++e) { v[2 * e] = bflo(yv[e]) * bflo(zv[e]); v[2 * e + 1] = bfhi(yv[e]) * bfhi(zv[e]); ss += v[2 * e] * v[2 * e] + v[2 * e + 1] * v[2 * e + 1]; }
        ss += __shfl_xor(ss, 1); ss += __shfl_xor(ss, 2); ss += __shfl_xor(ss, 4); ss += __shfl_xor(ss, 8); ss += __shfl_xor(ss, 16);
        const float rs = rsqrtf(ss * (1.0f / 256.0f) + NORM_EPS);
        u32x4 o; o.x = cvtpk(v[0] * rs * nw0.x, v[1] * rs * nw0.y); o.y = cvtpk(v[2] * rs * nw0.z, v[3] * rs * nw0.w); o.z = cvtpk(v[4] * rs * nw1.x, v[5] * rs * nw1.y); o.w = cvtpk(v[6] * rs * nw1.z, v[7] * rs * nw1.w);
        *(u32x4*)(Y + row * PLD + 256 + g * 256 + ch8) = o;
    }
}
#ifndef PH_EN
#define PH_EN 1023
#endif
#ifndef MK_N_LAUNCHES
#define MK_N_LAUNCHES 1
#endif
constexpr int N_PHASES = 1 + 9 * DEPTH;
constexpr int NA1 = 512;
constexpr int CW_STAT = 32768;
#ifdef PROBE_A
#define ITEM_T0() const unsigned long long it0_ = __builtin_amdgcn_s_memrealtime()
#define ITEM_T1(k_) do { __syncthreads(); if (threadIdx.x == 0) atomicMax(F.ctl + CW_STAT + 64 * ((k_) + 16 * l), (unsigned)(__builtin_amdgcn_s_memrealtime() - it0_)); } while (0)
#else
#define ITEM_T0() do {} while (0)
#define ITEM_T1(k_) do {} while (0)
#endif

__global__ void __launch_bounds__(NTHREADS, 2) hyb_fwd(Args args) {
    extern __shared__ __attribute__((aligned(16))) unsigned char lds_raw[];
    {   const int t0 = threadIdx.x;
        for (int u = t0; u < (LDS_BYTES - LDSCTL_OFF) / 4; u += NTHREADS) ((LAS unsigned*)((LAS unsigned char*)lds_raw + LDSCTL_OFF))[u] = 0u; }
    __syncthreads();
    const int ph_lo = args.ph_lo, ph_hi = args.ph_hi;
    const bool one_launch = (ph_hi - ph_lo) > 1;
    if (one_launch) { XcdBarrier b0 = xcd_barrier_post((unsigned*)(args.ws + WS_CTL) + CW_BAR, (volatile LAS unsigned*)((LAS unsigned char*)lds_raw + MISC_OFF) + 8); (void)b0; }
#ifdef PROBE_A
    unsigned long long t_prev = __builtin_amdgcn_s_memrealtime();
#endif
    for (int ph = ph_lo; ph < ph_hi; ++ph) {
        int tid_ = threadIdx.x; asm volatile("" : "+v"(tid_));
        kinptr_t kin = (kinptr_t)__builtin_amdgcn_kernarg_segment_ptr(); asm volatile("" : "+s"(kin));
        Frame F;
        F.lds = (LAS unsigned char*)lds_raw; F.MISC = (volatile LAS unsigned*)(F.lds + MISC_OFF);
        F.tid = tid_; F.lane = tid_ & 63; F.wave = __builtin_amdgcn_readfirstlane(tid_ >> 6);
        F.G = gridDim.x; { const int bx = blockIdx.x; F.vcu = (F.G % 8 == 0) ? (bx % 8) * (F.G / 8) + bx / 8 : bx; }
        F.in = kin;
        float* const outp = (float*)kin[25]; unsigned char* ws = (unsigned char*)kin[26];
        F.ws = ws; F.ctl = (unsigned*)(ws + WS_CTL);
        bf16_t* XB = (bf16_t*)(ws + WS_XB); bf16_t* PROJ = (bf16_t*)(ws + WS_PROJ); float* SSQ = (float*)(ws + WS_SSQ); float* GATES = (float*)(ws + WS_GATES);
        if (ph == 0) { if (PH_EN & 1) p0_prologue(F); }
        else {
            const int l = (ph - 1) / 9, k = (ph - 1) % 9;
            const unsigned char* WL = ws + WS_W + (size_t)l * W_LAYER;
            if ((PH_EN & 2) && (k == 0 || k == 7)) {
                pg8::Gemm g{XB, (const bf16_t*)(WL + (k == 0 ? W_GU1 : W_GU2)), M_TOK, NGU, DM, DM}; pg8::StaticOrder S; S.init(M_TOK, NGU, F.G, (int)blockIdx.x);
                EpiSwiglu E{{}, PROJ, SSQ};
                pg8::gemm_phase<EpiSwiglu, true, true>(F.lds, g, S, E, F.tid);
                { int t2 = threadIdx.x; asm volatile("" : "+v"(t2)); F.tid = t2; F.lane = t2 & 63; F.wave = __builtin_amdgcn_readfirstlane(t2 >> 6); side_convert(F, l, k); }
            } else if ((PH_EN & 4) && (k == 1 || k == 8 || k == 6)) {
                pg8::Gemm g; float alpha = 0.5f;
                if (k == 6) { g = pg8::Gemm{PROJ + PX, (const bf16_t*)(WL + W_OUT), M_TOK, DM, DM, PLD}; alpha = 1.0f; }
                else { g = pg8::Gemm{PROJ, (const bf16_t*)(WL + (k == 1 ? W_D1 : W_D2)), M_TOK, DM, FF, FF}; }
                pg8::StaticOrder S; S.init(M_TOK, DM, F.G, (int)blockIdx.x);
                if (ph == N_PHASES - 1) { EpiResid<true> E{outp, XB, SSQ, alpha, 1.0f / alpha}; pg8::gemm_phase<EpiResid<true>, false, true>(F.lds, g, S, E, F.tid); }
                else { EpiResid<false> E{outp, XB, SSQ, alpha, 1.0f / alpha}; pg8::gemm_phase<EpiResid<false>, false, true>(F.lds, g, S, E, F.tid); }
            } else if ((PH_EN & 8) && k == 2) {
                pg8::Gemm g{XB, (const bf16_t*)(WL + W_IN), M_TOK, NIN, DM, DM}; pg8::StaticOrder S; S.init(M_TOK, NIN, F.G, (int)blockIdx.x);
                EpiInProj E{{}, PROJ, GATES, SSQ, kin[15] + l * 64, kin[16] + l * 64, kin[7] + l * 8, kin[11] + l * 8};
                pg8::gemm_phase<EpiInProj, true, true>(F.lds, g, S, E, F.tid);
                { int t2 = threadIdx.x; asm volatile("" : "+v"(t2)); F.tid = t2; F.lane = t2 & 63; F.wave = __builtin_amdgcn_readfirstlane(t2 >> 6); side_convert(F, l, k); }
            } else if ((PH_EN & 16) && k == 3) {
                conv_phase(F, l);
            } else if (k == 4) {
                for (int first_ = (F.G == 256) ? 1 : 0;; first_ = 0) {
                    const int it = first_ ? (int)blockIdx.x : (q_next(F, 2 * l) + ((F.G == 256) ? 256 : 0)); if (it >= 48 + NA1) break;
                    { int t2 = threadIdx.x; asm volatile("" : "+v"(t2)); F.tid = t2; F.lane = t2 & 63; F.wave = __builtin_amdgcn_readfirstlane(t2 >> 6); }
                    ITEM_T0();
                    if (it < 16) { if (PH_EN & 32) mlstm_state_item(F, it); ITEM_T1(0); }
                    else if (it < 48) { if (PH_EN & 64) ssd_state_item(F, l, it - 16); ITEM_T1(1); }
                    else { const int r = it - 48; if (PH_EN & 128) attn_item(F, l, r & 15, 31 - (r >> 4)); ITEM_T1(2); } }
            } else if (k == 5 && NA1 == 512 && F.G == 256) {
                { int t2 = threadIdx.x; asm volatile("" : "+v"(t2)); F.tid = t2; F.lane = t2 & 63; F.wave = __builtin_amdgcn_readfirstlane(t2 >> 6); }
                ssd_out_item(F, l, F.vcu);
                __syncthreads();
                { int t2 = threadIdx.x; asm volatile("" : "+v"(t2)); F.tid = t2; F.lane = t2 & 63; F.wave = __builtin_amdgcn_readfirstlane(t2 >> 6); }
                mlstm_out_item(F, l, F.vcu);
            } else if (k == 5) {
                for (;;) { const int it = q_next(F, 2 * l + 1); if (it >= 512 + (512 - NA1)) break;
                    { int t2 = threadIdx.x; asm volatile("" : "+v"(t2)); F.tid = t2; F.lane = t2 & 63; F.wave = __builtin_amdgcn_readfirstlane(t2 >> 6); }
                    ITEM_T0();
                    if (it < 256) { if (PH_EN & 256) ssd_out_item(F, l, it); ITEM_T1(3); }
                    else if (it < 512) { if (PH_EN & 512) mlstm_out_item(F, l, it - 256); ITEM_T1(4); }
                    else { const int r = NA1 + it - 512; if (PH_EN & 128) attn_item(F, l, r & 15, 31 - (r >> 4)); } }
            }
        }
#ifdef PROBE_A
        if (ph + 1 < ph_hi) { XcdBarrier bar; bar.bar = F.ctl + CW_BAR; bar.x = xb_xcc_id(); bar.st = F.MISC + 8; xcd_barrier(bar); }
        { const unsigned long long t_now = __builtin_amdgcn_s_memrealtime(); if (threadIdx.x == 0) F.MISC[24 + ph] += (unsigned)(t_now - t_prev); t_prev = t_now; }
        if (ph + 1 == ph_hi && blockIdx.x == 0) { __syncthreads();
            unsigned va = (PROBE_A < 32) ? F.MISC[24 + PROBE_A] : xb_ld(F.ctl + CW_STAT + 64 * (PROBE_A - 32)), vb = (PROBE_B < 32) ? F.MISC[24 + PROBE_B] : xb_ld(F.ctl + CW_STAT + 64 * (PROBE_B - 32));
            if (PROBE_A == 44 || PROBE_A == 46) va = va / 512u * 100u; if (PROBE_A == 45) va = va / 512u * 10u; if (PROBE_B == 44 || PROBE_B == 46) vb = vb / 512u * 100u; if (PROBE_B == 45) vb = vb / 512u * 10u;
            unsigned qa = (va + 500u) / 1000u, qb = (vb + 500u) / 1000u; if (qa > 63u) qa = 63u; if (qb > 63u) qb = 63u;
            const unsigned long long wait = (unsigned long long)(qa * 6400u + qb * 409600u); const unsigned long long t0 = __builtin_amdgcn_s_memrealtime();
            while (__builtin_amdgcn_s_memrealtime() - t0 < wait) __builtin_amdgcn_s_sleep(8); }
        continue;
#endif
        if (ph + 1 < ph_hi) { XcdBarrier bar; bar.bar = F.ctl + CW_BAR; bar.x = xb_xcc_id(); bar.st = F.MISC + 8; xcd_barrier(bar); }
    }
}

extern "C" void kernel_launch(void* const* d_in, const int* in_sizes, int n_in, void* d_out, int out_size, void* d_ws, size_t ws_size, hipStream_t stream) {
    static int grid = 0;
    if (grid == 0) {
        if (n_in != 25 || in_sizes[0] != M_TOK * DM || out_size != M_TOK * DM || ws_size < WS_END) { fprintf(stderr, "kernel_launch: unexpected shapes (n_in %d, in0 %d, out %d, ws %zu)\n", n_in, n_in > 0 ? in_sizes[0] : -1, out_size, ws_size); grid = -1; return; }
        int dev = 0, cus = 0, per_cu = 0;
        if (hipGetDevice(&dev) != hipSuccess || hipDeviceGetAttribute(&cus, hipDeviceAttributeMultiprocessorCount, dev) != hipSuccess) { grid = -1; return; }
        if (hipFuncSetAttribute((const void*)hyb_fwd, hipFuncAttributeMaxDynamicSharedMemorySize, LDS_BYTES) != hipSuccess) { fprintf(stderr, "kernel_launch: hipFuncSetAttribute failed\n"); grid = -1; return; }
        if (hipOccupancyMaxActiveBlocksPerMultiprocessor(&per_cu, (const void*)hyb_fwd, NTHREADS, LDS_BYTES) != hipSuccess || per_cu < 1)
            fprintf(stderr, "kernel_launch: note: occupancy query reports %d workgroups per CU\n", per_cu);
        (void)hipGetLastError();
        grid = cus;
    }
    if (grid < 0) return;
    if (hipMemsetAsync((char*)d_ws + WS_CTL, 0, CTL_ZERO_BYTES, stream) != hipSuccess) { fprintf(stderr, "kernel_launch: memset failed\n"); return; }
    Args a{};
    for (int i = 0; i < 25; ++i) a.in[i] = (const float*)d_in[i];
    a.out = (float*)d_out; a.ws = (unsigned char*)d_ws;
#if MK_N_LAUNCHES == 1
    a.ph_lo = 0; a.ph_hi = N_PHASES;
    hipLaunchKernelGGL(hyb_fwd, dim3(grid), dim3(NTHREADS), LDS_BYTES, stream, a);
#else
    for (int p = 0; p < N_PHASES; ++p) { a.ph_lo = p; a.ph_hi = p + 1; hipLaunchKernelGGL(hyb_fwd, dim3(grid), dim3(NTHREADS), LDS_BYTES, stream, a); }
#endif
    const hipError_t le = hipPeekAtLastError();
    if (le != hipSuccess) fprintf(stderr, "kernel_launch: launch failed: %s\n", hipGetErrorName(le));
}
```

```cpp
#include <hip/hip_runtime.h>
#include <cstdio>
#include <cstdint>

#define LAS __attribute__((address_space(3)))
#define GAS __attribute__((address_space(1)))
typedef unsigned short bf16_t;
typedef short bf16x8 __attribute__((ext_vector_type(8)));
typedef short bf16x4 __attribute__((ext_vector_type(4)));
typedef float f32x4 __attribute__((ext_vector_type(4)));
typedef float f32x2 __attribute__((ext_vector_type(2)));
typedef unsigned u32x4 __attribute__((ext_vector_type(4)));
typedef unsigned u32x2 __attribute__((ext_vector_type(2)));
typedef __bf16 bf16x2_t __attribute__((ext_vector_type(2)));

constexpr int M_TOK = 16384, SEQ = 4096, NBATCH = 4, DM = 1024, FF = 2816, NGU = 2 * FF, NIN = 3584, DEPTH = 2;
constexpr int PLD = 3328;
constexpr int PQ = 0, PK = 256, PV = 512, PO = 768, PZ = 1024, PX = 1536, PDQ = 2560, PDK = 2816, PDV = 3072;
constexpr float NORM_EPS = 1e-6f;
constexpr float LOG2E = 1.4426950408889634f;

__device__ __forceinline__ unsigned cvtpk(float lo, float hi) { f32x2 v = {lo, hi}; bf16x2_t b = __builtin_convertvector(v, bf16x2_t); return __builtin_bit_cast(unsigned, b); }
__device__ __forceinline__ bf16_t f2bf(float f) { return (bf16_t)(cvtpk(f, 0.f) & 0xffffu); }
__device__ __forceinline__ float bf2f(bf16_t h) { return __uint_as_float(((unsigned)h) << 16); }
__device__ __forceinline__ float bflo(unsigned w) { return __uint_as_float(w << 16); }
__device__ __forceinline__ float bfhi(unsigned w) { return __uint_as_float(w & 0xffff0000u); }
__device__ __forceinline__ float fast_exp(float x) { return __builtin_amdgcn_exp2f(x * LOG2E); }
__device__ __forceinline__ float fast_rcp(float x) { return __builtin_amdgcn_rcpf(x); }
__device__ __forceinline__ float fast_log1pexp(float x) { const float e = __builtin_amdgcn_exp2f(x * LOG2E); return __builtin_amdgcn_logf(1.0f + e) * 0.6931471805599453f; }
__device__ __forceinline__ float sigmoidf_(float x) { return fast_rcp(1.f + fast_exp(-x)); }
__device__ __forceinline__ float siluf_(float x) { return x * sigmoidf_(x); }

__device__ __forceinline__ void st16_wt(void* p, u32x4 v) { asm volatile("global_store_dwordx4 %0, %1, off sc1\n\ts_nop 1" :: "v"(p), "v"(v) : "memory"); }

namespace pg8 {
constexpr int BM = 256, BK = 64, HALF = 128, HTB = HALF * BK * 2, STAGE_BYTES = 8 * HTB, NXCD = 8, WGM = 8;
__host__ __device__ __forceinline__ int lds_byte(int r, int c) { const int st = (r >> 4) * 2 + (c >> 5), rr = r & 15, cc = c & 31, ob = rr * 64 + cc * 2; return st * 1024 + (ob ^ (((ob >> 9) & 1) << 5)); }
__host__ __device__ __forceinline__ void stage_rc(int b, int& R, int& C) { const int st = b / 1024, sb = b % 1024, swz = sb ^ (((sb >> 9) & 1) << 5); R = (st >> 1) * 16 + swz / 64; C = (st & 1) * 32 + (swz % 64) / 2; }
__host__ __device__ __forceinline__ int perm32(int rho) { const int n = rho >> 4, i = rho & 15; return 8 * (i >> 2) + 4 * n + (i & 3); }

struct Unit { int pm, pn; };
struct Gemm { const bf16_t* A; const bf16_t* Bt; int M, N, K, lda; };

struct StaticOrder {
    int nM, nN, nwg, G, c;
    __device__ void init(int M, int N, int G_, int c_) { nM = M / BM; nN = N / BM; nwg = nM * nN; G = G_; c = c_; }
    __device__ bool next(int i, Unit& u) const {
        const long L = (long)i * G + c; if (L >= nwg) return false;
        int wgid = (int)L; { const int q = nwg / NXCD, r = nwg % NXCD, xcd = wgid % NXCD, off = wgid / NXCD; wgid = (xcd < r ? xcd * (q + 1) : r * (q + 1) + (xcd - r) * q) + off; }
        const int nig = WGM * nN, gid = wgid / nig, fm = gid * WGM, gsz = (nM - fm) < WGM ? (nM - fm) : WGM;
        u.pm = fm + ((wgid % nig) % gsz); u.pn = (wgid % nig) / gsz; return true;
    }
};

template <class Epi, bool ALIGN_EPI, bool SP2>
__device__ __forceinline__ void gemm_phase(LAS unsigned char* lds, const Gemm g, const StaticOrder& S, const Epi& E, const int tid) {
    const int wid = __builtin_amdgcn_readfirstlane(tid >> 6), lane = tid & 63, wr = wid >> 2, wc = wid & 3, fr = lane & 15, fq = lane >> 4;
    const int K = g.K, nt = K / BK, lda = g.lda;
    unsigned voffA[2], voffB[2];
#pragma unroll
    for (int i = 0; i < 2; ++i) { int R, C; stage_rc(tid * 16 + i * 8192, R, C); const int Rb = (R & ~31) + perm32(R & 31);
        voffA[i] = (unsigned)(R * lda + C) * 2u; voffB[i] = (unsigned)(Rb * K + C) * 2u; }
    const size_t kstep = (size_t)(BK * 2);
    const size_t hstepA = (size_t)HALF * lda * 2, hstepB = (size_t)HALF * K * 2;
    const size_t tstepA = 2 * hstepA, tstepB = 2 * hstepB;
    const unsigned ldsw = (unsigned)wid * 1024u;
    const int aoff = lds_byte(wr * 64 + fr, fq * 8), boff = lds_byte(wc * 32 + fr, fq * 8);
#define PG8_SA(b, h) (((b) * 2 + (h)) * HTB)
#define PG8_SB(b, h) ((4 + (b) * 2 + (h)) * HTB)
#define PG8_STAGE(bufoff, gbase, voff) do { _Pragma("unroll") for (int _i = 0; _i < 2; ++_i) \
        __builtin_amdgcn_global_load_lds((const unsigned*)((const char*)(gbase) + (voff)[_i]), (LAS unsigned*)(lds + (bufoff) + ldsw + _i * 8192), 16, 0, 0); } while (0)
#define PG8_LDA(dst, b, h) do { _Pragma("unroll") for (int m = 0; m < 4; ++m) _Pragma("unroll") for (int k = 0; k < 2; ++k) dst[m][k] = *(const LAS bf16x8*)(lds + PG8_SA(b, h) + aoff + m * 2048 + k * 1024); } while (0)
#define PG8_LDB(dst, b, h) do { _Pragma("unroll") for (int n = 0; n < 2; ++n) _Pragma("unroll") for (int k = 0; k < 2; ++k) dst[n][k] = *(const LAS bf16x8*)(lds + PG8_SB(b, h) + boff + n * 2048 + k * 1024); } while (0)
#define PG8_MMA(ai, bj, At, Bt) do { __builtin_amdgcn_s_setprio(1); _Pragma("unroll") for (int m = 0; m < 4; ++m) _Pragma("unroll") for (int n = 0; n < 2; ++n) _Pragma("unroll") for (int k = 0; k < 2; ++k) \
        acc[ai][bj][m][n] = __builtin_amdgcn_mfma_f32_16x16x32_bf16(Bt[n][k], At[m][k], acc[ai][bj][m][n], 0, 0, 0); __builtin_amdgcn_s_setprio(0); } while (0)
#define PG8_WAIT_V(n) asm volatile("s_waitcnt vmcnt(" #n ")" ::: "memory")
#define PG8_WAIT_L(n) asm volatile("s_waitcnt lgkmcnt(" #n ")" ::: "memory")
#define PG8_BAR __builtin_amdgcn_s_barrier()
#define PG8_SCHED __builtin_amdgcn_sched_barrier(0)
    Unit cur, nxt; int ui = 0;
    if (!S.next(0, cur)) return;
    f32x4 acc[2][2][4][2];
    typename Epi::Raw raw; E.init_load(raw, cur, wr, wc, fr, fq);
    if constexpr (!Epi::HAS_INIT) {
#pragma unroll
    for (int a = 0; a < 2; ++a)
#pragma unroll
        for (int b = 0; b < 2; ++b)
#pragma unroll
            for (int m = 0; m < 4; ++m)
#pragma unroll
                for (int n = 0; n < 2; ++n) acc[a][b][m][n] = (f32x4){0.f, 0.f, 0.f, 0.f};
    }
    bf16x8 At[4][2], B0[2][2], B1[2][2];
    const char* cA = (const char*)g.A + (size_t)cur.pm * tstepA; const char* cB = (const char*)g.Bt + (size_t)cur.pn * tstepB;
    if constexpr (SP2) {
        PG8_STAGE(PG8_SB(0, 0), cB, voffB); PG8_STAGE(PG8_SB(0, 1), cB + hstepB, voffB); PG8_STAGE(PG8_SA(0, 0), cA, voffA); PG8_STAGE(PG8_SA(0, 1), cA + hstepA, voffA);
        if constexpr (Epi::HAS_INIT) E.init_finish(raw, acc);
        if (wr == 1) PG8_BAR;
        PG8_WAIT_V(2); PG8_BAR;
        PG8_STAGE(PG8_SB(1, 0), cB + kstep, voffB); PG8_STAGE(PG8_SA(1, 0), cA + kstep, voffA); PG8_STAGE(PG8_SB(1, 1), cB + hstepB + kstep, voffB);
        PG8_WAIT_V(6); PG8_BAR;
    } else {
        PG8_STAGE(PG8_SB(0, 0), cB, voffB); PG8_STAGE(PG8_SA(0, 0), cA, voffA); PG8_STAGE(PG8_SB(0, 1), cB + hstepB, voffB); PG8_STAGE(PG8_SA(0, 1), cA + hstepA, voffA);
        if (wr == 1) PG8_BAR;
        PG8_WAIT_V(4); PG8_BAR;
        PG8_STAGE(PG8_SB(1, 0), cB + kstep, voffB); PG8_STAGE(PG8_SA(1, 0), cA + kstep, voffA); PG8_STAGE(PG8_SB(1, 1), cB + hstepB + kstep, voffB);
        PG8_WAIT_V(6); PG8_BAR;
    }
    for (;;) {
        const bool has_next = S.next(ui + 1, nxt);
        const char* nA = has_next ? (const char*)g.A + (size_t)nxt.pm * tstepA : cA; const char* nB = has_next ? (const char*)g.Bt + (size_t)nxt.pn * tstepB : cB;
        for (int t = 0; t < nt; t += 2) {
            const bool last = (t == nt - 2);
            const char* a1 = cA + (size_t)(t + 1) * kstep;
            const char* a2 = last ? nA : cA + (size_t)(t + 2) * kstep; const char* b2 = last ? nB : cB + (size_t)(t + 2) * kstep;
            const char* a3 = a2 + kstep; const char* b3 = b2 + kstep;
            if constexpr (SP2) {
            PG8_LDB(B0, 0, 0); PG8_LDB(B1, 0, 1); PG8_SCHED; PG8_LDA(At, 0, 0); PG8_STAGE(PG8_SA(1, 1), a1 + hstepA, voffA);
            PG8_WAIT_V(8); PG8_WAIT_L(0); PG8_BAR; PG8_MMA(0, 0, At, B0); PG8_MMA(0, 1, At, B1); PG8_BAR; PG8_SCHED;
            PG8_LDA(At, 0, 1); PG8_STAGE(PG8_SB(0, 0), b2, voffB); PG8_STAGE(PG8_SB(0, 1), b2 + hstepB, voffB); PG8_STAGE(PG8_SA(0, 0), a2, voffA);
            PG8_WAIT_V(8); PG8_WAIT_L(0); PG8_BAR; PG8_MMA(1, 0, At, B0); PG8_MMA(1, 1, At, B1); PG8_BAR; PG8_SCHED;
            PG8_LDB(B0, 1, 0); PG8_LDB(B1, 1, 1); PG8_SCHED; PG8_LDA(At, 1, 0); PG8_STAGE(PG8_SA(0, 1), a2 + hstepA, voffA);
            PG8_WAIT_V(8); PG8_WAIT_L(0); PG8_BAR; PG8_MMA(0, 0, At, B0); PG8_MMA(0, 1, At, B1); PG8_BAR; PG8_SCHED;
            PG8_LDA(At, 1, 1); PG8_STAGE(PG8_SB(1, 0), b3, voffB); PG8_STAGE(PG8_SB(1, 1), b3 + hstepB, voffB); PG8_STAGE(PG8_SA(1, 0), a3, voffA);
            PG8_WAIT_V(8); PG8_WAIT_L(0); PG8_BAR; PG8_MMA(1, 0, At, B0); PG8_MMA(1, 1, At, B1); PG8_BAR; PG8_SCHED;
            } else {
            PG8_LDB(B0, 0, 0); PG8_SCHED; PG8_LDA(At, 0, 0); PG8_STAGE(PG8_SA(1, 1), a1 + hstepA, voffA);
            PG8_WAIT_L(8); PG8_BAR; PG8_WAIT_L(0); PG8_MMA(0, 0, At, B0); PG8_BAR; PG8_SCHED;
            PG8_LDB(B1, 0, 1); PG8_STAGE(PG8_SB(0, 0), b2, voffB);
            PG8_BAR; PG8_WAIT_L(0); PG8_MMA(0, 1, At, B1); PG8_BAR;
            PG8_LDA(At, 0, 1); PG8_STAGE(PG8_SA(0, 0), a2, voffA);
            PG8_BAR; PG8_WAIT_L(0); PG8_MMA(1, 0, At, B0); PG8_BAR; PG8_SCHED;
            PG8_STAGE(PG8_SB(0, 1), b2 + hstepB, voffB);
            PG8_WAIT_V(6); PG8_BAR; PG8_MMA(1, 1, At, B1); PG8_BAR;
            PG8_LDB(B0, 1, 0); PG8_SCHED; PG8_LDA(At, 1, 0); PG8_STAGE(PG8_SA(0, 1), a2 + hstepA, voffA);
            PG8_WAIT_L(8); PG8_BAR; PG8_WAIT_L(0); PG8_MMA(0, 0, At, B0); PG8_BAR; PG8_SCHED;
            PG8_LDB(B1, 1, 1); PG8_STAGE(PG8_SB(1, 0), b3, voffB);
            PG8_BAR; PG8_WAIT_L(0); PG8_MMA(0, 1, At, B1); PG8_BAR;
            PG8_LDA(At, 1, 1); PG8_STAGE(PG8_SA(1, 0), a3, voffA);
            PG8_BAR; PG8_WAIT_L(0); PG8_MMA(1, 0, At, B0); PG8_BAR; PG8_SCHED;
            PG8_STAGE(PG8_SB(1, 1), b3 + hstepB, voffB);
            PG8_WAIT_V(6); PG8_BAR; PG8_MMA(1, 1, At, B1); PG8_BAR;
            }
        }
        if constexpr (ALIGN_EPI) { if (wr == 0) PG8_BAR; }
        E(acc, cur, wr, wc, fr, fq);
        if (!has_next) break;
#pragma unroll
        for (int a = 0; a < 2; ++a)
#pragma unroll
            for (int b = 0; b < 2; ++b)
#pragma unroll
                for (int m = 0; m < 4; ++m)
#pragma unroll
                    for (int n = 0; n < 2; ++n) acc[a][b][m][n] = (f32x4){0.f, 0.f, 0.f, 0.f};
        cur = nxt; cA = nA; cB = nB; ++ui;
        if constexpr (ALIGN_EPI) { if (wr == 1) PG8_BAR; }
    }
    PG8_WAIT_V(0);
    if constexpr (!ALIGN_EPI) { if (wr == 0) PG8_BAR; }
    PG8_BAR;
#undef PG8_SA
#undef PG8_SB
#undef PG8_STAGE
#undef PG8_LDA
#undef PG8_LDB
#undef PG8_MMA
#undef PG8_WAIT_V
#undef PG8_WAIT_L
#undef PG8_BAR
#undef PG8_SCHED
}
}
constexpr size_t MiB = 1u << 20;
constexpr size_t WS_CTL = 0, CTL_ZERO_BYTES = 1 * MiB;
constexpr size_t WS_SSQ = 1 * MiB;
constexpr size_t WS_GATES = 2 * MiB;
constexpr size_t WS_NST = 3 * MiB;
constexpr size_t WS_W = 4 * MiB;
constexpr size_t W_GU1 = 0, W_D1 = 11 * MiB, W_IN = W_D1 + 11 * MiB / 2, W_OUT = W_IN + 7 * MiB, W_GU2 = W_OUT + 2 * MiB, W_D2 = W_GU2 + 11 * MiB, W_LAYER = 42 * MiB;
static_assert(W_D2 + 11 * MiB / 2 == W_LAYER, "weights map");
constexpr size_t WS_XB = 88 * MiB;
constexpr size_t WS_CST = 120 * MiB;
constexpr size_t WS_SST = 128 * MiB;
constexpr size_t WS_PROJ = 144 * MiB;
constexpr size_t WS_END = 248 * MiB;
static_assert(WS_PROJ + (size_t)M_TOK * PLD * 2 <= WS_END, "ws map");

constexpr int CW_BAR = 4096;
constexpr int CW_Q = 16384;

constexpr int RING_BYTES = 131072;
constexpr int LDSCTL_OFF = RING_BYTES, MISC_OFF = LDSCTL_OFF + 320;
constexpr int LDS_BYTES = 147456;
constexpr int NWAVES = 8, NTHREADS = 512;

typedef GAS unsigned gu32;
#define RLX_AGENT __ATOMIC_RELAXED, __HIP_MEMORY_SCOPE_AGENT
#define LDS_WAIT() asm volatile("s_waitcnt lgkmcnt(0)" ::: "memory")
#define VM_WAIT() asm volatile("s_waitcnt vmcnt(0)" ::: "memory")

#define XB_TMO      128
#define XB_XCNT(j)  (256  + 64 * (j))
#define XB_XSUB(j)  (1280 + 64 * (j))
#define XB_XGEN(j)  (2304 + 64 * (j))
#define XB_TOP      3328
#define XB_TOPGEN   3392
#define XCD_BAR_WORDS 3456
#define XB_SPIN_CAP (1u << 22)
__device__ __forceinline__ unsigned xb_ld(unsigned* p)              { return __hip_atomic_load(p, __ATOMIC_RELAXED, __HIP_MEMORY_SCOPE_AGENT); }
__device__ __forceinline__ unsigned xb_add(unsigned* p, unsigned v) { return __hip_atomic_fetch_add(p, v, __ATOMIC_RELAXED, __HIP_MEMORY_SCOPE_AGENT); }
__device__ __forceinline__ unsigned xb_xcc_id() { return (unsigned)__builtin_amdgcn_s_getreg((3 << 11) | 20) & 0xFu; }
#define XB_SPIN(cond, bar) do { unsigned _sp = 0; while (cond) { __builtin_amdgcn_s_sleep(1); \
    if ((++_sp & 255u) == 0u) { if (xb_ld(&(bar)[XB_TMO])) break; if (_sp > XB_SPIN_CAP) { atomicAdd(&(bar)[XB_TMO], 1u); break; } } } } while (0)
struct XcdBarrier { unsigned* bar; unsigned x; volatile LAS unsigned* st; };
__device__ __forceinline__ XcdBarrier xcd_barrier_post(unsigned* bar, volatile LAS unsigned* st) {
    XcdBarrier b; b.bar = bar; b.x = xb_xcc_id(); b.st = st;
    if (threadIdx.x == 0) (void)xb_add(&bar[XB_XCNT(b.x)], 1u);
    return b;
}
__device__ __forceinline__ void xcd_barrier_complete(unsigned* bar, unsigned x, unsigned& nloc, unsigned& nx) {
    const unsigned G = gridDim.x * gridDim.y * gridDim.z;
    unsigned sum, cnt, mine, sp = 0u;
    for (;;) {
        sum = 0u; cnt = 0u; mine = 0u;
#pragma unroll
        for (unsigned j = 0; j < 16; ++j) { const unsigned c = xb_ld(&bar[XB_XCNT(j)]); sum += c; cnt += (c > 0u) ? 1u : 0u; mine = (j == x) ? c : mine; }
        if (sum == G) break;
        __builtin_amdgcn_s_sleep(1);
        if ((++sp & 255u) == 0u) { if (xb_ld(&bar[XB_TMO])) break; if (sp > XB_SPIN_CAP) { atomicAdd(&bar[XB_TMO], 1u); break; } }
    }
    nloc = mine > 0u ? mine : 1u; nx = cnt > 0u ? cnt : 1u;
}
__device__ __forceinline__ void xcd_barrier(const XcdBarrier& b) {
    asm volatile("s_waitcnt vmcnt(0)" ::: "memory");
    __syncthreads();
    if (threadIdx.x == 0) {
        unsigned* bar = b.bar;
        __builtin_amdgcn_s_waitcnt(0);
        unsigned nloc = b.st[0], nx = b.st[1];
        if (nloc == 0u) { xcd_barrier_complete(bar, b.x, nloc, nx); b.st[0] = nloc; b.st[1] = nx; }
        const unsigned old = xb_add(&bar[XB_XSUB(b.x)], 1u);
        const unsigned gen = old / nloc;
        if (old + 1u == (gen + 1u) * nloc) {
            __builtin_amdgcn_fence(__ATOMIC_RELEASE, "agent");
            asm volatile("s_waitcnt vmcnt(0)" ::: "memory");
            const unsigned og = xb_add(&bar[XB_TOP], 1u);
            const unsigned tg = og / nx;
            if (og + 1u == (tg + 1u) * nx) xb_add(&bar[XB_TOPGEN], 1u);
            else XB_SPIN(xb_ld(&bar[XB_TOPGEN]) == tg, bar);
            __builtin_amdgcn_fence(__ATOMIC_ACQUIRE, "agent");
            xb_add(&bar[XB_XGEN(b.x)], 1u);
            asm volatile("s_waitcnt vmcnt(0)" ::: "memory");
        } else {
            XB_SPIN(xb_ld(&bar[XB_XGEN(b.x)]) == gen, bar);
            __builtin_amdgcn_fence(__ATOMIC_ACQUIRE, "agent");
            asm volatile("s_waitcnt vmcnt(0)" ::: "memory");
        }
    }
    __syncthreads();
}

struct Args { const float* in[25]; float* out; unsigned char* ws; int ph_lo, ph_hi; };
typedef const float* fptr_t; typedef __attribute__((address_space(4))) const fptr_t* kinptr_t;
struct ArgView { kinptr_t in; };
struct Frame {
    LAS unsigned char* lds;
    volatile LAS unsigned* MISC;
    unsigned* ctl;
    int tid, lane, wave, vcu, G;
    kinptr_t in;
    unsigned char* ws;
};
__device__ __forceinline__ float wave_sum(float v) {
#pragma unroll
    for (int o = 1; o < 64; o <<= 1) v += __shfl_xor(v, o);
    return v;
}
__device__ __forceinline__ int q_next(Frame& F, int q) {
    __syncthreads();
    if (F.tid == 0) F.MISC[16] = xb_add(F.ctl + CW_Q + 64 * q, 1u);
    __syncthreads();
    return (int)F.MISC[16];
}

struct MapPlain { __device__ __forceinline__ int row(int n) const { return n; } __device__ __forceinline__ float scale(int) const { return 1.f; } };
struct MapGU { int off; __device__ __forceinline__ int row(int n) const { return 256 * (n >> 7) + off + (n & 127); } __device__ __forceinline__ float scale(int) const { return 1.f; } };
struct MapIn {
    __device__ __forceinline__ int row(int n) const {
        if (n < 1024) return n;
        if (n < 1032) return 13 * 256 + (n - 1024);
        if (n < 1544) return 4 * 256 + (n - 1032);
        if (n < 2568) return 6 * 256 + (n - 1544);
        if (n < 2576) return 13 * 256 + 8 + (n - 2568);
        return 10 * 256 + (n - 2576);
    }
    __device__ __forceinline__ float scale(int n) const { return (n >= 256 && n < 512) ? 0.125f : 1.f; }
};
template <class Map>
__device__ __forceinline__ void p0_transpose_item(const float* W, int K, int N, bf16_t* WT, int item, int lane, const float* gain, const Map map) {
    const int nblk = (N + 63) / 64, kb = item / nblk, nb = item % nblk, k0 = 64 * kb, n = 64 * nb + lane;
    if (n >= N) return;
    const float* src = W + (size_t)k0 * N + n;
    float v[64];
#pragma unroll
    for (int i = 0; i < 64; ++i) v[i] = src[(size_t)i * N];
    const float sc = map.scale(n);
    if (gain) {
#pragma unroll
        for (int i = 0; i < 64; i += 4) { const f32x4 g = *(const f32x4*)(gain + k0 + i); v[i] *= g.x; v[i + 1] *= g.y; v[i + 2] *= g.z; v[i + 3] *= g.w; }
    }
    u32x4* dst = (u32x4*)(WT + (size_t)map.row(n) * K + k0);
#pragma unroll
    for (int c = 0; c < 8; ++c) { u32x4 o; o.x = cvtpk(v[8 * c] * sc, v[8 * c + 1] * sc); o.y = cvtpk(v[8 * c + 2] * sc, v[8 * c + 3] * sc); o.z = cvtpk(v[8 * c + 4] * sc, v[8 * c + 5] * sc); o.w = cvtpk(v[8 * c + 6] * sc, v[8 * c + 7] * sc); dst[c] = o; }
}
constexpr int I_G = (DM / 64) * (FF / 64), I_D = (FF / 64) * (DM / 64), I_IN = (DM / 64) * ((3344 + 63) / 64), I_OUT = (DM / 64) * (DM / 64);
constexpr int R_GU1 = 0, R_D1 = 2 * I_G, R_IN = R_D1 + I_D, R_OUT = R_IN + I_IN, R_GU2 = R_OUT + I_OUT, R_D2 = R_GU2 + 2 * I_G, R_END = R_D2 + I_D;
__device__ __forceinline__ void convert_items(Frame& F, int l, int r_lo, int r_hi, int gw, int NGW) {
    bf16_t* WL = (bf16_t*)(F.ws + WS_W + (size_t)l * W_LAYER);
    for (int it = r_lo + gw; it < r_hi; it += NGW) {
        int r = it;
        if (r < I_G) { p0_transpose_item(F.in[2] + (size_t)l * DM * FF, DM, FF, (bf16_t*)((char*)WL + W_GU1), r, F.lane, F.in[1] + l * DM, MapGU{0}); continue; } r -= I_G;
        if (r < I_G) { p0_transpose_item(F.in[3] + (size_t)l * DM * FF, DM, FF, (bf16_t*)((char*)WL + W_GU1), r, F.lane, F.in[1] + l * DM, MapGU{128}); continue; } r -= I_G;
        if (r < I_D) { p0_transpose_item(F.in[4] + (size_t)l * FF * DM, FF, DM, (bf16_t*)((char*)WL + W_D1), r, F.lane, nullptr, MapPlain{}); continue; } r -= I_D;
        if (r < I_IN) { p0_transpose_item(F.in[6] + (size_t)l * DM * 3344, DM, 3344, (bf16_t*)((char*)WL + W_IN), r, F.lane, F.in[5] + l * DM, MapIn{}); continue; } r -= I_IN;
        if (r < I_OUT) { p0_transpose_item(F.in[20] + (size_t)l * DM * DM, DM, DM, (bf16_t*)((char*)WL + W_OUT), r, F.lane, nullptr, MapPlain{}); continue; } r -= I_OUT;
        if (r < I_G) { p0_transpose_item(F.in[22] + (size_t)l * DM * FF, DM, FF, (bf16_t*)((char*)WL + W_GU2), r, F.lane, F.in[21] + l * DM, MapGU{0}); continue; } r -= I_G;
        if (r < I_G) { p0_transpose_item(F.in[23] + (size_t)l * DM * FF, DM, FF, (bf16_t*)((char*)WL + W_GU2), r, F.lane, F.in[21] + l * DM, MapGU{128}); continue; } r -= I_G;
        p0_transpose_item(F.in[24] + (size_t)l * FF * DM, FF, DM, (bf16_t*)((char*)WL + W_D2), r, F.lane, nullptr, MapPlain{});
    }
    if (r_lo <= R_IN && R_IN < r_hi) {
        u32x4* z = (u32x4*)(F.ws + WS_W + (size_t)l * W_LAYER + W_IN + (size_t)(13 * 256 + 16) * DM * 2);
        const int n16 = 240 * DM * 2 / 16;
        unsigned z0 = 0u; asm volatile("" : "+v"(z0));
        for (int i = gw * 64 + F.lane; i < n16; i += NGW * 64) z[i] = (u32x4){z0, z0, z0, z0};
    }
}
__device__ __forceinline__ void side_convert(Frame& F, int l, int k) {
    if ((int)blockIdx.x < 128 || F.G != 256) return;
    const int gw = ((int)blockIdx.x - 128) * NWAVES + F.wave, NGW = 128 * NWAVES;
    if (l == 0 && k == 0) convert_items(F, 0, R_D1, R_OUT, gw, NGW);
    else if (l == 0 && k == 2) convert_items(F, 0, R_OUT, R_END, gw, NGW);
    else if (l == 0 && k == 7) convert_items(F, 1, R_GU1, R_D1, gw, NGW);
    else if (l == 1 && k == 0) convert_items(F, 1, R_D1, R_GU2, gw, NGW);
    else if (l == 1 && k == 2) convert_items(F, 1, R_GU2, R_D2, gw, NGW);
    else if (l == 1 && k == 7) convert_items(F, 1, R_D2, R_END, gw, NGW);
}
__device__ __forceinline__ void p0_prologue(Frame& F) {
    const int gw = F.vcu * NWAVES + F.wave, NGW = F.G * NWAVES;
    if (F.G == 256) convert_items(F, 0, R_GU1, R_D1, gw, NGW);
    else { convert_items(F, 0, 0, R_END, gw, NGW); convert_items(F, 1, 0, R_END, gw, NGW); }
    const float* x = F.in[0]; bf16_t* XB = (bf16_t*)(F.ws + WS_XB); float* SSQ = (float*)(F.ws + WS_SSQ);
    for (int m = gw; m < M_TOK; m += NGW) {
        const f32x4* xr = (const f32x4*)(x + (size_t)m * DM) + F.lane; float s = 0.f; f32x4 v[4];
#pragma unroll
        for (int j = 0; j < 4; ++j) { v[j] = xr[64 * j]; s += (v[j].x * v[j].x + v[j].y * v[j].y) + (v[j].z * v[j].z + v[j].w * v[j].w); }
        s = wave_sum(s);
        u32x2* o8 = (u32x2*)(XB + (size_t)m * DM) + F.lane;
#pragma unroll
        for (int j = 0; j < 4; ++j) o8[64 * j] = (u32x2){cvtpk(v[j].x, v[j].y), cvtpk(v[j].z, v[j].w)};
        if (F.lane < 16) SSQ[(size_t)m * 16 + F.lane] = (F.lane == 0) ? s : 0.f;
    }
}

__device__ __forceinline__ void rows_rs(const float* ssq, int rowbase, int fr, int fq, float (&rs)[8]) {
    f32x4 p[8];
#pragma unroll
    for (int i = 0; i < 8; ++i) { const int row = rowbase + (i >> 2) * 128 + (i & 3) * 16 + fr; p[i] = *(const f32x4*)(ssq + (size_t)row * 16 + 4 * fq); }
#pragma unroll
    for (int i = 0; i < 8; ++i) { float s = (p[i].x + p[i].y) + (p[i].z + p[i].w); s += __shfl_xor(s, 16); s += __shfl_xor(s, 32); rs[i] = rsqrtf(s * (1.0f / DM) + NORM_EPS); }
}
struct EpiNoInit { struct Raw {}; static constexpr bool HAS_INIT = false; __device__ __forceinline__ void init_load(Raw&, const pg8::Unit&, int, int, int, int) const {} };
struct EpiSwiglu : EpiNoInit {
    bf16_t* H; const float* ssq;
    __device__ __forceinline__ void operator()(const f32x4 (&acc)[2][2][4][2], const pg8::Unit& u, int wr, int wc, int fr, int fq) const {
        asm volatile("" : "+v"(fr), "+v"(fq));
        const int col0 = u.pn * 128 + wc * 32 + 8 * fq;
        float rs[8]; rows_rs(ssq, u.pm * 256 + wr * 64, fr, fq, rs);
#pragma unroll
        for (int ai = 0; ai < 2; ++ai)
#pragma unroll
            for (int m = 0; m < 4; ++m) {
                const int row = u.pm * 256 + ai * 128 + wr * 64 + m * 16 + fr; const float r = rs[ai * 4 + m];
                float hv[8];
#pragma unroll
                for (int n = 0; n < 2; ++n)
#pragma unroll
                    for (int j = 0; j < 4; ++j) { const float g = acc[ai][0][m][n][j] * r, up = acc[ai][1][m][n][j] * r; hv[4 * n + j] = siluf_(g) * up; }
                u32x4 w; w.x = cvtpk(hv[0], hv[1]); w.y = cvtpk(hv[2], hv[3]); w.z = cvtpk(hv[4], hv[5]); w.w = cvtpk(hv[6], hv[7]);
                st16_wt(H + (size_t)row * FF + col0, w);
                if (m & 1) asm volatile("" ::: "memory");
            }
    }
};
template <bool FINAL>
struct EpiResid {
    struct Raw { u32x4 r[2][4][2]; };
    static constexpr bool HAS_INIT = true;
    float* xout; bf16_t* XB; float* ssq; float alpha, ralpha;
    __device__ __forceinline__ void init_load(Raw& raw, const pg8::Unit& u, int wr, int wc, int fr, int fq) const {
        const int col0 = u.pn * 256 + wc * 32 + 8 * fq;
#pragma unroll
        for (int ai = 0; ai < 2; ++ai)
#pragma unroll
            for (int m = 0; m < 4; ++m) { const int row = u.pm * 256 + ai * 128 + wr * 64 + m * 16 + fr;
#pragma unroll
                for (int bj = 0; bj < 2; ++bj) raw.r[ai][m][bj] = *(const u32x4*)(XB + (size_t)row * DM + col0 + bj * 128); }
    }
    __device__ __forceinline__ void init_finish(const Raw& raw, f32x4 (&acc)[2][2][4][2]) const {
#pragma unroll
        for (int ai = 0; ai < 2; ++ai)
#pragma unroll
            for (int m = 0; m < 4; ++m)
#pragma unroll
                for (int bj = 0; bj < 2; ++bj) { const u32x4 w = raw.r[ai][m][bj];
                    acc[ai][bj][m][0] = (f32x4){bflo(w.x), bfhi(w.x), bflo(w.y), bfhi(w.y)} * ralpha; acc[ai][bj][m][1] = (f32x4){bflo(w.z), bfhi(w.z), bflo(w.w), bfhi(w.w)} * ralpha; }
    }
    __device__ __forceinline__ void operator()(const f32x4 (&acc)[2][2][4][2], const pg8::Unit& u, int wr, int wc, int fr, int fq) const {
        asm volatile("" : "+v"(fr), "+v"(fq));
        const int col0 = u.pn * 256 + wc * 32 + 8 * fq;
#pragma unroll
        for (int ai = 0; ai < 2; ++ai)
#pragma unroll
            for (int m = 0; m < 4; ++m) {
                const int row = u.pm * 256 + ai * 128 + wr * 64 + m * 16 + fr; float ss = 0.f;
#pragma unroll
                for (int bj = 0; bj < 2; ++bj) {
                    const size_t off = (size_t)row * DM + col0 + bj * 128;
                    const f32x4 y0 = acc[ai][bj][m][0] * alpha, y1 = acc[ai][bj][m][1] * alpha;
                    if (FINAL) { *(f32x4*)(xout + off) = y0; *(f32x4*)(xout + off + 4) = y1; }
                    else {
                        ss += (y0.x * y0.x + y0.y * y0.y) + (y0.z * y0.z + y0.w * y0.w) + (y1.x * y1.x + y1.y * y1.y) + (y1.z * y1.z + y1.w * y1.w);
                        u32x4 w; w.x = cvtpk(y0.x, y0.y); w.y = cvtpk(y0.z, y0.w); w.z = cvtpk(y1.x, y1.y); w.w = cvtpk(y1.z, y1.w);
                        st16_wt(XB + off, w); }
                }
                if (!FINAL) { ss += __shfl_xor(ss, 16); ss += __shfl_xor(ss, 32);
                    if (fq == 0) ssq[(size_t)row * 16 + u.pn * 4 + wc] = ss; }
                if (m & 1) asm volatile("" ::: "memory");
            }
    }
};
struct EpiInProj : EpiNoInit {
    bf16_t* PROJ; float* GATES; const float* ssq; const float* qnw; const float* knw; const float* gbias; const float* dtb;
    template <int KIND>
    __device__ __forceinline__ void body(const f32x4 (&acc)[2][2][4][2], const pg8::Unit& u, int wr, int wc, int fr, int fq, const float (&rs)[8]) const {
        const int t = u.pn, colw = wc * 32 + 8 * fq;
        float nw[8];
        if (KIND == 3) { const float* w = (t == 10 ? qnw : knw) + (wc & 1) * 32 + 8 * fq; const float sc = (t == 10) ? (0.17677669529663687f * LOG2E) : 1.f;
#pragma unroll
            for (int i = 0; i < 8; ++i) nw[i] = w[i] * sc; }
#pragma unroll
        for (int ai = 0; ai < 2; ++ai)
#pragma unroll
            for (int m = 0; m < 4; ++m) {
                const int row = u.pm * 256 + ai * 128 + wr * 64 + m * 16 + fr; const float r = rs[ai * 4 + m];
#pragma unroll
                for (int bj = 0; bj < 2; ++bj) {
                    float v[8];
#pragma unroll
                    for (int n = 0; n < 2; ++n)
#pragma unroll
                        for (int j = 0; j < 4; ++j) v[4 * n + j] = acc[ai][bj][m][n][j] * r;
                    if (KIND == 1) {
#pragma unroll
                        for (int i = 0; i < 8; ++i) v[i] = sigmoidf_(v[i]);
                    } else if (KIND == 2) {
#pragma unroll
                        for (int i = 0; i < 8; ++i) v[i] = siluf_(v[i]);
                    } else if (KIND == 3) {
                        float ss = 0.f;
#pragma unroll
                        for (int i = 0; i < 8; ++i) ss += v[i] * v[i];
                        ss += __shfl_xor(ss, 16); ss += __shfl_xor(ss, 32);
                        const float q = rsqrtf(ss * (1.0f / 32.0f) + NORM_EPS);
#pragma unroll
                        for (int i = 0; i < 8; ++i) v[i] = v[i] * q * nw[i];
                    }
                    u32x4 w; w.x = cvtpk(v[0], v[1]); w.y = cvtpk(v[2], v[3]); w.z = cvtpk(v[4], v[5]); w.w = cvtpk(v[6], v[7]);
                    st16_wt(PROJ + (size_t)row * PLD + t * 256 + bj * 128 + colw, w);
                }
                if (m & 1) asm volatile("" ::: "memory");
            }
    }
    __device__ __forceinline__ void gates(const f32x4 (&acc)[2][2][4][2], const pg8::Unit& u, int wr, int wc, int fr, int fq, const float (&rs)[8]) const {
        if (wc != 0 || fq >= 2) return;
#pragma unroll
        for (int ai = 0; ai < 2; ++ai)
#pragma unroll
            for (int m = 0; m < 4; ++m) {
                const int row = u.pm * 256 + ai * 128 + wr * 64 + m * 16 + fr; const float r = rs[ai * 4 + m];
                float v[8], o[8];
#pragma unroll
                for (int n = 0; n < 2; ++n)
#pragma unroll
                    for (int j = 0; j < 4; ++j) v[4 * n + j] = acc[ai][0][m][n][j] * r;
                if (fq == 0) {
#pragma unroll
                    for (int j = 0; j < 4; ++j) { o[j] = v[j] + gbias[j]; const float z = v[4 + j] + gbias[4 + j]; o[4 + j] = fminf(z, 0.f) - fast_log1pexp(-fabsf(z)); }
                } else {
#pragma unroll
                    for (int j = 0; j < 8; ++j) { const float z = v[j] + dtb[j]; o[j] = fmaxf(z, 0.f) + fast_log1pexp(-fabsf(z)); }
                }
                float* gp = GATES + (size_t)row * 16 + 8 * fq;
                *(f32x4*)gp = (f32x4){o[0], o[1], o[2], o[3]}; *(f32x4*)(gp + 4) = (f32x4){o[4], o[5], o[6], o[7]};
                asm volatile("" ::: "memory");
            }
    }
    __device__ __forceinline__ void operator()(const f32x4 (&acc)[2][2][4][2], const pg8::Unit& u, int wr, int wc, int fr, int fq) const {
        asm volatile("" : "+v"(fr), "+v"(fq));
        float rs[8]; rows_rs(ssq, u.pm * 256 + wr * 64, fr, fq, rs);
        const int t = u.pn;
        if (t == 13) gates(acc, u, wr, wc, fr, fq, rs);
        else if (t == 3) body<1>(acc, u, wr, wc, fr, fq, rs);
        else if (t == 4 || t == 5) body<2>(acc, u, wr, wc, fr, fq, rs);
        else if (t == 10 || t == 11) body<3>(acc, u, wr, wc, fr, fq, rs);
        else body<0>(acc, u, wr, wc, fr, fq, rs);
    }
};
#define MFMA16(a, b, c) __builtin_amdgcn_mfma_f32_16x16x32_bf16((a), (b), (c), 0, 0, 0)
#define WAVE_SYNC() do { asm volatile("s_waitcnt lgkmcnt(0)" ::: "memory"); __builtin_amdgcn_wave_barrier(); } while (0)
#define LDS_BARRIER() do { asm volatile("s_waitcnt lgkmcnt(0)" ::: "memory"); __builtin_amdgcn_s_barrier(); asm volatile("" ::: "memory"); } while (0)
__device__ __forceinline__ bf16x8 ld_g8(const bf16_t* p) { return *(const bf16x8*)p; }
__device__ __forceinline__ bf16x8 ld_l8(const LAS bf16_t* p) { return *(const LAS bf16x8*)p; }
__device__ __forceinline__ bf16x8 ld_l44(const LAS bf16_t* p0, const LAS bf16_t* p1) { const bf16x4 a = *(const LAS bf16x4*)p0, b = *(const LAS bf16x4*)p1; return (bf16x8){a[0], a[1], a[2], a[3], b[0], b[1], b[2], b[3]}; }
__device__ __forceinline__ bf16x8 pack8(const f32x4 a, const f32x4 b) { u32x4 w; w.x = cvtpk(a[0], a[1]); w.y = cvtpk(a[2], a[3]); w.z = cvtpk(b[0], b[1]); w.w = cvtpk(b[2], b[3]); return __builtin_bit_cast(bf16x8, w); }
__device__ __forceinline__ float wave_scan_incl(float v, int lane) {
#pragma unroll
    for (int o = 1; o < 64; o <<= 1) { const float t = __shfl_up(v, o); if (lane >= o) v += t; }
    return v;
}

typedef short v4i16_t __attribute__((ext_vector_type(4)));
__device__ __forceinline__ bf16x8 ld_tr8(const LAS bf16_t* T, int pitch, int k0, int c0, int lane) {
    const int i = lane & 15, fq = lane >> 4;
    const LAS bf16_t* p = T + (k0 + 8 * fq + (i >> 2)) * pitch + c0 + 4 * (i & 3);
    const v4i16_t lo = __builtin_amdgcn_ds_read_tr16_b64_v4i16((LAS v4i16_t*)p), hi = __builtin_amdgcn_ds_read_tr16_b64_v4i16((LAS v4i16_t*)(p + 4 * pitch));
    return (bf16x8){lo[0], lo[1], lo[2], lo[3], hi[0], hi[1], hi[2], hi[3]};
}
__device__ __forceinline__ bf16x8 ld_tr8p(const LAS bf16_t* T, int pitch, int k0, int c0, int lane) {
    const int i = lane & 15, fq = lane >> 4;
    const LAS bf16_t* p = T + (k0 + 4 * fq + (i >> 2)) * pitch + c0 + 4 * (i & 3);
    const v4i16_t lo = __builtin_amdgcn_ds_read_tr16_b64_v4i16((LAS v4i16_t*)p), hi = __builtin_amdgcn_ds_read_tr16_b64_v4i16((LAS v4i16_t*)(p + 16 * pitch));
    return (bf16x8){lo[0], lo[1], lo[2], lo[3], hi[0], hi[1], hi[2], hi[3]};
}

__device__ __forceinline__ void conv_phase(Frame& F, int l) {
    const bf16_t* PROJ = (const bf16_t*)(F.ws + WS_PROJ); bf16_t* XACT = (bf16_t*)F.in[25];
    const float* cw = F.in[9] + (size_t)l * 4 * 1024; const float* cb = F.in[10] + (size_t)l * 1024;
    for (int g = F.vcu * NTHREADS + F.tid; g < 1024 * 128; g += F.G * NTHREADS) {
        const int cg = g & 127, rb = g >> 7, ch0 = cg * 8, row0 = rb * 16;
        float w[4][8], bs[8];
#pragma unroll
        for (int j = 0; j < 4; ++j) { const f32x4 a = *(const f32x4*)(cw + j * 1024 + ch0), b = *(const f32x4*)(cw + j * 1024 + ch0 + 4);
            w[j][0] = a.x; w[j][1] = a.y; w[j][2] = a.z; w[j][3] = a.w; w[j][4] = b.x; w[j][5] = b.y; w[j][6] = b.z; w[j][7] = b.w; }
        { const f32x4 a = *(const f32x4*)(cb + ch0), b = *(const f32x4*)(cb + ch0 + 4); bs[0] = a.x; bs[1] = a.y; bs[2] = a.z; bs[3] = a.w; bs[4] = b.x; bs[5] = b.y; bs[6] = b.z; bs[7] = b.w; }
        float h3[8], h2[8], h1[8];
        const bool first = (row0 % SEQ) == 0;
        const bf16_t* src = PROJ + (size_t)row0 * PLD + PX + ch0;
        if (first) {
#pragma unroll
            for (int e = 0; e < 8; ++e) { h3[e] = 0.f; h2[e] = 0.f; h1[e] = 0.f; }
        } else {
            const u32x4 a = *(const u32x4*)(src - 3 * (size_t)PLD), b = *(const u32x4*)(src - 2 * (size_t)PLD), c = *(const u32x4*)(src - (size_t)PLD);
#pragma unroll
            for (int e = 0; e < 4; ++e) { h3[2 * e] = bflo(a[e]); h3[2 * e + 1] = bfhi(a[e]); h2[2 * e] = bflo(b[e]); h2[2 * e + 1] = bfhi(b[e]); h1[2 * e] = bflo(c[e]); h1[2 * e + 1] = bfhi(c[e]); }
        }
        u32x4 dr[16];
#pragma unroll
        for (int i = 0; i < 16; ++i) dr[i] = *(const u32x4*)(src + (size_t)i * PLD);
#pragma unroll
        for (int i = 0; i < 16; ++i) {
            const u32x4 d = dr[i]; float cur[8], o[8];
#pragma unroll
            for (int e = 0; e < 4; ++e) { cur[2 * e] = bflo(d[e]); cur[2 * e + 1] = bfhi(d[e]); }
#pragma unroll
            for (int e = 0; e < 8; ++e) { const float s = bs[e] + w[0][e] * h3[e] + w[1][e] * h2[e] + w[2][e] * h1[e] + w[3][e] * cur[e]; o[e] = siluf_(s); h3[e] = h2[e]; h2[e] = h1[e]; h1[e] = cur[e]; }
            u32x4 ow; ow.x = cvtpk(o[0], o[1]); ow.y = cvtpk(o[2], o[3]); ow.z = cvtpk(o[4], o[5]); ow.w = cvtpk(o[6], o[7]);
            *(u32x4*)(XACT + (size_t)(row0 + i) * 1024 + ch0) = ow;
        }
    }
}

__device__ __forceinline__ void mlstm_state_item(Frame& F, int bh) {
    const int b = bh >> 2, h = bh & 3, w = F.wave, vq = w & 3, dh = w >> 2, lane = F.lane, fr = lane & 15, fq = lane >> 4, tid = F.tid;
    constexpr int MP = 72, MBUF = 2 * 64 * MP * 2 + 128;
    LAS float* WG = (LAS float*)(F.lds + 2 * MBUF); LAS float* DEC = WG + 4096;
    const bf16_t* PROJ = (const bf16_t*)(F.ws + WS_PROJ); const float* GATES = (const float*)(F.ws + WS_GATES);
    bf16_t* CST = (bf16_t*)(F.ws + WS_CST); float* NST = (float*)(F.ws + WS_NST);
    const size_t rowb = (size_t)b * SEQ;
    for (int c = w; c < 64; c += 8) {
        const float* gq = GATES + (rowb + 64 * c + lane) * 16 + h; const float ig = gq[0], lf = gq[4];
        const float bs = wave_scan_incl(lf, lane); const float bl = __shfl(bs, 63);
        WG[64 * c + lane] = fast_exp(bl - bs + ig); if (lane == 0) DEC[c] = fast_exp(bl);
    }
    f32x4 acc[2], nacc[2];
    acc[0] = acc[1] = nacc[0] = nacc[1] = (f32x4){0.f, 0.f, 0.f, 0.f};
    const int ls = tid >> 3, lc = tid & 7;
    const bf16_t* kp = PROJ + (rowb + ls) * PLD + PK + h * 64 + 8 * lc; const bf16_t* vp = PROJ + (rowb + ls) * PLD + PV + h * 64 + 8 * lc;
    u32x4 k0, v0, k1, v1, k2, v2;
#define ML_LOAD(kr_, vr_, c_) do { const size_t o_ = (size_t)(c_) * 64 * PLD; kr_ = *(const u32x4*)(kp + o_); vr_ = *(const u32x4*)(vp + o_); } while (0)
#define ML_WRITE(kr_, vr_, c_) do { LAS bf16_t* KL_ = (LAS bf16_t*)(F.lds + ((c_) & 1) * MBUF); LAS bf16_t* VL_ = KL_ + 64 * MP; const float wg_ = WG[64 * (c_) + ls]; \
        *(LAS u32x4*)(KL_ + ls * MP + 8 * lc) = kr_; u32x4 o_; _Pragma("unroll") for (int e_ = 0; e_ < 4; ++e_) o_[e_] = cvtpk(wg_ * bflo(vr_[e_]), wg_ * bfhi(vr_[e_])); \
        *(LAS u32x4*)(VL_ + ls * MP + 8 * lc) = o_; if (lc == 0) (VL_ + 64 * MP)[ls] = f2bf(wg_); } while (0)
    LAS bf16_t* STG = (LAS bf16_t*)(F.lds + 2 * MBUF + 16384 + 256); LAS float* NSTG = (LAS float*)(STG + 2 * 4096);
#define ML_STAGE(c_) do { LAS bf16_t* sg_ = STG + ((c_) & 1) * 4096; \
        _Pragma("unroll") for (int dt = 0; dt < 2; ++dt) _Pragma("unroll") for (int r = 0; r < 4; ++r) sg_[(vq * 16 + 4 * fq + r) * 64 + dh * 32 + dt * 16 + fr] = f2bf(acc[dt][r]); \
        if (vq == 0 && fq == 0) { NSTG[((c_) & 1) * 64 + dh * 32 + fr] = nacc[0][0]; NSTG[((c_) & 1) * 64 + dh * 32 + 16 + fr] = nacc[1][0]; } } while (0)
    ML_LOAD(k0, v0, 0); ML_LOAD(k1, v1, 1); ML_LOAD(k2, v2, 2);
    __syncthreads();
    ML_WRITE(k0, v0, 0);
    ML_STAGE(0);
    LDS_BARRIER();
#define ML_STEP(KW, VW, KN, VN, c_) do { const int cc_ = (c_); const size_t ci = (size_t)bh * 64 + cc_; \
          \
        { const u32x4 st_ = *(const LAS u32x4*)(STG + ((cc_) & 1) * 4096 + tid * 8); *(u32x4*)(CST + ci * 4096 + tid * 8) = st_; \
          NST[ci * 64 + (tid & 63)] = NSTG[((cc_) & 1) * 64 + (tid & 63)]; }     \
        asm volatile("" ::: "memory"); \
        if (cc_ + 1 < 64) ML_WRITE(KW, VW, cc_ + 1); \
        asm volatile("" ::: "memory"); \
        ML_LOAD(KN, VN, (cc_ + 3 < 64 ? cc_ + 3 : 63)); \
        asm volatile("" ::: "memory"); \
        const float decay = DEC[cc_]; \
        const LAS bf16_t* KL = (const LAS bf16_t*)(F.lds + (cc_ & 1) * MBUF); const LAS bf16_t* VL = KL + 64 * MP; const LAS bf16_t* WV = VL + 64 * MP; \
        _Pragma("unroll") for (int dt = 0; dt < 2; ++dt) { acc[dt] = acc[dt] * decay; nacc[dt] = nacc[dt] * decay; } \
        _Pragma("unroll") for (int ks = 0; ks < 2; ++ks) { \
            const bf16x8 A = ld_tr8(VL, MP, 32 * ks, 16 * vq, lane); \
            bf16x8 An = ld_l8(WV + 32 * ks + 8 * fq); if (fr != 0) An = (bf16x8){0, 0, 0, 0, 0, 0, 0, 0}; \
            _Pragma("unroll") for (int dt = 0; dt < 2; ++dt) { const bf16x8 B = ld_tr8(KL, MP, 32 * ks, 32 * dh + 16 * dt, lane); \
                acc[dt] = MFMA16(A, B, acc[dt]); if (vq == 0) nacc[dt] = MFMA16(An, B, nacc[dt]); } } \
        ML_STAGE(cc_ + 1); \
        LDS_BARRIER(); } while (0)
    for (int c = 0; c < 63; c += 3) { ML_STEP(k1, v1, k0, v0, c); ML_STEP(k2, v2, k1, v1, c + 1); ML_STEP(k0, v0, k2, v2, c + 2); }
    ML_STEP(k1, v1, k0, v0, 63);
#undef ML_STEP
#undef ML_LOAD
#undef ML_WRITE
#undef ML_STAGE
}

template <int TH>
__device__ __forceinline__ void mlstm_out_wave(Frame& F, int l, int bc, int h) {
    const int b = bc >> 6, c = bc & 63, w = F.wave, lane = F.lane, fr = lane & 15, fq = lane >> 4;
    constexpr int VP = 72;
    LAS bf16_t* VL = (LAS bf16_t*)(F.lds + w * 12288); LAS float* BT_ = (LAS float*)(F.lds + w * 12288 + 9216); LAS float* GS = BT_ + 64;
    LAS bf16_t* YS = VL;
    const bf16_t* PROJ = (const bf16_t*)(F.ws + WS_PROJ); const float* GATES = (const float*)(F.ws + WS_GATES);
    const bf16_t* CST = (const bf16_t*)(F.ws + WS_CST); const float* NST = (const float*)(F.ws + WS_NST);
    bf16_t* Y = (bf16_t*)(F.ws + WS_PROJ) + PX;
    const size_t row0 = (size_t)b * SEQ + 64 * c; const size_t ci = (size_t)(b * 4 + h) * 64 + c;
    constexpr int NST_ = 2 * TH + 2, NKK = TH + 1;
    {
        const size_t row = row0 + lane;
        const float ig = GATES[row * 16 + h], lf = GATES[row * 16 + 4 + h];
        const bf16_t* vp = PROJ + row * PLD + PV + h * 64;
        u32x4 vr[8];
#pragma unroll
        for (int i = 0; i < 8; ++i) vr[i] = *(const u32x4*)(vp + 8 * i);
        const float bs = wave_scan_incl(lf, lane);
        BT_[lane] = bs; GS[lane] = ig - bs;
#pragma unroll
        for (int i = 0; i < 8; ++i) *(LAS u32x4*)(VL + lane * VP + 8 * i) = vr[i];
    }
    bf16x8 Qf[2][2], Kf[NST_][2];
#pragma unroll
    for (int tt = 0; tt < 2; ++tt)
#pragma unroll
        for (int ks = 0; ks < 2; ++ks) Qf[tt][ks] = ld_g8(PROJ + (row0 + 32 * TH + 16 * tt + fr) * PLD + PQ + h * 64 + 32 * ks + 8 * fq);
#pragma unroll
    for (int st = 0; st < NST_; ++st)
#pragma unroll
        for (int ks = 0; ks < 2; ++ks) Kf[st][ks] = ld_g8(PROJ + (row0 + 16 * st + fr) * PLD + PK + h * 64 + 32 * ks + 8 * fq);
    WAVE_SYNC();
    f32x4 P[2][NST_]; float den[2];
#pragma unroll
    for (int tt = 0; tt < 2; ++tt) {
        const int t = 32 * TH + 16 * tt + fr; const float bt = BT_[t]; float d1 = 0.f;
#pragma unroll
        for (int st = 0; st < NST_; ++st) {
            f32x4 s = (f32x4){0.f, 0.f, 0.f, 0.f};
#pragma unroll
            for (int ks = 0; ks < 2; ++ks) s = MFMA16(Kf[st][ks], Qf[tt][ks], s);
#pragma unroll
            for (int r = 0; r < 4; ++r) { const int sidx = 16 * st + 4 * fq + r; const float wv = (sidx <= t) ? s[r] * fast_exp(bt + GS[sidx]) : 0.f; s[r] = wv; d1 += wv; }
            P[tt][st] = s;
        }
        d1 += __shfl_xor(d1, 16); d1 += __shfl_xor(d1, 32);
        float d2 = 0.f;
#pragma unroll
        for (int ks = 0; ks < 2; ++ks) { const f32x4 n0 = *(const f32x4*)(NST + ci * 64 + 32 * ks + 8 * fq), n1 = *(const f32x4*)(NST + ci * 64 + 32 * ks + 8 * fq + 4);
            const u32x4 qw = __builtin_bit_cast(u32x4, Qf[tt][ks]);
            d2 += bflo(qw.x) * n0.x + bfhi(qw.x) * n0.y + bflo(qw.y) * n0.z + bfhi(qw.y) * n0.w + bflo(qw.z) * n1.x + bfhi(qw.z) * n1.y + bflo(qw.w) * n1.z + bfhi(qw.w) * n1.w; }
        d2 += __shfl_xor(d2, 16); d2 += __shfl_xor(d2, 32);
        den[tt] = d1 + fast_exp(bt) * d2;
    }
    const float* nw = F.in[8] + (size_t)l * 256 + h * 64;
    f32x4 acc[2][4];
#pragma unroll
    for (int tt = 0; tt < 2; ++tt) {
        bf16x8 Cf[4][2];
#pragma unroll
        for (int vt = 0; vt < 4; ++vt)
#pragma unroll
            for (int ks = 0; ks < 2; ++ks) Cf[vt][ks] = ld_g8(CST + ci * 4096 + (16 * vt + fr) * 64 + 32 * ks + 8 * fq);
#pragma unroll
        for (int vt = 0; vt < 4; ++vt) { acc[tt][vt] = (f32x4){0.f, 0.f, 0.f, 0.f};
#pragma unroll
            for (int ks = 0; ks < 2; ++ks) acc[tt][vt] = MFMA16(Qf[tt][ks], Cf[vt][ks], acc[tt][vt]); }
        float eb[4], dr[4];
#pragma unroll
        for (int r = 0; r < 4; ++r) { eb[r] = fast_exp(BT_[32 * TH + 16 * tt + 4 * fq + r]); dr[r] = __shfl(den[tt], 4 * fq + r); }
#pragma unroll
        for (int vt = 0; vt < 4; ++vt)
#pragma unroll
            for (int r = 0; r < 4; ++r) acc[tt][vt][r] *= eb[r];
#pragma unroll
        for (int kk = 0; kk < NKK; ++kk) { const bf16x8 PA = pack8(P[tt][2 * kk], P[tt][2 * kk + 1]);
            bf16x8 Bv[4];
#pragma unroll
            for (int vt = 0; vt < 4; ++vt) Bv[vt] = ld_tr8p(VL, VP, 32 * kk, 16 * vt, lane);
#pragma unroll
            for (int vt = 0; vt < 4; ++vt) acc[tt][vt] = MFMA16(PA, Bv[vt], acc[tt][vt]); }
#pragma unroll
        for (int r = 0; r < 4; ++r) { const float inv = fast_rcp(fmaxf(fabsf(dr[r]), 1.0f)); float s = 0.f;
#pragma unroll
            for (int vt = 0; vt < 4; ++vt) { acc[tt][vt][r] *= inv; s += acc[tt][vt][r] * acc[tt][vt][r]; }
            s += __shfl_xor(s, 1); s += __shfl_xor(s, 2); s += __shfl_xor(s, 4); s += __shfl_xor(s, 8); const float rs = rsqrtf(s * (1.0f / 64.0f) + NORM_EPS);
#pragma unroll
            for (int vt = 0; vt < 4; ++vt) acc[tt][vt][r] *= rs * nw[16 * vt + fr]; }
    }
    WAVE_SYNC();
#pragma unroll
    for (int tt = 0; tt < 2; ++tt)
#pragma unroll
        for (int vt = 0; vt < 4; ++vt)
#pragma unroll
            for (int r = 0; r < 4; ++r) YS[(16 * tt + 4 * fq + r) * VP + 16 * vt + fr] = f2bf(acc[tt][vt][r]);
    WAVE_SYNC();
#pragma unroll
    for (int i = 0; i < 4; ++i) { const int tr_ = (lane >> 3) + 8 * i, ch = lane & 7; const size_t row = row0 + 32 * TH + tr_;
        const u32x4 yv = *(const LAS u32x4*)(YS + tr_ * VP + 8 * ch); const u32x4 gv = *(const u32x4*)(PROJ + row * PLD + PO + h * 64 + 8 * ch); u32x4 o;
#pragma unroll
        for (int e = 0; e < 4; ++e) o[e] = cvtpk(bflo(yv[e]) * bflo(gv[e]), bfhi(yv[e]) * bfhi(gv[e]));
        *(u32x4*)(Y + row * PLD + h * 64 + 8 * ch) = o; }
    WAVE_SYNC();
}
__device__ __forceinline__ void mlstm_out_item(Frame& F, int l, int bc) {
    const int h = F.wave >> 1;
    if (F.wave & 1) mlstm_out_wave<1>(F, l, bc, h); else mlstm_out_wave<0>(F, l, bc, h);
}
typedef float f32x16 __attribute__((ext_vector_type(16)));
#define MFMA32(a, b, c) __builtin_amdgcn_mfma_f32_32x32x16_bf16((a), (b), (c), 0, 0, 0)
constexpr int AK_STR = 72, AV_STR = 96;
constexpr int ATT_KB = 128 * AK_STR * 2, ATT_VB = 128 * AV_STR * 2, ATT_BUF = ATT_KB + ATT_VB;
constexpr int ATT_TAB_OFF = 2 * ATT_BUF;
__device__ __forceinline__ int t5_bucket(int n) {
    if (n < 16) return n;
    int bk = 16;
    bk += (n >= 19); bk += (n >= 21); bk += (n >= 24); bk += (n >= 27); bk += (n >= 31); bk += (n >= 35); bk += (n >= 40); bk += (n >= 46);
    bk += (n >= 52); bk += (n >= 59); bk += (n >= 67); bk += (n >= 77); bk += (n >= 87); bk += (n >= 99); bk += (n >= 113);
    return bk;
}
__device__ __forceinline__ int crow16(int reg, int hi) { return (reg & 3) + 8 * (reg >> 2) + 4 * hi; }
__device__ __forceinline__ bf16x8 pack8r(const f32x16& p, const int s) { u32x4 w; w.x = cvtpk(p[8 * s], p[8 * s + 1]); w.y = cvtpk(p[8 * s + 2], p[8 * s + 3]); w.z = cvtpk(p[8 * s + 4], p[8 * s + 5]); w.w = cvtpk(p[8 * s + 6], p[8 * s + 7]); return __builtin_bit_cast(bf16x8, w); }
__device__ __forceinline__ void epilogue_attn(Frame& F, int l, int bh, int qi, f32x16 (&O1)[2], f32x16 (&O2)[2], float l1, float l2);
__device__ __forceinline__ void attn_item(Frame& F, int l, int bh, int qi) {
    const int b = bh >> 2, h = bh & 3, w = F.wave, lane = F.lane, tid = F.tid, r32 = lane & 31, hi = lane >> 5, qq = w & 3, kh = w >> 2;
#ifdef PROBE_A
    const unsigned long long tp0_ = __builtin_amdgcn_s_memrealtime();
#endif
    const bf16_t* PROJ = (const bf16_t*)(F.ws + WS_PROJ); bf16_t* Y = (bf16_t*)(F.ws + WS_PROJ) + PX;
    LAS float* TAB = (LAS float*)(F.lds + ATT_TAB_OFF);
    LAS bf16_t* QL = (LAS bf16_t*)(F.lds + ATT_TAB_OFF + 1024);
    const size_t row0 = (size_t)b * SEQ; const int q0 = qi * 128;
    if (tid < 256) TAB[tid] = F.in[19][t5_bucket(tid) * 4 + h] * LOG2E;
    const int npairs = qi + 1;
    const int lk = tid >> 3, lc = tid & 7;
    const bf16_t* kg = PROJ + (row0 + lk) * PLD + PDK + h * 64 + 8 * lc; const bf16_t* vg = PROJ + (row0 + lk) * PLD + PDV + h * 64 + 8 * lc;
    u32x4 ka0, ka1, va0, va1;
#define ATT_WRITE(k0_, k1_, v0_, v1_, buf) do { LAS bf16_t* KL_ = (LAS bf16_t*)(F.lds + (buf) * ATT_BUF); LAS bf16_t* VL_ = (LAS bf16_t*)(F.lds + (buf) * ATT_BUF + ATT_KB); \
        *(LAS u32x4*)(KL_ + lk * AK_STR + 8 * lc) = k0_; *(LAS u32x4*)(KL_ + (lk + 64) * AK_STR + 8 * lc) = k1_; \
        *(LAS u32x4*)(VL_ + lk * AV_STR + 8 * lc) = v0_; *(LAS u32x4*)(VL_ + (lk + 64) * AV_STR + 8 * lc) = v1_; } while (0)
#define ATT_LOAD(k0_, k1_, v0_, v1_, p) do { const size_t o_ = (size_t)(p) * 128 * PLD; k0_ = *(const u32x4*)(kg + o_); k1_ = *(const u32x4*)(kg + o_ + (size_t)64 * PLD); v0_ = *(const u32x4*)(vg + o_); v1_ = *(const u32x4*)(vg + o_ + (size_t)64 * PLD); } while (0)
    ATT_LOAD(ka0, ka1, va0, va1, 0);
    {
        const bf16_t* qg = PROJ + (row0 + q0 + lk) * PLD + PDQ + h * 64 + 8 * lc;
        const u32x4 q0r = *(const u32x4*)qg, q1r = *(const u32x4*)(qg + (size_t)64 * PLD);
        *(LAS u32x4*)(QL + lk * AK_STR + 8 * lc) = q0r; *(LAS u32x4*)(QL + (lk + 64) * AK_STR + 8 * lc) = q1r; }
    ATT_WRITE(ka0, ka1, va0, va1, 0);
    if (npairs > 1) ATT_LOAD(ka0, ka1, va0, va1, 1);
    const int qrow = q0 + 32 * qq + r32;
    f32x16 O1[2], O2[2];
#pragma unroll
    for (int i = 0; i < 16; ++i) { O1[0][i] = 0.f; O1[1][i] = 0.f; O2[0][i] = 0.f; O2[1][i] = 0.f; }
    f32x4 L1 = {0.f, 0.f, 0.f, 0.f}, L2 = {0.f, 0.f, 0.f, 0.f};
    __syncthreads();
    const float cfar = TAB[255];
    const f32x16 cinit = {0.f, 0.f, 0.f, 0.f, 0.f, 0.f, 0.f, 0.f, 0.f, 0.f, 0.f, 0.f, 0.f, 0.f, 0.f, 0.f};
    const int vlane = (4 * hi + ((lane & 15) >> 2)) * AV_STR + 16 * ((lane >> 4) & 1) + 4 * (lane & 3);
    const LAS bf16_t* qlp = QL + (32 * qq + r32) * AK_STR + 8 * hi;
#ifdef PROBE_SECTIONS
    unsigned long long dA_ = 0, dB_ = 0, dC_ = 0;
#define ATT_T(x_) const unsigned long long x_ = __builtin_amdgcn_s_memtime()
#define ATT_TW(x_) asm volatile("s_waitcnt lgkmcnt(0)" ::: "memory"); const unsigned long long x_ = __builtin_amdgcn_s_memtime()
#define ATT_TACC() do { dA_ += tb_ - ta_; dB_ += tc_ - tb_; dC_ += td_ - tc_; } while (0)
#else
#define ATT_T(x_) do {} while (0)
#define ATT_TW(x_) do {} while (0)
#define ATT_TACC() do {} while (0)
#endif
#define ATT_EXP(S1_, S2_, sub_, NEAR_) do { \
        if (NEAR_) { \
            _Pragma("unroll") for (int r = 0; r < 16; ++r) { const int rel = qrow - (k0 + 32 * (sub_) + crow16(r, hi)); const float bv = TAB[rel < 0 ? 0 : rel] - cfar; \
                const float p1 = __builtin_amdgcn_exp2f(S1_[r] + bv), p2 = __builtin_amdgcn_exp2f(S2_[r] + bv); \
                S1_[r] = rel < 0 ? 0.f : p1; S2_[r] = rel < 0 ? 0.f : p2; } \
        } else { \
            _Pragma("unroll") for (int r = 0; r < 16; ++r) { S1_[r] = __builtin_amdgcn_exp2f(S1_[r]); S2_[r] = __builtin_amdgcn_exp2f(S2_[r]); } \
        } \
        _Pragma("unroll") for (int r = 0; r < 16; r += 4) { L1 += (f32x4){S1_[r], S1_[r + 1], S1_[r + 2], S1_[r + 3]}; L2 += (f32x4){S2_[r], S2_[r + 1], S2_[r + 2], S2_[r + 3]}; } } while (0)
#define ATT_VLOAD(Vf_, sub_) do { _Pragma("unroll") for (int s = 0; s < 2; ++s) _Pragma("unroll") for (int vt = 0; vt < 2; ++vt) { const LAS bf16_t* vp = VL + (32 * (sub_) + 16 * s) * AV_STR + 32 * vt + vlane; \
            const v4i16_t lo = __builtin_amdgcn_ds_read_tr16_b64_v4i16((LAS v4i16_t*)vp), hi4 = __builtin_amdgcn_ds_read_tr16_b64_v4i16((LAS v4i16_t*)(vp + 8 * AV_STR)); \
            Vf_[s][vt] = (bf16x8){lo[0], lo[1], lo[2], lo[3], hi4[0], hi4[1], hi4[2], hi4[3]}; } } while (0)
#define ATT_PV(S1_, S2_, Vf_) do { _Pragma("unroll") for (int s = 0; s < 2; ++s) { const bf16x8 PA1 = pack8r(S1_, s), PA2 = pack8r(S2_, s); \
            _Pragma("unroll") for (int vt = 0; vt < 2; ++vt) { O1[vt] = MFMA32(PA1, Vf_[s][vt], O1[vt]); O2[vt] = MFMA32(PA2, Vf_[s][vt], O2[vt]); } } } while (0)
#define ATT_ITER(k0_, k1_, v0_, v1_, p_, NEAR_) do { const int p = (p_); ATT_T(ta_); \
        if (p + 1 < npairs) { ATT_WRITE(k0_, k1_, v0_, v1_, (p + 1) & 1); } \
        if (p + 2 < npairs) { ATT_LOAD(k0_, k1_, v0_, v1_, p + 2); } \
        ATT_TW(tb_); \
        const int k0 = 128 * p + 64 * kh; \
        if (!(NEAR_) || k0 <= q0 + 32 * qq + 31) { \
            const LAS bf16_t* KL = (const LAS bf16_t*)(F.lds + (p & 1) * ATT_BUF) + 64 * kh * AK_STR; const LAS bf16_t* VL = (const LAS bf16_t*)(F.lds + (p & 1) * ATT_BUF + ATT_KB) + 64 * kh * AV_STR; \
            f32x16 SA1, SA2, SB1, SB2; \
            {   const bf16x8 Q00 = ld_l8(qlp), Q01 = ld_l8(qlp + 16), Q10 = ld_l8(qlp + 32), Q11 = ld_l8(qlp + 48); \
                const LAS bf16_t* kp = KL + r32 * AK_STR + 8 * hi; \
                const bf16x8 a10 = ld_l8(kp), a11 = ld_l8(kp + 16), a20 = ld_l8(kp + 32), a21 = ld_l8(kp + 48); \
                const bf16x8 b10 = ld_l8(kp + 32 * AK_STR), b11 = ld_l8(kp + 32 * AK_STR + 16), b20 = ld_l8(kp + 32 * AK_STR + 32), b21 = ld_l8(kp + 32 * AK_STR + 48); \
                SA1 = MFMA32(a10, Q00, cinit); SA2 = MFMA32(a20, Q10, cinit); SA1 = MFMA32(a11, Q01, SA1); SA2 = MFMA32(a21, Q11, SA2); \
                SB1 = MFMA32(b10, Q00, cinit); SB2 = MFMA32(b20, Q10, cinit); SB1 = MFMA32(b11, Q01, SB1); SB2 = MFMA32(b21, Q11, SB2); } \
            bf16x8 Vf[2][2], Vg[2][2]; \
            ATT_VLOAD(Vf, 0); ATT_VLOAD(Vg, 1); \
            ATT_EXP(SA1, SA2, 0, NEAR_); \
            ATT_PV(SA1, SA2, Vf); \
            ATT_EXP(SB1, SB2, 1, NEAR_); \
            ATT_PV(SB1, SB2, Vg); \
            if (!(NEAR_)) {   \
                __builtin_amdgcn_sched_group_barrier(0x8, 4, 0); \
                _Pragma("unroll") for (int g_ = 0; g_ < 4; ++g_) { __builtin_amdgcn_sched_group_barrier(0x8, 1, 0); __builtin_amdgcn_sched_group_barrier(0x400, 8, 0); } \
                __builtin_amdgcn_sched_group_barrier(0x2, 24, 0); \
                _Pragma("unroll") for (int g_ = 0; g_ < 8; ++g_) { __builtin_amdgcn_sched_group_barrier(0x8, 1, 0); __builtin_amdgcn_sched_group_barrier(0x400, 4, 0); __builtin_amdgcn_sched_group_barrier(0x2, 2, 0); } } \
        } \
        ATT_T(tc_); \
        LDS_BARRIER(); ATT_T(td_); ATT_TACC(); } while (0)
#ifdef PROBE_A
    if (lane == 0) atomicMax(F.ctl + 32768 + 64 * (11 + 16 * l), (unsigned)(__builtin_amdgcn_s_memrealtime() - tp0_));
#endif
    int pp = 0;
    for (; pp + 1 < qi; ++pp) ATT_ITER(ka0, ka1, va0, va1, pp, 0);
    for (; pp < npairs; ++pp) ATT_ITER(ka0, ka1, va0, va1, pp, 1);
#undef ATT_EXP
#undef ATT_VLOAD
#undef ATT_PV
#undef ATT_ITER
#ifdef PROBE_SECTIONS
    if (qi == 31 && lane == 0) { atomicMax(F.ctl + 32768 + 64 * (8 + 16 * l), (unsigned)(dA_ / 32) * 10u); atomicMax(F.ctl + 32768 + 64 * (9 + 16 * l), (unsigned)(dB_ / 32) * 10u); atomicMax(F.ctl + 32768 + 64 * (10 + 16 * l), (unsigned)(dC_ / 32) * 10u); }
#endif
#undef ATT_WRITE
#undef ATT_LOAD
    float l1 = (L1.x + L1.y) + (L1.z + L1.w), l2 = (L2.x + L2.y) + (L2.z + L2.w);
    epilogue_attn(F, l, bh, qi, O1, O2, l1, l2);
}
__device__ __forceinline__ void epilogue_attn(Frame& F, int l, int bh, int qi, f32x16 (&O1)[2], f32x16 (&O2)[2], float l1, float l2) {
    int t3 = threadIdx.x; asm volatile("" : "+v"(t3));
    const int lane = t3 & 63, w = __builtin_amdgcn_readfirstlane(t3 >> 6), r32 = lane & 31, hi = lane >> 5, qq = w & 3, kh = w >> 2, b = bh >> 2, h = bh & 3;
    bf16_t* Y = (bf16_t*)(F.ws + WS_PROJ) + PX;
    const size_t row0 = (size_t)b * SEQ; const int q0 = qi * 128;
    LAS float* XCH = (LAS float*)F.lds + (size_t)qq * 66 * 64 + lane;
    if (kh == 1) {
#pragma unroll
        for (int vt = 0; vt < 2; ++vt)
#pragma unroll
            for (int r = 0; r < 16; ++r) { XCH[(vt * 16 + r) * 64] = O1[vt][r]; XCH[(32 + vt * 16 + r) * 64] = O2[vt][r]; }
        XCH[64 * 64] = l1; XCH[65 * 64] = l2;
    }
    __syncthreads();
    if (kh == 0) {
        const float* lm = F.in[17] + (size_t)l * 128;
        float d1 = (lane < 32) ? lm[lane] * lm[32 + lane] : 0.f, d2 = (lane < 32) ? lm[64 + lane] * lm[96 + lane] : 0.f;
        d1 = wave_sum(d1); d2 = wave_sum(d2);
        int lq = l; asm volatile("" : "+s"(lq));
        const float lam_init = (lq == 0) ? 0.2f : 0.35550906759f;
        const float lam = __int_as_float(__builtin_amdgcn_readfirstlane(__float_as_int(fast_exp(d1) - fast_exp(d2) + lam_init)));
#pragma unroll
        for (int vt = 0; vt < 2; ++vt)
#pragma unroll
            for (int r = 0; r < 16; ++r) { O1[vt][r] += XCH[(vt * 16 + r) * 64]; O2[vt][r] += XCH[(32 + vt * 16 + r) * 64]; }
        l1 += XCH[64 * 64]; l2 += XCH[65 * 64];
        l1 += __shfl_xor(l1, 32); l2 += __shfl_xor(l2, 32);
        const float i1 = fast_rcp(l1), i2 = lam * fast_rcp(l2);
        const float* sw = F.in[18] + (size_t)l * 64; const float osc = 1.0f - lam_init;
        const float sw0 = sw[r32], sw1 = sw[32 + r32];
#pragma unroll
        for (int r = 0; r < 16; ++r) {
            const int qr = crow16(r, hi);
            const float a1 = __shfl(i1, qr), a2 = __shfl(i2, qr);
            const float o0 = O1[0][r] * a1 - O2[0][r] * a2, o1 = O1[1][r] * a1 - O2[1][r] * a2;
            float s = o0 * o0 + o1 * o1;
            s += __shfl_xor(s, 1); s += __shfl_xor(s, 2); s += __shfl_xor(s, 4); s += __shfl_xor(s, 8); s += __shfl_xor(s, 16);
            const float rs = rsqrtf(s * (1.0f / 64.0f) + NORM_EPS) * osc;
            const size_t row = row0 + q0 + 32 * qq + qr;
            Y[row * PLD + 768 + h * 64 + r32] = f2bf(o0 * rs * sw0); Y[row * PLD + 768 + h * 64 + 32 + r32] = f2bf(o1 * rs * sw1);
        }
    }
}

constexpr int SSD_STR = 136;
constexpr int SX_P = 72, SB_P = 136, SS_BUF = 128 * SX_P * 2 + 128 * SB_P * 2;
__device__ __forceinline__ void ssd_state_item(Frame& F, int l, int bhh) {
    const int b = bhh >> 3, hh = bhh & 7, g = hh >> 2, w = F.wave, lane = F.lane, fr = lane & 15, fq = lane >> 4, tid = F.tid;
    LAS float* XS = (LAS float*)(F.lds + 2 * SS_BUF); LAS float* CD = XS + 4096;
    const bf16_t* XACT = (const bf16_t*)F.in[25]; const float* GATES = (const float*)(F.ws + WS_GATES); bf16_t* SST = (bf16_t*)(F.ws + WS_SST);
    const float Ah = -expf(F.in[12][l * 8 + hh]);
    for (int c = w; c < 32; c += 8) {
        const size_t r0 = (size_t)b * SEQ + 128 * c;
        const float dt0 = GATES[(r0 + lane) * 16 + 8 + hh], dt1 = GATES[(r0 + 64 + lane) * 16 + 8 + hh];
        const float s0 = wave_scan_incl(dt0 * Ah, lane); const float t0 = __shfl(s0, 63);
        const float s1 = wave_scan_incl(dt1 * Ah, lane) + t0; const float last = __shfl(s1, 63);
        XS[128 * c + lane] = dt0 * fast_exp(last - s0); XS[128 * c + 64 + lane] = dt1 * fast_exp(last - s1);
        if (lane == 0) CD[c] = fast_exp(last);
    }
    const int pt = w & 3, nh = w >> 2;
    f32x4 acc[4];
#pragma unroll
    for (int j = 0; j < 4; ++j) acc[j] = (f32x4){0.f, 0.f, 0.f, 0.f};
    const bf16_t* xg = XACT + ((size_t)b * SEQ + (tid >> 3)) * 1024 + hh * 64 + 8 * (tid & 7);
    const bf16_t* bg = XACT + ((size_t)b * SEQ + (tid >> 4)) * 1024 + 512 + g * 128 + 8 * (tid & 15);
    u32x4 xa[2], ba[4], xb[2], bb[4], xc[2], bc[4];
#define SS_LOAD(xr, br, c_) do { const size_t o_ = (size_t)(c_) * 128 * 1024; xr[0] = *(const u32x4*)(xg + o_); xr[1] = *(const u32x4*)(xg + o_ + 64 * 1024); \
        _Pragma("unroll") for (int i_ = 0; i_ < 4; ++i_) br[i_] = *(const u32x4*)(bg + o_ + (size_t)i_ * 32 * 1024); } while (0)
#define SS_WRITE(xr, br, c_) do { LAS bf16_t* XL_ = (LAS bf16_t*)(F.lds + ((c_) & 1) * SS_BUF); LAS bf16_t* BL_ = XL_ + 128 * SX_P; \
        _Pragma("unroll") for (int i_ = 0; i_ < 2; ++i_) { const int s_ = (tid >> 3) + 64 * i_; const float sc_ = XS[128 * (c_) + s_]; u32x4 o_; \
            _Pragma("unroll") for (int e_ = 0; e_ < 4; ++e_) o_[e_] = cvtpk(sc_ * bflo(xr[i_][e_]), sc_ * bfhi(xr[i_][e_])); \
            *(LAS u32x4*)(XL_ + s_ * SX_P + 8 * (tid & 7)) = o_; } \
        _Pragma("unroll") for (int i_ = 0; i_ < 4; ++i_) *(LAS u32x4*)(BL_ + ((tid >> 4) + 32 * i_) * SB_P + 8 * (tid & 15)) = br[i_]; } while (0)
    LAS bf16_t* SSTG = (LAS bf16_t*)(F.lds + 2 * SS_BUF + 16384 + 128);
#define SS_STAGE(c_) do { LAS bf16_t* sg_ = SSTG + ((c_) & 1) * 8192; \
        _Pragma("unroll") for (int j = 0; j < 4; ++j) _Pragma("unroll") for (int r = 0; r < 4; ++r) sg_[(16 * pt + 4 * fq + r) * 128 + 16 * (4 * nh + j) + fr] = f2bf(acc[j][r]); } while (0)
    SS_LOAD(xa, ba, 0); SS_LOAD(xb, bb, 1); SS_LOAD(xc, bc, 2);
    __syncthreads();
    SS_WRITE(xa, ba, 0);
    SS_LOAD(xa, ba, 3);
    LDS_BARRIER();
#define SS_STEP(XW, BW, c_) do { const int cc_ = (c_); const size_t si = ((size_t)(b * 32 + cc_) * 8 + hh) * 8192; \
        _Pragma("unroll") for (int j = 0; j < 4; ++j) _Pragma("unroll") for (int r = 0; r < 4; ++r) SST[si + (16 * pt + 4 * fq + r) * 128 + 16 * (4 * nh + j) + fr] = f2bf(acc[j][r]); \
        asm volatile("" ::: "memory"); \
        if (cc_ + 1 < 32) { SS_WRITE(XW, BW, cc_ + 1); } \
        asm volatile("" ::: "memory"); \
        SS_LOAD(XW, BW, (cc_ + 4 < 32 ? cc_ + 4 : 31)); \
        asm volatile("" ::: "memory"); \
        const float cd = CD[cc_]; \
        _Pragma("unroll") for (int j = 0; j < 4; ++j) acc[j] = acc[j] * cd; \
        const LAS bf16_t* XL = (const LAS bf16_t*)(F.lds + (cc_ & 1) * SS_BUF); const LAS bf16_t* BL = XL + 128 * SX_P; \
        bf16x8 Af[4], Bf[4][4]; \
        _Pragma("unroll") for (int ks = 0; ks < 4; ++ks) { Af[ks] = ld_tr8(XL, SX_P, 32 * ks, 16 * pt, lane); \
            _Pragma("unroll") for (int j = 0; j < 4; ++j) Bf[ks][j] = ld_tr8(BL, SB_P, 32 * ks, 16 * (4 * nh + j), lane); } \
        asm volatile("s_waitcnt lgkmcnt(0)" ::: "memory"); __builtin_amdgcn_sched_barrier(0); \
        _Pragma("unroll") for (int ks = 0; ks < 4; ++ks) _Pragma("unroll") for (int j = 0; j < 4; ++j) acc[j] = MFMA16(Af[ks], Bf[ks][j], acc[j]); \
        LDS_BARRIER(); } while (0)
    for (int c = 0; c < 30; c += 3) { SS_STEP(xb, bb, c); SS_STEP(xc, bc, c + 1); SS_STEP(xa, ba, c + 2); }
    SS_STEP(xb, bb, 30); SS_STEP(xc, bc, 31);
#undef SS_STEP
#undef SS_STAGE
#undef SS_LOAD
#undef SS_WRITE
}

constexpr int SO_BP = 136, SO_XP = 72, SO_SP = 136, SO_YP = 264;
constexpr int SO_B_BYTES = 128 * SO_BP * 2, SO_H_BYTES = 128 * SO_XP * 2 + 64 * SO_SP * 2, SO_ACS_OFF = SO_B_BYTES + 2 * SO_H_BYTES;
__device__ __forceinline__ void ssd_out_item(Frame& F, int l, int it) {
    const int g = it & 1, c = (it >> 1) & 31, b = it >> 6, w = F.wave, lane = F.lane, fr = lane & 15, fq = lane >> 4, tid = F.tid;
    LAS bf16_t* BL = (LAS bf16_t*)F.lds;
    LAS float* ACS = (LAS float*)(F.lds + SO_ACS_OFF); LAS float* DTS = ACS + 512; LAS float* ETAB = DTS + 512; LAS float* REFS = ETAB + 512;
    const bf16_t* XACT = (const bf16_t*)F.in[25]; const float* GATES = (const float*)(F.ws + WS_GATES); const bf16_t* SST = (const bf16_t*)(F.ws + WS_SST);
    const bf16_t* PROJ = (const bf16_t*)(F.ws + WS_PROJ); bf16_t* Y = (bf16_t*)(F.ws + WS_PROJ) + PX;
    const size_t r0 = (size_t)b * SEQ + 128 * c;
    const bf16_t* bgp = XACT + (r0 + (tid >> 4)) * 1024 + 512 + g * 128 + 8 * (tid & 15);
    const bf16_t* xgp = XACT + (r0 + (tid >> 3)) * 1024 + g * 256 + 8 * (tid & 7);
    const bf16_t* sgp = SST + ((size_t)(b * 32 + c) * 8 + g * 4) * 8192 + (tid >> 4) * 128 + 8 * (tid & 15);
    u32x4 xr[2], sr[2];
#define SO_LOADH(hd_) do { xr[0] = *(const u32x4*)(xgp + (hd_) * 64); xr[1] = *(const u32x4*)(xgp + (hd_) * 64 + 64 * 1024); \
        sr[0] = *(const u32x4*)(sgp + (size_t)(hd_) * 8192); sr[1] = *(const u32x4*)(sgp + (size_t)(hd_) * 8192 + 32 * 128); } while (0)
#define SO_WRITEH(hd_) do { LAS bf16_t* XL_ = (LAS bf16_t*)(F.lds + SO_B_BYTES + ((hd_) & 1) * SO_H_BYTES); LAS bf16_t* SL_ = XL_ + 128 * SO_XP; \
        *(LAS u32x4*)(XL_ + (tid >> 3) * SO_XP + 8 * (tid & 7)) = xr[0]; *(LAS u32x4*)(XL_ + ((tid >> 3) + 64) * SO_XP + 8 * (tid & 7)) = xr[1]; \
        *(LAS u32x4*)(SL_ + (tid >> 4) * SO_SP + 8 * (tid & 15)) = sr[0]; *(LAS u32x4*)(SL_ + ((tid >> 4) + 32) * SO_SP + 8 * (tid & 15)) = sr[1]; } while (0)
    {   u32x4 br[4];
#pragma unroll
        for (int i = 0; i < 4; ++i) br[i] = *(const u32x4*)(bgp + (size_t)i * 32 * 1024);
        SO_LOADH(0);
#pragma unroll
        for (int i = 0; i < 4; ++i) *(LAS u32x4*)(BL + ((tid >> 4) + 32 * i) * SO_BP + 8 * (tid & 15)) = br[i];
        SO_WRITEH(0);
    }
    if (w < 4) {
        const int hh = g * 4 + w; const float Ah = -expf(F.in[12][l * 8 + hh]);
        const float dt0 = GATES[(r0 + lane) * 16 + 8 + hh], dt1 = GATES[(r0 + 64 + lane) * 16 + 8 + hh];
        const float s0 = wave_scan_incl(dt0 * Ah, lane); const float t0 = __shfl(s0, 63);
        const float s1 = wave_scan_incl(dt1 * Ah, lane) + t0;
        ACS[128 * w + lane] = s0; ACS[128 * w + 64 + lane] = s1; DTS[128 * w + lane] = dt0; DTS[128 * w + 64 + lane] = dt1;
        const float e0 = __shfl(s0, 31), e2 = __shfl(s1, 31), e3 = __shfl(s1, 63);
        ETAB[128 * w + lane] = fast_exp((lane < 32 ? e0 : t0) - s0) * dt0; ETAB[128 * w + 64 + lane] = fast_exp((lane < 32 ? e2 : e3) - s1) * dt1;
        if (lane == 0) { REFS[4 * w + 0] = e0; REFS[4 * w + 1] = t0; REFS[4 * w + 2] = e2; REFS[4 * w + 3] = e3; }
    }
    SO_LOADH(1);
    const int lrow = 16 * w + fr, nkk = (w >> 1) + 1;
    bf16x8 Cf[4];
#pragma unroll
    for (int ks = 0; ks < 4; ++ks) Cf[ks] = ld_g8(XACT + (r0 + lrow) * 1024 + 768 + g * 128 + 32 * ks + 8 * fq);
    asm volatile("" : "+v"(Cf[0]), "+v"(Cf[1]), "+v"(Cf[2]), "+v"(Cf[3]));
    LDS_BARRIER();
    f32x4 G[4][2];
#pragma unroll
    for (int kk = 0; kk < 4; ++kk) { G[kk][0] = (f32x4){0.f, 0.f, 0.f, 0.f}; G[kk][1] = (f32x4){0.f, 0.f, 0.f, 0.f};
        if (kk < nkk) {
            bf16x8 b0[4], b1[4];
#pragma unroll
            for (int ks = 0; ks < 4; ++ks) { b0[ks] = ld_l8(BL + (32 * kk + fr) * SO_BP + 32 * ks + 8 * fq); b1[ks] = ld_l8(BL + (32 * kk + 16 + fr) * SO_BP + 32 * ks + 8 * fq); }
#pragma unroll
            for (int ks = 0; ks < 4; ++ks) { G[kk][0] = MFMA16(b0[ks], Cf[ks], G[kk][0]); G[kk][1] = MFMA16(b1[ks], Cf[ks], G[kk][1]); } } }
    const float* Dk = F.in[13] + l * 8 + g * 4;
    f32x4 yacc[4][4];
#pragma unroll
    for (int hd = 0; hd < 4; ++hd) {
        const LAS bf16_t* XL = (const LAS bf16_t*)(F.lds + SO_B_BYTES + (hd & 1) * SO_H_BYTES); const LAS bf16_t* SL = XL + 128 * SO_XP;
        bf16x8 Sf[4][4];
#pragma unroll
        for (int pt = 0; pt < 4; ++pt)
#pragma unroll
            for (int ks = 0; ks < 4; ++ks) Sf[pt][ks] = ld_l8(SL + (16 * pt + fr) * SO_SP + 32 * ks + 8 * fq);
        float ea[4], xv[4][4];
#pragma unroll
        for (int r = 0; r < 4; ++r) ea[r] = fast_exp(ACS[128 * hd + 16 * w + 4 * fq + r]);
#pragma unroll
        for (int pt = 0; pt < 4; ++pt)
#pragma unroll
            for (int r = 0; r < 4; ++r) xv[pt][r] = bf2f(XL[(16 * w + 4 * fq + r) * SO_XP + 16 * pt + fr]);
        const float dsk = Dk[hd];
#pragma unroll
        for (int pt = 0; pt < 4; ++pt) { f32x4 a = (f32x4){0.f, 0.f, 0.f, 0.f};
#pragma unroll
            for (int ks = 0; ks < 4; ++ks) a = MFMA16(Cf[ks], Sf[pt][ks], a);
#pragma unroll
            for (int r = 0; r < 4; ++r) a[r] = a[r] * ea[r] + dsk * xv[pt][r];
            yacc[hd][pt] = a; }
        const float al = ACS[128 * hd + lrow];
#pragma unroll
        for (int kk = 0; kk < 4; ++kk) if (kk < nkk) {
            f32x4 P0, P1;
            if (kk + 1 < nkk) {
                const float fk = fast_exp(al - REFS[4 * hd + kk]);
#pragma unroll
                for (int r = 0; r < 4; ++r) { const int s0 = 32 * kk + 4 * fq + r; P0[r] = G[kk][0][r] * fk * ETAB[128 * hd + s0]; P1[r] = G[kk][1][r] * fk * ETAB[128 * hd + s0 + 16]; }
            } else {
#pragma unroll
                for (int r = 0; r < 4; ++r) { const int s0 = 32 * kk + 4 * fq + r, s1 = s0 + 16;
                    P0[r] = (s0 <= lrow) ? G[kk][0][r] * fast_exp(al - ACS[128 * hd + s0]) * DTS[128 * hd + s0] : 0.f;
                    P1[r] = (s1 <= lrow) ? G[kk][1][r] * fast_exp(al - ACS[128 * hd + s1]) * DTS[128 * hd + s1] : 0.f; }
            }
            const bf16x8 PA = pack8(P0, P1);
            bf16x8 Bx[4];
#pragma unroll
            for (int pt = 0; pt < 4; ++pt) Bx[pt] = ld_tr8p(XL, SO_XP, 32 * kk, 16 * pt, lane);
#pragma unroll
            for (int pt = 0; pt < 4; ++pt) yacc[hd][pt] = MFMA16(PA, Bx[pt], yacc[hd][pt]);
        }
        if (hd + 1 < 4) { SO_WRITEH(hd + 1); if (hd + 2 < 4) SO_LOADH(hd + 2); }
        LDS_BARRIER();
    }
#undef SO_LOADH
#undef SO_WRITEH
    const float* nw = F.in[14] + (size_t)l * 512 + g * 256; const int ch8 = 8 * (tid & 31);
    const f32x4 nw0 = *(const f32x4*)(nw + ch8), nw1 = *(const f32x4*)(nw + ch8 + 4);
    u32x4 zv8[8];
#pragma unroll
    for (int i = 0; i < 8; ++i) zv8[i] = *(const u32x4*)(PROJ + (r0 + (tid >> 5) + 16 * i) * PLD + PZ + g * 256 + ch8);
    LAS bf16_t* YL = (LAS bf16_t*)F.lds;
#pragma unroll
    for (int hd = 0; hd < 4; ++hd)
#pragma unroll
        for (int pt = 0; pt < 4; ++pt)
#pragma unroll
            for (int r = 0; r < 4; ++r) YL[(16 * w + 4 * fq + r) * SO_YP + hd * 64 + 16 * pt + fr] = f2bf(yacc[hd][pt][r]);
    LDS_BARRIER();
#pragma unroll
    for (int i = 0; i < 8; ++i) {
        const int lr = (tid >> 5) + 16 * i; const size_t row = r0 + lr;
        const u32x4 yv = *(const LAS u32x4*)(YL + lr * SO_YP + ch8); const u32x4 zv = zv8[i];
        float v[8]; float ss = 0.f;
#pragma unroll
        for (int e = 0; e < 4; ++e) { v[2 * e] = bflo(yv[e]) * bflo(zv[e]); v[2 * e + 1] = bfhi(yv[e]) * bfhi(zv[e]); ss += v[2 * e] * v[2 * e] + v[2 * e + 1] * v[2 * e + 1]; }
        ss += __shfl_xor(ss, 1); ss += __shfl_xor(ss, 2); ss += __shfl_xor(ss, 4); ss += __shfl_xor(ss, 8); ss += __shfl_xor(ss, 16);
        const float rs = rsqrtf(ss * (1.0f / 256.0f) + NORM_EPS);
        u32x4 o; o.x = cvtpk(v[0] * rs * nw0.x, v[1] * rs * nw0.y); o.y = cvtpk(v[2] * rs * nw0.z, v[3] * rs * nw0.w); o.z = cvtpk(v[4] * rs * nw1.x, v[5] * rs * nw1.y); o.w = cvtpk(v[6] * rs * nw1.z, v[7] * rs * nw1.w);
        *(u32x4*)(Y + row * PLD + 256 + g * 256 + ch8) = o;
    }
}
#ifndef PH_EN
#define PH_EN 1023
#endif
#ifndef MK_N_LAUNCHES
#define MK_N_LAUNCHES 1
#endif
constexpr int N_PHASES = 1 + 9 * DEPTH;
constexpr int NA1 = 512;
constexpr int CW_STAT = 32768;
#ifdef PROBE_A
#define ITEM_T0() const unsigned long long it0_ = __builtin_amdgcn_s_memrealtime()
#define ITEM_T1(k_) do { __syncthreads(); if (threadIdx.x == 0) atomicMax(F.ctl + CW_STAT + 64 * ((k_) + 16 * l), (unsigned)(__builtin_amdgcn_s_memrealtime() - it0_)); } while (0)
#else
#define ITEM_T0() do {} while (0)
#define ITEM_T1(k_) do {} while (0)
#endif

__global__ void __launch_bounds__(NTHREADS, 2) hyb_fwd(Args args) {
    extern __shared__ __attribute__((aligned(16))) unsigned char lds_raw[];
    {   const int t0 = threadIdx.x;
        for (int u = t0; u < (LDS_BYTES - LDSCTL_OFF) / 4; u += NTHREADS) ((LAS unsigned*)((LAS unsigned char*)lds_raw + LDSCTL_OFF))[u] = 0u; }
    __syncthreads();
    const int ph_lo = args.ph_lo, ph_hi = args.ph_hi;
    const bool one_launch = (ph_hi - ph_lo) > 1;
    if (one_launch) { XcdBarrier b0 = xcd_barrier_post((unsigned*)(args.ws + WS_CTL) + CW_BAR, (volatile LAS unsigned*)((LAS unsigned char*)lds_raw + MISC_OFF) + 8); (void)b0; }
#ifdef PROBE_A
    unsigned long long t_prev = __builtin_amdgcn_s_memrealtime();
#endif
    for (int ph = ph_lo; ph < ph_hi; ++ph) {
        int tid_ = threadIdx.x; asm volatile("" : "+v"(tid_));
        kinptr_t kin = (kinptr_t)__builtin_amdgcn_kernarg_segment_ptr(); asm volatile("" : "+s"(kin));
        Frame F;
        F.lds = (LAS unsigned char*)lds_raw; F.MISC = (volatile LAS unsigned*)(F.lds + MISC_OFF);
        F.tid = tid_; F.lane = tid_ & 63; F.wave = __builtin_amdgcn_readfirstlane(tid_ >> 6);
        F.G = gridDim.x; { const int bx = blockIdx.x; F.vcu = (F.G % 8 == 0) ? (bx % 8) * (F.G / 8) + bx / 8 : bx; }
        F.in = kin;
        float* const outp = (float*)kin[25]; unsigned char* ws = (unsigned char*)kin[26];
        F.ws = ws; F.ctl = (unsigned*)(ws + WS_CTL);
        bf16_t* XB = (bf16_t*)(ws + WS_XB); bf16_t* PROJ = (bf16_t*)(ws + WS_PROJ); float* SSQ = (float*)(ws + WS_SSQ); float* GATES = (float*)(ws + WS_GATES);
        if (ph == 0) { if (PH_EN & 1) p0_prologue(F); }
        else {
            const int l = (ph - 1) / 9, k = (ph - 1) % 9;
            const unsigned char* WL = ws + WS_W + (size_t)l * W_LAYER;
            if ((PH_EN & 2) && (k == 0 || k == 7)) {
                pg8::Gemm g{XB, (const bf16_t*)(WL + (k == 0 ? W_GU1 : W_GU2)), M_TOK, NGU, DM, DM}; pg8::StaticOrder S; S.init(M_TOK, NGU, F.G, (int)blockIdx.x);
                EpiSwiglu E{{}, PROJ, SSQ};
                pg8::gemm_phase<EpiSwiglu, true, true>(F.lds, g, S, E, F.tid);
                { int t2 = threadIdx.x; asm volatile("" : "+v"(t2)); F.tid = t2; F.lane = t2 & 63; F.wave = __builtin_amdgcn_readfirstlane(t2 >> 6); side_convert(F, l, k); }
            } else if ((PH_EN & 4) && (k == 1 || k == 8 || k == 6)) {
                pg8::Gemm g; float alpha = 0.5f;
                if (k == 6) { g = pg8::Gemm{PROJ + PX, (const bf16_t*)(WL + W_OUT), M_TOK, DM, DM, PLD}; alpha = 1.0f; }
                else { g = pg8::Gemm{PROJ, (const bf16_t*)(WL + (k == 1 ? W_D1 : W_D2)), M_TOK, DM, FF, FF}; }
                pg8::StaticOrder S; S.init(M_TOK, DM, F.G, (int)blockIdx.x);
                if (ph == N_PHASES - 1) { EpiResid<true> E{outp, XB, SSQ, alpha, 1.0f / alpha}; pg8::gemm_phase<EpiResid<true>, false, true>(F.lds, g, S, E, F.tid); }
                else { EpiResid<false> E{outp, XB, SSQ, alpha, 1.0f / alpha}; pg8::gemm_phase<EpiResid<false>, false, true>(F.lds, g, S, E, F.tid); }
            } else if ((PH_EN & 8) && k == 2) {
                pg8::Gemm g{XB, (const bf16_t*)(WL + W_IN), M_TOK, NIN, DM, DM}; pg8::StaticOrder S; S.init(M_TOK, NIN, F.G, (int)blockIdx.x);
                EpiInProj E{{}, PROJ, GATES, SSQ, kin[15] + l * 64, kin[16] + l * 64, kin[7] + l * 8, kin[11] + l * 8};
                pg8::gemm_phase<EpiInProj, true, true>(F.lds, g, S, E, F.tid);
                { int t2 = threadIdx.x; asm volatile("" : "+v"(t2)); F.tid = t2; F.lane = t2 & 63; F.wave = __builtin_amdgcn_readfirstlane(t2 >> 6); side_convert(F, l, k); }
            } else if ((PH_EN & 16) && k == 3) {
                conv_phase(F, l);
            } else if (k == 4) {
                for (int first_ = (F.G == 256) ? 1 : 0;; first_ = 0) {
                    const int it = first_ ? (int)blockIdx.x : (q_next(F, 2 * l) + ((F.G == 256) ? 256 : 0)); if (it >= 48 + NA1) break;
                    { int t2 = threadIdx.x; asm volatile("" : "+v"(t2)); F.tid = t2; F.lane = t2 & 63; F.wave = __builtin_amdgcn_readfirstlane(t2 >> 6); }
                    ITEM_T0();
                    if (it < 16) { if (PH_EN & 32) mlstm_state_item(F, it); ITEM_T1(0); }
                    else if (it < 48) { if (PH_EN & 64) ssd_state_item(F, l, it - 16); ITEM_T1(1); }
                    else { const int r = it - 48; if (PH_EN & 128) attn_item(F, l, r & 15, 31 - (r >> 4)); ITEM_T1(2); } }
            } else if (k == 5 && NA1 == 512 && F.G == 256) {
                { int t2 = threadIdx.x; asm volatile("" : "+v"(t2)); F.tid = t2; F.lane = t2 & 63; F.wave = __builtin_amdgcn_readfirstlane(t2 >> 6); }
                ssd_out_item(F, l, F.vcu);
                __syncthreads();
                { int t2 = threadIdx.x; asm volatile("" : "+v"(t2)); F.tid = t2; F.lane = t2 & 63; F.wave = __builtin_amdgcn_readfirstlane(t2 >> 6); }
                mlstm_out_item(F, l, F.vcu);
            } else if (k == 5) {
                for (;;) { const int it = q_next(F, 2 * l + 1); if (it >= 512 + (512 - NA1)) break;
                    { int t2 = threadIdx.x; asm volatile("" : "+v"(t2)); F.tid = t2; F.lane = t2 & 63; F.wave = __builtin_amdgcn_readfirstlane(t2 >> 6); }
                    ITEM_T0();
                    if (it < 256) { if (PH_EN & 256) ssd_out_item(F, l, it); ITEM_T1(3); }
                    else if (it < 512) { if (PH_EN & 512) mlstm_out_item(F, l, it - 256); ITEM_T1(4); }
                    else { const int r = NA1 + it - 512; if (PH_EN & 128) attn_item(F, l, r & 15, 31 - (r >> 4)); } }
            }
        }
#ifdef PROBE_A
        if (ph + 1 < ph_hi) { XcdBarrier bar; bar.bar = F.ctl + CW_BAR; bar.x = xb_xcc_id(); bar.st = F.MISC + 8; xcd_barrier(bar); }
        { const unsigned long long t_now = __builtin_amdgcn_s_memrealtime(); if (threadIdx.x == 0) F.MISC[24 + ph] += (unsigned)(t_now - t_prev); t_prev = t_now; }
        if (ph + 1 == ph_hi && blockIdx.x == 0) { __syncthreads();
            unsigned va = (PROBE_A < 32) ? F.MISC[24 + PROBE_A] : xb_ld(F.ctl + CW_STAT + 64 * (PROBE_A - 32)), vb = (PROBE_B < 32) ? F.MISC[24 + PROBE_B] : xb_ld(F.ctl + CW_STAT + 64 * (PROBE_B - 32));
            if (PROBE_A == 44 || PROBE_A == 46) va = va / 512u * 100u; if (PROBE_A == 45) va = va / 512u * 10u; if (PROBE_B == 44 || PROBE_B == 46) vb = vb / 512u * 100u; if (PROBE_B == 45) vb = vb / 512u * 10u;
            unsigned qa = (va + 500u) / 1000u, qb = (vb + 500u) / 1000u; if (qa > 63u) qa = 63u; if (qb > 63u) qb = 63u;
            const unsigned long long wait = (unsigned long long)(qa * 6400u + qb * 409600u); const unsigned long long t0 = __builtin_amdgcn_s_memrealtime();
            while (__builtin_amdgcn_s_memrealtime() - t0 < wait) __builtin_amdgcn_s_sleep(8); }
        continue;
#endif
        if (ph + 1 < ph_hi) { XcdBarrier bar; bar.bar = F.ctl + CW_BAR; bar.x = xb_xcc_id(); bar.st = F.MISC + 8; xcd_barrier(bar); }
    }
}

extern "C" void kernel_launch(void* const* d_in, const int* in_sizes, int n_in, void* d_out, int out_size, void* d_ws, size_t ws_size, hipStream_t stream) {
    static int grid = 0;
    if (grid == 0) {
        if (n_in != 25 || in_sizes[0] != M_TOK * DM || out_size != M_TOK * DM || ws_size < WS_END) { fprintf(stderr, "kernel_launch: unexpected shapes (n_in %d, in0 %d, out %d, ws %zu)\n", n_in, n_in > 0 ? in_sizes[0] : -1, out_size, ws_size); grid = -1; return; }
        int dev = 0, cus = 0, per_cu = 0;
        if (hipGetDevice(&dev) != hipSuccess || hipDeviceGetAttribute(&cus, hipDeviceAttributeMultiprocessorCount, dev) != hipSuccess) { grid = -1; return; }
        if (hipFuncSetAttribute((const void*)hyb_fwd, hipFuncAttributeMaxDynamicSharedMemorySize, LDS_BYTES) != hipSuccess) { fprintf(stderr, "kernel_launch: hipFuncSetAttribute failed\n"); grid = -1; return; }
        if (hipOccupancyMaxActiveBlocksPerMultiprocessor(&per_cu, (const void*)hyb_fwd, NTHREADS, LDS_BYTES) != hipSuccess || per_cu < 1)
            fprintf(stderr, "kernel_launch: note: occupancy query reports %d workgroups per CU\n", per_cu);
        (void)hipGetLastError();
        grid = cus;
    }
    if (grid < 0) return;
    if (hipMemsetAsync((char*)d_ws + WS_CTL, 0, CTL_ZERO_BYTES, stream) != hipSuccess) { fprintf(stderr, "kernel_launch: memset failed\n"); return; }
    Args a{};
    for (int i = 0; i < 25; ++i) a.in[i] = (const float*)d_in[i];
    a.out = (float*)d_out; a.ws = (unsigned char*)d_ws;
#if MK_N_LAUNCHES == 1
    a.ph_lo = 0; a.ph_hi = N_PHASES;
    hipLaunchKernelGGL(hyb_fwd, dim3(grid), dim3(NTHREADS), LDS_BYTES, stream, a);
#else
    for (int p = 0; p < N_PHASES; ++p) { a.ph_lo = p; a.ph_hi = p + 1; hipLaunchKernelGGL(hyb_fwd, dim3(grid), dim3(NTHREADS), LDS_BYTES, stream, a); }
#endif
    const hipError_t le = hipPeekAtLastError();
    if (le != hipSuccess) fprintf(stderr, "kernel_launch: launch failed: %s\n", hipGetErrorName(le));
}
```

```cpp
#include <hip/hip_runtime.h>
#include <cstdio>
#include <cstdint>

#define LAS __attribute__((address_space(3)))
#define GAS __attribute__((address_space(1)))
typedef unsigned short bf16_t;
typedef short bf16x8 __attribute__((ext_vector_type(8)));
typedef short bf16x4 __attribute__((ext_vector_type(4)));
typedef float f32x4 __attribute__((ext_vector_type(4)));
typedef float f32x2 __attribute__((ext_vector_type(2)));
typedef unsigned u32x4 __attribute__((ext_vector_type(4)));
typedef unsigned u32x2 __attribute__((ext_vector_type(2)));
typedef __bf16 bf16x2_t __attribute__((ext_vector_type(2)));

constexpr int M_TOK = 16384, SEQ = 4096, NBATCH = 4, DM = 1024, FF = 2816, NGU = 2 * FF, NIN = 3584, DEPTH = 2;
constexpr int PLD = 3328;
constexpr int PQ = 0, PK = 256, PV = 512, PO = 768, PZ = 1024, PX = 1536, PDQ = 2560, PDK = 2816, PDV = 3072;
constexpr float NORM_EPS = 1e-6f;
constexpr float LOG2E = 1.4426950408889634f;

__device__ __forceinline__ unsigned cvtpk(float lo, float hi) { f32x2 v = {lo, hi}; bf16x2_t b = __builtin_convertvector(v, bf16x2_t); return __builtin_bit_cast(unsigned, b); }
__device__ __forceinline__ bf16_t f2bf(float f) { return (bf16_t)(cvtpk(f, 0.f) & 0xffffu); }
__device__ __forceinline__ float bf2f(bf16_t h) { return __uint_as_float(((unsigned)h) << 16); }
__device__ __forceinline__ float bflo(unsigned w) { return __uint_as_float(w << 16); }
__device__ __forceinline__ float bfhi(unsigned w) { return __uint_as_float(w & 0xffff0000u); }
__device__ __forceinline__ float fast_exp(float x) { return __builtin_amdgcn_exp2f(x * LOG2E); }
__device__ __forceinline__ float fast_rcp(float x) { return __builtin_amdgcn_rcpf(x); }
__device__ __forceinline__ float fast_log1pexp(float x) { const float e = __builtin_amdgcn_exp2f(x * LOG2E); return __builtin_amdgcn_logf(1.0f + e) * 0.6931471805599453f; }
__device__ __forceinline__ float sigmoidf_(float x) { return fast_rcp(1.f + fast_exp(-x)); }
__device__ __forceinline__ float siluf_(float x) { return x * sigmoidf_(x); }

__device__ __forceinline__ void st16_wt(void* p, u32x4 v) { asm volatile("global_store_dwordx4 %0, %1, off sc1\n\ts_nop 1" :: "v"(p), "v"(v) : "memory"); }

namespace pg8 {
constexpr int BM = 256, BK = 64, HALF = 128, HTB = HALF * BK * 2, STAGE_BYTES = 8 * HTB, NXCD = 8, WGM = 8;
__host__ __device__ __forceinline__ int lds_byte(int r, int c) { const int st = (r >> 4) * 2 + (c >> 5), rr = r & 15, cc = c & 31, ob = rr * 64 + cc * 2; return st * 1024 + (ob ^ (((ob >> 9) & 1) << 5)); }
__host__ __device__ __forceinline__ void stage_rc(int b, int& R, int& C) { const int st = b / 1024, sb = b % 1024, swz = sb ^ (((sb >> 9) & 1) << 5); R = (st >> 1) * 16 + swz / 64; C = (st & 1) * 32 + (swz % 64) / 2; }
__host__ __device__ __forceinline__ int perm32(int rho) { const int n = rho >> 4, i = rho & 15; return 8 * (i >> 2) + 4 * n + (i & 3); }

struct Unit { int pm, pn; };
struct Gemm { const bf16_t* A; const bf16_t* Bt; int M, N, K, lda; };

struct StaticOrder {
    int nM, nN, nwg, G, c;
    __device__ void init(int M, int N, int G_, int c_) { nM = M / BM; nN = N / BM; nwg = nM * nN; G = G_; c = c_; }
    __device__ bool next(int i, Unit& u) const {
        const long L = (long)i * G + c; if (L >= nwg) return false;
        int wgid = (int)L; { const int q = nwg / NXCD, r = nwg % NXCD, xcd = wgid % NXCD, off = wgid / NXCD; wgid = (xcd < r ? xcd * (q + 1) : r * (q + 1) + (xcd - r) * q) + off; }
        const int nig = WGM * nN, gid = wgid / nig, fm = gid * WGM, gsz = (nM - fm) < WGM ? (nM - fm) : WGM;
        u.pm = fm + ((wgid % nig) % gsz); u.pn = (wgid % nig) / gsz; return true;
    }
};

template <class Epi, bool ALIGN_EPI, bool SP2>
__device__ __forceinline__ void gemm_phase(LAS unsigned char* lds, const Gemm g, const StaticOrder& S, const Epi& E, const int tid) {
    const int wid = __builtin_amdgcn_readfirstlane(tid >> 6), lane = tid & 63, wr = wid >> 2, wc = wid & 3, fr = lane & 15, fq = lane >> 4;
    const int K = g.K, nt = K / BK, lda = g.lda;
    unsigned voffA[2], voffB[2];
#pragma unroll
    for (int i = 0; i < 2; ++i) { int R, C; stage_rc(tid * 16 + i * 8192, R, C); const int Rb = (R & ~31) + perm32(R & 31);
        voffA[i] = (unsigned)(R * lda + C) * 2u; voffB[i] = (unsigned)(Rb * K + C) * 2u; }
    const size_t kstep = (size_t)(BK * 2);
    const size_t hstepA = (size_t)HALF * lda * 2, hstepB = (size_t)HALF * K * 2;
    const size_t tstepA = 2 * hstepA, tstepB = 2 * hstepB;
    const unsigned ldsw = (unsigned)wid * 1024u;
    const int aoff = lds_byte(wr * 64 + fr, fq * 8), boff = lds_byte(wc * 32 + fr, fq * 8);
#define PG8_SA(b, h) (((b) * 2 + (h)) * HTB)
#define PG8_SB(b, h) ((4 + (b) * 2 + (h)) * HTB)
#define PG8_STAGE(bufoff, gbase, voff) do { _Pragma("unroll") for (int _i = 0; _i < 2; ++_i) \
        __builtin_amdgcn_global_load_lds((const unsigned*)((const char*)(gbase) + (voff)[_i]), (LAS unsigned*)(lds + (bufoff) + ldsw + _i * 8192), 16, 0, 0); } while (0)
#define PG8_LDA(dst, b, h) do { _Pragma("unroll") for (int m = 0; m < 4; ++m) _Pragma("unroll") for (int k = 0; k < 2; ++k) dst[m][k] = *(const LAS bf16x8*)(lds + PG8_SA(b, h) + aoff + m * 2048 + k * 1024); } while (0)
#define PG8_LDB(dst, b, h) do { _Pragma("unroll") for (int n = 0; n < 2; ++n) _Pragma("unroll") for (int k = 0; k < 2; ++k) dst[n][k] = *(const LAS bf16x8*)(lds + PG8_SB(b, h) + boff + n * 2048 + k * 1024); } while (0)
#define PG8_MMA(ai, bj, At, Bt) do { __builtin_amdgcn_s_setprio(1); _Pragma("unroll") for (int m = 0; m < 4; ++m) _Pragma("unroll") for (int n = 0; n < 2; ++n) _Pragma("unroll") for (int k = 0; k < 2; ++k) \
        acc[ai][bj][m][n] = __builtin_amdgcn_mfma_f32_16x16x32_bf16(Bt[n][k], At[m][k], acc[ai][bj][m][n], 0, 0, 0); __builtin_amdgcn_s_setprio(0); } while (0)
#define PG8_WAIT_V(n) asm volatile("s_waitcnt vmcnt(" #n ")" ::: "memory")
#define PG8_WAIT_L(n) asm volatile("s_waitcnt lgkmcnt(" #n ")" ::: "memory")
#define PG8_BAR __builtin_amdgcn_s_barrier()
#define PG8_SCHED __builtin_amdgcn_sched_barrier(0)
    Unit cur, nxt; int ui = 0;
    if (!S.next(0, cur)) return;
    f32x4 acc[2][2][4][2];
    typename Epi::Raw raw; E.init_load(raw, cur, wr, wc, fr, fq);
    if constexpr (!Epi::HAS_INIT) {
#pragma unroll
    for (int a = 0; a < 2; ++a)
#pragma unroll
        for (int b = 0; b < 2; ++b)
#pragma unroll
            for (int m = 0; m < 4; ++m)
#pragma unroll
                for (int n = 0; n < 2; ++n) acc[a][b][m][n] = (f32x4){0.f, 0.f, 0.f, 0.f};
    }
    bf16x8 At[4][2], B0[2][2], B1[2][2];
    const char* cA = (const char*)g.A + (size_t)cur.pm * tstepA; const char* cB = (const char*)g.Bt + (size_t)cur.pn * tstepB;
    if constexpr (SP2) {
        PG8_STAGE(PG8_SB(0, 0), cB, voffB); PG8_STAGE(PG8_SB(0, 1), cB + hstepB, voffB); PG8_STAGE(PG8_SA(0, 0), cA, voffA); PG8_STAGE(PG8_SA(0, 1), cA + hstepA, voffA);
        if constexpr (Epi::HAS_INIT) E.init_finish(raw, acc);
        if (wr == 1) PG8_BAR;
        PG8_WAIT_V(2); PG8_BAR;
        PG8_STAGE(PG8_SB(1, 0), cB + kstep, voffB); PG8_STAGE(PG8_SA(1, 0), cA + kstep, voffA); PG8_STAGE(PG8_SB(1, 1), cB + hstepB + kstep, voffB);
        PG8_WAIT_V(6); PG8_BAR;
    } else {
        PG8_STAGE(PG8_SB(0, 0), cB, voffB); PG8_STAGE(PG8_SA(0, 0), cA, voffA); PG8_STAGE(PG8_SB(0, 1), cB + hstepB, voffB); PG8_STAGE(PG8_SA(0, 1), cA + hstepA, voffA);
        if (wr == 1) PG8_BAR;
        PG8_WAIT_V(4); PG8_BAR;
        PG8_STAGE(PG8_SB(1, 0), cB + kstep, voffB); PG8_STAGE(PG8_SA(1, 0), cA + kstep, voffA); PG8_STAGE(PG8_SB(1, 1), cB + hstepB + kstep, voffB);
        PG8_WAIT_V(6); PG8_BAR;
    }
    for (;;) {
        const bool has_next = S.next(ui + 1, nxt);
        const char* nA = has_next ? (const char*)g.A + (size_t)nxt.pm * tstepA : cA; const char* nB = has_next ? (const char*)g.Bt + (size_t)nxt.pn * tstepB : cB;
        for (int t = 0; t < nt; t += 2) {
            const bool last = (t == nt - 2);
            const char* a1 = cA + (size_t)(t + 1) * kstep;
            const char* a2 = last ? nA : cA + (size_t)(t + 2) * kstep; const char* b2 = last ? nB : cB + (size_t)(t + 2) * kstep;
            const char* a3 = a2 + kstep; const char* b3 = b2 + kstep;
            if constexpr (SP2) {
            PG8_LDB(B0, 0, 0); PG8_LDB(B1, 0, 1); PG8_SCHED; PG8_LDA(At, 0, 0); PG8_STAGE(PG8_SA(1, 1), a1 + hstepA, voffA);
            PG8_WAIT_V(8); PG8_WAIT_L(0); PG8_BAR; PG8_MMA(0, 0, At, B0); PG8_MMA(0, 1, At, B1); PG8_BAR; PG8_SCHED;
            PG8_LDA(At, 0, 1); PG8_STAGE(PG8_SB(0, 0), b2, voffB); PG8_STAGE(PG8_SB(0, 1), b2 + hstepB, voffB); PG8_STAGE(PG8_SA(0, 0), a2, voffA);
            PG8_WAIT_V(8); PG8_WAIT_L(0); PG8_BAR; PG8_MMA(1, 0, At, B0); PG8_MMA(1, 1, At, B1); PG8_BAR; PG8_SCHED;
            PG8_LDB(B0, 1, 0); PG8_LDB(B1, 1, 1); PG8_SCHED; PG8_LDA(At, 1, 0); PG8_STAGE(PG8_SA(0, 1), a2 + hstepA, voffA);
            PG8_WAIT_V(8); PG8_WAIT_L(0); PG8_BAR; PG8_MMA(0, 0, At, B0); PG8_MMA(0, 1, At, B1); PG8_BAR; PG8_SCHED;
            PG8_LDA(At, 1, 1); PG8_STAGE(PG8_SB(1, 0), b3, voffB); PG8_STAGE(PG8_SB(1, 1), b3 + hstepB, voffB); PG8_STAGE(PG8_SA(1, 0), a3, voffA);
            PG8_WAIT_V(8); PG8_WAIT_L(0); PG8_BAR; PG8_MMA(1, 0, At, B0); PG8_MMA(1, 1, At, B1); PG8_BAR; PG8_SCHED;
            } else {
            PG8_LDB(B0, 0, 0); PG8_SCHED; PG8_LDA(At, 0, 0); PG8_STAGE(PG8_SA(1, 1), a1 + hstepA, voffA);
            PG8_WAIT_L(8); PG8_BAR; PG8_WAIT_L(0); PG8_MMA(0, 0, At, B0); PG8_BAR; PG8_SCHED;
            PG8_LDB(B1, 0, 1); PG8_STAGE(PG8_SB(0, 0), b2, voffB);
            PG8_BAR; PG8_WAIT_L(0); PG8_MMA(0, 1, At, B1); PG8_BAR;
            PG8_LDA(At, 0, 1); PG8_STAGE(PG8_SA(0, 0), a2, voffA);
            PG8_BAR; PG8_WAIT_L(0); PG8_MMA(1, 0, At, B0); PG8_BAR; PG8_SCHED;
            PG8_STAGE(PG8_SB(0, 1), b2 + hstepB, voffB);
            PG8_WAIT_V(6); PG8_BAR; PG8_MMA(1, 1, At, B1); PG8_BAR;
            PG8_LDB(B0, 1, 0); PG8_SCHED; PG8_LDA(At, 1, 0); PG8_STAGE(PG8_SA(0, 1), a2 + hstepA, voffA);
            PG8_WAIT_L(8); PG8_BAR; PG8_WAIT_L(0); PG8_MMA(0, 0, At, B0); PG8_BAR; PG8_SCHED;
            PG8_LDB(B1, 1, 1); PG8_STAGE(PG8_SB(1, 0), b3, voffB);
            PG8_BAR; PG8_WAIT_L(0); PG8_MMA(0, 1, At, B1); PG8_BAR;
            PG8_LDA(At, 1, 1); PG8_STAGE(PG8_SA(1, 0), a3, voffA);
            PG8_BAR; PG8_WAIT_L(0); PG8_MMA(1, 0, At, B0); PG8_BAR; PG8_SCHED;
            PG8_STAGE(PG8_SB(1, 1), b3 + hstepB, voffB);
            PG8_WAIT_V(6); PG8_BAR; PG8_MMA(1, 1, At, B1); PG8_BAR;
            }
        }
        if constexpr (ALIGN_EPI) { if (wr == 0) PG8_BAR; }
        E(acc, cur, wr, wc, fr, fq);
        if (!has_next) break;
#pragma unroll
        for (int a = 0; a < 2; ++a)
#pragma unroll
            for (int b = 0; b < 2; ++b)
#pragma unroll
                for (int m = 0; m < 4; ++m)
#pragma unroll
                    for (int n = 0; n < 2; ++n) acc[a][b][m][n] = (f32x4){0.f, 0.f, 0.f, 0.f};
        cur = nxt; cA = nA; cB = nB; ++ui;
        if constexpr (ALIGN_EPI) { if (wr == 1) PG8_BAR; }
    }
    PG8_WAIT_V(0);
    if constexpr (!ALIGN_EPI) { if (wr == 0) PG8_BAR; }
    PG8_BAR;
#undef PG8_SA
#undef PG8_SB
#undef PG8_STAGE
#undef PG8_LDA
#undef PG8_LDB
#undef PG8_MMA
#undef PG8_WAIT_V
#undef PG8_WAIT_L
#undef PG8_BAR
#undef PG8_SCHED
}
}
constexpr size_t MiB = 1u << 20;
constexpr size_t WS_CTL = 0, CTL_ZERO_BYTES = 1 * MiB;
constexpr size_t WS_SSQ = 1 * MiB;
constexpr size_t WS_GATES = 2 * MiB;
constexpr size_t WS_NST = 3 * MiB;
constexpr size_t WS_W = 4 * MiB;
constexpr size_t W_GU1 = 0, W_D1 = 11 * MiB, W_IN = W_D1 + 11 * MiB / 2, W_OUT = W_IN + 7 * MiB, W_GU2 = W_OUT + 2 * MiB, W_D2 = W_GU2 + 11 * MiB, W_LAYER = 42 * MiB;
static_assert(W_D2 + 11 * MiB / 2 == W_LAYER, "weights map");
constexpr size_t WS_XB = 88 * MiB;
constexpr size_t WS_CST = 120 * MiB;
constexpr size_t WS_SST = 128 * MiB;
constexpr size_t WS_PROJ = 144 * MiB;
constexpr size_t WS_END = 248 * MiB;
static_assert(WS_PROJ + (size_t)M_TOK * PLD * 2 <= WS_END, "ws map");

constexpr int CW_BAR = 4096;
constexpr int CW_Q = 16384;

constexpr int RING_BYTES = 131072;
constexpr int LDSCTL_OFF = RING_BYTES, MISC_OFF = LDSCTL_OFF + 320;
constexpr int LDS_BYTES = 147456;
constexpr int NWAVES = 8, NTHREADS = 512;

typedef GAS unsigned gu32;
#define RLX_AGENT __ATOMIC_RELAXED, __HIP_MEMORY_SCOPE_AGENT
#define LDS_WAIT() asm volatile("s_waitcnt lgkmcnt(0)" ::: "memory")
#define VM_WAIT() asm volatile("s_waitcnt vmcnt(0)" ::: "memory")

#define XB_TMO      128
#define XB_XCNT(j)  (256  + 64 * (j))
#define XB_XSUB(j)  (1280 + 64 * (j))
#define XB_XGEN(j)  (2304 + 64 * (j))
#define XB_TOP      3328
#define XB_TOPGEN   3392
#define XCD_BAR_WORDS 3456
#define XB_SPIN_CAP (1u << 22)
__device__ __forceinline__ unsigned xb_ld(unsigned* p)              { return __hip_atomic_load(p, __ATOMIC_RELAXED, __HIP_MEMORY_SCOPE_AGENT); }
__device__ __forceinline__ unsigned xb_add(unsigned* p, unsigned v) { return __hip_atomic_fetch_add(p, v, __ATOMIC_RELAXED, __HIP_MEMORY_SCOPE_AGENT); }
__device__ __forceinline__ unsigned xb_xcc_id() { return (unsigned)__builtin_amdgcn_s_getreg((3 << 11) | 20) & 0xFu; }
#define XB_SPIN(cond, bar) do { unsigned _sp = 0; while (cond) { __builtin_amdgcn_s_sleep(1); \
    if ((++_sp & 255u) == 0u) { if (xb_ld(&(bar)[XB_TMO])) break; if (_sp > XB_SPIN_CAP) { atomicAdd(&(bar)[XB_TMO], 1u); break; } } } } while (0)
struct XcdBarrier { unsigned* bar; unsigned x; volatile LAS unsigned* st; };
__device__ __forceinline__ XcdBarrier xcd_barrier_post(unsigned* bar, volatile LAS unsigned* st) {
    XcdBarrier b; b.bar = bar; b.x = xb_xcc_id(); b.st = st;
    if (threadIdx.x == 0) (void)xb_add(&bar[XB_XCNT(b.x)], 1u);
    return b;
}
__device__ __forceinline__ void xcd_barrier_complete(unsigned* bar, unsigned x, unsigned& nloc, unsigned& nx) {
    const unsigned G = gridDim.x * gridDim.y * gridDim.z;
    unsigned sum, cnt, mine, sp = 0u;
    for (;;) {
        sum = 0u; cnt = 0u; mine = 0u;
#pragma unroll
        for (unsigned j = 0; j < 16; ++j) { const unsigned c = xb_ld(&bar[XB_XCNT(j)]); sum += c; cnt += (c > 0u) ? 1u : 0u; mine = (j == x) ? c : mine; }
        if (sum == G) break;
        __builtin_amdgcn_s_sleep(1);
        if ((++sp & 255u) == 0u) { if (xb_ld(&bar[XB_TMO])) break; if (sp > XB_SPIN_CAP) { atomicAdd(&bar[XB_TMO], 1u); break; } }
    }
    nloc = mine > 0u ? mine : 1u; nx = cnt > 0u ? cnt : 1u;
}
__device__ __forceinline__ void xcd_barrier(const XcdBarrier& b) {
    asm volatile("s_waitcnt vmcnt(0)" ::: "memory");
    __syncthreads();
    if (threadIdx.x == 0) {
        unsigned* bar = b.bar;
        __builtin_amdgcn_s_waitcnt(0);
        unsigned nloc = b.st[0], nx = b.st[1];
        if (nloc == 0u) { xcd_barrier_complete(bar, b.x, nloc, nx); b.st[0] = nloc; b.st[1] = nx; }
        const unsigned old = xb_add(&bar[XB_XSUB(b.x)], 1u);
        const unsigned gen = old / nloc;
        if (old + 1u == (gen + 1u) * nloc) {
            __builtin_amdgcn_fence(__ATOMIC_RELEASE, "agent");
            asm volatile("s_waitcnt vmcnt(0)" ::: "memory");
            const unsigned og = xb_add(&bar[XB_TOP], 1u);
            const unsigned tg = og / nx;
            if (og + 1u == (tg + 1u) * nx) xb_add(&bar[XB_TOPGEN], 1u);
            else XB_SPIN(xb_ld(&bar[XB_TOPGEN]) == tg, bar);
            __builtin_amdgcn_fence(__ATOMIC_ACQUIRE, "agent");
            xb_add(&bar[XB_XGEN(b.x)], 1u);
            asm volatile("s_waitcnt vmcnt(0)" ::: "memory");
        } else {
            XB_SPIN(xb_ld(&bar[XB_XGEN(b.x)]) == gen, bar);
            __builtin_amdgcn_fence(__ATOMIC_ACQUIRE, "agent");
            asm volatile("s_waitcnt vmcnt(0)" ::: "memory");
        }
    }
    __syncthreads();
}

struct Args { const float* in[25]; float* out; unsigned char* ws; int ph_lo, ph_hi; };
typedef const float* fptr_t; typedef __attribute__((address_space(4))) const fptr_t* kinptr_t;
struct ArgView { kinptr_t in; };
struct Frame {
    LAS unsigned char* lds;
    volatile LAS unsigned* MISC;
    unsigned* ctl;
    int tid, lane, wave, vcu, G;
    kinptr_t in;
    unsigned char* ws;
};
__device__ __forceinline__ float wave_sum(float v) {
#pragma unroll
    for (int o = 1; o < 64; o <<= 1) v += __shfl_xor(v, o);
    return v;
}
__device__ __forceinline__ int q_next(Frame& F, int q) {
    __syncthreads();
    if (F.tid == 0) F.MISC[16] = xb_add(F.ctl + CW_Q + 64 * q, 1u);
    __syncthreads();
    return (int)F.MISC[16];
}

struct MapPlain { __device__ __forceinline__ int row(int n) const { return n; } __device__ __forceinline__ float scale(int) const { return 1.f; } };
struct MapGU { int off; __device__ __forceinline__ int row(int n) const { return 256 * (n >> 7) + off + (n & 127); } __device__ __forceinline__ float scale(int) const { return 1.f; } };
struct MapIn {
    __device__ __forceinline__ int row(int n) const {
        if (n < 1024) return n;
        if (n < 1032) return 13 * 256 + (n - 1024);
        if (n < 1544) return 4 * 256 + (n - 1032);
        if (n < 2568) return 6 * 256 + (n - 1544);
        if (n < 2576) return 13 * 256 + 8 + (n - 2568);
        return 10 * 256 + (n - 2576);
    }
    __device__ __forceinline__ float scale(int n) const { return (n >= 256 && n < 512) ? 0.125f : 1.f; }
};
template <class Map>
__device__ __forceinline__ void p0_transpose_item(const float* W, int K, int N, bf16_t* WT, int item, int lane, const float* gain, const Map map) {
    const int nblk = (N + 63) / 64, kb = item / nblk, nb = item % nblk, k0 = 64 * kb, n = 64 * nb + lane;
    if (n >= N) return;
    const float* src = W + (size_t)k0 * N + n;
    float v[64];
#pragma unroll
    for (int i = 0; i < 64; ++i) v[i] = src[(size_t)i * N];
    const float sc = map.scale(n);
    if (gain) {
#pragma unroll
        for (int i = 0; i < 64; i += 4) { const f32x4 g = *(const f32x4*)(gain + k0 + i); v[i] *= g.x; v[i + 1] *= g.y; v[i + 2] *= g.z; v[i + 3] *= g.w; }
    }
    u32x4* dst = (u32x4*)(WT + (size_t)map.row(n) * K + k0);
#pragma unroll
    for (int c = 0; c < 8; ++c) { u32x4 o; o.x = cvtpk(v[8 * c] * sc, v[8 * c + 1] * sc); o.y = cvtpk(v[8 * c + 2] * sc, v[8 * c + 3] * sc); o.z = cvtpk(v[8 * c + 4] * sc, v[8 * c + 5] * sc); o.w = cvtpk(v[8 * c + 6] * sc, v[8 * c + 7] * sc); dst[c] = o; }
}
constexpr int I_G = (DM / 64) * (FF / 64), I_D = (FF / 64) * (DM / 64), I_IN = (DM / 64) * ((3344 + 63) / 64), I_OUT = (DM / 64) * (DM / 64);
constexpr int R_GU1 = 0, R_D1 = 2 * I_G, R_IN = R_D1 + I_D, R_OUT = R_IN + I_IN, R_GU2 = R_OUT + I_OUT, R_D2 = R_GU2 + 2 * I_G, R_END = R_D2 + I_D;
__device__ __forceinline__ void convert_items(Frame& F, int l, int r_lo, int r_hi, int gw, int NGW) {
    bf16_t* WL = (bf16_t*)(F.ws + WS_W + (size_t)l * W_LAYER);
    for (int it = r_lo + gw; it < r_hi; it += NGW) {
        int r = it;
        if (r < I_G) { p0_transpose_item(F.in[2] + (size_t)l * DM * FF, DM, FF, (bf16_t*)((char*)WL + W_GU1), r, F.lane, F.in[1] + l * DM, MapGU{0}); continue; } r -= I_G;
        if (r < I_G) { p0_transpose_item(F.in[3] + (size_t)l * DM * FF, DM, FF, (bf16_t*)((char*)WL + W_GU1), r, F.lane, F.in[1] + l * DM, MapGU{128}); continue; } r -= I_G;
        if (r < I_D) { p0_transpose_item(F.in[4] + (size_t)l * FF * DM, FF, DM, (bf16_t*)((char*)WL + W_D1), r, F.lane, nullptr, MapPlain{}); continue; } r -= I_D;
        if (r < I_IN) { p0_transpose_item(F.in[6] + (size_t)l * DM * 3344, DM, 3344, (bf16_t*)((char*)WL + W_IN), r, F.lane, F.in[5] + l * DM, MapIn{}); continue; } r -= I_IN;
        if (r < I_OUT) { p0_transpose_item(F.in[20] + (size_t)l * DM * DM, DM, DM, (bf16_t*)((char*)WL + W_OUT), r, F.lane, nullptr, MapPlain{}); continue; } r -= I_OUT;
        if (r < I_G) { p0_transpose_item(F.in[22] + (size_t)l * DM * FF, DM, FF, (bf16_t*)((char*)WL + W_GU2), r, F.lane, F.in[21] + l * DM, MapGU{0}); continue; } r -= I_G;
        if (r < I_G) { p0_transpose_item(F.in[23] + (size_t)l * DM * FF, DM, FF, (bf16_t*)((char*)WL + W_GU2), r, F.lane, F.in[21] + l * DM, MapGU{128}); continue; } r -= I_G;
        p0_transpose_item(F.in[24] + (size_t)l * FF * DM, FF, DM, (bf16_t*)((char*)WL + W_D2), r, F.lane, nullptr, MapPlain{});
    }
    if (r_lo <= R_IN && R_IN < r_hi) {
        u32x4* z = (u32x4*)(F.ws + WS_W + (size_t)l * W_LAYER + W_IN + (size_t)(13 * 256 + 16) * DM * 2);
        const int n16 = 240 * DM * 2 / 16;
        unsigned z0 = 0u; asm volatile("" : "+v"(z0));
        for (int i = gw * 64 + F.lane; i < n16; i += NGW * 64) z[i] = (u32x4){z0, z0, z0, z0};
    }
}
__device__ __forceinline__ void side_convert(Frame& F, int l, int k) {
    if ((int)blockIdx.x < 128 || F.G != 256) return;
    const int gw = ((int)blockIdx.x - 128) * NWAVES + F.wave, NGW = 128 * NWAVES;
    if (l == 0 && k == 0) convert_items(F, 0, R_D1, R_OUT, gw, NGW);
    else if (l == 0 && k == 2) convert_items(F, 0, R_OUT, R_END, gw, NGW);
    else if (l == 0 && k == 7) convert_items(F, 1, R_GU1, R_D1, gw, NGW);
    else if (l == 1 && k == 0) convert_items(F, 1, R_D1, R_GU2, gw, NGW);
    else if (l == 1 && k == 2) convert_items(F, 1, R_GU2, R_D2, gw, NGW);
    else if (l == 1 && k == 7) convert_items(F, 1, R_D2, R_END, gw, NGW);
}
__device__ __forceinline__ void p0_prologue(Frame& F) {
    const int gw = F.vcu * NWAVES + F.wave, NGW = F.G * NWAVES;
    if (F.G == 256) convert_items(F, 0, R_GU1, R_D1, gw, NGW);
    else { convert_items(F, 0, 0, R_END, gw, NGW); convert_items(F, 1, 0, R_END, gw, NGW); }
    const float* x = F.in[0]; bf16_t* XB = (bf16_t*)(F.ws + WS_XB); float* SSQ = (float*)(F.ws + WS_SSQ);
    for (int m = gw; m < M_TOK; m += NGW) {
        const f32x4* xr = (const f32x4*)(x + (size_t)m * DM) + F.lane; float s = 0.f; f32x4 v[4];
#pragma unroll
        for (int j = 0; j < 4; ++j) { v[j] = xr[64 * j]; s += (v[j].x * v[j].x + v[j].y * v[j].y) + (v[j].z * v[j].z + v[j].w * v[j].w); }
        s = wave_sum(s);
        u32x2* o8 = (u32x2*)(XB + (size_t)m * DM) + F.lane;
#pragma unroll
        for (int j = 0; j < 4; ++j) o8[64 * j] = (u32x2){cvtpk(v[j].x, v[j].y), cvtpk(v[j].z, v[j].w)};
        if (F.lane < 16) SSQ[(size_t)m * 16 + F.lane] = (F.lane == 0) ? s : 0.f;
    }
}

__device__ __forceinline__ void rows_rs(const float* ssq, int rowbase, int fr, int fq, float (&rs)[8]) {
    f32x4 p[8];
#pragma unroll
    for (int i = 0; i < 8; ++i) { const int row = rowbase + (i >> 2) * 128 + (i & 3) * 16 + fr; p[i] = *(const f32x4*)(ssq + (size_t)row * 16 + 4 * fq); }
#pragma unroll
    for (int i = 0; i < 8; ++i) { float s = (p[i].x + p[i].y) + (p[i].z + p[i].w); s += __shfl_xor(s, 16); s += __shfl_xor(s, 32); rs[i] = rsqrtf(s * (1.0f / DM) + NORM_EPS); }
}
struct EpiNoInit { struct Raw {}; static constexpr bool HAS_INIT = false; __device__ __forceinline__ void init_load(Raw&, const pg8::Unit&, int, int, int, int) const {} };
struct EpiSwiglu : EpiNoInit {
    bf16_t* H; const float* ssq;
    __device__ __forceinline__ void operator()(const f32x4 (&acc)[2][2][4][2], const pg8::Unit& u, int wr, int wc, int fr, int fq) const {
        asm volatile("" : "+v"(fr), "+v"(fq));
        const int col0 = u.pn * 128 + wc * 32 + 8 * fq;
        float rs[8]; rows_rs(ssq, u.pm * 256 + wr * 64, fr, fq, rs);
#pragma unroll
        for (int ai = 0; ai < 2; ++ai)
#pragma unroll
            for (int m = 0; m < 4; ++m) {
                const int row = u.pm * 256 + ai * 128 + wr * 64 + m * 16 + fr; const float r = rs[ai * 4 + m];
                float hv[8];
#pragma unroll
                for (int n = 0; n < 2; ++n)
#pragma unroll
                    for (int j = 0; j < 4; ++j) { const float g = acc[ai][0][m][n][j] * r, up = acc[ai][1][m][n][j] * r; hv[4 * n + j] = siluf_(g) * up; }
                u32x4 w; w.x = cvtpk(hv[0], hv[1]); w.y = cvtpk(hv[2], hv[3]); w.z = cvtpk(hv[4], hv[5]); w.w = cvtpk(hv[6], hv[7]);
                st16_wt(H + (size_t)row * FF + col0, w);
                if (m & 1) asm volatile("" ::: "memory");
            }
    }
};
template <bool FINAL>
struct EpiResid {
    struct Raw { u32x4 r[2][4][2]; };
    static constexpr bool HAS_INIT = true;
    float* xout; bf16_t* XB; float* ssq; float alpha, ralpha;
    __device__ __forceinline__ void init_load(Raw& raw, const pg8::Unit& u, int wr, int wc, int fr, int fq) const {
        const int col0 = u.pn * 256 + wc * 32 + 8 * fq;
#pragma unroll
        for (int ai = 0; ai < 2; ++ai)
#pragma unroll
            for (int m = 0; m < 4; ++m) { const int row = u.pm * 256 + ai * 128 + wr * 64 + m * 16 + fr;
#pragma unroll
                for (int bj = 0; bj < 2; ++bj) raw.r[ai][m][bj] = *(const u32x4*)(XB + (size_t)row * DM + col0 + bj * 128); }
    }
    __device__ __forceinline__ void init_finish(const Raw& raw, f32x4 (&acc)[2][2][4][2]) const {
#pragma unroll
        for (int ai = 0; ai < 2; ++ai)
#pragma unroll
            for (int m = 0; m < 4; ++m)
#pragma unroll
                for (int bj = 0; bj < 2; ++bj) { const u32x4 w = raw.r[ai][m][bj];
                    acc[ai][bj][m][0] = (f32x4){bflo(w.x), bfhi(w.x), bflo(w.y), bfhi(w.y)} * ralpha; acc[ai][bj][m][1] = (f32x4){bflo(w.z), bfhi(w.z), bflo(w.w), bfhi(w.w)} * ralpha; }
    }
    __device__ __forceinline__ void operator()(const f32x4 (&acc)[2][2][4][2], const pg8::Unit& u, int wr, int wc, int fr, int fq) const {
        asm volatile("" : "+v"(fr), "+v"(fq));
        const int col0 = u.pn * 256 + wc * 32 + 8 * fq;
#pragma unroll
        for (int ai = 0; ai < 2; ++ai)
#pragma unroll
            for (int m = 0; m < 4; ++m) {
                const int row = u.pm * 256 + ai * 128 + wr * 64 + m * 16 + fr; float ss = 0.f;
#pragma unroll
                for (int bj = 0; bj < 2; ++bj) {
                    const size_t off = (size_t)row * DM + col0 + bj * 128;
                    const f32x4 y0 = acc[ai][bj][m][0] * alpha, y1 = acc[ai][bj][m][1] * alpha;
                    if (FINAL) { *(f32x4*)(xout + off) = y0; *(f32x4*)(xout + off + 4) = y1; }
                    else {
                        ss += (y0.x * y0.x + y0.y * y0.y) + (y0.z * y0.z + y0.w * y0.w) + (y1.x * y1.x + y1.y * y1.y) + (y1.z * y1.z + y1.w * y1.w);
                        u32x4 w; w.x = cvtpk(y0.x, y0.y); w.y = cvtpk(y0.z, y0.w); w.z = cvtpk(y1.x, y1.y); w.w = cvtpk(y1.z, y1.w);
                        st16_wt(XB + off, w); }
                }
                if (!FINAL) { ss += __shfl_xor(ss, 16); ss += __shfl_xor(ss, 32);
                    if (fq == 0) ssq[(size_t)row * 16 + u.pn * 4 + wc] = ss; }
                if (m & 1) asm volatile("" ::: "memory");
            }
    }
};
struct EpiInProj : EpiNoInit {
    bf16_t* PROJ; float* GATES; const float* ssq; const float* qnw; const float* knw; const float* gbias; const float* dtb;
    template <int KIND>
    __device__ __forceinline__ void body(const f32x4 (&acc)[2][2][4][2], const pg8::Unit& u, int wr, int wc, int fr, int fq, const float (&rs)[8]) const {
        const int t = u.pn, colw = wc * 32 + 8 * fq;
        float nw[8];
        if (KIND == 3) { const float* w = (t == 10 ? qnw : knw) + (wc & 1) * 32 + 8 * fq; const float sc = (t == 10) ? (0.17677669529663687f * LOG2E) : 1.f;
#pragma unroll
            for (int i = 0; i < 8; ++i) nw[i] = w[i] * sc; }
#pragma unroll
        for (int ai = 0; ai < 2; ++ai)
#pragma unroll
            for (int m = 0; m < 4; ++m) {
                const int row = u.pm * 256 + ai * 128 + wr * 64 + m * 16 + fr; const float r = rs[ai * 4 + m];
#pragma unroll
                for (int bj = 0; bj < 2; ++bj) {
                    float v[8];
#pragma unroll
                    for (int n = 0; n < 2; ++n)
#pragma unroll
                        for (int j = 0; j < 4; ++j) v[4 * n + j] = acc[ai][bj][m][n][j] * r;
                    if (KIND == 1) {
#pragma unroll
                        for (int i = 0; i < 8; ++i) v[i] = sigmoidf_(v[i]);
                    } else if (KIND == 2) {
#pragma unroll
                        for (int i = 0; i < 8; ++i) v[i] = siluf_(v[i]);
                    } else if (KIND == 3) {
                        float ss = 0.f;
#pragma unroll
                        for (int i = 0; i < 8; ++i) ss += v[i] * v[i];
                        ss += __shfl_xor(ss, 16); ss += __shfl_xor(ss, 32);
                        const float q = rsqrtf(ss * (1.0f / 32.0f) + NORM_EPS);
#pragma unroll
                        for (int i = 0; i < 8; ++i) v[i] = v[i] * q * nw[i];
                    }
                    u32x4 w; w.x = cvtpk(v[0], v[1]); w.y = cvtpk(v[2], v[3]); w.z = cvtpk(v[4], v[5]); w.w = cvtpk(v[6], v[7]);
                    st16_wt(PROJ + (size_t)row * PLD + t * 256 + bj * 128 + colw, w);
                }
                if (m & 1) asm volatile("" ::: "memory");
            }
    }
    __device__ __forceinline__ void gates(const f32x4 (&acc)[2][2][4][2], const pg8::Unit& u, int wr, int wc, int fr, int fq, const float (&rs)[8]) const {
        if (wc != 0 || fq >= 2) return;
#pragma unroll
        for (int ai = 0; ai < 2; ++ai)
#pragma unroll
            for (int m = 0; m < 4; ++m) {
                const int row = u.pm * 256 + ai * 128 + wr * 64 + m * 16 + fr; const float r = rs[ai * 4 + m];
                float v[8], o[8];
#pragma unroll
                for (int n = 0; n < 2; ++n)
#pragma unroll
                    for (int j = 0; j < 4; ++j) v[4 * n + j] = acc[ai][0][m][n][j] * r;
                if (fq == 0) {
#pragma unroll
                    for (int j = 0; j < 4; ++j) { o[j] = v[j] + gbias[j]; const float z = v[4 + j] + gbias[4 + j]; o[4 + j] = fminf(z, 0.f) - fast_log1pexp(-fabsf(z)); }
                } else {
#pragma unroll
                    for (int j = 0; j < 8; ++j) { const float z = v[j] + dtb[j]; o[j] = fmaxf(z, 0.f) + fast_log1pexp(-fabsf(z)); }
                }
                float* gp = GATES + (size_t)row * 16 + 8 * fq;
                *(f32x4*)gp = (f32x4){o[0], o[1], o[2], o[3]}; *(f32x4*)(gp + 4) = (f32x4){o[4], o[5], o[6], o[7]};
                asm volatile("" ::: "memory");
            }
    }
    __device__ __forceinline__ void operator()(const f32x4 (&acc)[2][2][4][2], const pg8::Unit& u, int wr, int wc, int fr, int fq) const {
        asm volatile("" : "+v"(fr), "+v"(fq));
        float rs[8]; rows_rs(ssq, u.pm * 256 + wr * 64, fr, fq, rs);
        const int t = u.pn;
        if (t == 13) gates(acc, u, wr, wc, fr, fq, rs);
        else if (t == 3) body<1>(acc, u, wr, wc, fr, fq, rs);
        else if (t == 4 || t == 5) body<2>(acc, u, wr, wc, fr, fq, rs);
        else if (t == 10 || t == 11) body<3>(acc, u, wr, wc, fr, fq, rs);
        else body<0>(acc, u, wr, wc, fr, fq, rs);
    }
};
#define MFMA16(a, b, c) __builtin_amdgcn_mfma_f32_16x16x32_bf16((a), (b), (c), 0, 0, 0)
#define WAVE_SYNC() do { asm volatile("s_waitcnt lgkmcnt(0)" ::: "memory"); __builtin_amdgcn_wave_barrier(); } while (0)
#define LDS_BARRIER() do { asm volatile("s_waitcnt lgkmcnt(0)" ::: "memory"); __builtin_amdgcn_s_barrier(); asm volatile("" ::: "memory"); } while (0)
__device__ __forceinline__ bf16x8 ld_g8(const bf16_t* p) { return *(const bf16x8*)p; }
__device__ __forceinline__ bf16x8 ld_l8(const LAS bf16_t* p) { return *(const LAS bf16x8*)p; }
__device__ __forceinline__ bf16x8 ld_l44(const LAS bf16_t* p0, const LAS bf16_t* p1) { const bf16x4 a = *(const LAS bf16x4*)p0, b = *(const LAS bf16x4*)p1; return (bf16x8){a[0], a[1], a[2], a[3], b[0], b[1], b[2], b[3]}; }
__device__ __forceinline__ bf16x8 pack8(const f32x4 a, const f32x4 b) { u32x4 w; w.x = cvtpk(a[0], a[1]); w.y = cvtpk(a[2], a[3]); w.z = cvtpk(b[0], b[1]); w.w = cvtpk(b[2], b[3]); return __builtin_bit_cast(bf16x8, w); }
__device__ __forceinline__ float wave_scan_incl(float v, int lane) {
#pragma unroll
    for (int o = 1; o < 64; o <<= 1) { const float t = __shfl_up(v, o); if (lane >= o) v += t; }
    return v;
}

typedef short v4i16_t __attribute__((ext_vector_type(4)));
__device__ __forceinline__ bf16x8 ld_tr8(const LAS bf16_t* T, int pitch, int k0, int c0, int lane) {
    const int i = lane & 15, fq = lane >> 4;
    const LAS bf16_t* p = T + (k0 + 8 * fq + (i >> 2)) * pitch + c0 + 4 * (i & 3);
    const v4i16_t lo = __builtin_amdgcn_ds_read_tr16_b64_v4i16((LAS v4i16_t*)p), hi = __builtin_amdgcn_ds_read_tr16_b64_v4i16((LAS v4i16_t*)(p + 4 * pitch));
    return (bf16x8){lo[0], lo[1], lo[2], lo[3], hi[0], hi[1], hi[2], hi[3]};
}
__device__ __forceinline__ bf16x8 ld_tr8p(const LAS bf16_t* T, int pitch, int k0, int c0, int lane) {
    const int i = lane & 15, fq = lane >> 4;
    const LAS bf16_t* p = T + (k0 + 4 * fq + (i >> 2)) * pitch + c0 + 4 * (i & 3);
    const v4i16_t lo = __builtin_amdgcn_ds_read_tr16_b64_v4i16((LAS v4i16_t*)p), hi = __builtin_amdgcn_ds_read_tr16_b64_v4i16((LAS v4i16_t*)(p + 16 * pitch));
    return (bf16x8){lo[0], lo[1], lo[2], lo[3], hi[0], hi[1], hi[2], hi[3]};
}

__device__ __forceinline__ void conv_phase(Frame& F, int l) {
    const bf16_t* PROJ = (const bf16_t*)(F.ws + WS_PROJ); bf16_t* XACT = (bf16_t*)F.in[25];
    const float* cw = F.in[9] + (size_t)l * 4 * 1024; const float* cb = F.in[10] + (size_t)l * 1024;
    for (int g = F.vcu * NTHREADS + F.tid; g < 1024 * 128; g += F.G * NTHREADS) {
        const int cg = g & 127, rb = g >> 7, ch0 = cg * 8, row0 = rb * 16;
        float w[4][8], bs[8];
#pragma unroll
        for (int j = 0; j < 4; ++j) { const f32x4 a = *(const f32x4*)(cw + j * 1024 + ch0), b = *(const f32x4*)(cw + j * 1024 + ch0 + 4);
            w[j][0] = a.x; w[j][1] = a.y; w[j][2] = a.z; w[j][3] = a.w; w[j][4] = b.x; w[j][5] = b.y; w[j][6] = b.z; w[j][7] = b.w; }
        { const f32x4 a = *(const f32x4*)(cb + ch0), b = *(const f32x4*)(cb + ch0 + 4); bs[0] = a.x; bs[1] = a.y; bs[2] = a.z; bs[3] = a.w; bs[4] = b.x; bs[5] = b.y; bs[6] = b.z; bs[7] = b.w; }
        float h3[8], h2[8], h1[8];
        const bool first = (row0 % SEQ) == 0;
        const bf16_t* src = PROJ + (size_t)row0 * PLD + PX + ch0;
        if (first) {
#pragma unroll
            for (int e = 0; e < 8; ++e) { h3[e] = 0.f; h2[e] = 0.f; h1[e] = 0.f; }
        } else {
            const u32x4 a = *(const u32x4*)(src - 3 * (size_t)PLD), b = *(const u32x4*)(src - 2 * (size_t)PLD), c = *(const u32x4*)(src - (size_t)PLD);
#pragma unroll
            for (int e = 0; e < 4; ++e) { h3[2 * e] = bflo(a[e]); h3[2 * e + 1] = bfhi(a[e]); h2[2 * e] = bflo(b[e]); h2[2 * e + 1] = bfhi(b[e]); h1[2 * e] = bflo(c[e]); h1[2 * e + 1] = bfhi(c[e]); }
        }
        u32x4 dr[16];
#pragma unroll
        for (int i = 0; i < 16; ++i) dr[i] = *(const u32x4*)(src + (size_t)i * PLD);
#pragma unroll
        for (int i = 0; i < 16; ++i) {
            const u32x4 d = dr[i]; float cur[8], o[8];
#pragma unroll
            for (int e = 0; e < 4; ++e) { cur[2 * e] = bflo(d[e]); cur[2 * e + 1] = bfhi(d[e]); }
#pragma unroll
            for (int e = 0; e < 8; ++e) { const float s = bs[e] + w[0][e] * h3[e] + w[1][e] * h2[e] + w[2][e] * h1[e] + w[3][e] * cur[e]; o[e] = siluf_(s); h3[e] = h2[e]; h2[e] = h1[e]; h1[e] = cur[e]; }
            u32x4 ow; ow.x = cvtpk(o[0], o[1]); ow.y = cvtpk(o[2], o[3]); ow.z = cvtpk(o[4], o[5]); ow.w = cvtpk(o[6], o[7]);
            *(u32x4*)(XACT + (size_t)(row0 + i) * 1024 + ch0) = ow;
        }
    }
}

__device__ __forceinline__ void mlstm_state_item(Frame& F, int bh) {
    const int b = bh >> 2, h = bh & 3, w = F.wave, vq = w & 3, dh = w >> 2, lane = F.lane, fr = lane & 15, fq = lane >> 4, tid = F.tid;
    constexpr int MP = 72, MBUF = 2 * 64 * MP * 2 + 128;
    LAS float* WG = (LAS float*)(F.lds + 2 * MBUF); LAS float* DEC = WG + 4096;
    const bf16_t* PROJ = (const bf16_t*)(F.ws + WS_PROJ); const float* GATES = (const float*)(F.ws + WS_GATES);
    bf16_t* CST = (bf16_t*)(F.ws + WS_CST); float* NST = (float*)(F.ws + WS_NST);
    const size_t rowb = (size_t)b * SEQ;
    {
        float igv[8], lfv[8];
#pragma unroll
        for (int i = 0; i < 8; ++i) { const float* gq = GATES + (rowb + 64 * (w + 8 * i) + lane) * 16 + h; igv[i] = gq[0]; lfv[i] = gq[4]; }
#pragma unroll
        for (int i = 0; i < 8; ++i) { const int c = w + 8 * i;
            const float bs = wave_scan_incl(lfv[i], lane); const float bl = __shfl(bs, 63);
            WG[64 * c + lane] = fast_exp(bl - bs + igv[i]); if (lane == 0) DEC[c] = fast_exp(bl); }
    }
    f32x4 acc[2], nacc[2];
    acc[0] = acc[1] = nacc[0] = nacc[1] = (f32x4){0.f, 0.f, 0.f, 0.f};
    const int ls = tid >> 3, lc = tid & 7;
    const bf16_t* kp = PROJ + (rowb + ls) * PLD + PK + h * 64 + 8 * lc; const bf16_t* vp = PROJ + (rowb + ls) * PLD + PV + h * 64 + 8 * lc;
    u32x4 k0, v0, k1, v1, k2, v2;
#define ML_LOAD(kr_, vr_, c_) do { const size_t o_ = (size_t)(c_) * 64 * PLD; kr_ = *(const u32x4*)(kp + o_); vr_ = *(const u32x4*)(vp + o_); } while (0)
#define ML_WRITE(kr_, vr_, c_) do { LAS bf16_t* KL_ = (LAS bf16_t*)(F.lds + ((c_) & 1) * MBUF); LAS bf16_t* VL_ = KL_ + 64 * MP; const float wg_ = WG[64 * (c_) + ls]; \
        *(LAS u32x4*)(KL_ + ls * MP + 8 * lc) = kr_; u32x4 o_; _Pragma("unroll") for (int e_ = 0; e_ < 4; ++e_) o_[e_] = cvtpk(wg_ * bflo(vr_[e_]), wg_ * bfhi(vr_[e_])); \
        *(LAS u32x4*)(VL_ + ls * MP + 8 * lc) = o_; if (lc == 0) (VL_ + 64 * MP)[ls] = f2bf(wg_); } while (0)
    LAS bf16_t* STG = (LAS bf16_t*)(F.lds + 2 * MBUF + 16384 + 256); LAS float* NSTG = (LAS float*)(STG + 2 * 4096);
#define ML_STAGE(c_) do { LAS bf16_t* sg_ = STG + ((c_) & 1) * 4096; \
        _Pragma("unroll") for (int dt = 0; dt < 2; ++dt) _Pragma("unroll") for (int r = 0; r < 4; ++r) sg_[(vq * 16 + 4 * fq + r) * 64 + dh * 32 + dt * 16 + fr] = f2bf(acc[dt][r]); \
        if (vq == 0 && fq == 0) { NSTG[((c_) & 1) * 64 + dh * 32 + fr] = nacc[0][0]; NSTG[((c_) & 1) * 64 + dh * 32 + 16 + fr] = nacc[1][0]; } } while (0)
    ML_LOAD(k0, v0, 0); ML_LOAD(k1, v1, 1); ML_LOAD(k2, v2, 2);
    __syncthreads();
    ML_WRITE(k0, v0, 0);
    ML_STAGE(0);
    LDS_BARRIER();
#define ML_STEP(KW, VW, KN, VN, c_) do { const int cc_ = (c_); const size_t ci = (size_t)bh * 64 + cc_; \
          \
        { const u32x4 st_ = *(const LAS u32x4*)(STG + ((cc_) & 1) * 4096 + tid * 8); *(u32x4*)(CST + ci * 4096 + tid * 8) = st_; \
          NST[ci * 64 + (tid & 63)] = NSTG[((cc_) & 1) * 64 + (tid & 63)]; }     \
        asm volatile("" ::: "memory"); \
        if (cc_ + 1 < 64) ML_WRITE(KW, VW, cc_ + 1); \
        asm volatile("" ::: "memory"); \
        ML_LOAD(KN, VN, (cc_ + 3 < 64 ? cc_ + 3 : 63)); \
        asm volatile("" ::: "memory"); \
        const float decay = DEC[cc_]; \
        const LAS bf16_t* KL = (const LAS bf16_t*)(F.lds + (cc_ & 1) * MBUF); const LAS bf16_t* VL = KL + 64 * MP; const LAS bf16_t* WV = VL + 64 * MP; \
        _Pragma("unroll") for (int dt = 0; dt < 2; ++dt) { acc[dt] = acc[dt] * decay; nacc[dt] = nacc[dt] * decay; } \
        _Pragma("unroll") for (int ks = 0; ks < 2; ++ks) { \
            const bf16x8 A = ld_tr8(VL, MP, 32 * ks, 16 * vq, lane); \
            bf16x8 An = ld_l8(WV + 32 * ks + 8 * fq); if (fr != 0) An = (bf16x8){0, 0, 0, 0, 0, 0, 0, 0}; \
            _Pragma("unroll") for (int dt = 0; dt < 2; ++dt) { const bf16x8 B = ld_tr8(KL, MP, 32 * ks, 32 * dh + 16 * dt, lane); \
                acc[dt] = MFMA16(A, B, acc[dt]); if (vq == 0) nacc[dt] = MFMA16(An, B, nacc[dt]); } } \
        ML_STAGE(cc_ + 1); \
        LDS_BARRIER(); } while (0)
    for (int c = 0; c < 63; c += 3) { ML_STEP(k1, v1, k0, v0, c); ML_STEP(k2, v2, k1, v1, c + 1); ML_STEP(k0, v0, k2, v2, c + 2); }
    ML_STEP(k1, v1, k0, v0, 63);
#undef ML_STEP
#undef ML_LOAD
#undef ML_WRITE
#undef ML_STAGE
}

template <int TH>
__device__ __forceinline__ void mlstm_out_wave(Frame& F, int l, int bc, int h) {
    const int b = bc >> 6, c = bc & 63, w = F.wave, lane = F.lane, fr = lane & 15, fq = lane >> 4;
    constexpr int VP = 72;
    LAS bf16_t* VL = (LAS bf16_t*)(F.lds + w * 12288); LAS float* BT_ = (LAS float*)(F.lds + w * 12288 + 9216); LAS float* GS = BT_ + 64;
    LAS bf16_t* YS = VL;
    const bf16_t* PROJ = (const bf16_t*)(F.ws + WS_PROJ); const float* GATES = (const float*)(F.ws + WS_GATES);
    const bf16_t* CST = (const bf16_t*)(F.ws + WS_CST); const float* NST = (const float*)(F.ws + WS_NST);
    bf16_t* Y = (bf16_t*)(F.ws + WS_PROJ) + PX;
    const size_t row0 = (size_t)b * SEQ + 64 * c; const size_t ci = (size_t)(b * 4 + h) * 64 + c;
    constexpr int NST_ = 2 * TH + 2, NKK = TH + 1;
    {
        const size_t row = row0 + lane;
        const float ig = GATES[row * 16 + h], lf = GATES[row * 16 + 4 + h];
        const bf16_t* vp = PROJ + row * PLD + PV + h * 64;
        u32x4 vr[8];
#pragma unroll
        for (int i = 0; i < 8; ++i) vr[i] = *(const u32x4*)(vp + 8 * i);
        const float bs = wave_scan_incl(lf, lane);
        BT_[lane] = bs; GS[lane] = ig - bs;
#pragma unroll
        for (int i = 0; i < 8; ++i) *(LAS u32x4*)(VL + lane * VP + 8 * i) = vr[i];
    }
    bf16x8 Qf[2][2], Kf[NST_][2];
#pragma unroll
    for (int tt = 0; tt < 2; ++tt)
#pragma unroll
        for (int ks = 0; ks < 2; ++ks) Qf[tt][ks] = ld_g8(PROJ + (row0 + 32 * TH + 16 * tt + fr) * PLD + PQ + h * 64 + 32 * ks + 8 * fq);
#pragma unroll
    for (int st = 0; st < NST_; ++st)
#pragma unroll
        for (int ks = 0; ks < 2; ++ks) Kf[st][ks] = ld_g8(PROJ + (row0 + 16 * st + fr) * PLD + PK + h * 64 + 32 * ks + 8 * fq);
    bf16x8 Cf[4][2];
#pragma unroll
    for (int vt = 0; vt < 4; ++vt)
#pragma unroll
        for (int ks = 0; ks < 2; ++ks) Cf[vt][ks] = ld_g8(CST + ci * 4096 + (16 * vt + fr) * 64 + 32 * ks + 8 * fq);
    u32x4 ogv[4];
#pragma unroll
    for (int i = 0; i < 4; ++i) ogv[i] = *(const u32x4*)(PROJ + (row0 + 32 * TH + (lane >> 3) + 8 * i) * PLD + PO + h * 64 + 8 * (lane & 7));
    f32x4 nv[2][2];
#pragma unroll
    for (int ks = 0; ks < 2; ++ks) { nv[ks][0] = *(const f32x4*)(NST + ci * 64 + 32 * ks + 8 * fq); nv[ks][1] = *(const f32x4*)(NST + ci * 64 + 32 * ks + 8 * fq + 4); }
    WAVE_SYNC();
    f32x4 P[2][NST_]; float den[2];
#pragma unroll
    for (int tt = 0; tt < 2; ++tt) {
        const int t = 32 * TH + 16 * tt + fr; const float bt = BT_[t]; float d1 = 0.f;
#pragma unroll
        for (int st = 0; st < NST_; ++st) {
            f32x4 s = (f32x4){0.f, 0.f, 0.f, 0.f};
#pragma unroll
            for (int ks = 0; ks < 2; ++ks) s = MFMA16(Kf[st][ks], Qf[tt][ks], s);
#pragma unroll
            for (int r = 0; r < 4; ++r) { const int sidx = 16 * st + 4 * fq + r; const float wv = (sidx <= t) ? s[r] * fast_exp(bt + GS[sidx]) : 0.f; s[r] = wv; d1 += wv; }
            P[tt][st] = s;
        }
        d1 += __shfl_xor(d1, 16); d1 += __shfl_xor(d1, 32);
        float d2 = 0.f;
#pragma unroll
        for (int ks = 0; ks < 2; ++ks) { const f32x4 n0 = nv[ks][0], n1 = nv[ks][1];
            const u32x4 qw = __builtin_bit_cast(u32x4, Qf[tt][ks]);
            d2 += bflo(qw.x) * n0.x + bfhi(qw.x) * n0.y + bflo(qw.y) * n0.z + bfhi(qw.y) * n0.w + bflo(qw.z) * n1.x + bfhi(qw.z) * n1.y + bflo(qw.w) * n1.z + bfhi(qw.w) * n1.w; }
        d2 += __shfl_xor(d2, 16); d2 += __shfl_xor(d2, 32);
        den[tt] = d1 + fast_exp(bt) * d2;
    }
    const float* nw = F.in[8] + (size_t)l * 256 + h * 64;
    f32x4 acc[2][4];
#pragma unroll
    for (int tt = 0; tt < 2; ++tt) {
#pragma unroll
        for (int vt = 0; vt < 4; ++vt) { acc[tt][vt] = (f32x4){0.f, 0.f, 0.f, 0.f};
#pragma unroll
            for (int ks = 0; ks < 2; ++ks) acc[tt][vt] = MFMA16(Qf[tt][ks], Cf[vt][ks], acc[tt][vt]); }
        float eb[4], dr[4];
#pragma unroll
        for (int r = 0; r < 4; ++r) { eb[r] = fast_exp(BT_[32 * TH + 16 * tt + 4 * fq + r]); dr[r] = __shfl(den[tt], 4 * fq + r); }
#pragma unroll
        for (int vt = 0; vt < 4; ++vt)
#pragma unroll
            for (int r = 0; r < 4; ++r) acc[tt][vt][r] *= eb[r];
#pragma unroll
        for (int kk = 0; kk < NKK; ++kk) { const bf16x8 PA = pack8(P[tt][2 * kk], P[tt][2 * kk + 1]);
            bf16x8 Bv[4];
#pragma unroll
            for (int vt = 0; vt < 4; ++vt) Bv[vt] = ld_tr8p(VL, VP, 32 * kk, 16 * vt, lane);
#pragma unroll
            for (int vt = 0; vt < 4; ++vt) acc[tt][vt] = MFMA16(PA, Bv[vt], acc[tt][vt]); }
#pragma unroll
        for (int r = 0; r < 4; ++r) { const float inv = fast_rcp(fmaxf(fabsf(dr[r]), 1.0f)); float s = 0.f;
#pragma unroll
            for (int vt = 0; vt < 4; ++vt) { acc[tt][vt][r] *= inv; s += acc[tt][vt][r] * acc[tt][vt][r]; }
            s += __shfl_xor(s, 1); s += __shfl_xor(s, 2); s += __shfl_xor(s, 4); s += __shfl_xor(s, 8); const float rs = rsqrtf(s * (1.0f / 64.0f) + NORM_EPS);
#pragma unroll
            for (int vt = 0; vt < 4; ++vt) acc[tt][vt][r] *= rs * nw[16 * vt + fr]; }
    }
    WAVE_SYNC();
#pragma unroll
    for (int tt = 0; tt < 2; ++tt)
#pragma unroll
        for (int vt = 0; vt < 4; ++vt)
#pragma unroll
            for (int r = 0; r < 4; ++r) YS[(16 * tt + 4 * fq + r) * VP + 16 * vt + fr] = f2bf(acc[tt][vt][r]);
    WAVE_SYNC();
#pragma unroll
    for (int i = 0; i < 4; ++i) { const int tr_ = (lane >> 3) + 8 * i, ch = lane & 7; const size_t row = row0 + 32 * TH + tr_;
        const u32x4 yv = *(const LAS u32x4*)(YS + tr_ * VP + 8 * ch); const u32x4 gv = ogv[i]; u32x4 o;
#pragma unroll
        for (int e = 0; e < 4; ++e) o[e] = cvtpk(bflo(yv[e]) * bflo(gv[e]), bfhi(yv[e]) * bfhi(gv[e]));
        *(u32x4*)(Y + row * PLD + h * 64 + 8 * ch) = o; }
    WAVE_SYNC();
}
__device__ __forceinline__ void mlstm_out_item(Frame& F, int l, int bc) {
    const int h = F.wave >> 1;
    if (F.wave & 1) mlstm_out_wave<1>(F, l, bc, h); else mlstm_out_wave<0>(F, l, bc, h);
}
typedef float f32x16 __attribute__((ext_vector_type(16)));
#define MFMA32(a, b, c) __builtin_amdgcn_mfma_f32_32x32x16_bf16((a), (b), (c), 0, 0, 0)
constexpr int AK_STR = 72, AV_STR = 96;
constexpr int ATT_KB = 128 * AK_STR * 2, ATT_VB = 128 * AV_STR * 2, ATT_BUF = ATT_KB + ATT_VB;
constexpr int ATT_TAB_OFF = 2 * ATT_BUF;
__device__ __forceinline__ int t5_bucket(int n) {
    if (n < 16) return n;
    int bk = 16;
    bk += (n >= 19); bk += (n >= 21); bk += (n >= 24); bk += (n >= 27); bk += (n >= 31); bk += (n >= 35); bk += (n >= 40); bk += (n >= 46);
    bk += (n >= 52); bk += (n >= 59); bk += (n >= 67); bk += (n >= 77); bk += (n >= 87); bk += (n >= 99); bk += (n >= 113);
    return bk;
}
__device__ __forceinline__ int crow16(int reg, int hi) { return (reg & 3) + 8 * (reg >> 2) + 4 * hi; }
__device__ __forceinline__ bf16x8 pack8r(const f32x16& p, const int s) { u32x4 w; w.x = cvtpk(p[8 * s], p[8 * s + 1]); w.y = cvtpk(p[8 * s + 2], p[8 * s + 3]); w.z = cvtpk(p[8 * s + 4], p[8 * s + 5]); w.w = cvtpk(p[8 * s + 6], p[8 * s + 7]); return __builtin_bit_cast(bf16x8, w); }
__device__ __forceinline__ void epilogue_attn(Frame& F, int l, int bh, int qi, f32x16 (&O1)[2], f32x16 (&O2)[2], float l1, float l2);
__device__ __forceinline__ void attn_item(Frame& F, int l, int bh, int qi) {
    const int b = bh >> 2, h = bh & 3, w = F.wave, lane = F.lane, tid = F.tid, r32 = lane & 31, hi = lane >> 5, qq = w & 3, kh = w >> 2;
#ifdef PROBE_A
    const unsigned long long tp0_ = __builtin_amdgcn_s_memrealtime();
#endif
    const bf16_t* PROJ = (const bf16_t*)(F.ws + WS_PROJ); bf16_t* Y = (bf16_t*)(F.ws + WS_PROJ) + PX;
    LAS float* TAB = (LAS float*)(F.lds + ATT_TAB_OFF);
    LAS bf16_t* QL = (LAS bf16_t*)(F.lds + ATT_TAB_OFF + 1024);
    const size_t row0 = (size_t)b * SEQ; const int q0 = qi * 128;
    if (tid < 256) TAB[tid] = F.in[19][t5_bucket(tid) * 4 + h] * LOG2E;
    const int npairs = qi + 1;
    const int lk = tid >> 3, lc = tid & 7;
    const bf16_t* kg = PROJ + (row0 + lk) * PLD + PDK + h * 64 + 8 * lc; const bf16_t* vg = PROJ + (row0 + lk) * PLD + PDV + h * 64 + 8 * lc;
    u32x4 ka0, ka1, va0, va1;
#define ATT_WRITE(k0_, k1_, v0_, v1_, buf) do { LAS bf16_t* KL_ = (LAS bf16_t*)(F.lds + (buf) * ATT_BUF); LAS bf16_t* VL_ = (LAS bf16_t*)(F.lds + (buf) * ATT_BUF + ATT_KB); \
        *(LAS u32x4*)(KL_ + lk * AK_STR + 8 * lc) = k0_; *(LAS u32x4*)(KL_ + (lk + 64) * AK_STR + 8 * lc) = k1_; \
        *(LAS u32x4*)(VL_ + lk * AV_STR + 8 * lc) = v0_; *(LAS u32x4*)(VL_ + (lk + 64) * AV_STR + 8 * lc) = v1_; } while (0)
#define ATT_LOAD(k0_, k1_, v0_, v1_, p) do { const size_t o_ = (size_t)(p) * 128 * PLD; k0_ = *(const u32x4*)(kg + o_); k1_ = *(const u32x4*)(kg + o_ + (size_t)64 * PLD); v0_ = *(const u32x4*)(vg + o_); v1_ = *(const u32x4*)(vg + o_ + (size_t)64 * PLD); } while (0)
    ATT_LOAD(ka0, ka1, va0, va1, 0);
    {
        const bf16_t* qg = PROJ + (row0 + q0 + lk) * PLD + PDQ + h * 64 + 8 * lc;
        const u32x4 q0r = *(const u32x4*)qg, q1r = *(const u32x4*)(qg + (size_t)64 * PLD);
        *(LAS u32x4*)(QL + lk * AK_STR + 8 * lc) = q0r; *(LAS u32x4*)(QL + (lk + 64) * AK_STR + 8 * lc) = q1r; }
    ATT_WRITE(ka0, ka1, va0, va1, 0);
    if (npairs > 1) ATT_LOAD(ka0, ka1, va0, va1, 1);
    const int qrow = q0 + 32 * qq + r32;
    f32x16 O1[2], O2[2];
#pragma unroll
    for (int i = 0; i < 16; ++i) { O1[0][i] = 0.f; O1[1][i] = 0.f; O2[0][i] = 0.f; O2[1][i] = 0.f; }
    f32x4 L1 = {0.f, 0.f, 0.f, 0.f}, L2 = {0.f, 0.f, 0.f, 0.f};
    __syncthreads();
    const float cfar = TAB[255];
    const f32x16 cinit = {0.f, 0.f, 0.f, 0.f, 0.f, 0.f, 0.f, 0.f, 0.f, 0.f, 0.f, 0.f, 0.f, 0.f, 0.f, 0.f};
    const int vlane = (4 * hi + ((lane & 15) >> 2)) * AV_STR + 16 * ((lane >> 4) & 1) + 4 * (lane & 3);
    const LAS bf16_t* qlp = QL + (32 * qq + r32) * AK_STR + 8 * hi;
#ifdef PROBE_SECTIONS
    unsigned long long dA_ = 0, dB_ = 0, dC_ = 0;
#define ATT_T(x_) const unsigned long long x_ = __builtin_amdgcn_s_memtime()
#define ATT_TW(x_) asm volatile("s_waitcnt lgkmcnt(0)" ::: "memory"); const unsigned long long x_ = __builtin_amdgcn_s_memtime()
#define ATT_TACC() do { dA_ += tb_ - ta_; dB_ += tc_ - tb_; dC_ += td_ - tc_; } while (0)
#else
#define ATT_T(x_) do {} while (0)
#define ATT_TW(x_) do {} while (0)
#define ATT_TACC() do {} while (0)
#endif
#define ATT_EXP(S1_, S2_, sub_, NEAR_) do { \
        if (NEAR_) { \
            _Pragma("unroll") for (int r = 0; r < 16; ++r) { const int rel = qrow - (k0 + 32 * (sub_) + crow16(r, hi)); const float bv = TAB[rel < 0 ? 0 : rel] - cfar; \
                const float p1 = __builtin_amdgcn_exp2f(S1_[r] + bv), p2 = __builtin_amdgcn_exp2f(S2_[r] + bv); \
                S1_[r] = rel < 0 ? 0.f : p1; S2_[r] = rel < 0 ? 0.f : p2; } \
        } else { \
            _Pragma("unroll") for (int r = 0; r < 16; ++r) { S1_[r] = __builtin_amdgcn_exp2f(S1_[r]); S2_[r] = __builtin_amdgcn_exp2f(S2_[r]); } \
        } \
        _Pragma("unroll") for (int r = 0; r < 16; r += 4) { L1 += (f32x4){S1_[r], S1_[r + 1], S1_[r + 2], S1_[r + 3]}; L2 += (f32x4){S2_[r], S2_[r + 1], S2_[r + 2], S2_[r + 3]}; } } while (0)
#define ATT_VLOAD(Vf_, sub_) do { _Pragma("unroll") for (int s = 0; s < 2; ++s) _Pragma("unroll") for (int vt = 0; vt < 2; ++vt) { const LAS bf16_t* vp = VL + (32 * (sub_) + 16 * s) * AV_STR + 32 * vt + vlane; \
            const v4i16_t lo = __builtin_amdgcn_ds_read_tr16_b64_v4i16((LAS v4i16_t*)vp), hi4 = __builtin_amdgcn_ds_read_tr16_b64_v4i16((LAS v4i16_t*)(vp + 8 * AV_STR)); \
            Vf_[s][vt] = (bf16x8){lo[0], lo[1], lo[2], lo[3], hi4[0], hi4[1], hi4[2], hi4[3]}; } } while (0)
#define ATT_PV(S1_, S2_, Vf_) do { _Pragma("unroll") for (int s = 0; s < 2; ++s) { const bf16x8 PA1 = pack8r(S1_, s), PA2 = pack8r(S2_, s); \
            _Pragma("unroll") for (int vt = 0; vt < 2; ++vt) { O1[vt] = MFMA32(PA1, Vf_[s][vt], O1[vt]); O2[vt] = MFMA32(PA2, Vf_[s][vt], O2[vt]); } } } while (0)
#define ATT_ITER(k0_, k1_, v0_, v1_, p_, NEAR_) do { const int p = (p_); ATT_T(ta_); \
        if (p + 1 < npairs) { ATT_WRITE(k0_, k1_, v0_, v1_, (p + 1) & 1); } \
        if (p + 2 < npairs) { ATT_LOAD(k0_, k1_, v0_, v1_, p + 2); } \
        ATT_TW(tb_); \
        const int k0 = 128 * p + 64 * kh; \
        if (!(NEAR_) || k0 <= q0 + 32 * qq + 31) { \
            const LAS bf16_t* KL = (const LAS bf16_t*)(F.lds + (p & 1) * ATT_BUF) + 64 * kh * AK_STR; const LAS bf16_t* VL = (const LAS bf16_t*)(F.lds + (p & 1) * ATT_BUF + ATT_KB) + 64 * kh * AV_STR; \
            f32x16 SA1, SA2, SB1, SB2; \
            {   const bf16x8 Q00 = ld_l8(qlp), Q01 = ld_l8(qlp + 16), Q10 = ld_l8(qlp + 32), Q11 = ld_l8(qlp + 48); \
                const LAS bf16_t* kp = KL + r32 * AK_STR + 8 * hi; \
                const bf16x8 a10 = ld_l8(kp), a11 = ld_l8(kp + 16), a20 = ld_l8(kp + 32), a21 = ld_l8(kp + 48); \
                const bf16x8 b10 = ld_l8(kp + 32 * AK_STR), b11 = ld_l8(kp + 32 * AK_STR + 16), b20 = ld_l8(kp + 32 * AK_STR + 32), b21 = ld_l8(kp + 32 * AK_STR + 48); \
                SA1 = MFMA32(a10, Q00, cinit); SA2 = MFMA32(a20, Q10, cinit); SA1 = MFMA32(a11, Q01, SA1); SA2 = MFMA32(a21, Q11, SA2); \
                SB1 = MFMA32(b10, Q00, cinit); SB2 = MFMA32(b20, Q10, cinit); SB1 = MFMA32(b11, Q01, SB1); SB2 = MFMA32(b21, Q11, SB2); } \
            bf16x8 Vf[2][2], Vg[2][2]; \
            ATT_VLOAD(Vf, 0); ATT_VLOAD(Vg, 1); \
            ATT_EXP(SA1, SA2, 0, NEAR_); \
            ATT_PV(SA1, SA2, Vf); \
            ATT_EXP(SB1, SB2, 1, NEAR_); \
            ATT_PV(SB1, SB2, Vg); \
            if (!(NEAR_)) {   \
                __builtin_amdgcn_sched_group_barrier(0x8, 4, 0); \
                _Pragma("unroll") for (int g_ = 0; g_ < 4; ++g_) { __builtin_amdgcn_sched_group_barrier(0x8, 1, 0); __builtin_amdgcn_sched_group_barrier(0x400, 8, 0); } \
                __builtin_amdgcn_sched_group_barrier(0x2, 24, 0); \
                _Pragma("unroll") for (int g_ = 0; g_ < 8; ++g_) { __builtin_amdgcn_sched_group_barrier(0x8, 1, 0); __builtin_amdgcn_sched_group_barrier(0x400, 4, 0); __builtin_amdgcn_sched_group_barrier(0x2, 2, 0); } } \
        } \
        ATT_T(tc_); \
        LDS_BARRIER(); ATT_T(td_); ATT_TACC(); } while (0)
#ifdef PROBE_A
    if (lane == 0) atomicMax(F.ctl + 32768 + 64 * (11 + 16 * l), (unsigned)(__builtin_amdgcn_s_memrealtime() - tp0_));
#endif
    int pp = 0;
    for (; pp + 1 < qi; ++pp) ATT_ITER(ka0, ka1, va0, va1, pp, 0);
    for (; pp < npairs; ++pp) ATT_ITER(ka0, ka1, va0, va1, pp, 1);
#undef ATT_EXP
#undef ATT_VLOAD
#undef ATT_PV
#undef ATT_ITER
#ifdef PROBE_SECTIONS
    if (qi == 31 && lane == 0) { atomicMax(F.ctl + 32768 + 64 * (8 + 16 * l), (unsigned)(dA_ / 32) * 10u); atomicMax(F.ctl + 32768 + 64 * (9 + 16 * l), (unsigned)(dB_ / 32) * 10u); atomicMax(F.ctl + 32768 + 64 * (10 + 16 * l), (unsigned)(dC_ / 32) * 10u); }
#endif
#undef ATT_WRITE
#undef ATT_LOAD
    float l1 = (L1.x + L1.y) + (L1.z + L1.w), l2 = (L2.x + L2.y) + (L2.z + L2.w);
    epilogue_attn(F, l, bh, qi, O1, O2, l1, l2);
}
__device__ __forceinline__ void epilogue_attn(Frame& F, int l, int bh, int qi, f32x16 (&O1)[2], f32x16 (&O2)[2], float l1, float l2) {
    int t3 = threadIdx.x; asm volatile("" : "+v"(t3));
    const int lane = t3 & 63, w = __builtin_amdgcn_readfirstlane(t3 >> 6), r32 = lane & 31, hi = lane >> 5, qq = w & 3, kh = w >> 2, b = bh >> 2, h = bh & 3;
    bf16_t* Y = (bf16_t*)(F.ws + WS_PROJ) + PX;
    const size_t row0 = (size_t)b * SEQ; const int q0 = qi * 128;
    LAS float* XCH = (LAS float*)F.lds + (size_t)qq * 66 * 64 + lane;
    if (kh == 1) {
#pragma unroll
        for (int vt = 0; vt < 2; ++vt)
#pragma unroll
            for (int r = 0; r < 16; ++r) { XCH[(vt * 16 + r) * 64] = O1[vt][r]; XCH[(32 + vt * 16 + r) * 64] = O2[vt][r]; }
        XCH[64 * 64] = l1; XCH[65 * 64] = l2;
    }
    __syncthreads();
    if (kh == 0) {
        const float* lm = F.in[17] + (size_t)l * 128;
        float d1 = (lane < 32) ? lm[lane] * lm[32 + lane] : 0.f, d2 = (lane < 32) ? lm[64 + lane] * lm[96 + lane] : 0.f;
        d1 = wave_sum(d1); d2 = wave_sum(d2);
        int lq = l; asm volatile("" : "+s"(lq));
        const float lam_init = (lq == 0) ? 0.2f : 0.35550906759f;
        const float lam = __int_as_float(__builtin_amdgcn_readfirstlane(__float_as_int(fast_exp(d1) - fast_exp(d2) + lam_init)));
#pragma unroll
        for (int vt = 0; vt < 2; ++vt)
#pragma unroll
            for (int r = 0; r < 16; ++r) { O1[vt][r] += XCH[(vt * 16 + r) * 64]; O2[vt][r] += XCH[(32 + vt * 16 + r) * 64]; }
        l1 += XCH[64 * 64]; l2 += XCH[65 * 64];
        l1 += __shfl_xor(l1, 32); l2 += __shfl_xor(l2, 32);
        const float i1 = fast_rcp(l1), i2 = lam * fast_rcp(l2);
        const float* sw = F.in[18] + (size_t)l * 64; const float osc = 1.0f - lam_init;
        const float sw0 = sw[r32], sw1 = sw[32 + r32];
#pragma unroll
        for (int r = 0; r < 16; ++r) {
            const int qr = crow16(r, hi);
            const float a1 = __shfl(i1, qr), a2 = __shfl(i2, qr);
            const float o0 = O1[0][r] * a1 - O2[0][r] * a2, o1 = O1[1][r] * a1 - O2[1][r] * a2;
            float s = o0 * o0 + o1 * o1;
            s += __shfl_xor(s, 1); s += __shfl_xor(s, 2); s += __shfl_xor(s, 4); s += __shfl_xor(s, 8); s += __shfl_xor(s, 16);
            const float rs = rsqrtf(s * (1.0f / 64.0f) + NORM_EPS) * osc;
            const size_t row = row0 + q0 + 32 * qq + qr;
            Y[row * PLD + 768 + h * 64 + r32] = f2bf(o0 * rs * sw0); Y[row * PLD + 768 + h * 64 + 32 + r32] = f2bf(o1 * rs * sw1);
        }
    }
}

constexpr int SSD_STR = 136;
constexpr int SX_P = 72, SB_P = 136, SS_BUF = 128 * SX_P * 2 + 128 * SB_P * 2;
__device__ __forceinline__ void ssd_state_item(Frame& F, int l, int bhh) {
    const int b = bhh >> 3, hh = bhh & 7, g = hh >> 2, w = F.wave, lane = F.lane, fr = lane & 15, fq = lane >> 4, tid = F.tid;
    LAS float* XS = (LAS float*)(F.lds + 2 * SS_BUF); LAS float* CD = XS + 4096;
    const bf16_t* XACT = (const bf16_t*)F.in[25]; const float* GATES = (const float*)(F.ws + WS_GATES); bf16_t* SST = (bf16_t*)(F.ws + WS_SST);
    const float Ah = -expf(F.in[12][l * 8 + hh]);
    {   float d0v[4], d1v[4];
#pragma unroll
        for (int i = 0; i < 4; ++i) { const size_t r0 = (size_t)b * SEQ + 128 * (w + 8 * i); d0v[i] = GATES[(r0 + lane) * 16 + 8 + hh]; d1v[i] = GATES[(r0 + 64 + lane) * 16 + 8 + hh]; }
#pragma unroll
        for (int i = 0; i < 4; ++i) { const int c = w + 8 * i; const float dt0 = d0v[i], dt1 = d1v[i];
            const float s0 = wave_scan_incl(dt0 * Ah, lane); const float t0 = __shfl(s0, 63);
            const float s1 = wave_scan_incl(dt1 * Ah, lane) + t0; const float last = __shfl(s1, 63);
            XS[128 * c + lane] = dt0 * fast_exp(last - s0); XS[128 * c + 64 + lane] = dt1 * fast_exp(last - s1);
            if (lane == 0) CD[c] = fast_exp(last); }
    }
    const int pt = w & 3, nh = w >> 2;
    f32x4 acc[4];
#pragma unroll
    for (int j = 0; j < 4; ++j) acc[j] = (f32x4){0.f, 0.f, 0.f, 0.f};
    const bf16_t* xg = XACT + ((size_t)b * SEQ + (tid >> 3)) * 1024 + hh * 64 + 8 * (tid & 7);
    const bf16_t* bg = XACT + ((size_t)b * SEQ + (tid >> 4)) * 1024 + 512 + g * 128 + 8 * (tid & 15);
    u32x4 xa[2], ba[4], xb[2], bb[4], xc[2], bc[4];
#define SS_LOAD(xr, br, c_) do { const size_t o_ = (size_t)(c_) * 128 * 1024; xr[0] = *(const u32x4*)(xg + o_); xr[1] = *(const u32x4*)(xg + o_ + 64 * 1024); \
        _Pragma("unroll") for (int i_ = 0; i_ < 4; ++i_) br[i_] = *(const u32x4*)(bg + o_ + (size_t)i_ * 32 * 1024); } while (0)
#define SS_WRITE(xr, br, c_) do { LAS bf16_t* XL_ = (LAS bf16_t*)(F.lds + ((c_) & 1) * SS_BUF); LAS bf16_t* BL_ = XL_ + 128 * SX_P; \
        _Pragma("unroll") for (int i_ = 0; i_ < 2; ++i_) { const int s_ = (tid >> 3) + 64 * i_; const float sc_ = XS[128 * (c_) + s_]; u32x4 o_; \
            _Pragma("unroll") for (int e_ = 0; e_ < 4; ++e_) o_[e_] = cvtpk(sc_ * bflo(xr[i_][e_]), sc_ * bfhi(xr[i_][e_])); \
            *(LAS u32x4*)(XL_ + s_ * SX_P + 8 * (tid & 7)) = o_; } \
        _Pragma("unroll") for (int i_ = 0; i_ < 4; ++i_) *(LAS u32x4*)(BL_ + ((tid >> 4) + 32 * i_) * SB_P + 8 * (tid & 15)) = br[i_]; } while (0)
    LAS bf16_t* SSTG = (LAS bf16_t*)(F.lds + 2 * SS_BUF + 16384 + 128);
#define SS_STAGE(c_) do { LAS bf16_t* sg_ = SSTG + ((c_) & 1) * 8192; \
        _Pragma("unroll") for (int j = 0; j < 4; ++j) _Pragma("unroll") for (int r = 0; r < 4; ++r) sg_[(16 * pt + 4 * fq + r) * 128 + 16 * (4 * nh + j) + fr] = f2bf(acc[j][r]); } while (0)
    SS_LOAD(xa, ba, 0); SS_LOAD(xb, bb, 1); SS_LOAD(xc, bc, 2);
    __syncthreads();
    SS_WRITE(xa, ba, 0);
    SS_LOAD(xa, ba, 3);
    LDS_BARRIER();
#define SS_STEP(XW, BW, c_) do { const int cc_ = (c_); const size_t si = ((size_t)(b * 32 + cc_) * 8 + hh) * 8192; \
        _Pragma("unroll") for (int j = 0; j < 4; ++j) _Pragma("unroll") for (int r = 0; r < 4; ++r) SST[si + (16 * pt + 4 * fq + r) * 128 + 16 * (4 * nh + j) + fr] = f2bf(acc[j][r]); \
        asm volatile("" ::: "memory"); \
        if (cc_ + 1 < 32) { SS_WRITE(XW, BW, cc_ + 1); } \
        asm volatile("" ::: "memory"); \
        SS_LOAD(XW, BW, (cc_ + 4 < 32 ? cc_ + 4 : 31)); \
        asm volatile("" ::: "memory"); \
        const float cd = CD[cc_]; \
        _Pragma("unroll") for (int j = 0; j < 4; ++j) acc[j] = acc[j] * cd; \
        const LAS bf16_t* XL = (const LAS bf16_t*)(F.lds + (cc_ & 1) * SS_BUF); const LAS bf16_t* BL = XL + 128 * SX_P; \
        bf16x8 Af[4], Bf[4][4]; \
        _Pragma("unroll") for (int ks = 0; ks < 4; ++ks) { Af[ks] = ld_tr8(XL, SX_P, 32 * ks, 16 * pt, lane); \
            _Pragma("unroll") for (int j = 0; j < 4; ++j) Bf[ks][j] = ld_tr8(BL, SB_P, 32 * ks, 16 * (4 * nh + j), lane); } \
        asm volatile("s_waitcnt lgkmcnt(0)" ::: "memory"); __builtin_amdgcn_sched_barrier(0); \
        _Pragma("unroll") for (int ks = 0; ks < 4; ++ks) _Pragma("unroll") for (int j = 0; j < 4; ++j) acc[j] = MFMA16(Af[ks], Bf[ks][j], acc[j]); \
        LDS_BARRIER(); } while (0)
    for (int c = 0; c < 30; c += 3) { SS_STEP(xb, bb, c); SS_STEP(xc, bc, c + 1); SS_STEP(xa, ba, c + 2); }
    SS_STEP(xb, bb, 30); SS_STEP(xc, bc, 31);
#undef SS_STEP
#undef SS_STAGE
#undef SS_LOAD
#undef SS_WRITE
}

constexpr int SO_BP = 136, SO_XP = 72, SO_SP = 136, SO_YP = 264;
constexpr int SO_B_BYTES = 128 * SO_BP * 2, SO_H_BYTES = 128 * SO_XP * 2 + 64 * SO_SP * 2, SO_ACS_OFF = SO_B_BYTES + 2 * SO_H_BYTES;
__device__ __forceinline__ void ssd_out_item(Frame& F, int l, int it) {
    const int g = it & 1, c = (it >> 1) & 31, b = it >> 6, w = F.wave, lane = F.lane, fr = lane & 15, fq = lane >> 4, tid = F.tid;
    LAS bf16_t* BL = (LAS bf16_t*)F.lds;
    LAS float* ACS = (LAS float*)(F.lds + SO_ACS_OFF); LAS float* DTS = ACS + 512; LAS float* ETAB = DTS + 512; LAS float* REFS = ETAB + 512;
    const bf16_t* XACT = (const bf16_t*)F.in[25]; const float* GATES = (const float*)(F.ws + WS_GATES); const bf16_t* SST = (const bf16_t*)(F.ws + WS_SST);
    const bf16_t* PROJ = (const bf16_t*)(F.ws + WS_PROJ); bf16_t* Y = (bf16_t*)(F.ws + WS_PROJ) + PX;
    const size_t r0 = (size_t)b * SEQ + 128 * c;
    const float gdt0 = GATES[(r0 + lane) * 16 + 8 + g * 4 + (w & 3)], gdt1 = GATES[(r0 + 64 + lane) * 16 + 8 + g * 4 + (w & 3)];
    const bf16_t* bgp = XACT + (r0 + (tid >> 4)) * 1024 + 512 + g * 128 + 8 * (tid & 15);
    const bf16_t* xgp = XACT + (r0 + (tid >> 3)) * 1024 + g * 256 + 8 * (tid & 7);
    const bf16_t* sgp = SST + ((size_t)(b * 32 + c) * 8 + g * 4) * 8192 + (tid >> 4) * 128 + 8 * (tid & 15);
    u32x4 xr[2], sr[2];
#define SO_LOADH(hd_) do { xr[0] = *(const u32x4*)(xgp + (hd_) * 64); xr[1] = *(const u32x4*)(xgp + (hd_) * 64 + 64 * 1024); \
        sr[0] = *(const u32x4*)(sgp + (size_t)(hd_) * 8192); sr[1] = *(const u32x4*)(sgp + (size_t)(hd_) * 8192 + 32 * 128); } while (0)
#define SO_WRITEH(hd_) do { LAS bf16_t* XL_ = (LAS bf16_t*)(F.lds + SO_B_BYTES + ((hd_) & 1) * SO_H_BYTES); LAS bf16_t* SL_ = XL_ + 128 * SO_XP; \
        *(LAS u32x4*)(XL_ + (tid >> 3) * SO_XP + 8 * (tid & 7)) = xr[0]; *(LAS u32x4*)(XL_ + ((tid >> 3) + 64) * SO_XP + 8 * (tid & 7)) = xr[1]; \
        *(LAS u32x4*)(SL_ + (tid >> 4) * SO_SP + 8 * (tid & 15)) = sr[0]; *(LAS u32x4*)(SL_ + ((tid >> 4) + 32) * SO_SP + 8 * (tid & 15)) = sr[1]; } while (0)
    {   u32x4 br[4];
#pragma unroll
        for (int i = 0; i < 4; ++i) br[i] = *(const u32x4*)(bgp + (size_t)i * 32 * 1024);
        SO_LOADH(0);
#pragma unroll
        for (int i = 0; i < 4; ++i) *(LAS u32x4*)(BL + ((tid >> 4) + 32 * i) * SO_BP + 8 * (tid & 15)) = br[i];
        SO_WRITEH(0);
    }
    if (w < 4) {
        const int hh = g * 4 + w; const float Ah = -expf(F.in[12][l * 8 + hh]);
        const float dt0 = gdt0, dt1 = gdt1;
        const float s0 = wave_scan_incl(dt0 * Ah, lane); const float t0 = __shfl(s0, 63);
        const float s1 = wave_scan_incl(dt1 * Ah, lane) + t0;
        ACS[128 * w + lane] = s0; ACS[128 * w + 64 + lane] = s1; DTS[128 * w + lane] = dt0; DTS[128 * w + 64 + lane] = dt1;
        const float e0 = __shfl(s0, 31), e2 = __shfl(s1, 31), e3 = __shfl(s1, 63);
        ETAB[128 * w + lane] = fast_exp((lane < 32 ? e0 : t0) - s0) * dt0; ETAB[128 * w + 64 + lane] = fast_exp((lane < 32 ? e2 : e3) - s1) * dt1;
        if (lane == 0) { REFS[4 * w + 0] = e0; REFS[4 * w + 1] = t0; REFS[4 * w + 2] = e2; REFS[4 * w + 3] = e3; }
    }
    SO_LOADH(1);
    const int lrow = 16 * w + fr, nkk = (w >> 1) + 1;
    bf16x8 Cf[4];
#pragma unroll
    for (int ks = 0; ks < 4; ++ks) Cf[ks] = ld_g8(XACT + (r0 + lrow) * 1024 + 768 + g * 128 + 32 * ks + 8 * fq);
    asm volatile("" : "+v"(Cf[0]), "+v"(Cf[1]), "+v"(Cf[2]), "+v"(Cf[3]));
    LDS_BARRIER();
    f32x4 G[4][2];
#pragma unroll
    for (int kk = 0; kk < 4; ++kk) { G[kk][0] = (f32x4){0.f, 0.f, 0.f, 0.f}; G[kk][1] = (f32x4){0.f, 0.f, 0.f, 0.f};
        if (kk < nkk) {
            bf16x8 b0[4], b1[4];
#pragma unroll
            for (int ks = 0; ks < 4; ++ks) { b0[ks] = ld_l8(BL + (32 * kk + fr) * SO_BP + 32 * ks + 8 * fq); b1[ks] = ld_l8(BL + (32 * kk + 16 + fr) * SO_BP + 32 * ks + 8 * fq); }
#pragma unroll
            for (int ks = 0; ks < 4; ++ks) { G[kk][0] = MFMA16(b0[ks], Cf[ks], G[kk][0]); G[kk][1] = MFMA16(b1[ks], Cf[ks], G[kk][1]); } } }
    const float* Dk = F.in[13] + l * 8 + g * 4;
    f32x4 yacc[4][4];
#pragma unroll
    for (int hd = 0; hd < 4; ++hd) {
        const LAS bf16_t* XL = (const LAS bf16_t*)(F.lds + SO_B_BYTES + (hd & 1) * SO_H_BYTES); const LAS bf16_t* SL = XL + 128 * SO_XP;
        bf16x8 Sf[4][4];
#pragma unroll
        for (int pt = 0; pt < 4; ++pt)
#pragma unroll
            for (int ks = 0; ks < 4; ++ks) Sf[pt][ks] = ld_l8(SL + (16 * pt + fr) * SO_SP + 32 * ks + 8 * fq);
        float ea[4], xv[4][4];
#pragma unroll
        for (int r = 0; r < 4; ++r) ea[r] = fast_exp(ACS[128 * hd + 16 * w + 4 * fq + r]);
#pragma unroll
        for (int pt = 0; pt < 4; ++pt)
#pragma unroll
            for (int r = 0; r < 4; ++r) xv[pt][r] = bf2f(XL[(16 * w + 4 * fq + r) * SO_XP + 16 * pt + fr]);
        const float dsk = Dk[hd];
#pragma unroll
        for (int pt = 0; pt < 4; ++pt) { f32x4 a = (f32x4){0.f, 0.f, 0.f, 0.f};
#pragma unroll
            for (int ks = 0; ks < 4; ++ks) a = MFMA16(Cf[ks], Sf[pt][ks], a);
#pragma unroll
            for (int r = 0; r < 4; ++r) a[r] = a[r] * ea[r] + dsk * xv[pt][r];
            yacc[hd][pt] = a; }
        const float al = ACS[128 * hd + lrow];
#pragma unroll
        for (int kk = 0; kk < 4; ++kk) if (kk < nkk) {
            f32x4 P0, P1;
            if (kk + 1 < nkk) {
                const float fk = fast_exp(al - REFS[4 * hd + kk]);
#pragma unroll
                for (int r = 0; r < 4; ++r) { const int s0 = 32 * kk + 4 * fq + r; P0[r] = G[kk][0][r] * fk * ETAB[128 * hd + s0]; P1[r] = G[kk][1][r] * fk * ETAB[128 * hd + s0 + 16]; }
            } else {
#pragma unroll
                for (int r = 0; r < 4; ++r) { const int s0 = 32 * kk + 4 * fq + r, s1 = s0 + 16;
                    P0[r] = (s0 <= lrow) ? G[kk][0][r] * fast_exp(al - ACS[128 * hd + s0]) * DTS[128 * hd + s0] : 0.f;
                    P1[r] = (s1 <= lrow) ? G[kk][1][r] * fast_exp(al - ACS[128 * hd + s1]) * DTS[128 * hd + s1] : 0.f; }
            }
            const bf16x8 PA = pack8(P0, P1);
            bf16x8 Bx[4];
#pragma unroll
            for (int pt = 0; pt < 4; ++pt) Bx[pt] = ld_tr8p(XL, SO_XP, 32 * kk, 16 * pt, lane);
#pragma unroll
            for (int pt = 0; pt < 4; ++pt) yacc[hd][pt] = MFMA16(PA, Bx[pt], yacc[hd][pt]);
        }
        if (hd + 1 < 4) { SO_WRITEH(hd + 1); if (hd + 2 < 4) SO_LOADH(hd + 2); }
        LDS_BARRIER();
    }
#undef SO_LOADH
#undef SO_WRITEH
    const float* nw = F.in[14] + (size_t)l * 512 + g * 256; const int ch8 = 8 * (tid & 31);
    const f32x4 nw0 = *(const f32x4*)(nw + ch8), nw1 = *(const f32x4*)(nw + ch8 + 4);
    u32x4 zv8[8];
#pragma unroll
    for (int i = 0; i < 8; ++i) zv8[i] = *(const u32x4*)(PROJ + (r0 + (tid >> 5) + 16 * i) * PLD + PZ + g * 256 + ch8);
    LAS bf16_t* YL = (LAS bf16_t*)F.lds;
#pragma unroll
    for (int hd = 0; hd < 4; ++hd)
#pragma unroll
        for (int pt = 0; pt < 4; ++pt)
#pragma unroll
            for (int r = 0; r < 4; ++r) YL[(16 * w + 4 * fq + r) * SO_YP + hd * 64 + 16 * pt + fr] = f2bf(yacc[hd][pt][r]);
    LDS_BARRIER();
#pragma unroll
    for (int i = 0; i < 8; ++i) {
        const int lr = (tid >> 5) + 16 * i; const size_t row = r0 + lr;
        const u32x4 yv = *(const LAS u32x4*)(YL + lr * SO_YP + ch8); const u32x4 zv = zv8[i];
        float v[8]; float ss = 0.f;
#pragma unroll
        for (int e = 0; e < 4; ++e) { v[2 * e] = bflo(yv[e]) * bflo(zv[e]); v[2 * e + 1] = bfhi(yv[e]) * bfhi(zv[e]); ss += v[2 * e] * v[2 * e] + v[2 * e + 1] * v[2 * e + 1]; }
        ss += __shfl_xor(ss, 1); ss += __shfl_xor(ss, 2); ss += __shfl_xor(ss, 4); ss += __shfl_xor(ss, 8); ss += __shfl_xor(ss, 16);
        const float rs = rsqrtf(ss * (1.0f / 256.0f) + NORM_EPS);
        u32x4 o; o.x = cvtpk(v[0] * rs * nw0.x, v[1] * rs * nw0.y); o.y = cvtpk(v[2] * rs * nw0.z, v[3] * rs * nw0.w); o.z = cvtpk(v[4] * rs * nw1.x, v[5] * rs * nw1.y); o.w = cvtpk(v[6] * rs * nw1.z, v[7] * rs * nw1.w);
        *(u32x4*)(Y + row * PLD + 256 + g * 256 + ch8) = o;
    }
}
#ifndef PH_EN
#define PH_EN 1023
#endif
#ifndef MK_N_LAUNCHES
#define MK_N_LAUNCHES 1
#endif
constexpr int N_PHASES = 1 + 9 * DEPTH;
constexpr int NA1 = 512;
constexpr int CW_STAT = 32768;
#ifdef PROBE_A
#define ITEM_T0() const unsigned long long it0_ = __builtin_amdgcn_s_memrealtime()
#define ITEM_T1(k_) do { __syncthreads(); if (threadIdx.x == 0) atomicMax(F.ctl + CW_STAT + 64 * ((k_) + 16 * l), (unsigned)(__builtin_amdgcn_s_memrealtime() - it0_)); } while (0)
#else
#define ITEM_T0() do {} while (0)
#define ITEM_T1(k_) do {} while (0)
#endif

__global__ void __launch_bounds__(NTHREADS, 2) hyb_fwd(Args args) {
    extern __shared__ __attribute__((aligned(16))) unsigned char lds_raw[];
    {   const int t0 = threadIdx.x;
        for (int u = t0; u < (LDS_BYTES - LDSCTL_OFF) / 4; u += NTHREADS) ((LAS unsigned*)((LAS unsigned char*)lds_raw + LDSCTL_OFF))[u] = 0u; }
    __syncthreads();
    const int ph_lo = args.ph_lo, ph_hi = args.ph_hi;
    const bool one_launch = (ph_hi - ph_lo) > 1;
    if (one_launch) { XcdBarrier b0 = xcd_barrier_post((unsigned*)(args.ws + WS_CTL) + CW_BAR, (volatile LAS unsigned*)((LAS unsigned char*)lds_raw + MISC_OFF) + 8); (void)b0; }
#ifdef PROBE_A
    unsigned long long t_prev = __builtin_amdgcn_s_memrealtime();
#endif
    for (int ph = ph_lo; ph < ph_hi; ++ph) {
        int tid_ = threadIdx.x; asm volatile("" : "+v"(tid_));
        kinptr_t kin = (kinptr_t)__builtin_amdgcn_kernarg_segment_ptr(); asm volatile("" : "+s"(kin));
        Frame F;
        F.lds = (LAS unsigned char*)lds_raw; F.MISC = (volatile LAS unsigned*)(F.lds + MISC_OFF);
        F.tid = tid_; F.lane = tid_ & 63; F.wave = __builtin_amdgcn_readfirstlane(tid_ >> 6);
        F.G = gridDim.x; { const int bx = blockIdx.x; F.vcu = (F.G % 8 == 0) ? (bx % 8) * (F.G / 8) + bx / 8 : bx; }
        F.in = kin;
        float* const outp = (float*)kin[25]; unsigned char* ws = (unsigned char*)kin[26];
        F.ws = ws; F.ctl = (unsigned*)(ws + WS_CTL);
        bf16_t* XB = (bf16_t*)(ws + WS_XB); bf16_t* PROJ = (bf16_t*)(ws + WS_PROJ); float* SSQ = (float*)(ws + WS_SSQ); float* GATES = (float*)(ws + WS_GATES);
        if (ph == 0) { if (PH_EN & 1) p0_prologue(F); }
        else {
            const int l = (ph - 1) / 9, k = (ph - 1) % 9;
            const unsigned char* WL = ws + WS_W + (size_t)l * W_LAYER;
            if ((PH_EN & 2) && (k == 0 || k == 7)) {
                pg8::Gemm g{XB, (const bf16_t*)(WL + (k == 0 ? W_GU1 : W_GU2)), M_TOK, NGU, DM, DM}; pg8::StaticOrder S; S.init(M_TOK, NGU, F.G, (int)blockIdx.x);
                EpiSwiglu E{{}, PROJ, SSQ};
                pg8::gemm_phase<EpiSwiglu, true, true>(F.lds, g, S, E, F.tid);
                { int t2 = threadIdx.x; asm volatile("" : "+v"(t2)); F.tid = t2; F.lane = t2 & 63; F.wave = __builtin_amdgcn_readfirstlane(t2 >> 6); side_convert(F, l, k); }
            } else if ((PH_EN & 4) && (k == 1 || k == 8 || k == 6)) {
                pg8::Gemm g; float alpha = 0.5f;
                if (k == 6) { g = pg8::Gemm{PROJ + PX, (const bf16_t*)(WL + W_OUT), M_TOK, DM, DM, PLD}; alpha = 1.0f; }
                else { g = pg8::Gemm{PROJ, (const bf16_t*)(WL + (k == 1 ? W_D1 : W_D2)), M_TOK, DM, FF, FF}; }
                pg8::StaticOrder S; S.init(M_TOK, DM, F.G, (int)blockIdx.x);
                if (ph == N_PHASES - 1) { EpiResid<true> E{outp, XB, SSQ, alpha, 1.0f / alpha}; pg8::gemm_phase<EpiResid<true>, false, true>(F.lds, g, S, E, F.tid); }
                else { EpiResid<false> E{outp, XB, SSQ, alpha, 1.0f / alpha}; pg8::gemm_phase<EpiResid<false>, false, true>(F.lds, g, S, E, F.tid); }
            } else if ((PH_EN & 8) && k == 2) {
                pg8::Gemm g{XB, (const bf16_t*)(WL + W_IN), M_TOK, NIN, DM, DM}; pg8::StaticOrder S; S.init(M_TOK, NIN, F.G, (int)blockIdx.x);
                EpiInProj E{{}, PROJ, GATES, SSQ, kin[15] + l * 64, kin[16] + l * 64, kin[7] + l * 8, kin[11] + l * 8};
                pg8::gemm_phase<EpiInProj, true, true>(F.lds, g, S, E, F.tid);
                { int t2 = threadIdx.x; asm volatile("" : "+v"(t2)); F.tid = t2; F.lane = t2 & 63; F.wave = __builtin_amdgcn_readfirstlane(t2 >> 6); side_convert(F, l, k); }
            } else if ((PH_EN & 16) && k == 3) {
                conv_phase(F, l);
            } else if (k == 4) {
                for (int first_ = (F.G == 256) ? 1 : 0;; first_ = 0) {
                    const int it = first_ ? (int)blockIdx.x : (q_next(F, 2 * l) + ((F.G == 256) ? 256 : 0)); if (it >= 48 + NA1) break;
                    { int t2 = threadIdx.x; asm volatile("" : "+v"(t2)); F.tid = t2; F.lane = t2 & 63; F.wave = __builtin_amdgcn_readfirstlane(t2 >> 6); }
                    ITEM_T0();
                    if (it < 16) { if (PH_EN & 32) mlstm_state_item(F, it); ITEM_T1(0); }
                    else if (it < 48) { if (PH_EN & 64) ssd_state_item(F, l, it - 16); ITEM_T1(1); }
                    else { const int r = it - 48; if (PH_EN & 128) attn_item(F, l, r & 15, 31 - (r >> 4)); ITEM_T1(2); } }
            } else if (k == 5 && NA1 == 512 && F.G == 256) {
                { int t2 = threadIdx.x; asm volatile("" : "+v"(t2)); F.tid = t2; F.lane = t2 & 63; F.wave = __builtin_amdgcn_readfirstlane(t2 >> 6); }
                ssd_out_item(F, l, F.vcu);
                __syncthreads();
                { int t2 = threadIdx.x; asm volatile("" : "+v"(t2)); F.tid = t2; F.lane = t2 & 63; F.wave = __builtin_amdgcn_readfirstlane(t2 >> 6); }
                mlstm_out_item(F, l, F.vcu);
            } else if (k == 5) {
                for (;;) { const int it = q_next(F, 2 * l + 1); if (it >= 512 + (512 - NA1)) break;
                    { int t2 = threadIdx.x; asm volatile("" : "+v"(t2)); F.tid = t2; F.lane = t2 & 63; F.wave = __builtin_amdgcn_readfirstlane(t2 >> 6); }
                    ITEM_T0();
                    if (it < 256) { if (PH_EN & 256) ssd_out_item(F, l, it); ITEM_T1(3); }
                    else if (it < 512) { if (PH_EN & 512) mlstm_out_item(F, l, it - 256); ITEM_T1(4); }
                    else { const int r = NA1 + it - 512; if (PH_EN & 128) attn_item(F, l, r & 15, 31 - (r >> 4)); } }
            }
        }
#ifdef PROBE_A
        if (ph + 1 < ph_hi) { XcdBarrier bar; bar.bar = F.ctl + CW_BAR; bar.x = xb_xcc_id(); bar.st = F.MISC + 8; xcd_barrier(bar); }
        { const unsigned long long t_now = __builtin_amdgcn_s_memrealtime(); if (threadIdx.x == 0) F.MISC[24 + ph] += (unsigned)(t_now - t_prev); t_prev = t_now; }
        if (ph + 1 == ph_hi && blockIdx.x == 0) { __syncthreads();
            unsigned va = (PROBE_A < 32) ? F.MISC[24 + PROBE_A] : xb_ld(F.ctl + CW_STAT + 64 * (PROBE_A - 32)), vb = (PROBE_B < 32) ? F.MISC[24 + PROBE_B] : xb_ld(F.ctl + CW_STAT + 64 * (PROBE_B - 32));
            if (PROBE_A == 44 || PROBE_A == 46) va = va / 512u * 100u; if (PROBE_A == 45) va = va / 512u * 10u; if (PROBE_B == 44 || PROBE_B == 46) vb = vb / 512u * 100u; if (PROBE_B == 45) vb = vb / 512u * 10u;
            unsigned qa = (va + 500u) / 1000u, qb = (vb + 500u) / 1000u; if (qa > 63u) qa = 63u; if (qb > 63u) qb = 63u;
            const unsigned long long wait = (unsigned long long)(qa * 6400u + qb * 409600u); const unsigned long long t0 = __builtin_amdgcn_s_memrealtime();
            while (__builtin_amdgcn_s_memrealtime() - t0 < wait) __builtin_amdgcn_s_sleep(8); }
        continue;
#endif
        if (ph + 1 < ph_hi) { XcdBarrier bar; bar.bar = F.ctl + CW_BAR; bar.x = xb_xcc_id(); bar.st = F.MISC + 8; xcd_barrier(bar); }
    }
}

extern "C" void kernel_launch(void* const* d_in, const int* in_sizes, int n_in, void* d_out, int out_size, void* d_ws, size_t ws_size, hipStream_t stream) {
    static int grid = 0;
    if (grid == 0) {
        if (n_in != 25 || in_sizes[0] != M_TOK * DM || out_size != M_TOK * DM || ws_size < WS_END) { fprintf(stderr, "kernel_launch: unexpected shapes (n_in %d, in0 %d, out %d, ws %zu)\n", n_in, n_in > 0 ? in_sizes[0] : -1, out_size, ws_size); grid = -1; return; }
        int dev = 0, cus = 0, per_cu = 0;
        if (hipGetDevice(&dev) != hipSuccess || hipDeviceGetAttribute(&cus, hipDeviceAttributeMultiprocessorCount, dev) != hipSuccess) { grid = -1; return; }
        if (hipFuncSetAttribute((const void*)hyb_fwd, hipFuncAttributeMaxDynamicSharedMemorySize, LDS_BYTES) != hipSuccess) { fprintf(stderr, "kernel_launch: hipFuncSetAttribute failed\n"); grid = -1; return; }
        if (hipOccupancyMaxActiveBlocksPerMultiprocessor(&per_cu, (const void*)hyb_fwd, NTHREADS, LDS_BYTES) != hipSuccess || per_cu < 1)
            fprintf(stderr, "kernel_launch: note: occupancy query reports %d workgroups per CU\n", per_cu);
        (void)hipGetLastError();
        grid = cus;
    }
    if (grid < 0) return;
    if (hipMemsetAsync((char*)d_ws + WS_CTL, 0, CTL_ZERO_BYTES, stream) != hipSuccess) { fprintf(stderr, "kernel_launch: memset failed\n"); return; }
    Args a{};
    for (int i = 0; i < 25; ++i) a.in[i] = (const float*)d_in[i];
    a.out = (float*)d_out; a.ws = (unsigned char*)d_ws;
#if MK_N_LAUNCHES == 1
    a.ph_lo = 0; a.ph_hi = N_PHASES;
    hipLaunchKernelGGL(hyb_fwd, dim3(grid), dim3(NTHREADS), LDS_BYTES, stream, a);
#else
    for (int p = 0; p < N_PHASES; ++p) { a.ph_lo = p; a.ph_hi = p + 1; hipLaunchKernelGGL(hyb_fwd, dim3(grid), dim3(NTHREADS), LDS_BYTES, stream, a); }
#endif
    const hipError_t le = hipPeekAtLastError();
    if (le != hipSuccess) fprintf(stderr, "kernel_launch: launch failed: %s\n", hipGetErrorName(le));
}
```

```cpp
#include <hip/hip_runtime.h>
#include <cstdio>
#include <cstdint>

#define LAS __attribute__((address_space(3)))
#define GAS __attribute__((address_space(1)))
typedef unsigned short bf16_t;
typedef short bf16x8 __attribute__((ext_vector_type(8)));
typedef short bf16x4 __attribute__((ext_vector_type(4)));
typedef float f32x4 __attribute__((ext_vector_type(4)));
typedef float f32x2 __attribute__((ext_vector_type(2)));
typedef unsigned u32x4 __attribute__((ext_vector_type(4)));
typedef unsigned u32x2 __attribute__((ext_vector_type(2)));
typedef __bf16 bf16x2_t __attribute__((ext_vector_type(2)));

constexpr int M_TOK = 16384, SEQ = 4096, NBATCH = 4, DM = 1024, FF = 2816, NGU = 2 * FF, NIN = 3584, DEPTH = 2;
constexpr int PLD = 3328;
constexpr int PQ = 0, PK = 256, PV = 512, PO = 768, PZ = 1024, PX = 1536, PDQ = 2560, PDK = 2816, PDV = 3072;
constexpr float NORM_EPS = 1e-6f;
constexpr float LOG2E = 1.4426950408889634f;

__device__ __forceinline__ unsigned cvtpk(float lo, float hi) { f32x2 v = {lo, hi}; bf16x2_t b = __builtin_convertvector(v, bf16x2_t); return __builtin_bit_cast(unsigned, b); }
__device__ __forceinline__ bf16_t f2bf(float f) { return (bf16_t)(cvtpk(f, 0.f) & 0xffffu); }
__device__ __forceinline__ float bf2f(bf16_t h) { return __uint_as_float(((unsigned)h) << 16); }
__device__ __forceinline__ float bflo(unsigned w) { return __uint_as_float(w << 16); }
__device__ __forceinline__ float bfhi(unsigned w) { return __uint_as_float(w & 0xffff0000u); }
__device__ __forceinline__ float fast_exp(float x) { return __builtin_amdgcn_exp2f(x * LOG2E); }
__device__ __forceinline__ float fast_rcp(float x) { return __builtin_amdgcn_rcpf(x); }
__device__ __forceinline__ float fast_log1pexp(float x) { const float e = __builtin_amdgcn_exp2f(x * LOG2E); return __builtin_amdgcn_logf(1.0f + e) * 0.6931471805599453f; }
__device__ __forceinline__ float sigmoidf_(float x) { return fast_rcp(1.f + fast_exp(-x)); }
__device__ __forceinline__ float siluf_(float x) { return x * sigmoidf_(x); }

__device__ __forceinline__ void st16_wt(void* p, u32x4 v) { asm volatile("global_store_dwordx4 %0, %1, off sc1\n\ts_nop 1" :: "v"(p), "v"(v) : "memory"); }

namespace pg8 {
constexpr int BM = 256, BK = 64, HALF = 128, HTB = HALF * BK * 2, STAGE_BYTES = 8 * HTB, NXCD = 8, WGM = 8;
__host__ __device__ __forceinline__ int lds_byte(int r, int c) { const int st = (r >> 4) * 2 + (c >> 5), rr = r & 15, cc = c & 31, ob = rr * 64 + cc * 2; return st * 1024 + (ob ^ (((ob >> 9) & 1) << 5)); }
__host__ __device__ __forceinline__ void stage_rc(int b, int& R, int& C) { const int st = b / 1024, sb = b % 1024, swz = sb ^ (((sb >> 9) & 1) << 5); R = (st >> 1) * 16 + swz / 64; C = (st & 1) * 32 + (swz % 64) / 2; }
__host__ __device__ __forceinline__ int perm32(int rho) { const int n = rho >> 4, i = rho & 15; return 8 * (i >> 2) + 4 * n + (i & 3); }

struct Unit { int pm, pn; };
struct Gemm { const bf16_t* A; const bf16_t* Bt; int M, N, K, lda; };

struct StaticOrder {
    int nM, nN, nwg, G, c;
    __device__ void init(int M, int N, int G_, int c_) { nM = M / BM; nN = N / BM; nwg = nM * nN; G = G_; c = c_; }
    __device__ bool next(int i, Unit& u) const {
        const long L = (long)i * G + c; if (L >= nwg) return false;
        int wgid = (int)L; { const int q = nwg / NXCD, r = nwg % NXCD, xcd = wgid % NXCD, off = wgid / NXCD; wgid = (xcd < r ? xcd * (q + 1) : r * (q + 1) + (xcd - r) * q) + off; }
        const int nig = WGM * nN, gid = wgid / nig, fm = gid * WGM, gsz = (nM - fm) < WGM ? (nM - fm) : WGM;
        u.pm = fm + ((wgid % nig) % gsz); u.pn = (wgid % nig) / gsz; return true;
    }
};

template <class Epi, bool ALIGN_EPI, bool SP2>
__device__ __forceinline__ void gemm_phase(LAS unsigned char* lds, const Gemm g, const StaticOrder& S, const Epi& E, const int tid) {
    const int wid = __builtin_amdgcn_readfirstlane(tid >> 6), lane = tid & 63, wr = wid >> 2, wc = wid & 3, fr = lane & 15, fq = lane >> 4;
    const int K = g.K, nt = K / BK, lda = g.lda;
    unsigned voffA[2], voffB[2];
#pragma unroll
    for (int i = 0; i < 2; ++i) { int R, C; stage_rc(tid * 16 + i * 8192, R, C); const int Rb = (R & ~31) + perm32(R & 31);
        voffA[i] = (unsigned)(R * lda + C) * 2u; voffB[i] = (unsigned)(Rb * K + C) * 2u; }
    const size_t kstep = (size_t)(BK * 2);
    const size_t hstepA = (size_t)HALF * lda * 2, hstepB = (size_t)HALF * K * 2;
    const size_t tstepA = 2 * hstepA, tstepB = 2 * hstepB;
    const unsigned ldsw = (unsigned)wid * 1024u;
    const int aoff = lds_byte(wr * 64 + fr, fq * 8), boff = lds_byte(wc * 32 + fr, fq * 8);
#define PG8_SA(b, h) (((b) * 2 + (h)) * HTB)
#define PG8_SB(b, h) ((4 + (b) * 2 + (h)) * HTB)
#define PG8_STAGE(bufoff, gbase, voff) do { _Pragma("unroll") for (int _i = 0; _i < 2; ++_i) \
        __builtin_amdgcn_global_load_lds((const unsigned*)((const char*)(gbase) + (voff)[_i]), (LAS unsigned*)(lds + (bufoff) + ldsw + _i * 8192), 16, 0, 0); } while (0)
#define PG8_LDA(dst, b, h) do { _Pragma("unroll") for (int m = 0; m < 4; ++m) _Pragma("unroll") for (int k = 0; k < 2; ++k) dst[m][k] = *(const LAS bf16x8*)(lds + PG8_SA(b, h) + aoff + m * 2048 + k * 1024); } while (0)
#define PG8_LDB(dst, b, h) do { _Pragma("unroll") for (int n = 0; n < 2; ++n) _Pragma("unroll") for (int k = 0; k < 2; ++k) dst[n][k] = *(const LAS bf16x8*)(lds + PG8_SB(b, h) + boff + n * 2048 + k * 1024); } while (0)
#define PG8_MMA(ai, bj, At, Bt) do { __builtin_amdgcn_s_setprio(1); _Pragma("unroll") for (int m = 0; m < 4; ++m) _Pragma("unroll") for (int n = 0; n < 2; ++n) _Pragma("unroll") for (int k = 0; k < 2; ++k) \
        acc[ai][bj][m][n] = __builtin_amdgcn_mfma_f32_16x16x32_bf16(Bt[n][k], At[m][k], acc[ai][bj][m][n], 0, 0, 0); __builtin_amdgcn_s_setprio(0); } while (0)
#define PG8_WAIT_V(n) asm volatile("s_waitcnt vmcnt(" #n ")" ::: "memory")
#define PG8_WAIT_L(n) asm volatile("s_waitcnt lgkmcnt(" #n ")" ::: "memory")
#define PG8_BAR __builtin_amdgcn_s_barrier()
#define PG8_SCHED __builtin_amdgcn_sched_barrier(0)
    Unit cur, nxt; int ui = 0;
    if (!S.next(0, cur)) return;
    f32x4 acc[2][2][4][2];
    typename Epi::Raw raw; E.init_load(raw, cur, wr, wc, fr, fq);
    if constexpr (!Epi::HAS_INIT) {
#pragma unroll
    for (int a = 0; a < 2; ++a)
#pragma unroll
        for (int b = 0; b < 2; ++b)
#pragma unroll
            for (int m = 0; m < 4; ++m)
#pragma unroll
                for (int n = 0; n < 2; ++n) acc[a][b][m][n] = (f32x4){0.f, 0.f, 0.f, 0.f};
    }
    bf16x8 At[4][2], B0[2][2], B1[2][2];
    const char* cA = (const char*)g.A + (size_t)cur.pm * tstepA; const char* cB = (const char*)g.Bt + (size_t)cur.pn * tstepB;
    if constexpr (SP2) {
        PG8_STAGE(PG8_SB(0, 0), cB, voffB); PG8_STAGE(PG8_SB(0, 1), cB + hstepB, voffB); PG8_STAGE(PG8_SA(0, 0), cA, voffA); PG8_STAGE(PG8_SA(0, 1), cA + hstepA, voffA);
        if constexpr (Epi::HAS_INIT) E.init_finish(raw, acc);
        if (wr == 1) PG8_BAR;
        PG8_WAIT_V(2); PG8_BAR;
        PG8_STAGE(PG8_SB(1, 0), cB + kstep, voffB); PG8_STAGE(PG8_SA(1, 0), cA + kstep, voffA); PG8_STAGE(PG8_SB(1, 1), cB + hstepB + kstep, voffB);
        PG8_WAIT_V(6); PG8_BAR;
    } else {
        PG8_STAGE(PG8_SB(0, 0), cB, voffB); PG8_STAGE(PG8_SA(0, 0), cA, voffA); PG8_STAGE(PG8_SB(0, 1), cB + hstepB, voffB); PG8_STAGE(PG8_SA(0, 1), cA + hstepA, voffA);
        if (wr == 1) PG8_BAR;
        PG8_WAIT_V(4); PG8_BAR;
        PG8_STAGE(PG8_SB(1, 0), cB + kstep, voffB); PG8_STAGE(PG8_SA(1, 0), cA + kstep, voffA); PG8_STAGE(PG8_SB(1, 1), cB + hstepB + kstep, voffB);
        PG8_WAIT_V(6); PG8_BAR;
    }
    for (;;) {
        const bool has_next = S.next(ui + 1, nxt);
        const char* nA = has_next ? (const char*)g.A + (size_t)nxt.pm * tstepA : cA; const char* nB = has_next ? (const char*)g.Bt + (size_t)nxt.pn * tstepB : cB;
        for (int t = 0; t < nt; t += 2) {
            const bool last = (t == nt - 2);
            const char* a1 = cA + (size_t)(t + 1) * kstep;
            const char* a2 = last ? nA : cA + (size_t)(t + 2) * kstep; const char* b2 = last ? nB : cB + (size_t)(t + 2) * kstep;
            const char* a3 = a2 + kstep; const char* b3 = b2 + kstep;
            if constexpr (SP2) {
            PG8_LDB(B0, 0, 0); PG8_LDB(B1, 0, 1); PG8_SCHED; PG8_LDA(At, 0, 0); PG8_STAGE(PG8_SA(1, 1), a1 + hstepA, voffA);
            PG8_WAIT_V(8); PG8_WAIT_L(0); PG8_BAR; PG8_MMA(0, 0, At, B0); PG8_MMA(0, 1, At, B1); PG8_BAR; PG8_SCHED;
            PG8_LDA(At, 0, 1); PG8_STAGE(PG8_SB(0, 0), b2, voffB); PG8_STAGE(PG8_SB(0, 1), b2 + hstepB, voffB); PG8_STAGE(PG8_SA(0, 0), a2, voffA);
            PG8_WAIT_V(8); PG8_WAIT_L(0); PG8_BAR; PG8_MMA(1, 0, At, B0); PG8_MMA(1, 1, At, B1); PG8_BAR; PG8_SCHED;
            PG8_LDB(B0, 1, 0); PG8_LDB(B1, 1, 1); PG8_SCHED; PG8_LDA(At, 1, 0); PG8_STAGE(PG8_SA(0, 1), a2 + hstepA, voffA);
            PG8_WAIT_V(8); PG8_WAIT_L(0); PG8_BAR; PG8_MMA(0, 0, At, B0); PG8_MMA(0, 1, At, B1); PG8_BAR; PG8_SCHED;
            PG8_LDA(At, 1, 1); PG8_STAGE(PG8_SB(1, 0), b3, voffB); PG8_STAGE(PG8_SB(1, 1), b3 + hstepB, voffB); PG8_STAGE(PG8_SA(1, 0), a3, voffA);
            PG8_WAIT_V(8); PG8_WAIT_L(0); PG8_BAR; PG8_MMA(1, 0, At, B0); PG8_MMA(1, 1, At, B1); PG8_BAR; PG8_SCHED;
            } else {
            PG8_LDB(B0, 0, 0); PG8_SCHED; PG8_LDA(At, 0, 0); PG8_STAGE(PG8_SA(1, 1), a1 + hstepA, voffA);
            PG8_WAIT_L(8); PG8_BAR; PG8_WAIT_L(0); PG8_MMA(0, 0, At, B0); PG8_BAR; PG8_SCHED;
            PG8_LDB(B1, 0, 1); PG8_STAGE(PG8_SB(0, 0), b2, voffB);
            PG8_BAR; PG8_WAIT_L(0); PG8_MMA(0, 1, At, B1); PG8_BAR;
            PG8_LDA(At, 0, 1); PG8_STAGE(PG8_SA(0, 0), a2, voffA);
            PG8_BAR; PG8_WAIT_L(0); PG8_MMA(1, 0, At, B0); PG8_BAR; PG8_SCHED;
            PG8_STAGE(PG8_SB(0, 1), b2 + hstepB, voffB);
            PG8_WAIT_V(6); PG8_BAR; PG8_MMA(1, 1, At, B1); PG8_BAR;
            PG8_LDB(B0, 1, 0); PG8_SCHED; PG8_LDA(At, 1, 0); PG8_STAGE(PG8_SA(0, 1), a2 + hstepA, voffA);
            PG8_WAIT_L(8); PG8_BAR; PG8_WAIT_L(0); PG8_MMA(0, 0, At, B0); PG8_BAR; PG8_SCHED;
            PG8_LDB(B1, 1, 1); PG8_STAGE(PG8_SB(1, 0), b3, voffB);
            PG8_BAR; PG8_WAIT_L(0); PG8_MMA(0, 1, At, B1); PG8_BAR;
            PG8_LDA(At, 1, 1); PG8_STAGE(PG8_SA(1, 0), a3, voffA);
            PG8_BAR; PG8_WAIT_L(0); PG8_MMA(1, 0, At, B0); PG8_BAR; PG8_SCHED;
            PG8_STAGE(PG8_SB(1, 1), b3 + hstepB, voffB);
            PG8_WAIT_V(6); PG8_BAR; PG8_MMA(1, 1, At, B1); PG8_BAR;
            }
        }
        if constexpr (ALIGN_EPI) { if (wr == 0) PG8_BAR; }
        E(acc, cur, wr, wc, fr, fq);
        if (!has_next) break;
#pragma unroll
        for (int a = 0; a < 2; ++a)
#pragma unroll
            for (int b = 0; b < 2; ++b)
#pragma unroll
                for (int m = 0; m < 4; ++m)
#pragma unroll
                    for (int n = 0; n < 2; ++n) acc[a][b][m][n] = (f32x4){0.f, 0.f, 0.f, 0.f};
        cur = nxt; cA = nA; cB = nB; ++ui;
        if constexpr (ALIGN_EPI) { if (wr == 1) PG8_BAR; }
    }
    PG8_WAIT_V(0);
    if constexpr (!ALIGN_EPI) { if (wr == 0) PG8_BAR; }
    PG8_BAR;
#undef PG8_SA
#undef PG8_SB
#undef PG8_STAGE
#undef PG8_LDA
#undef PG8_LDB
#undef PG8_MMA
#undef PG8_WAIT_V
#undef PG8_WAIT_L
#undef PG8_BAR
#undef PG8_SCHED
}
}
constexpr size_t MiB = 1u << 20;
constexpr size_t WS_CTL = 0, CTL_ZERO_BYTES = 1 * MiB;
constexpr size_t WS_SSQ = 1 * MiB;
constexpr size_t WS_GATES = 2 * MiB;
constexpr size_t WS_NST = 3 * MiB;
constexpr size_t WS_W = 4 * MiB;
constexpr size_t W_GU1 = 0, W_D1 = 11 * MiB, W_IN = W_D1 + 11 * MiB / 2, W_OUT = W_IN + 7 * MiB, W_GU2 = W_OUT + 2 * MiB, W_D2 = W_GU2 + 11 * MiB, W_LAYER = 42 * MiB;
static_assert(W_D2 + 11 * MiB / 2 == W_LAYER, "weights map");
constexpr size_t WS_XB = 88 * MiB;
constexpr size_t WS_CST = 120 * MiB;
constexpr size_t WS_SST = 128 * MiB;
constexpr size_t WS_PROJ = 144 * MiB;
constexpr size_t WS_END = 248 * MiB;
static_assert(WS_PROJ + (size_t)M_TOK * PLD * 2 <= WS_END, "ws map");

constexpr int CW_BAR = 4096;
constexpr int CW_Q = 16384;

constexpr int RING_BYTES = 131072;
constexpr int LDSCTL_OFF = RING_BYTES, MISC_OFF = LDSCTL_OFF + 320;
constexpr int LDS_BYTES = 147456;
constexpr int NWAVES = 8, NTHREADS = 512;

typedef GAS unsigned gu32;
#define RLX_AGENT __ATOMIC_RELAXED, __HIP_MEMORY_SCOPE_AGENT
#define LDS_WAIT() asm volatile("s_waitcnt lgkmcnt(0)" ::: "memory")
#define VM_WAIT() asm volatile("s_waitcnt vmcnt(0)" ::: "memory")

#define XB_TMO      128
#define XB_XCNT(j)  (256  + 64 * (j))
#define XB_XSUB(j)  (1280 + 64 * (j))
#define XB_XGEN(j)  (2304 + 64 * (j))
#define XB_TOP      3328
#define XB_TOPGEN   3392
#define XCD_BAR_WORDS 3456
#define XB_SPIN_CAP (1u << 22)
__device__ __forceinline__ unsigned xb_ld(unsigned* p)              { return __hip_atomic_load(p, __ATOMIC_RELAXED, __HIP_MEMORY_SCOPE_AGENT); }
__device__ __forceinline__ unsigned xb_add(unsigned* p, unsigned v) { return __hip_atomic_fetch_add(p, v, __ATOMIC_RELAXED, __HIP_MEMORY_SCOPE_AGENT); }
__device__ __forceinline__ unsigned xb_xcc_id() { return (unsigned)__builtin_amdgcn_s_getreg((3 << 11) | 20) & 0xFu; }
#define XB_SPIN(cond, bar) do { unsigned _sp = 0; while (cond) { __builtin_amdgcn_s_sleep(1); \
    if ((++_sp & 255u) == 0u) { if (xb_ld(&(bar)[XB_TMO])) break; if (_sp > XB_SPIN_CAP) { atomicAdd(&(bar)[XB_TMO], 1u); break; } } } } while (0)
struct XcdBarrier { unsigned* bar; unsigned x; volatile LAS unsigned* st; };
__device__ __forceinline__ XcdBarrier xcd_barrier_post(unsigned* bar, volatile LAS unsigned* st) {
    XcdBarrier b; b.bar = bar; b.x = xb_xcc_id(); b.st = st;
    if (threadIdx.x == 0) (void)xb_add(&bar[XB_XCNT(b.x)], 1u);
    return b;
}
__device__ __forceinline__ void xcd_barrier_complete(unsigned* bar, unsigned x, unsigned& nloc, unsigned& nx) {
    const unsigned G = gridDim.x * gridDim.y * gridDim.z;
    unsigned sum, cnt, mine, sp = 0u;
    for (;;) {
        sum = 0u; cnt = 0u; mine = 0u;
#pragma unroll
        for (unsigned j = 0; j < 16; ++j) { const unsigned c = xb_ld(&bar[XB_XCNT(j)]); sum += c; cnt += (c > 0u) ? 1u : 0u; mine = (j == x) ? c : mine; }
        if (sum == G) break;
        __builtin_amdgcn_s_sleep(1);
        if ((++sp & 255u) == 0u) { if (xb_ld(&bar[XB_TMO])) break; if (sp > XB_SPIN_CAP) { atomicAdd(&bar[XB_TMO], 1u); break; } }
    }
    nloc = mine > 0u ? mine : 1u; nx = cnt > 0u ? cnt : 1u;
}
__device__ __forceinline__ void xcd_barrier(const XcdBarrier& b) {
    asm volatile("s_waitcnt vmcnt(0)" ::: "memory");
    __syncthreads();
    if (threadIdx.x == 0) {
        unsigned* bar = b.bar;
        __builtin_amdgcn_s_waitcnt(0);
        unsigned nloc = b.st[0], nx = b.st[1];
        if (nloc == 0u) { xcd_barrier_complete(bar, b.x, nloc, nx); b.st[0] = nloc; b.st[1] = nx; }
        const unsigned old = xb_add(&bar[XB_XSUB(b.x)], 1u);
        const unsigned gen = old / nloc;
        if (old + 1u == (gen + 1u) * nloc) {
            __builtin_amdgcn_fence(__ATOMIC_RELEASE, "agent");
            asm volatile("s_waitcnt vmcnt(0)" ::: "memory");
            const unsigned og = xb_add(&bar[XB_TOP], 1u);
            const unsigned tg = og / nx;
            if (og + 1u == (tg + 1u) * nx) xb_add(&bar[XB_TOPGEN], 1u);
            else XB_SPIN(xb_ld(&bar[XB_TOPGEN]) == tg, bar);
            __builtin_amdgcn_fence(__ATOMIC_ACQUIRE, "agent");
            xb_add(&bar[XB_XGEN(b.x)], 1u);
            asm volatile("s_waitcnt vmcnt(0)" ::: "memory");
        } else {
            XB_SPIN(xb_ld(&bar[XB_XGEN(b.x)]) == gen, bar);
            __builtin_amdgcn_fence(__ATOMIC_ACQUIRE, "agent");
            asm volatile("s_waitcnt vmcnt(0)" ::: "memory");
        }
    }
    __syncthreads();
}

struct Args { const float* in[25]; float* out; unsigned char* ws; int ph_lo, ph_hi; };
typedef const float* fptr_t; typedef __attribute__((address_space(4))) const fptr_t* kinptr_t;
struct ArgView { kinptr_t in; };
struct Frame {
    LAS unsigned char* lds;
    volatile LAS unsigned* MISC;
    unsigned* ctl;
    int tid, lane, wave, vcu, G;
    kinptr_t in;
    unsigned char* ws;
};
__device__ __forceinline__ float wave_sum(float v) {
#pragma unroll
    for (int o = 1; o < 64; o <<= 1) v += __shfl_xor(v, o);
    return v;
}
__device__ __forceinline__ int q_next(Frame& F, int q) {
    __syncthreads();
    if (F.tid == 0) F.MISC[16] = xb_add(F.ctl + CW_Q + 64 * q, 1u);
    __syncthreads();
    return (int)F.MISC[16];
}

struct MapPlain { __device__ __forceinline__ int row(int n) const { return n; } __device__ __forceinline__ float scale(int) const { return 1.f; } };
struct MapGU { int off; __device__ __forceinline__ int row(int n) const { return 256 * (n >> 7) + off + (n & 127); } __device__ __forceinline__ float scale(int) const { return 1.f; } };
struct MapIn {
    __device__ __forceinline__ int row(int n) const {
        if (n < 1024) return n;
        if (n < 1032) return 13 * 256 + (n - 1024);
        if (n < 1544) return 4 * 256 + (n - 1032);
        if (n < 2568) return 6 * 256 + (n - 1544);
        if (n < 2576) return 13 * 256 + 8 + (n - 2568);
        return 10 * 256 + (n - 2576);
    }
    __device__ __forceinline__ float scale(int n) const { return (n >= 256 && n < 512) ? 0.125f : 1.f; }
};
template <class Map>
__device__ __forceinline__ void p0_transpose_item(const float* W, int K, int N, bf16_t* WT, int item, int lane, const float* gain, const Map map) {
    const int nblk = (N + 63) / 64, kb = item / nblk, nb = item % nblk, k0 = 64 * kb, n = 64 * nb + lane;
    if (n >= N) return;
    const float* src = W + (size_t)k0 * N + n;
    float v[64];
#pragma unroll
    for (int i = 0; i < 64; ++i) v[i] = src[(size_t)i * N];
    const float sc = map.scale(n);
    if (gain) {
#pragma unroll
        for (int i = 0; i < 64; i += 4) { const f32x4 g = *(const f32x4*)(gain + k0 + i); v[i] *= g.x; v[i + 1] *= g.y; v[i + 2] *= g.z; v[i + 3] *= g.w; }
    }
    u32x4* dst = (u32x4*)(WT + (size_t)map.row(n) * K + k0);
#pragma unroll
    for (int c = 0; c < 8; ++c) { u32x4 o; o.x = cvtpk(v[8 * c] * sc, v[8 * c + 1] * sc); o.y = cvtpk(v[8 * c + 2] * sc, v[8 * c + 3] * sc); o.z = cvtpk(v[8 * c + 4] * sc, v[8 * c + 5] * sc); o.w = cvtpk(v[8 * c + 6] * sc, v[8 * c + 7] * sc); dst[c] = o; }
}
constexpr int I_G = (DM / 64) * (FF / 64), I_D = (FF / 64) * (DM / 64), I_IN = (DM / 64) * ((3344 + 63) / 64), I_OUT = (DM / 64) * (DM / 64);
constexpr int R_GU1 = 0, R_D1 = 2 * I_G, R_IN = R_D1 + I_D, R_OUT = R_IN + I_IN, R_GU2 = R_OUT + I_OUT, R_D2 = R_GU2 + 2 * I_G, R_END = R_D2 + I_D;
__device__ __forceinline__ void convert_items(Frame& F, int l, int r_lo, int r_hi, int gw, int NGW) {
    bf16_t* WL = (bf16_t*)(F.ws + WS_W + (size_t)l * W_LAYER);
    for (int it = r_lo + gw; it < r_hi; it += NGW) {
        int r = it;
        if (r < I_G) { p0_transpose_item(F.in[2] + (size_t)l * DM * FF, DM, FF, (bf16_t*)((char*)WL + W_GU1), r, F.lane, F.in[1] + l * DM, MapGU{0}); continue; } r -= I_G;
        if (r < I_G) { p0_transpose_item(F.in[3] + (size_t)l * DM * FF, DM, FF, (bf16_t*)((char*)WL + W_GU1), r, F.lane, F.in[1] + l * DM, MapGU{128}); continue; } r -= I_G;
        if (r < I_D) { p0_transpose_item(F.in[4] + (size_t)l * FF * DM, FF, DM, (bf16_t*)((char*)WL + W_D1), r, F.lane, nullptr, MapPlain{}); continue; } r -= I_D;
        if (r < I_IN) { p0_transpose_item(F.in[6] + (size_t)l * DM * 3344, DM, 3344, (bf16_t*)((char*)WL + W_IN), r, F.lane, F.in[5] + l * DM, MapIn{}); continue; } r -= I_IN;
        if (r < I_OUT) { p0_transpose_item(F.in[20] + (size_t)l * DM * DM, DM, DM, (bf16_t*)((char*)WL + W_OUT), r, F.lane, nullptr, MapPlain{}); continue; } r -= I_OUT;
        if (r < I_G) { p0_transpose_item(F.in[22] + (size_t)l * DM * FF, DM, FF, (bf16_t*)((char*)WL + W_GU2), r, F.lane, F.in[21] + l * DM, MapGU{0}); continue; } r -= I_G;
        if (r < I_G) { p0_transpose_item(F.in[23] + (size_t)l * DM * FF, DM, FF, (bf16_t*)((char*)WL + W_GU2), r, F.lane, F.in[21] + l * DM, MapGU{128}); continue; } r -= I_G;
        p0_transpose_item(F.in[24] + (size_t)l * FF * DM, FF, DM, (bf16_t*)((char*)WL + W_D2), r, F.lane, nullptr, MapPlain{});
    }
    if (r_lo <= R_IN && R_IN < r_hi) {
        u32x4* z = (u32x4*)(F.ws + WS_W + (size_t)l * W_LAYER + W_IN + (size_t)(13 * 256 + 16) * DM * 2);
        const int n16 = 240 * DM * 2 / 16;
        unsigned z0 = 0u; asm volatile("" : "+v"(z0));
        for (int i = gw * 64 + F.lane; i < n16; i += NGW * 64) z[i] = (u32x4){z0, z0, z0, z0};
    }
}
__device__ __forceinline__ void side_convert(Frame& F, int l, int k) {
    if ((int)blockIdx.x < 128 || F.G != 256) return;
    const int gw = ((int)blockIdx.x - 128) * NWAVES + F.wave, NGW = 128 * NWAVES;
    if (l == 0 && k == 0) convert_items(F, 0, R_D1, R_OUT, gw, NGW);
    else if (l == 0 && k == 2) convert_items(F, 0, R_OUT, R_END, gw, NGW);
    else if (l == 0 && k == 7) convert_items(F, 1, R_GU1, R_D1, gw, NGW);
    else if (l == 1 && k == 0) convert_items(F, 1, R_D1, R_GU2, gw, NGW);
    else if (l == 1 && k == 2) convert_items(F, 1, R_GU2, R_D2, gw, NGW);
    else if (l == 1 && k == 7) convert_items(F, 1, R_D2, R_END, gw, NGW);
}
__device__ __forceinline__ void p0_prologue(Frame& F) {
    const int gw = F.vcu * NWAVES + F.wave, NGW = F.G * NWAVES;
    if (F.G == 256) convert_items(F, 0, R_GU1, R_D1, gw, NGW);
    else { convert_items(F, 0, 0, R_END, gw, NGW); convert_items(F, 1, 0, R_END, gw, NGW); }
    const float* x = F.in[0]; bf16_t* XB = (bf16_t*)(F.ws + WS_XB); float* SSQ = (float*)(F.ws + WS_SSQ);
    for (int m = gw; m < M_TOK; m += NGW) {
        const f32x4* xr = (const f32x4*)(x + (size_t)m * DM) + F.lane; float s = 0.f; f32x4 v[4];
#pragma unroll
        for (int j = 0; j < 4; ++j) { v[j] = xr[64 * j]; s += (v[j].x * v[j].x + v[j].y * v[j].y) + (v[j].z * v[j].z + v[j].w * v[j].w); }
        s = wave_sum(s);
        u32x2* o8 = (u32x2*)(XB + (size_t)m * DM) + F.lane;
#pragma unroll
        for (int j = 0; j < 4; ++j) o8[64 * j] = (u32x2){cvtpk(v[j].x, v[j].y), cvtpk(v[j].z, v[j].w)};
        if (F.lane < 16) SSQ[(size_t)m * 16 + F.lane] = (F.lane == 0) ? s : 0.f;
    }
}

__device__ __forceinline__ void rows_rs(const float* ssq, int rowbase, int fr, int fq, float (&rs)[8]) {
    f32x4 p[8];
#pragma unroll
    for (int i = 0; i < 8; ++i) { const int row = rowbase + (i >> 2) * 128 + (i & 3) * 16 + fr; p[i] = *(const f32x4*)(ssq + (size_t)row * 16 + 4 * fq); }
#pragma unroll
    for (int i = 0; i < 8; ++i) { float s = (p[i].x + p[i].y) + (p[i].z + p[i].w); s += __shfl_xor(s, 16); s += __shfl_xor(s, 32); rs[i] = rsqrtf(s * (1.0f / DM) + NORM_EPS); }
}
struct EpiNoInit { struct Raw {}; static constexpr bool HAS_INIT = false; __device__ __forceinline__ void init_load(Raw&, const pg8::Unit&, int, int, int, int) const {} };
struct EpiSwiglu : EpiNoInit {
    bf16_t* H; const float* ssq;
    __device__ __forceinline__ void operator()(const f32x4 (&acc)[2][2][4][2], const pg8::Unit& u, int wr, int wc, int fr, int fq) const {
        asm volatile("" : "+v"(fr), "+v"(fq));
        const int col0 = u.pn * 128 + wc * 32 + 8 * fq;
        float rs[8]; rows_rs(ssq, u.pm * 256 + wr * 64, fr, fq, rs);
#pragma unroll
        for (int ai = 0; ai < 2; ++ai)
#pragma unroll
            for (int m = 0; m < 4; ++m) {
                const int row = u.pm * 256 + ai * 128 + wr * 64 + m * 16 + fr; const float r = rs[ai * 4 + m];
                float hv[8];
#pragma unroll
                for (int n = 0; n < 2; ++n)
#pragma unroll
                    for (int j = 0; j < 4; ++j) { const float g = acc[ai][0][m][n][j] * r, up = acc[ai][1][m][n][j] * r; hv[4 * n + j] = siluf_(g) * up; }
                u32x4 w; w.x = cvtpk(hv[0], hv[1]); w.y = cvtpk(hv[2], hv[3]); w.z = cvtpk(hv[4], hv[5]); w.w = cvtpk(hv[6], hv[7]);
                st16_wt(H + (size_t)row * FF + col0, w);
                if (m & 1) asm volatile("" ::: "memory");
            }
    }
};
template <bool FINAL>
struct EpiResid {
    struct Raw { u32x4 r[2][4][2]; };
    static constexpr bool HAS_INIT = true;
    float* xout; bf16_t* XB; float* ssq; float alpha, ralpha;
    __device__ __forceinline__ void init_load(Raw& raw, const pg8::Unit& u, int wr, int wc, int fr, int fq) const {
        const int col0 = u.pn * 256 + wc * 32 + 8 * fq;
#pragma unroll
        for (int ai = 0; ai < 2; ++ai)
#pragma unroll
            for (int m = 0; m < 4; ++m) { const int row = u.pm * 256 + ai * 128 + wr * 64 + m * 16 + fr;
#pragma unroll
                for (int bj = 0; bj < 2; ++bj) raw.r[ai][m][bj] = *(const u32x4*)(XB + (size_t)row * DM + col0 + bj * 128); }
    }
    __device__ __forceinline__ void init_finish(const Raw& raw, f32x4 (&acc)[2][2][4][2]) const {
#pragma unroll
        for (int ai = 0; ai < 2; ++ai)
#pragma unroll
            for (int m = 0; m < 4; ++m)
#pragma unroll
                for (int bj = 0; bj < 2; ++bj) { const u32x4 w = raw.r[ai][m][bj];
                    acc[ai][bj][m][0] = (f32x4){bflo(w.x), bfhi(w.x), bflo(w.y), bfhi(w.y)} * ralpha; acc[ai][bj][m][1] = (f32x4){bflo(w.z), bfhi(w.z), bflo(w.w), bfhi(w.w)} * ralpha; }
    }
    __device__ __forceinline__ void operator()(const f32x4 (&acc)[2][2][4][2], const pg8::Unit& u, int wr, int wc, int fr, int fq) const {
        asm volatile("" : "+v"(fr), "+v"(fq));
        const int col0 = u.pn * 256 + wc * 32 + 8 * fq;
#pragma unroll
        for (int ai = 0; ai < 2; ++ai)
#pragma unroll
            for (int m = 0; m < 4; ++m) {
                const int row = u.pm * 256 + ai * 128 + wr * 64 + m * 16 + fr; float ss = 0.f;
#pragma unroll
                for (int bj = 0; bj < 2; ++bj) {
                    const size_t off = (size_t)row * DM + col0 + bj * 128;
                    const f32x4 y0 = acc[ai][bj][m][0] * alpha, y1 = acc[ai][bj][m][1] * alpha;
                    if (FINAL) { *(f32x4*)(xout + off) = y0; *(f32x4*)(xout + off + 4) = y1; }
                    else {
                        ss += (y0.x * y0.x + y0.y * y0.y) + (y0.z * y0.z + y0.w * y0.w) + (y1.x * y1.x + y1.y * y1.y) + (y1.z * y1.z + y1.w * y1.w);
                        u32x4 w; w.x = cvtpk(y0.x, y0.y); w.y = cvtpk(y0.z, y0.w); w.z = cvtpk(y1.x, y1.y); w.w = cvtpk(y1.z, y1.w);
                        st16_wt(XB + off, w); }
                }
                if (!FINAL) { ss += __shfl_xor(ss, 16); ss += __shfl_xor(ss, 32);
                    if (fq == 0) ssq[(size_t)row * 16 + u.pn * 4 + wc] = ss; }
                if (m & 1) asm volatile("" ::: "memory");
            }
    }
};
struct EpiInProj : EpiNoInit {
    bf16_t* PROJ; float* GATES; const float* ssq; const float* qnw; const float* knw; const float* gbias; const float* dtb;
    template <int KIND>
    __device__ __forceinline__ void body(const f32x4 (&acc)[2][2][4][2], const pg8::Unit& u, int wr, int wc, int fr, int fq, const float (&rs)[8]) const {
        const int t = u.pn, colw = wc * 32 + 8 * fq;
        float nw[8];
        if (KIND == 3) { const float* w = (t == 10 ? qnw : knw) + (wc & 1) * 32 + 8 * fq; const float sc = (t == 10) ? (0.17677669529663687f * LOG2E) : 1.f;
#pragma unroll
            for (int i = 0; i < 8; ++i) nw[i] = w[i] * sc; }
#pragma unroll
        for (int ai = 0; ai < 2; ++ai)
#pragma unroll
            for (int m = 0; m < 4; ++m) {
                const int row = u.pm * 256 + ai * 128 + wr * 64 + m * 16 + fr; const float r = rs[ai * 4 + m];
#pragma unroll
                for (int bj = 0; bj < 2; ++bj) {
                    float v[8];
#pragma unroll
                    for (int n = 0; n < 2; ++n)
#pragma unroll
                        for (int j = 0; j < 4; ++j) v[4 * n + j] = acc[ai][bj][m][n][j] * r;
                    if (KIND == 1) {
#pragma unroll
                        for (int i = 0; i < 8; ++i) v[i] = sigmoidf_(v[i]);
                    } else if (KIND == 2) {
#pragma unroll
                        for (int i = 0; i < 8; ++i) v[i] = siluf_(v[i]);
                    } else if (KIND == 3) {
                        float ss = 0.f;
#pragma unroll
                        for (int i = 0; i < 8; ++i) ss += v[i] * v[i];
                        ss += __shfl_xor(ss, 16); ss += __shfl_xor(ss, 32);
                        const float q = rsqrtf(ss * (1.0f / 32.0f) + NORM_EPS);
#pragma unroll
                        for (int i = 0; i < 8; ++i) v[i] = v[i] * q * nw[i];
                    }
                    u32x4 w; w.x = cvtpk(v[0], v[1]); w.y = cvtpk(v[2], v[3]); w.z = cvtpk(v[4], v[5]); w.w = cvtpk(v[6], v[7]);
                    st16_wt(PROJ + (size_t)row * PLD + t * 256 + bj * 128 + colw, w);
                }
                if (m & 1) asm volatile("" ::: "memory");
            }
    }
    __device__ __forceinline__ void gates(const f32x4 (&acc)[2][2][4][2], const pg8::Unit& u, int wr, int wc, int fr, int fq, const float (&rs)[8]) const {
        if (wc != 0 || fq >= 2) return;
#pragma unroll
        for (int ai = 0; ai < 2; ++ai)
#pragma unroll
            for (int m = 0; m < 4; ++m) {
                const int row = u.pm * 256 + ai * 128 + wr * 64 + m * 16 + fr; const float r = rs[ai * 4 + m];
                float v[8], o[8];
#pragma unroll
                for (int n = 0; n < 2; ++n)
#pragma unroll
                    for (int j = 0; j < 4; ++j) v[4 * n + j] = acc[ai][0][m][n][j] * r;
                if (fq == 0) {
#pragma unroll
                    for (int j = 0; j < 4; ++j) { o[j] = v[j] + gbias[j]; const float z = v[4 + j] + gbias[4 + j]; o[4 + j] = fminf(z, 0.f) - fast_log1pexp(-fabsf(z)); }
                } else {
#pragma unroll
                    for (int j = 0; j < 8; ++j) { const float z = v[j] + dtb[j]; o[j] = fmaxf(z, 0.f) + fast_log1pexp(-fabsf(z)); }
                }
                float* gp = GATES + (size_t)row * 16 + 8 * fq;
                *(f32x4*)gp = (f32x4){o[0], o[1], o[2], o[3]}; *(f32x4*)(gp + 4) = (f32x4){o[4], o[5], o[6], o[7]};
                asm volatile("" ::: "memory");
            }
    }
    __device__ __forceinline__ void operator()(const f32x4 (&acc)[2][2][4][2], const pg8::Unit& u, int wr, int wc, int fr, int fq) const {
        asm volatile("" : "+v"(fr), "+v"(fq));
        float rs[8]; rows_rs(ssq, u.pm * 256 + wr * 64, fr, fq, rs);
        const int t = u.pn;
        if (t == 13) gates(acc, u, wr, wc, fr, fq, rs);
        else if (t == 3) body<1>(acc, u, wr, wc, fr, fq, rs);
        else if (t == 4 || t == 5) body<2>(acc, u, wr, wc, fr, fq, rs);
        else if (t == 10 || t == 11) body<3>(acc, u, wr, wc, fr, fq, rs);
        else body<0>(acc, u, wr, wc, fr, fq, rs);
    }
};
#define MFMA16(a, b, c) __builtin_amdgcn_mfma_f32_16x16x32_bf16((a), (b), (c), 0, 0, 0)
#define WAVE_SYNC() do { asm volatile("s_waitcnt lgkmcnt(0)" ::: "memory"); __builtin_amdgcn_wave_barrier(); } while (0)
#define LDS_BARRIER() do { asm volatile("s_waitcnt lgkmcnt(0)" ::: "memory"); __builtin_amdgcn_s_barrier(); asm volatile("" ::: "memory"); } while (0)
__device__ __forceinline__ bf16x8 ld_g8(const bf16_t* p) { return *(const bf16x8*)p; }
__device__ __forceinline__ bf16x8 ld_l8(const LAS bf16_t* p) { return *(const LAS bf16x8*)p; }
__device__ __forceinline__ bf16x8 ld_l44(const LAS bf16_t* p0, const LAS bf16_t* p1) { const bf16x4 a = *(const LAS bf16x4*)p0, b = *(const LAS bf16x4*)p1; return (bf16x8){a[0], a[1], a[2], a[3], b[0], b[1], b[2], b[3]}; }
__device__ __forceinline__ bf16x8 pack8(const f32x4 a, const f32x4 b) { u32x4 w; w.x = cvtpk(a[0], a[1]); w.y = cvtpk(a[2], a[3]); w.z = cvtpk(b[0], b[1]); w.w = cvtpk(b[2], b[3]); return __builtin_bit_cast(bf16x8, w); }
__device__ __forceinline__ float wave_scan_incl(float v, int lane) {
#pragma unroll
    for (int o = 1; o < 64; o <<= 1) { const float t = __shfl_up(v, o); if (lane >= o) v += t; }
    return v;
}

typedef short v4i16_t __attribute__((ext_vector_type(4)));
__device__ __forceinline__ bf16x8 ld_tr8(const LAS bf16_t* T, int pitch, int k0, int c0, int lane) {
    const int i = lane & 15, fq = lane >> 4;
    const LAS bf16_t* p = T + (k0 + 8 * fq + (i >> 2)) * pitch + c0 + 4 * (i & 3);
    const v4i16_t lo = __builtin_amdgcn_ds_read_tr16_b64_v4i16((LAS v4i16_t*)p), hi = __builtin_amdgcn_ds_read_tr16_b64_v4i16((LAS v4i16_t*)(p + 4 * pitch));
    return (bf16x8){lo[0], lo[1], lo[2], lo[3], hi[0], hi[1], hi[2], hi[3]};
}
__device__ __forceinline__ bf16x8 ld_tr8p(const LAS bf16_t* T, int pitch, int k0, int c0, int lane) {
    const int i = lane & 15, fq = lane >> 4;
    const LAS bf16_t* p = T + (k0 + 4 * fq + (i >> 2)) * pitch + c0 + 4 * (i & 3);
    const v4i16_t lo = __builtin_amdgcn_ds_read_tr16_b64_v4i16((LAS v4i16_t*)p), hi = __builtin_amdgcn_ds_read_tr16_b64_v4i16((LAS v4i16_t*)(p + 16 * pitch));
    return (bf16x8){lo[0], lo[1], lo[2], lo[3], hi[0], hi[1], hi[2], hi[3]};
}

__device__ __forceinline__ void conv_phase(Frame& F, int l) {
    const bf16_t* PROJ = (const bf16_t*)(F.ws + WS_PROJ); bf16_t* XACT = (bf16_t*)F.in[25];
    const float* cw = F.in[9] + (size_t)l * 4 * 1024; const float* cb = F.in[10] + (size_t)l * 1024;
    for (int g = F.vcu * NTHREADS + F.tid; g < 1024 * 128; g += F.G * NTHREADS) {
        const int cg = g & 127, rb = g >> 7, ch0 = cg * 8, row0 = rb * 16;
        float w[4][8], bs[8];
#pragma unroll
        for (int j = 0; j < 4; ++j) { const f32x4 a = *(const f32x4*)(cw + j * 1024 + ch0), b = *(const f32x4*)(cw + j * 1024 + ch0 + 4);
            w[j][0] = a.x; w[j][1] = a.y; w[j][2] = a.z; w[j][3] = a.w; w[j][4] = b.x; w[j][5] = b.y; w[j][6] = b.z; w[j][7] = b.w; }
        { const f32x4 a = *(const f32x4*)(cb + ch0), b = *(const f32x4*)(cb + ch0 + 4); bs[0] = a.x; bs[1] = a.y; bs[2] = a.z; bs[3] = a.w; bs[4] = b.x; bs[5] = b.y; bs[6] = b.z; bs[7] = b.w; }
        float h3[8], h2[8], h1[8];
        const bool first = (row0 % SEQ) == 0;
        const bf16_t* src = PROJ + (size_t)row0 * PLD + PX + ch0;
        if (first) {
#pragma unroll
            for (int e = 0; e < 8; ++e) { h3[e] = 0.f; h2[e] = 0.f; h1[e] = 0.f; }
        } else {
            const u32x4 a = *(const u32x4*)(src - 3 * (size_t)PLD), b = *(const u32x4*)(src - 2 * (size_t)PLD), c = *(const u32x4*)(src - (size_t)PLD);
#pragma unroll
            for (int e = 0; e < 4; ++e) { h3[2 * e] = bflo(a[e]); h3[2 * e + 1] = bfhi(a[e]); h2[2 * e] = bflo(b[e]); h2[2 * e + 1] = bfhi(b[e]); h1[2 * e] = bflo(c[e]); h1[2 * e + 1] = bfhi(c[e]); }
        }
        u32x4 dr[16];
#pragma unroll
        for (int i = 0; i < 16; ++i) dr[i] = *(const u32x4*)(src + (size_t)i * PLD);
#pragma unroll
        for (int i = 0; i < 16; ++i) {
            const u32x4 d = dr[i]; float cur[8], o[8];
#pragma unroll
            for (int e = 0; e < 4; ++e) { cur[2 * e] = bflo(d[e]); cur[2 * e + 1] = bfhi(d[e]); }
#pragma unroll
            for (int e = 0; e < 8; ++e) { const float s = bs[e] + w[0][e] * h3[e] + w[1][e] * h2[e] + w[2][e] * h1[e] + w[3][e] * cur[e]; o[e] = siluf_(s); h3[e] = h2[e]; h2[e] = h1[e]; h1[e] = cur[e]; }
            u32x4 ow; ow.x = cvtpk(o[0], o[1]); ow.y = cvtpk(o[2], o[3]); ow.z = cvtpk(o[4], o[5]); ow.w = cvtpk(o[6], o[7]);
            *(u32x4*)(XACT + (size_t)(row0 + i) * 1024 + ch0) = ow;
        }
    }
}

__device__ __forceinline__ void mlstm_state_item(Frame& F, int bh) {
    const int b = bh >> 2, h = bh & 3, w = F.wave, vq = w & 3, dh = w >> 2, lane = F.lane, fr = lane & 15, fq = lane >> 4, tid = F.tid;
    constexpr int MP = 72, MBUF = 2 * 64 * MP * 2 + 128;
    LAS float* WG = (LAS float*)(F.lds + 2 * MBUF); LAS float* DEC = WG + 4096;
    const bf16_t* PROJ = (const bf16_t*)(F.ws + WS_PROJ); const float* GATES = (const float*)(F.ws + WS_GATES);
    bf16_t* CST = (bf16_t*)(F.ws + WS_CST); float* NST = (float*)(F.ws + WS_NST);
    const size_t rowb = (size_t)b * SEQ;
    {
        float igv[8], lfv[8];
#pragma unroll
        for (int i = 0; i < 8; ++i) { const float* gq = GATES + (rowb + 64 * (w + 8 * i) + lane) * 16 + h; igv[i] = gq[0]; lfv[i] = gq[4]; }
#pragma unroll
        for (int i = 0; i < 8; ++i) { const int c = w + 8 * i;
            const float bs = wave_scan_incl(lfv[i], lane); const float bl = __shfl(bs, 63);
            WG[64 * c + lane] = fast_exp(bl - bs + igv[i]); if (lane == 0) DEC[c] = fast_exp(bl); }
    }
    f32x4 acc[2], nacc[2];
    acc[0] = acc[1] = nacc[0] = nacc[1] = (f32x4){0.f, 0.f, 0.f, 0.f};
    const int ls = tid >> 3, lc = tid & 7;
    const bf16_t* kp = PROJ + (rowb + ls) * PLD + PK + h * 64 + 8 * lc; const bf16_t* vp = PROJ + (rowb + ls) * PLD + PV + h * 64 + 8 * lc;
    u32x4 k0, v0, k1, v1, k2, v2;
#define ML_LOAD(kr_, vr_, c_) do { const size_t o_ = (size_t)(c_) * 64 * PLD; kr_ = *(const u32x4*)(kp + o_); vr_ = *(const u32x4*)(vp + o_); } while (0)
#define ML_WRITE(kr_, vr_, c_) do { LAS bf16_t* KL_ = (LAS bf16_t*)(F.lds + ((c_) & 1) * MBUF); LAS bf16_t* VL_ = KL_ + 64 * MP; const float wg_ = WG[64 * (c_) + ls]; \
        *(LAS u32x4*)(KL_ + ls * MP + 8 * lc) = kr_; u32x4 o_; _Pragma("unroll") for (int e_ = 0; e_ < 4; ++e_) o_[e_] = cvtpk(wg_ * bflo(vr_[e_]), wg_ * bfhi(vr_[e_])); \
        *(LAS u32x4*)(VL_ + ls * MP + 8 * lc) = o_; if (lc == 0) (VL_ + 64 * MP)[ls] = f2bf(wg_); } while (0)
    LAS bf16_t* STG = (LAS bf16_t*)(F.lds + 2 * MBUF + 16384 + 256); LAS float* NSTG = (LAS float*)(STG + 2 * 4096);
#define ML_STAGE(c_) do { LAS bf16_t* sg_ = STG + ((c_) & 1) * 4096; \
        _Pragma("unroll") for (int dt = 0; dt < 2; ++dt) _Pragma("unroll") for (int r = 0; r < 4; ++r) sg_[(vq * 16 + 4 * fq + r) * 64 + dh * 32 + dt * 16 + fr] = f2bf(acc[dt][r]); \
        if (vq == 0 && fq == 0) { NSTG[((c_) & 1) * 64 + dh * 32 + fr] = nacc[0][0]; NSTG[((c_) & 1) * 64 + dh * 32 + 16 + fr] = nacc[1][0]; } } while (0)
    ML_LOAD(k0, v0, 0); ML_LOAD(k1, v1, 1); ML_LOAD(k2, v2, 2);
    __syncthreads();
    ML_WRITE(k0, v0, 0);
    ML_STAGE(0);
    LDS_BARRIER();
#define ML_STEP(KW, VW, KN, VN, c_) do { const int cc_ = (c_); const size_t ci = (size_t)bh * 64 + cc_; \
          \
        { const u32x4 st_ = *(const LAS u32x4*)(STG + ((cc_) & 1) * 4096 + tid * 8); *(u32x4*)(CST + ci * 4096 + tid * 8) = st_; \
          NST[ci * 64 + (tid & 63)] = NSTG[((cc_) & 1) * 64 + (tid & 63)]; }     \
        asm volatile("" ::: "memory"); \
        if (cc_ + 1 < 64) ML_WRITE(KW, VW, cc_ + 1); \
        asm volatile("" ::: "memory"); \
        ML_LOAD(KN, VN, (cc_ + 3 < 64 ? cc_ + 3 : 63)); \
        asm volatile("" ::: "memory"); \
        const float decay = DEC[cc_]; \
        const LAS bf16_t* KL = (const LAS bf16_t*)(F.lds + (cc_ & 1) * MBUF); const LAS bf16_t* VL = KL + 64 * MP; const LAS bf16_t* WV = VL + 64 * MP; \
        _Pragma("unroll") for (int dt = 0; dt < 2; ++dt) { acc[dt] = acc[dt] * decay; nacc[dt] = nacc[dt] * decay; } \
        _Pragma("unroll") for (int ks = 0; ks < 2; ++ks) { \
            const bf16x8 A = ld_tr8(VL, MP, 32 * ks, 16 * vq, lane); \
            bf16x8 An = ld_l8(WV + 32 * ks + 8 * fq); if (fr != 0) An = (bf16x8){0, 0, 0, 0, 0, 0, 0, 0}; \
            _Pragma("unroll") for (int dt = 0; dt < 2; ++dt) { const bf16x8 B = ld_tr8(KL, MP, 32 * ks, 32 * dh + 16 * dt, lane); \
                acc[dt] = MFMA16(A, B, acc[dt]); if (vq == 0) nacc[dt] = MFMA16(An, B, nacc[dt]); } } \
        ML_STAGE(cc_ + 1); \
        LDS_BARRIER(); } while (0)
    for (int c = 0; c < 63; c += 3) { ML_STEP(k1, v1, k0, v0, c); ML_STEP(k2, v2, k1, v1, c + 1); ML_STEP(k0, v0, k2, v2, c + 2); }
    ML_STEP(k1, v1, k0, v0, 63);
#undef ML_STEP
#undef ML_LOAD
#undef ML_WRITE
#undef ML_STAGE
}

template <int TH>
__device__ __forceinline__ void mlstm_out_wave(Frame& F, int l, int bc, int h) {
    const int b = bc >> 6, c = bc & 63, w = F.wave, lane = F.lane, fr = lane & 15, fq = lane >> 4;
    constexpr int VP = 72;
    LAS bf16_t* VL = (LAS bf16_t*)(F.lds + w * 12288); LAS float* BT_ = (LAS float*)(F.lds + w * 12288 + 9216); LAS float* GS = BT_ + 64;
    LAS bf16_t* YS = VL;
    const bf16_t* PROJ = (const bf16_t*)(F.ws + WS_PROJ); const float* GATES = (const float*)(F.ws + WS_GATES);
    const bf16_t* CST = (const bf16_t*)(F.ws + WS_CST); const float* NST = (const float*)(F.ws + WS_NST);
    bf16_t* Y = (bf16_t*)(F.ws + WS_PROJ) + PX;
    const size_t row0 = (size_t)b * SEQ + 64 * c; const size_t ci = (size_t)(b * 4 + h) * 64 + c;
    constexpr int NST_ = 2 * TH + 2, NKK = TH + 1;
    {
        const size_t row = row0 + lane;
        const float ig = GATES[row * 16 + h], lf = GATES[row * 16 + 4 + h];
        const bf16_t* vp = PROJ + row * PLD + PV + h * 64;
        u32x4 vr[8];
#pragma unroll
        for (int i = 0; i < 8; ++i) vr[i] = *(const u32x4*)(vp + 8 * i);
        const float bs = wave_scan_incl(lf, lane);
        BT_[lane] = bs; GS[lane] = ig - bs;
#pragma unroll
        for (int i = 0; i < 8; ++i) *(LAS u32x4*)(VL + lane * VP + 8 * i) = vr[i];
    }
    bf16x8 Qf[2][2], Kf[NST_][2];
#pragma unroll
    for (int tt = 0; tt < 2; ++tt)
#pragma unroll
        for (int ks = 0; ks < 2; ++ks) Qf[tt][ks] = ld_g8(PROJ + (row0 + 32 * TH + 16 * tt + fr) * PLD + PQ + h * 64 + 32 * ks + 8 * fq);
#pragma unroll
    for (int st = 0; st < NST_; ++st)
#pragma unroll
        for (int ks = 0; ks < 2; ++ks) Kf[st][ks] = ld_g8(PROJ + (row0 + 16 * st + fr) * PLD + PK + h * 64 + 32 * ks + 8 * fq);
    bf16x8 Cf[4][2];
#pragma unroll
    for (int vt = 0; vt < 4; ++vt)
#pragma unroll
        for (int ks = 0; ks < 2; ++ks) Cf[vt][ks] = ld_g8(CST + ci * 4096 + (16 * vt + fr) * 64 + 32 * ks + 8 * fq);
    u32x4 ogv[4];
#pragma unroll
    for (int i = 0; i < 4; ++i) ogv[i] = *(const u32x4*)(PROJ + (row0 + 32 * TH + (lane >> 3) + 8 * i) * PLD + PO + h * 64 + 8 * (lane & 7));
    f32x4 nv[2][2];
#pragma unroll
    for (int ks = 0; ks < 2; ++ks) { nv[ks][0] = *(const f32x4*)(NST + ci * 64 + 32 * ks + 8 * fq); nv[ks][1] = *(const f32x4*)(NST + ci * 64 + 32 * ks + 8 * fq + 4); }
    WAVE_SYNC();
    f32x4 P[2][NST_]; float den[2];
#pragma unroll
    for (int tt = 0; tt < 2; ++tt) {
        const int t = 32 * TH + 16 * tt + fr; const float bt = BT_[t]; float d1 = 0.f;
#pragma unroll
        for (int st = 0; st < NST_; ++st) {
            f32x4 s = (f32x4){0.f, 0.f, 0.f, 0.f};
#pragma unroll
            for (int ks = 0; ks < 2; ++ks) s = MFMA16(Kf[st][ks], Qf[tt][ks], s);
#pragma unroll
            for (int r = 0; r < 4; ++r) { const int sidx = 16 * st + 4 * fq + r; const float wv = (sidx <= t) ? s[r] * fast_exp(bt + GS[sidx]) : 0.f; s[r] = wv; d1 += wv; }
            P[tt][st] = s;
        }
        d1 += __shfl_xor(d1, 16); d1 += __shfl_xor(d1, 32);
        float d2 = 0.f;
#pragma unroll
        for (int ks = 0; ks < 2; ++ks) { const f32x4 n0 = nv[ks][0], n1 = nv[ks][1];
            const u32x4 qw = __builtin_bit_cast(u32x4, Qf[tt][ks]);
            d2 += bflo(qw.x) * n0.x + bfhi(qw.x) * n0.y + bflo(qw.y) * n0.z + bfhi(qw.y) * n0.w + bflo(qw.z) * n1.x + bfhi(qw.z) * n1.y + bflo(qw.w) * n1.z + bfhi(qw.w) * n1.w; }
        d2 += __shfl_xor(d2, 16); d2 += __shfl_xor(d2, 32);
        den[tt] = d1 + fast_exp(bt) * d2;
    }
    const float* nw = F.in[8] + (size_t)l * 256 + h * 64;
    f32x4 acc[2][4];
#pragma unroll
    for (int tt = 0; tt < 2; ++tt) {
#pragma unroll
        for (int vt = 0; vt < 4; ++vt) { acc[tt][vt] = (f32x4){0.f, 0.f, 0.f, 0.f};
#pragma unroll
            for (int ks = 0; ks < 2; ++ks) acc[tt][vt] = MFMA16(Qf[tt][ks], Cf[vt][ks], acc[tt][vt]); }
        float eb[4], dr[4];
#pragma unroll
        for (int r = 0; r < 4; ++r) { eb[r] = fast_exp(BT_[32 * TH + 16 * tt + 4 * fq + r]); dr[r] = __shfl(den[tt], 4 * fq + r); }
#pragma unroll
        for (int vt = 0; vt < 4; ++vt)
#pragma unroll
            for (int r = 0; r < 4; ++r) acc[tt][vt][r] *= eb[r];
#pragma unroll
        for (int kk = 0; kk < NKK; ++kk) { const bf16x8 PA = pack8(P[tt][2 * kk], P[tt][2 * kk + 1]);
            bf16x8 Bv[4];
#pragma unroll
            for (int vt = 0; vt < 4; ++vt) Bv[vt] = ld_tr8p(VL, VP, 32 * kk, 16 * vt, lane);
#pragma unroll
            for (int vt = 0; vt < 4; ++vt) acc[tt][vt] = MFMA16(PA, Bv[vt], acc[tt][vt]); }
#pragma unroll
        for (int r = 0; r < 4; ++r) { const float inv = fast_rcp(fmaxf(fabsf(dr[r]), 1.0f)); float s = 0.f;
#pragma unroll
            for (int vt = 0; vt < 4; ++vt) { acc[tt][vt][r] *= inv; s += acc[tt][vt][r] * acc[tt][vt][r]; }
            s += __shfl_xor(s, 1); s += __shfl_xor(s, 2); s += __shfl_xor(s, 4); s += __shfl_xor(s, 8); const float rs = rsqrtf(s * (1.0f / 64.0f) + NORM_EPS);
#pragma unroll
            for (int vt = 0; vt < 4; ++vt) acc[tt][vt][r] *= rs * nw[16 * vt + fr]; }
    }
    WAVE_SYNC();
#pragma unroll
    for (int tt = 0; tt < 2; ++tt)
#pragma unroll
        for (int vt = 0; vt < 4; ++vt)
#pragma unroll
            for (int r = 0; r < 4; ++r) YS[(16 * tt + 4 * fq + r) * VP + 16 * vt + fr] = f2bf(acc[tt][vt][r]);
    WAVE_SYNC();
#pragma unroll
    for (int i = 0; i < 4; ++i) { const int tr_ = (lane >> 3) + 8 * i, ch = lane & 7; const size_t row = row0 + 32 * TH + tr_;
        const u32x4 yv = *(const LAS u32x4*)(YS + tr_ * VP + 8 * ch); const u32x4 gv = ogv[i]; u32x4 o;
#pragma unroll
        for (int e = 0; e < 4; ++e) o[e] = cvtpk(bflo(yv[e]) * bflo(gv[e]), bfhi(yv[e]) * bfhi(gv[e]));
        *(u32x4*)(Y + row * PLD + h * 64 + 8 * ch) = o; }
    WAVE_SYNC();
}
__device__ __forceinline__ void mlstm_out_item(Frame& F, int l, int bc) {
    const int h = F.wave >> 1;
    if (F.wave & 1) mlstm_out_wave<1>(F, l, bc, h); else mlstm_out_wave<0>(F, l, bc, h);
}
typedef float f32x16 __attribute__((ext_vector_type(16)));
#define MFMA32(a, b, c) __builtin_amdgcn_mfma_f32_32x32x16_bf16((a), (b), (c), 0, 0, 0)
constexpr int AK_STR = 72, AV_STR = 96;
constexpr int ATT_KB = 128 * AK_STR * 2, ATT_VB = 128 * AV_STR * 2, ATT_BUF = ATT_KB + ATT_VB;
constexpr int ATT_TAB_OFF = 2 * ATT_BUF;
__device__ __forceinline__ int t5_bucket(int n) {
    if (n < 16) return n;
    int bk = 16;
    bk += (n >= 19); bk += (n >= 21); bk += (n >= 24); bk += (n >= 27); bk += (n >= 31); bk += (n >= 35); bk += (n >= 40); bk += (n >= 46);
    bk += (n >= 52); bk += (n >= 59); bk += (n >= 67); bk += (n >= 77); bk += (n >= 87); bk += (n >= 99); bk += (n >= 113);
    return bk;
}
__device__ __forceinline__ int crow16(int reg, int hi) { return (reg & 3) + 8 * (reg >> 2) + 4 * hi; }
__device__ __forceinline__ bf16x8 pack8r(const f32x16& p, const int s) { u32x4 w; w.x = cvtpk(p[8 * s], p[8 * s + 1]); w.y = cvtpk(p[8 * s + 2], p[8 * s + 3]); w.z = cvtpk(p[8 * s + 4], p[8 * s + 5]); w.w = cvtpk(p[8 * s + 6], p[8 * s + 7]); return __builtin_bit_cast(bf16x8, w); }
__device__ __forceinline__ void epilogue_attn(Frame& F, int l, int bh, int qi, f32x16 (&O1)[2], f32x16 (&O2)[2], float l1, float l2);
__device__ __forceinline__ void attn_item(Frame& F, int l, int bh, int qi, const bool prefetch_next) {
    const int b = bh >> 2, h = bh & 3, w = F.wave, lane = F.lane, tid = F.tid, r32 = lane & 31, hi = lane >> 5, qq = w & 3, kh = w >> 2;
#ifdef PROBE_A
    const unsigned long long tp0_ = __builtin_amdgcn_s_memrealtime();
#endif
    const bf16_t* PROJ = (const bf16_t*)(F.ws + WS_PROJ); bf16_t* Y = (bf16_t*)(F.ws + WS_PROJ) + PX;
    LAS float* TAB = (LAS float*)(F.lds + ATT_TAB_OFF);
    LAS bf16_t* QL = (LAS bf16_t*)(F.lds + ATT_TAB_OFF + 2048);
    const size_t row0 = (size_t)b * SEQ; const int q0 = qi * 128;
    unsigned nxq_ = 0u; if (prefetch_next && qi < 2 && tid == 0) nxq_ = xb_add(F.ctl + CW_Q + 64 * (2 * l), 1u);
    if (tid < 384) { const int rel = tid - 128; const float cf = F.in[19][31 * 4 + h]; TAB[tid] = rel < 0 ? -1e30f : (F.in[19][t5_bucket(rel) * 4 + h] - cf) * LOG2E; }
    const int npairs = qi + 1;
    const int lk = tid >> 3, lc = tid & 7;
    const bf16_t* kg = PROJ + (row0 + lk) * PLD + PDK + h * 64 + 8 * lc; const bf16_t* vg = PROJ + (row0 + lk) * PLD + PDV + h * 64 + 8 * lc;
    u32x4 ka0, ka1, va0, va1;
#define ATT_WRITE(k0_, k1_, v0_, v1_, buf) do { LAS bf16_t* KL_ = (LAS bf16_t*)(F.lds + (buf) * ATT_BUF); LAS bf16_t* VL_ = (LAS bf16_t*)(F.lds + (buf) * ATT_BUF + ATT_KB); \
        *(LAS u32x4*)(KL_ + lk * AK_STR + 8 * lc) = k0_; *(LAS u32x4*)(KL_ + (lk + 64) * AK_STR + 8 * lc) = k1_; \
        *(LAS u32x4*)(VL_ + lk * AV_STR + 8 * lc) = v0_; *(LAS u32x4*)(VL_ + (lk + 64) * AV_STR + 8 * lc) = v1_; } while (0)
#define ATT_LOAD(k0_, k1_, v0_, v1_, p) do { const size_t o_ = (size_t)(p) * 128 * PLD; k0_ = *(const u32x4*)(kg + o_); k1_ = *(const u32x4*)(kg + o_ + (size_t)64 * PLD); v0_ = *(const u32x4*)(vg + o_); v1_ = *(const u32x4*)(vg + o_ + (size_t)64 * PLD); } while (0)
    ATT_LOAD(ka0, ka1, va0, va1, 0);
    {
        const bf16_t* qg = PROJ + (row0 + q0 + lk) * PLD + PDQ + h * 64 + 8 * lc;
        const u32x4 q0r = *(const u32x4*)qg, q1r = *(const u32x4*)(qg + (size_t)64 * PLD);
        *(LAS u32x4*)(QL + lk * AK_STR + 8 * lc) = q0r; *(LAS u32x4*)(QL + (lk + 64) * AK_STR + 8 * lc) = q1r; }
    ATT_WRITE(ka0, ka1, va0, va1, 0);
    if (npairs > 1) ATT_LOAD(ka0, ka1, va0, va1, 1);
    const int qrow = q0 + 32 * qq + r32;
    f32x16 O1[2], O2[2];
#pragma unroll
    for (int i = 0; i < 16; ++i) { O1[0][i] = 0.f; O1[1][i] = 0.f; O2[0][i] = 0.f; O2[1][i] = 0.f; }
    f32x4 L1 = {0.f, 0.f, 0.f, 0.f}, L2 = {0.f, 0.f, 0.f, 0.f};
    __syncthreads();
    const f32x16 cinit = {0.f, 0.f, 0.f, 0.f, 0.f, 0.f, 0.f, 0.f, 0.f, 0.f, 0.f, 0.f, 0.f, 0.f, 0.f, 0.f};
    const int vlane = (4 * hi + ((lane & 15) >> 2)) * AV_STR + 16 * ((lane >> 4) & 1) + 4 * (lane & 3);
    const LAS bf16_t* qlp = QL + (32 * qq + r32) * AK_STR + 8 * hi;
#ifdef PROBE_SECTIONS
    unsigned long long dA_ = 0, dB_ = 0, dC_ = 0;
#define ATT_T(x_) const unsigned long long x_ = __builtin_amdgcn_s_memtime()
#define ATT_TW(x_) asm volatile("s_waitcnt lgkmcnt(0)" ::: "memory"); const unsigned long long x_ = __builtin_amdgcn_s_memtime()
#define ATT_TACC() do { dA_ += tb_ - ta_; dB_ += tc_ - tb_; dC_ += td_ - tc_; } while (0)
#else
#define ATT_T(x_) do {} while (0)
#define ATT_TW(x_) do {} while (0)
#define ATT_TACC() do {} while (0)
#endif
#define ATT_EXP(S1_, S2_, sub_, NEAR_) do { \
        _Pragma("unroll") for (int r = 0; r < 16; ++r) { S1_[r] = __builtin_amdgcn_exp2f(S1_[r]); S2_[r] = __builtin_amdgcn_exp2f(S2_[r]); } \
        _Pragma("unroll") for (int r = 0; r < 16; r += 4) { L1 += (f32x4){S1_[r], S1_[r + 1], S1_[r + 2], S1_[r + 3]}; L2 += (f32x4){S2_[r], S2_[r + 1], S2_[r + 2], S2_[r + 3]}; } } while (0)
#define ATT_VLOAD(Vf_, sub_) do { _Pragma("unroll") for (int s = 0; s < 2; ++s) _Pragma("unroll") for (int vt = 0; vt < 2; ++vt) { const LAS bf16_t* vp = VL + (32 * (sub_) + 16 * s) * AV_STR + 32 * vt + vlane; \
            const v4i16_t lo = __builtin_amdgcn_ds_read_tr16_b64_v4i16((LAS v4i16_t*)vp), hi4 = __builtin_amdgcn_ds_read_tr16_b64_v4i16((LAS v4i16_t*)(vp + 8 * AV_STR)); \
            Vf_[s][vt] = (bf16x8){lo[0], lo[1], lo[2], lo[3], hi4[0], hi4[1], hi4[2], hi4[3]}; } } while (0)
#define ATT_PV(S1_, S2_, Vf_) do { _Pragma("unroll") for (int s = 0; s < 2; ++s) { const bf16x8 PA1 = pack8r(S1_, s), PA2 = pack8r(S2_, s); \
            _Pragma("unroll") for (int vt = 0; vt < 2; ++vt) { O1[vt] = MFMA32(PA1, Vf_[s][vt], O1[vt]); O2[vt] = MFMA32(PA2, Vf_[s][vt], O2[vt]); } } } while (0)
#define ATT_ITER(k0_, k1_, v0_, v1_, p_, NEAR_) do { const int p = (p_); ATT_T(ta_); \
        if (p + 1 < npairs) { ATT_WRITE(k0_, k1_, v0_, v1_, (p + 1) & 1); } \
        if (!(NEAR_) && prefetch_next && p + 2 == qi && tid == 0) nxq_ = xb_add(F.ctl + CW_Q + 64 * (2 * l), 1u);     \
        if (p + 2 < npairs) { ATT_LOAD(k0_, k1_, v0_, v1_, p + 2); } \
        ATT_TW(tb_); \
        const int k0 = 128 * p + 64 * kh; \
        if (!(NEAR_) || k0 <= q0 + 32 * qq + 31) { \
            const LAS bf16_t* KL = (const LAS bf16_t*)(F.lds + (p & 1) * ATT_BUF) + 64 * kh * AK_STR; const LAS bf16_t* VL = (const LAS bf16_t*)(F.lds + (p & 1) * ATT_BUF + ATT_KB) + 64 * kh * AV_STR; \
            f32x16 SA1, SA2, SB1, SB2, CA = cinit, CB = cinit; \
            if (NEAR_) { const LAS float* tb_ = TAB + (qrow - 4 * hi - k0 + 101);     \
                _Pragma("unroll") for (int r = 0; r < 16; ++r) { CA[r] = tb_[27 - ((r & 3) + 8 * (r >> 2))]; CB[r] = tb_[27 - 32 - ((r & 3) + 8 * (r >> 2))]; } } \
            {   const bf16x8 Q00 = ld_l8(qlp), Q01 = ld_l8(qlp + 16), Q10 = ld_l8(qlp + 32), Q11 = ld_l8(qlp + 48); \
                const LAS bf16_t* kp = KL + r32 * AK_STR + 8 * hi; \
                const bf16x8 a10 = ld_l8(kp), a11 = ld_l8(kp + 16), a20 = ld_l8(kp + 32), a21 = ld_l8(kp + 48); \
                const bf16x8 b10 = ld_l8(kp + 32 * AK_STR), b11 = ld_l8(kp + 32 * AK_STR + 16), b20 = ld_l8(kp + 32 * AK_STR + 32), b21 = ld_l8(kp + 32 * AK_STR + 48); \
                SA1 = MFMA32(a10, Q00, CA); SA2 = MFMA32(a20, Q10, CA); SA1 = MFMA32(a11, Q01, SA1); SA2 = MFMA32(a21, Q11, SA2); \
                SB1 = MFMA32(b10, Q00, CB); SB2 = MFMA32(b20, Q10, CB); SB1 = MFMA32(b11, Q01, SB1); SB2 = MFMA32(b21, Q11, SB2); } \
            bf16x8 Vf[2][2], Vg[2][2]; \
            ATT_VLOAD(Vf, 0); ATT_VLOAD(Vg, 1); \
            ATT_EXP(SA1, SA2, 0, NEAR_); \
            ATT_PV(SA1, SA2, Vf); \
            ATT_EXP(SB1, SB2, 1, NEAR_); \
            ATT_PV(SB1, SB2, Vg); \
            {   \
                __builtin_amdgcn_sched_group_barrier(0x8, 4, 0); \
                _Pragma("unroll") for (int g_ = 0; g_ < 4; ++g_) { __builtin_amdgcn_sched_group_barrier(0x8, 1, 0); __builtin_amdgcn_sched_group_barrier(0x400, 8, 0); } \
                __builtin_amdgcn_sched_group_barrier(0x2, 24, 0); \
                _Pragma("unroll") for (int g_ = 0; g_ < 8; ++g_) { __builtin_amdgcn_sched_group_barrier(0x8, 1, 0); __builtin_amdgcn_sched_group_barrier(0x400, 4, 0); __builtin_amdgcn_sched_group_barrier(0x2, 2, 0); } } \
        } \
        ATT_T(tc_); \
        LDS_BARRIER(); ATT_T(td_); ATT_TACC(); } while (0)
#ifdef PROBE_A
    if (lane == 0) atomicMax(F.ctl + 32768 + 64 * (11 + 16 * l), (unsigned)(__builtin_amdgcn_s_memrealtime() - tp0_));
#endif
    int pp = 0;
    for (; pp + 1 < qi; ++pp) ATT_ITER(ka0, ka1, va0, va1, pp, 0);
    for (; pp < npairs; ++pp) ATT_ITER(ka0, ka1, va0, va1, pp, 1);
    if (prefetch_next && tid == 0) F.MISC[17] = nxq_;
#undef ATT_EXP
#undef ATT_VLOAD
#undef ATT_PV
#undef ATT_ITER
#ifdef PROBE_SECTIONS
    if (qi == 31 && lane == 0) { atomicMax(F.ctl + 32768 + 64 * (8 + 16 * l), (unsigned)(dA_ / 32) * 10u); atomicMax(F.ctl + 32768 + 64 * (9 + 16 * l), (unsigned)(dB_ / 32) * 10u); atomicMax(F.ctl + 32768 + 64 * (10 + 16 * l), (unsigned)(dC_ / 32) * 10u); }
#endif
#undef ATT_WRITE
#undef ATT_LOAD
    float l1 = (L1.x + L1.y) + (L1.z + L1.w), l2 = (L2.x + L2.y) + (L2.z + L2.w);
    epilogue_attn(F, l, bh, qi, O1, O2, l1, l2);
}
__device__ __forceinline__ void epilogue_attn(Frame& F, int l, int bh, int qi, f32x16 (&O1)[2], f32x16 (&O2)[2], float l1, float l2) {
    int t3 = threadIdx.x; asm volatile("" : "+v"(t3));
    const int lane = t3 & 63, w = __builtin_amdgcn_readfirstlane(t3 >> 6), r32 = lane & 31, hi = lane >> 5, qq = w & 3, kh = w >> 2, b = bh >> 2, h = bh & 3;
    bf16_t* Y = (bf16_t*)(F.ws + WS_PROJ) + PX;
    const size_t row0 = (size_t)b * SEQ; const int q0 = qi * 128;
    LAS float* XCH = (LAS float*)F.lds + (size_t)qq * 66 * 64 + lane;
    if (kh == 1) {
#pragma unroll
        for (int vt = 0; vt < 2; ++vt)
#pragma unroll
            for (int r = 0; r < 16; ++r) { XCH[(vt * 16 + r) * 64] = O1[vt][r]; XCH[(32 + vt * 16 + r) * 64] = O2[vt][r]; }
        XCH[64 * 64] = l1; XCH[65 * 64] = l2;
    }
    __syncthreads();
    if (kh == 0) {
        const float* lm = F.in[17] + (size_t)l * 128;
        float d1 = (lane < 32) ? lm[lane] * lm[32 + lane] : 0.f, d2 = (lane < 32) ? lm[64 + lane] * lm[96 + lane] : 0.f;
        d1 = wave_sum(d1); d2 = wave_sum(d2);
        int lq = l; asm volatile("" : "+s"(lq));
        const float lam_init = (lq == 0) ? 0.2f : 0.35550906759f;
        const float lam = __int_as_float(__builtin_amdgcn_readfirstlane(__float_as_int(fast_exp(d1) - fast_exp(d2) + lam_init)));
#pragma unroll
        for (int vt = 0; vt < 2; ++vt)
#pragma unroll
            for (int r = 0; r < 16; ++r) { O1[vt][r] += XCH[(vt * 16 + r) * 64]; O2[vt][r] += XCH[(32 + vt * 16 + r) * 64]; }
        l1 += XCH[64 * 64]; l2 += XCH[65 * 64];
        l1 += __shfl_xor(l1, 32); l2 += __shfl_xor(l2, 32);
        const float i1 = fast_rcp(l1), i2 = lam * fast_rcp(l2);
        const float* sw = F.in[18] + (size_t)l * 64; const float osc = 1.0f - lam_init;
        const float sw0 = sw[r32], sw1 = sw[32 + r32];
#pragma unroll
        for (int r = 0; r < 16; ++r) {
            const int qr = crow16(r, hi);
            const float a1 = __shfl(i1, qr), a2 = __shfl(i2, qr);
            const float o0 = O1[0][r] * a1 - O2[0][r] * a2, o1 = O1[1][r] * a1 - O2[1][r] * a2;
            float s = o0 * o0 + o1 * o1;
            s += __shfl_xor(s, 1); s += __shfl_xor(s, 2); s += __shfl_xor(s, 4); s += __shfl_xor(s, 8); s += __shfl_xor(s, 16);
            const float rs = rsqrtf(s * (1.0f / 64.0f) + NORM_EPS) * osc;
            const size_t row = row0 + q0 + 32 * qq + qr;
            Y[row * PLD + 768 + h * 64 + r32] = f2bf(o0 * rs * sw0); Y[row * PLD + 768 + h * 64 + 32 + r32] = f2bf(o1 * rs * sw1);
        }
    }
}

constexpr int SSD_STR = 136;
constexpr int SX_P = 72, SB_P = 136, SS_BUF = 128 * SX_P * 2 + 128 * SB_P * 2;
__device__ __forceinline__ void ssd_state_item(Frame& F, int l, int bhh) {
    const int b = bhh >> 3, hh = bhh & 7, g = hh >> 2, w = F.wave, lane = F.lane, fr = lane & 15, fq = lane >> 4, tid = F.tid;
    LAS float* XS = (LAS float*)(F.lds + 2 * SS_BUF); LAS float* CD = XS + 4096;
    const bf16_t* XACT = (const bf16_t*)F.in[25]; const float* GATES = (const float*)(F.ws + WS_GATES); bf16_t* SST = (bf16_t*)(F.ws + WS_SST);
    const float Ah = -expf(F.in[12][l * 8 + hh]);
    {   float d0v[4], d1v[4];
#pragma unroll
        for (int i = 0; i < 4; ++i) { const size_t r0 = (size_t)b * SEQ + 128 * (w + 8 * i); d0v[i] = GATES[(r0 + lane) * 16 + 8 + hh]; d1v[i] = GATES[(r0 + 64 + lane) * 16 + 8 + hh]; }
#pragma unroll
        for (int i = 0; i < 4; ++i) { const int c = w + 8 * i; const float dt0 = d0v[i], dt1 = d1v[i];
            const float s0 = wave_scan_incl(dt0 * Ah, lane); const float t0 = __shfl(s0, 63);
            const float s1 = wave_scan_incl(dt1 * Ah, lane) + t0; const float last = __shfl(s1, 63);
            XS[128 * c + lane] = dt0 * fast_exp(last - s0); XS[128 * c + 64 + lane] = dt1 * fast_exp(last - s1);
            if (lane == 0) CD[c] = fast_exp(last); }
    }
    const int pt = w & 3, nh = w >> 2;
    f32x4 acc[4];
#pragma unroll
    for (int j = 0; j < 4; ++j) acc[j] = (f32x4){0.f, 0.f, 0.f, 0.f};
    const bf16_t* xg = XACT + ((size_t)b * SEQ + (tid >> 3)) * 1024 + hh * 64 + 8 * (tid & 7);
    const bf16_t* bg = XACT + ((size_t)b * SEQ + (tid >> 4)) * 1024 + 512 + g * 128 + 8 * (tid & 15);
    u32x4 xa[2], ba[4], xb[2], bb[4], xc[2], bc[4];
#define SS_LOAD(xr, br, c_) do { const size_t o_ = (size_t)(c_) * 128 * 1024; xr[0] = *(const u32x4*)(xg + o_); xr[1] = *(const u32x4*)(xg + o_ + 64 * 1024); \
        _Pragma("unroll") for (int i_ = 0; i_ < 4; ++i_) br[i_] = *(const u32x4*)(bg + o_ + (size_t)i_ * 32 * 1024); } while (0)
#define SS_WRITE(xr, br, c_) do { LAS bf16_t* XL_ = (LAS bf16_t*)(F.lds + ((c_) & 1) * SS_BUF); LAS bf16_t* BL_ = XL_ + 128 * SX_P; \
        _Pragma("unroll") for (int i_ = 0; i_ < 2; ++i_) { const int s_ = (tid >> 3) + 64 * i_; const float sc_ = XS[128 * (c_) + s_]; u32x4 o_; \
            _Pragma("unroll") for (int e_ = 0; e_ < 4; ++e_) o_[e_] = cvtpk(sc_ * bflo(xr[i_][e_]), sc_ * bfhi(xr[i_][e_])); \
            *(LAS u32x4*)(XL_ + s_ * SX_P + 8 * (tid & 7)) = o_; } \
        _Pragma("unroll") for (int i_ = 0; i_ < 4; ++i_) *(LAS u32x4*)(BL_ + ((tid >> 4) + 32 * i_) * SB_P + 8 * (tid & 15)) = br[i_]; } while (0)
    LAS bf16_t* SSTG = (LAS bf16_t*)(F.lds + 2 * SS_BUF + 16384 + 128);
#define SS_STAGE(c_) do { LAS bf16_t* sg_ = SSTG + ((c_) & 1) * 8192; \
        _Pragma("unroll") for (int j = 0; j < 4; ++j) _Pragma("unroll") for (int r = 0; r < 4; ++r) sg_[(16 * pt + 4 * fq + r) * 128 + 16 * (4 * nh + j) + fr] = f2bf(acc[j][r]); } while (0)
    SS_LOAD(xa, ba, 0); SS_LOAD(xb, bb, 1); SS_LOAD(xc, bc, 2);
    __syncthreads();
    SS_WRITE(xa, ba, 0);
    SS_LOAD(xa, ba, 3);
    LDS_BARRIER();
#define SS_STEP(XW, BW, c_) do { const int cc_ = (c_); const size_t si = ((size_t)(b * 32 + cc_) * 8 + hh) * 8192; \
        _Pragma("unroll") for (int j = 0; j < 4; ++j) _Pragma("unroll") for (int r = 0; r < 4; ++r) SST[si + (16 * pt + 4 * fq + r) * 128 + 16 * (4 * nh + j) + fr] = f2bf(acc[j][r]); \
        asm volatile("" ::: "memory"); \
        if (cc_ + 1 < 32) { SS_WRITE(XW, BW, cc_ + 1); } \
        asm volatile("" ::: "memory"); \
        SS_LOAD(XW, BW, (cc_ + 4 < 32 ? cc_ + 4 : 31)); \
        asm volatile("" ::: "memory"); \
        const float cd = CD[cc_]; \
        _Pragma("unroll") for (int j = 0; j < 4; ++j) acc[j] = acc[j] * cd; \
        const LAS bf16_t* XL = (const LAS bf16_t*)(F.lds + (cc_ & 1) * SS_BUF); const LAS bf16_t* BL = XL + 128 * SX_P; \
        bf16x8 Af[4], Bf[4][4]; \
        _Pragma("unroll") for (int ks = 0; ks < 4; ++ks) { Af[ks] = ld_tr8(XL, SX_P, 32 * ks, 16 * pt, lane); \
            _Pragma("unroll") for (int j = 0; j < 4; ++j) Bf[ks][j] = ld_tr8(BL, SB_P, 32 * ks, 16 * (4 * nh + j), lane); } \
        asm volatile("s_waitcnt lgkmcnt(0)" ::: "memory"); __builtin_amdgcn_sched_barrier(0); \
        _Pragma("unroll") for (int ks = 0; ks < 4; ++ks) _Pragma("unroll") for (int j = 0; j < 4; ++j) acc[j] = MFMA16(Af[ks], Bf[ks][j], acc[j]); \
        LDS_BARRIER(); } while (0)
    for (int c = 0; c < 30; c += 3) { SS_STEP(xb, bb, c); SS_STEP(xc, bc, c + 1); SS_STEP(xa, ba, c + 2); }
    SS_STEP(xb, bb, 30); SS_STEP(xc, bc, 31);
#undef SS_STEP
#undef SS_STAGE
#undef SS_LOAD
#undef SS_WRITE
}

constexpr int SO_BP = 136, SO_XP = 72, SO_SP = 136, SO_YP = 264;
constexpr int SO_B_BYTES = 128 * SO_BP * 2, SO_H_BYTES = 128 * SO_XP * 2 + 64 * SO_SP * 2, SO_ACS_OFF = SO_B_BYTES + 2 * SO_H_BYTES;
__device__ __forceinline__ void ssd_out_item(Frame& F, int l, int it) {
    const int g = it & 1, c = (it >> 1) & 31, b = it >> 6, w = F.wave, lane = F.lane, fr = lane & 15, fq = lane >> 4, tid = F.tid;
    LAS bf16_t* BL = (LAS bf16_t*)F.lds;
    LAS float* ACS = (LAS float*)(F.lds + SO_ACS_OFF); LAS float* DTS = ACS + 512; LAS float* ETAB = DTS + 512; LAS float* REFS = ETAB + 512;
    const bf16_t* XACT = (const bf16_t*)F.in[25]; const float* GATES = (const float*)(F.ws + WS_GATES); const bf16_t* SST = (const bf16_t*)(F.ws + WS_SST);
    const bf16_t* PROJ = (const bf16_t*)(F.ws + WS_PROJ); bf16_t* Y = (bf16_t*)(F.ws + WS_PROJ) + PX;
    const size_t r0 = (size_t)b * SEQ + 128 * c;
    const float gdt0 = GATES[(r0 + lane) * 16 + 8 + g * 4 + (w & 3)], gdt1 = GATES[(r0 + 64 + lane) * 16 + 8 + g * 4 + (w & 3)];
    const bf16_t* bgp = XACT + (r0 + (tid >> 4)) * 1024 + 512 + g * 128 + 8 * (tid & 15);
    const bf16_t* xgp = XACT + (r0 + (tid >> 3)) * 1024 + g * 256 + 8 * (tid & 7);
    const bf16_t* sgp = SST + ((size_t)(b * 32 + c) * 8 + g * 4) * 8192 + (tid >> 4) * 128 + 8 * (tid & 15);
    u32x4 xr[2], sr[2];
#define SO_LOADH(hd_) do { xr[0] = *(const u32x4*)(xgp + (hd_) * 64); xr[1] = *(const u32x4*)(xgp + (hd_) * 64 + 64 * 1024); \
        sr[0] = *(const u32x4*)(sgp + (size_t)(hd_) * 8192); sr[1] = *(const u32x4*)(sgp + (size_t)(hd_) * 8192 + 32 * 128); } while (0)
#define SO_WRITEH(hd_) do { LAS bf16_t* XL_ = (LAS bf16_t*)(F.lds + SO_B_BYTES + ((hd_) & 1) * SO_H_BYTES); LAS bf16_t* SL_ = XL_ + 128 * SO_XP; \
        *(LAS u32x4*)(XL_ + (tid >> 3) * SO_XP + 8 * (tid & 7)) = xr[0]; *(LAS u32x4*)(XL_ + ((tid >> 3) + 64) * SO_XP + 8 * (tid & 7)) = xr[1]; \
        *(LAS u32x4*)(SL_ + (tid >> 4) * SO_SP + 8 * (tid & 15)) = sr[0]; *(LAS u32x4*)(SL_ + ((tid >> 4) + 32) * SO_SP + 8 * (tid & 15)) = sr[1]; } while (0)
    {   u32x4 br[4];
#pragma unroll
        for (int i = 0; i < 4; ++i) br[i] = *(const u32x4*)(bgp + (size_t)i * 32 * 1024);
        SO_LOADH(0);
#pragma unroll
        for (int i = 0; i < 4; ++i) *(LAS u32x4*)(BL + ((tid >> 4) + 32 * i) * SO_BP + 8 * (tid & 15)) = br[i];
        SO_WRITEH(0);
    }
    if (w < 4) {
        const int hh = g * 4 + w; const float Ah = -expf(F.in[12][l * 8 + hh]);
        const float dt0 = gdt0, dt1 = gdt1;
        const float s0 = wave_scan_incl(dt0 * Ah, lane); const float t0 = __shfl(s0, 63);
        const float s1 = wave_scan_incl(dt1 * Ah, lane) + t0;
        ACS[128 * w + lane] = s0; ACS[128 * w + 64 + lane] = s1; DTS[128 * w + lane] = dt0; DTS[128 * w + 64 + lane] = dt1;
        const float e0 = __shfl(s0, 31), e2 = __shfl(s1, 31), e3 = __shfl(s1, 63);
        ETAB[128 * w + lane] = fast_exp((lane < 32 ? e0 : t0) - s0) * dt0; ETAB[128 * w + 64 + lane] = fast_exp((lane < 32 ? e2 : e3) - s1) * dt1;
        if (lane == 0) { REFS[4 * w + 0] = e0; REFS[4 * w + 1] = t0; REFS[4 * w + 2] = e2; REFS[4 * w + 3] = e3; }
    }
    SO_LOADH(1);
    const int lrow = 16 * w + fr, nkk = (w >> 1) + 1;
    bf16x8 Cf[4];
#pragma unroll
    for (int ks = 0; ks < 4; ++ks) Cf[ks] = ld_g8(XACT + (r0 + lrow) * 1024 + 768 + g * 128 + 32 * ks + 8 * fq);
    asm volatile("" : "+v"(Cf[0]), "+v"(Cf[1]), "+v"(Cf[2]), "+v"(Cf[3]));
    LDS_BARRIER();
    f32x4 G[4][2];
#pragma unroll
    for (int kk = 0; kk < 4; ++kk) { G[kk][0] = (f32x4){0.f, 0.f, 0.f, 0.f}; G[kk][1] = (f32x4){0.f, 0.f, 0.f, 0.f};
        if (kk < nkk) {
            bf16x8 b0[4], b1[4];
#pragma unroll
            for (int ks = 0; ks < 4; ++ks) { b0[ks] = ld_l8(BL + (32 * kk + fr) * SO_BP + 32 * ks + 8 * fq); b1[ks] = ld_l8(BL + (32 * kk + 16 + fr) * SO_BP + 32 * ks + 8 * fq); }
#pragma unroll
            for (int ks = 0; ks < 4; ++ks) { G[kk][0] = MFMA16(b0[ks], Cf[ks], G[kk][0]); G[kk][1] = MFMA16(b1[ks], Cf[ks], G[kk][1]); } } }
    const float* Dk = F.in[13] + l * 8 + g * 4;
    f32x4 yacc[4][4];
#pragma unroll
    for (int hd = 0; hd < 4; ++hd) {
        const LAS bf16_t* XL = (const LAS bf16_t*)(F.lds + SO_B_BYTES + (hd & 1) * SO_H_BYTES); const LAS bf16_t* SL = XL + 128 * SO_XP;
        bf16x8 Sf[4][4];
#pragma unroll
        for (int pt = 0; pt < 4; ++pt)
#pragma unroll
            for (int ks = 0; ks < 4; ++ks) Sf[pt][ks] = ld_l8(SL + (16 * pt + fr) * SO_SP + 32 * ks + 8 * fq);
        float ea[4], xv[4][4];
#pragma unroll
        for (int r = 0; r < 4; ++r) ea[r] = fast_exp(ACS[128 * hd + 16 * w + 4 * fq + r]);
#pragma unroll
        for (int pt = 0; pt < 4; ++pt)
#pragma unroll
            for (int r = 0; r < 4; ++r) xv[pt][r] = bf2f(XL[(16 * w + 4 * fq + r) * SO_XP + 16 * pt + fr]);
        const float dsk = Dk[hd];
#pragma unroll
        for (int pt = 0; pt < 4; ++pt) { f32x4 a = (f32x4){0.f, 0.f, 0.f, 0.f};
#pragma unroll
            for (int ks = 0; ks < 4; ++ks) a = MFMA16(Cf[ks], Sf[pt][ks], a);
#pragma unroll
            for (int r = 0; r < 4; ++r) a[r] = a[r] * ea[r] + dsk * xv[pt][r];
            yacc[hd][pt] = a; }
        const float al = ACS[128 * hd + lrow];
#pragma unroll
        for (int kk = 0; kk < 4; ++kk) if (kk < nkk) {
            f32x4 P0, P1;
            if (kk + 1 < nkk) {
                const float fk = fast_exp(al - REFS[4 * hd + kk]);
#pragma unroll
                for (int r = 0; r < 4; ++r) { const int s0 = 32 * kk + 4 * fq + r; P0[r] = G[kk][0][r] * fk * ETAB[128 * hd + s0]; P1[r] = G[kk][1][r] * fk * ETAB[128 * hd + s0 + 16]; }
            } else {
#pragma unroll
                for (int r = 0; r < 4; ++r) { const int s0 = 32 * kk + 4 * fq + r, s1 = s0 + 16;
                    P0[r] = (s0 <= lrow) ? G[kk][0][r] * fast_exp(al - ACS[128 * hd + s0]) * DTS[128 * hd + s0] : 0.f;
                    P1[r] = (s1 <= lrow) ? G[kk][1][r] * fast_exp(al - ACS[128 * hd + s1]) * DTS[128 * hd + s1] : 0.f; }
            }
            const bf16x8 PA = pack8(P0, P1);
            bf16x8 Bx[4];
#pragma unroll
            for (int pt = 0; pt < 4; ++pt) Bx[pt] = ld_tr8p(XL, SO_XP, 32 * kk, 16 * pt, lane);
#pragma unroll
            for (int pt = 0; pt < 4; ++pt) yacc[hd][pt] = MFMA16(PA, Bx[pt], yacc[hd][pt]);
        }
        if (hd + 1 < 4) { SO_WRITEH(hd + 1); if (hd + 2 < 4) SO_LOADH(hd + 2); }
        LDS_BARRIER();
    }
#undef SO_LOADH
#undef SO_WRITEH
    const float* nw = F.in[14] + (size_t)l * 512 + g * 256; const int ch8 = 8 * (tid & 31);
    const f32x4 nw0 = *(const f32x4*)(nw + ch8), nw1 = *(const f32x4*)(nw + ch8 + 4);
    u32x4 zv8[8];
#pragma unroll
    for (int i = 0; i < 8; ++i) zv8[i] = *(const u32x4*)(PROJ + (r0 + (tid >> 5) + 16 * i) * PLD + PZ + g * 256 + ch8);
    LAS bf16_t* YL = (LAS bf16_t*)F.lds;
#pragma unroll
    for (int hd = 0; hd < 4; ++hd)
#pragma unroll
        for (int pt = 0; pt < 4; ++pt)
#pragma unroll
            for (int r = 0; r < 4; ++r) YL[(16 * w + 4 * fq + r) * SO_YP + hd * 64 + 16 * pt + fr] = f2bf(yacc[hd][pt][r]);
    LDS_BARRIER();
#pragma unroll
    for (int i = 0; i < 8; ++i) {
        const int lr = (tid >> 5) + 16 * i; const size_t row = r0 + lr;
        const u32x4 yv = *(const LAS u32x4*)(YL + lr * SO_YP + ch8); const u32x4 zv = zv8[i];
        float v[8]; float ss = 0.f;
#pragma unroll
        for (int e = 0; e < 4; ++e) { v[2 * e] = bflo(yv[e]) * bflo(zv[e]); v[2 * e + 1] = bfhi(yv[e]) * bfhi(zv[e]); ss += v[2 * e] * v[2 * e] + v[2 * e + 1] * v[2 * e + 1]; }
        ss += __shfl_xor(ss, 1); ss += __shfl_xor(ss, 2); ss += __shfl_xor(ss, 4); ss += __shfl_xor(ss, 8); ss += __shfl_xor(ss, 16);
        const float rs = rsqrtf(ss * (1.0f / 256.0f) + NORM_EPS);
        u32x4 o; o.x = cvtpk(v[0] * rs * nw0.x, v[1] * rs * nw0.y); o.y = cvtpk(v[2] * rs * nw0.z, v[3] * rs * nw0.w); o.z = cvtpk(v[4] * rs * nw1.x, v[5] * rs * nw1.y); o.w = cvtpk(v[6] * rs * nw1.z, v[7] * rs * nw1.w);
        *(u32x4*)(Y + row * PLD + 256 + g * 256 + ch8) = o;
    }
}
#ifndef PH_EN
#define PH_EN 1023
#endif
#ifndef MK_N_LAUNCHES
#define MK_N_LAUNCHES 1
#endif
constexpr int N_PHASES = 1 + 9 * DEPTH;
constexpr int NA1 = 512;
constexpr int CW_STAT = 32768;
#ifdef PROBE_A
#define ITEM_T0() const unsigned long long it0_ = __builtin_amdgcn_s_memrealtime()
#define ITEM_T1(k_) do { __syncthreads(); if (threadIdx.x == 0) atomicMax(F.ctl + CW_STAT + 64 * ((k_) + 16 * l), (unsigned)(__builtin_amdgcn_s_memrealtime() - it0_)); } while (0)
#define ITEM_TSUM(k_) do { if (threadIdx.x == 0) atomicAdd(F.ctl + CW_STAT + 64 * ((k_) + 16 * l), (unsigned)(__builtin_amdgcn_s_memrealtime() - it0_)); } while (0)
#else
#define ITEM_T0() do {} while (0)
#define ITEM_T1(k_) do {} while (0)
#define ITEM_TSUM(k_) do {} while (0)
#endif

__global__ void __launch_bounds__(NTHREADS, 2) hyb_fwd(Args args) {
    extern __shared__ __attribute__((aligned(16))) unsigned char lds_raw[];
    {   const int t0 = threadIdx.x;
        for (int u = t0; u < (LDS_BYTES - LDSCTL_OFF) / 4; u += NTHREADS) ((LAS unsigned*)((LAS unsigned char*)lds_raw + LDSCTL_OFF))[u] = 0u; }
    __syncthreads();
    const int ph_lo = args.ph_lo, ph_hi = args.ph_hi;
    const bool one_launch = (ph_hi - ph_lo) > 1;
    if (one_launch) { XcdBarrier b0 = xcd_barrier_post((unsigned*)(args.ws + WS_CTL) + CW_BAR, (volatile LAS unsigned*)((LAS unsigned char*)lds_raw + MISC_OFF) + 8); (void)b0; }
#ifdef PROBE_A
    unsigned long long t_prev = __builtin_amdgcn_s_memrealtime();
#endif
    for (int ph = ph_lo; ph < ph_hi; ++ph) {
        int tid_ = threadIdx.x; asm volatile("" : "+v"(tid_));
        kinptr_t kin = (kinptr_t)__builtin_amdgcn_kernarg_segment_ptr(); asm volatile("" : "+s"(kin));
        Frame F;
        F.lds = (LAS unsigned char*)lds_raw; F.MISC = (volatile LAS unsigned*)(F.lds + MISC_OFF);
        F.tid = tid_; F.lane = tid_ & 63; F.wave = __builtin_amdgcn_readfirstlane(tid_ >> 6);
        F.G = gridDim.x; { const int bx = blockIdx.x; F.vcu = (F.G % 8 == 0) ? (bx % 8) * (F.G / 8) + bx / 8 : bx; }
        F.in = kin;
        float* const outp = (float*)kin[25]; unsigned char* ws = (unsigned char*)kin[26];
        F.ws = ws; F.ctl = (unsigned*)(ws + WS_CTL);
        bf16_t* XB = (bf16_t*)(ws + WS_XB); bf16_t* PROJ = (bf16_t*)(ws + WS_PROJ); float* SSQ = (float*)(ws + WS_SSQ); float* GATES = (float*)(ws + WS_GATES);
        if (ph == 0) { if (PH_EN & 1) p0_prologue(F); }
        else {
            const int l = (ph - 1) / 9, k = (ph - 1) % 9;
            const unsigned char* WL = ws + WS_W + (size_t)l * W_LAYER;
            if ((PH_EN & 2) && (k == 0 || k == 7)) {
                pg8::Gemm g{XB, (const bf16_t*)(WL + (k == 0 ? W_GU1 : W_GU2)), M_TOK, NGU, DM, DM}; pg8::StaticOrder S; S.init(M_TOK, NGU, F.G, (int)blockIdx.x);
                EpiSwiglu E{{}, PROJ, SSQ};
                pg8::gemm_phase<EpiSwiglu, true, true>(F.lds, g, S, E, F.tid);
                { int t2 = threadIdx.x; asm volatile("" : "+v"(t2)); F.tid = t2; F.lane = t2 & 63; F.wave = __builtin_amdgcn_readfirstlane(t2 >> 6); side_convert(F, l, k); }
            } else if ((PH_EN & 4) && (k == 1 || k == 8 || k == 6)) {
                pg8::Gemm g; float alpha = 0.5f;
                if (k == 6) { g = pg8::Gemm{PROJ + PX, (const bf16_t*)(WL + W_OUT), M_TOK, DM, DM, PLD}; alpha = 1.0f; }
                else { g = pg8::Gemm{PROJ, (const bf16_t*)(WL + (k == 1 ? W_D1 : W_D2)), M_TOK, DM, FF, FF}; }
                pg8::StaticOrder S; S.init(M_TOK, DM, F.G, (int)blockIdx.x);
                if (ph == N_PHASES - 1) { EpiResid<true> E{outp, XB, SSQ, alpha, 1.0f / alpha}; pg8::gemm_phase<EpiResid<true>, false, true>(F.lds, g, S, E, F.tid); }
                else { EpiResid<false> E{outp, XB, SSQ, alpha, 1.0f / alpha}; pg8::gemm_phase<EpiResid<false>, false, true>(F.lds, g, S, E, F.tid); }
            } else if ((PH_EN & 8) && k == 2) {
                pg8::Gemm g{XB, (const bf16_t*)(WL + W_IN), M_TOK, NIN, DM, DM}; pg8::StaticOrder S; S.init(M_TOK, NIN, F.G, (int)blockIdx.x);
                EpiInProj E{{}, PROJ, GATES, SSQ, kin[15] + l * 64, kin[16] + l * 64, kin[7] + l * 8, kin[11] + l * 8};
                pg8::gemm_phase<EpiInProj, true, true>(F.lds, g, S, E, F.tid);
                { int t2 = threadIdx.x; asm volatile("" : "+v"(t2)); F.tid = t2; F.lane = t2 & 63; F.wave = __builtin_amdgcn_readfirstlane(t2 >> 6); side_convert(F, l, k); }
            } else if ((PH_EN & 16) && k == 3) {
                conv_phase(F, l);
            } else if (k == 4) {
                const int qoff_ = (F.G == 256) ? 256 : 0;
                for (int it = (F.G == 256) ? (int)blockIdx.x : q_next(F, 2 * l);;) {
                    if (it >= 48 + NA1) break;
                    { int t2 = threadIdx.x; asm volatile("" : "+v"(t2)); F.tid = t2; F.lane = t2 & 63; F.wave = __builtin_amdgcn_readfirstlane(t2 >> 6); }
                    ITEM_T0();
                    if (it < 16) { if (PH_EN & 32) mlstm_state_item(F, it); ITEM_T1(0); it = q_next(F, 2 * l) + qoff_; }
                    else if (it < 48) { if (PH_EN & 64) ssd_state_item(F, l, it - 16); ITEM_T1(1); it = q_next(F, 2 * l) + qoff_; }
                    else { const int r = it - 48; attn_item(F, l, r & 15, 31 - (r >> 4), true); ITEM_T1(2); ITEM_TSUM(12);
                        __syncthreads(); it = (int)F.MISC[17] + qoff_; } }
#ifdef PROBE_A
                if (threadIdx.x == 0) atomicAdd(F.ctl + CW_STAT + 64 * (13 + 16 * l), (unsigned)(__builtin_amdgcn_s_memrealtime() - t_prev));
#endif
            } else if (k == 5 && NA1 == 512 && F.G == 256) {
                { int t2 = threadIdx.x; asm volatile("" : "+v"(t2)); F.tid = t2; F.lane = t2 & 63; F.wave = __builtin_amdgcn_readfirstlane(t2 >> 6); }
                ssd_out_item(F, l, F.vcu);
                __syncthreads();
                { int t2 = threadIdx.x; asm volatile("" : "+v"(t2)); F.tid = t2; F.lane = t2 & 63; F.wave = __builtin_amdgcn_readfirstlane(t2 >> 6); }
                mlstm_out_item(F, l, F.vcu);
            } else if (k == 5) {
                for (;;) { const int it = q_next(F, 2 * l + 1); if (it >= 512 + (512 - NA1)) break;
                    { int t2 = threadIdx.x; asm volatile("" : "+v"(t2)); F.tid = t2; F.lane = t2 & 63; F.wave = __builtin_amdgcn_readfirstlane(t2 >> 6); }
                    ITEM_T0();
                    if (it < 256) { if (PH_EN & 256) ssd_out_item(F, l, it); ITEM_T1(3); }
                    else if (it < 512) { if (PH_EN & 512) mlstm_out_item(F, l, it - 256); ITEM_T1(4); }
                    else { const int r = NA1 + it - 512; if (PH_EN & 128) attn_item(F, l, r & 15, 31 - (r >> 4), false); } }
            }
        }
#ifdef PROBE_A
        if (ph + 1 < ph_hi) { XcdBarrier bar; bar.bar = F.ctl + CW_BAR; bar.x = xb_xcc_id(); bar.st = F.MISC + 8; xcd_barrier(bar); }
        { const unsigned long long t_now = __builtin_amdgcn_s_memrealtime(); if (threadIdx.x == 0) F.MISC[24 + ph] += (unsigned)(t_now - t_prev); t_prev = t_now; }
        if (ph + 1 == ph_hi && blockIdx.x == 0) { __syncthreads();
            unsigned va = (PROBE_A < 32) ? F.MISC[24 + PROBE_A] : xb_ld(F.ctl + CW_STAT + 64 * (PROBE_A - 32)), vb = (PROBE_B < 32) ? F.MISC[24 + PROBE_B] : xb_ld(F.ctl + CW_STAT + 64 * (PROBE_B - 32));
            if (PROBE_A == 44 || PROBE_A == 45) va = va / 256u * 5u; if (PROBE_B == 44 || PROBE_B == 45) vb = vb / 256u * 5u;
            unsigned qa = (va + 500u) / 1000u, qb = (vb + 500u) / 1000u; if (qa > 63u) qa = 63u; if (qb > 63u) qb = 63u;
            const unsigned long long wait = (unsigned long long)(qa * 6400u + qb * 409600u); const unsigned long long t0 = __builtin_amdgcn_s_memrealtime();
            while (__builtin_amdgcn_s_memrealtime() - t0 < wait) __builtin_amdgcn_s_sleep(8); }
        continue;
#endif
        if (ph + 1 < ph_hi) { XcdBarrier bar; bar.bar = F.ctl + CW_BAR; bar.x = xb_xcc_id(); bar.st = F.MISC + 8; xcd_barrier(bar); }
    }
}

extern "C" void kernel_launch(void* const* d_in, const int* in_sizes, int n_in, void* d_out, int out_size, void* d_ws, size_t ws_size, hipStream_t stream) {
    static int grid = 0;
    if (grid == 0) {
        if (n_in != 25 || in_sizes[0] != M_TOK * DM || out_size != M_TOK * DM || ws_size < WS_END) { fprintf(stderr, "kernel_launch: unexpected shapes (n_in %d, in0 %d, out %d, ws %zu)\n", n_in, n_in > 0 ? in_sizes[0] : -1, out_size, ws_size); grid = -1; return; }
        int dev = 0, cus = 0, per_cu = 0;
        if (hipGetDevice(&dev) != hipSuccess || hipDeviceGetAttribute(&cus, hipDeviceAttributeMultiprocessorCount, dev) != hipSuccess) { grid = -1; return; }
        if (hipFuncSetAttribute((const void*)hyb_fwd, hipFuncAttributeMaxDynamicSharedMemorySize, LDS_BYTES) != hipSuccess) { fprintf(stderr, "kernel_launch: hipFuncSetAttribute failed\n"); grid = -1; return; }
        if (hipOccupancyMaxActiveBlocksPerMultiprocessor(&per_cu, (const void*)hyb_fwd, NTHREADS, LDS_BYTES) != hipSuccess || per_cu < 1)
            fprintf(stderr, "kernel_launch: note: occupancy query reports %d workgroups per CU\n", per_cu);
        (void)hipGetLastError();
        grid = cus;
    }
    if (grid < 0) return;
    if (hipMemsetAsync((char*)d_ws + WS_CTL, 0, CTL_ZERO_BYTES, stream) != hipSuccess) { fprintf(stderr, "kernel_launch: memset failed\n"); return; }
    Args a{};
    for (int i = 0; i < 25; ++i) a.in[i] = (const float*)d_in[i];
    a.out = (float*)d_out; a.ws = (unsigned char*)d_ws;
#if MK_N_LAUNCHES == 1
    a.ph_lo = 0; a.ph_hi = N_PHASES;
    hipLaunchKernelGGL(hyb_fwd, dim3(grid), dim3(NTHREADS), LDS_BYTES, stream, a);
#else
    for (int p = 0; p < N_PHASES; ++p) { a.ph_lo = p; a.ph_hi = p + 1; hipLaunchKernelGGL(hyb_fwd, dim3(grid), dim3(NTHREADS), LDS_BYTES, stream, a); }
#endif
    const hipError_t le = hipPeekAtLastError();
    if (le != hipSuccess) fprintf(stderr, "kernel_launch: launch failed: %s\n", hipGetErrorName(le));
}
```

```cpp
#include <hip/hip_runtime.h>
#include <cstdio>
#include <cstdint>

#define LAS __attribute__((address_space(3)))
#define GAS __attribute__((address_space(1)))
typedef unsigned short bf16_t;
typedef short bf16x8 __attribute__((ext_vector_type(8)));
typedef short bf16x4 __attribute__((ext_vector_type(4)));
typedef float f32x4 __attribute__((ext_vector_type(4)));
typedef float f32x2 __attribute__((ext_vector_type(2)));
typedef unsigned u32x4 __attribute__((ext_vector_type(4)));
typedef unsigned u32x2 __attribute__((ext_vector_type(2)));
typedef __bf16 bf16x2_t __attribute__((ext_vector_type(2)));

constexpr int M_TOK = 16384, SEQ = 4096, NBATCH = 4, DM = 1024, FF = 2816, NGU = 2 * FF, NIN = 3584, DEPTH = 2;
constexpr int PLD = 3328;
constexpr int PQ = 0, PK = 256, PV = 512, PO = 768, PZ = 1024, PX = 1536, PDQ = 2560, PDK = 2816, PDV = 3072;
constexpr float NORM_EPS = 1e-6f;
constexpr float LOG2E = 1.4426950408889634f;

__device__ __forceinline__ unsigned cvtpk(float lo, float hi) { f32x2 v = {lo, hi}; bf16x2_t b = __builtin_convertvector(v, bf16x2_t); return __builtin_bit_cast(unsigned, b); }
__device__ __forceinline__ bf16_t f2bf(float f) { return (bf16_t)(cvtpk(f, 0.f) & 0xffffu); }
__device__ __forceinline__ float bf2f(bf16_t h) { return __uint_as_float(((unsigned)h) << 16); }
__device__ __forceinline__ float bflo(unsigned w) { return __uint_as_float(w << 16); }
__device__ __forceinline__ float bfhi(unsigned w) { return __uint_as_float(w & 0xffff0000u); }
__device__ __forceinline__ float fast_exp(float x) { return __builtin_amdgcn_exp2f(x * LOG2E); }
__device__ __forceinline__ float fast_rcp(float x) { return __builtin_amdgcn_rcpf(x); }
__device__ __forceinline__ float fast_log1pexp(float x) { const float e = __builtin_amdgcn_exp2f(x * LOG2E); return __builtin_amdgcn_logf(1.0f + e) * 0.6931471805599453f; }
__device__ __forceinline__ float sigmoidf_(float x) { return fast_rcp(1.f + fast_exp(-x)); }
__device__ __forceinline__ float siluf_(float x) { return x * sigmoidf_(x); }

__device__ __forceinline__ void st16_wt(void* p, u32x4 v) { asm volatile("global_store_dwordx4 %0, %1, off sc1\n\ts_nop 1" :: "v"(p), "v"(v) : "memory"); }

namespace pg8 {
constexpr int BM = 256, BK = 64, HALF = 128, HTB = HALF * BK * 2, STAGE_BYTES = 8 * HTB, NXCD = 8, WGM = 8;
__host__ __device__ __forceinline__ int lds_byte(int r, int c) { const int st = (r >> 4) * 2 + (c >> 5), rr = r & 15, cc = c & 31, ob = rr * 64 + cc * 2; return st * 1024 + (ob ^ (((ob >> 9) & 1) << 5)); }
__host__ __device__ __forceinline__ void stage_rc(int b, int& R, int& C) { const int st = b / 1024, sb = b % 1024, swz = sb ^ (((sb >> 9) & 1) << 5); R = (st >> 1) * 16 + swz / 64; C = (st & 1) * 32 + (swz % 64) / 2; }
__host__ __device__ __forceinline__ int perm32(int rho) { const int n = rho >> 4, i = rho & 15; return 8 * (i >> 2) + 4 * n + (i & 3); }

struct Unit { int pm, pn; };
struct Gemm { const bf16_t* A; const bf16_t* Bt; int M, N, K, lda; };

struct StaticOrder {
    int nM, nN, nwg, G, c;
    __device__ void init(int M, int N, int G_, int c_) { nM = M / BM; nN = N / BM; nwg = nM * nN; G = G_; c = c_; }
    __device__ bool next(int i, Unit& u) const {
        const long L = (long)i * G + c; if (L >= nwg) return false;
        int wgid = (int)L; { const int q = nwg / NXCD, r = nwg % NXCD, xcd = wgid % NXCD, off = wgid / NXCD; wgid = (xcd < r ? xcd * (q + 1) : r * (q + 1) + (xcd - r) * q) + off; }
        const int nig = WGM * nN, gid = wgid / nig, fm = gid * WGM, gsz = (nM - fm) < WGM ? (nM - fm) : WGM;
        u.pm = fm + ((wgid % nig) % gsz); u.pn = (wgid % nig) / gsz; return true;
    }
};

template <class Epi, bool ALIGN_EPI, bool SP2>
__device__ __forceinline__ void gemm_phase(LAS unsigned char* lds, const Gemm g, const StaticOrder& S, const Epi& E, const int tid) {
    const int wid = __builtin_amdgcn_readfirstlane(tid >> 6), lane = tid & 63, wr = wid >> 2, wc = wid & 3, fr = lane & 15, fq = lane >> 4;
    const int K = g.K, nt = K / BK, lda = g.lda;
    unsigned voffA[2], voffB[2];
#pragma unroll
    for (int i = 0; i < 2; ++i) { int R, C; stage_rc(tid * 16 + i * 8192, R, C); const int Rb = (R & ~31) + perm32(R & 31);
        voffA[i] = (unsigned)(R * lda + C) * 2u; voffB[i] = (unsigned)(Rb * K + C) * 2u; }
    const size_t kstep = (size_t)(BK * 2);
    const size_t hstepA = (size_t)HALF * lda * 2, hstepB = (size_t)HALF * K * 2;
    const size_t tstepA = 2 * hstepA, tstepB = 2 * hstepB;
    const unsigned ldsw = (unsigned)wid * 1024u;
    const int aoff = lds_byte(wr * 64 + fr, fq * 8), boff = lds_byte(wc * 32 + fr, fq * 8);
#define PG8_SA(b, h) (((b) * 2 + (h)) * HTB)
#define PG8_SB(b, h) ((4 + (b) * 2 + (h)) * HTB)
#define PG8_STAGE(bufoff, gbase, voff) do { _Pragma("unroll") for (int _i = 0; _i < 2; ++_i) \
        __builtin_amdgcn_global_load_lds((const unsigned*)((const char*)(gbase) + (voff)[_i]), (LAS unsigned*)(lds + (bufoff) + ldsw + _i * 8192), 16, 0, 0); } while (0)
#define PG8_LDA(dst, b, h) do { _Pragma("unroll") for (int m = 0; m < 4; ++m) _Pragma("unroll") for (int k = 0; k < 2; ++k) dst[m][k] = *(const LAS bf16x8*)(lds + PG8_SA(b, h) + aoff + m * 2048 + k * 1024); } while (0)
#define PG8_LDB(dst, b, h) do { _Pragma("unroll") for (int n = 0; n < 2; ++n) _Pragma("unroll") for (int k = 0; k < 2; ++k) dst[n][k] = *(const LAS bf16x8*)(lds + PG8_SB(b, h) + boff + n * 2048 + k * 1024); } while (0)
#define PG8_MMA(ai, bj, At, Bt) do { __builtin_amdgcn_s_setprio(1); _Pragma("unroll") for (int m = 0; m < 4; ++m) _Pragma("unroll") for (int n = 0; n < 2; ++n) _Pragma("unroll") for (int k = 0; k < 2; ++k) \
        acc[ai][bj][m][n] = __builtin_amdgcn_mfma_f32_16x16x32_bf16(Bt[n][k], At[m][k], acc[ai][bj][m][n], 0, 0, 0); __builtin_amdgcn_s_setprio(0); } while (0)
#define PG8_WAIT_V(n) asm volatile("s_waitcnt vmcnt(" #n ")" ::: "memory")
#define PG8_WAIT_L(n) asm volatile("s_waitcnt lgkmcnt(" #n ")" ::: "memory")
#define PG8_BAR __builtin_amdgcn_s_barrier()
#define PG8_SCHED __builtin_amdgcn_sched_barrier(0)
    Unit cur, nxt; int ui = 0;
    if (!S.next(0, cur)) return;
    f32x4 acc[2][2][4][2];
    typename Epi::Raw raw; E.init_load(raw, cur, wr, wc, fr, fq);
    if constexpr (!Epi::HAS_INIT) {
#pragma unroll
    for (int a = 0; a < 2; ++a)
#pragma unroll
        for (int b = 0; b < 2; ++b)
#pragma unroll
            for (int m = 0; m < 4; ++m)
#pragma unroll
                for (int n = 0; n < 2; ++n) acc[a][b][m][n] = (f32x4){0.f, 0.f, 0.f, 0.f};
    }
    bf16x8 At[4][2], B0[2][2], B1[2][2];
    const char* cA = (const char*)g.A + (size_t)cur.pm * tstepA; const char* cB = (const char*)g.Bt + (size_t)cur.pn * tstepB;
    if constexpr (SP2) {
        PG8_STAGE(PG8_SB(0, 0), cB, voffB); PG8_STAGE(PG8_SB(0, 1), cB + hstepB, voffB); PG8_STAGE(PG8_SA(0, 0), cA, voffA); PG8_STAGE(PG8_SA(0, 1), cA + hstepA, voffA);
        if constexpr (Epi::HAS_INIT) E.init_finish(raw, acc);
        if (wr == 1) PG8_BAR;
        PG8_WAIT_V(2); PG8_BAR;
        PG8_STAGE(PG8_SB(1, 0), cB + kstep, voffB); PG8_STAGE(PG8_SA(1, 0), cA + kstep, voffA); PG8_STAGE(PG8_SB(1, 1), cB + hstepB + kstep, voffB);
        PG8_WAIT_V(6); PG8_BAR;
    } else {
        PG8_STAGE(PG8_SB(0, 0), cB, voffB); PG8_STAGE(PG8_SA(0, 0), cA, voffA); PG8_STAGE(PG8_SB(0, 1), cB + hstepB, voffB); PG8_STAGE(PG8_SA(0, 1), cA + hstepA, voffA);
        if (wr == 1) PG8_BAR;
        PG8_WAIT_V(4); PG8_BAR;
        PG8_STAGE(PG8_SB(1, 0), cB + kstep, voffB); PG8_STAGE(PG8_SA(1, 0), cA + kstep, voffA); PG8_STAGE(PG8_SB(1, 1), cB + hstepB + kstep, voffB);
        PG8_WAIT_V(6); PG8_BAR;
    }
    for (;;) {
        const bool has_next = S.next(ui + 1, nxt);
        const char* nA = has_next ? (const char*)g.A + (size_t)nxt.pm * tstepA : cA; const char* nB = has_next ? (const char*)g.Bt + (size_t)nxt.pn * tstepB : cB;
        for (int t = 0; t < nt; t += 2) {
            const bool last = (t == nt - 2);
            const char* a1 = cA + (size_t)(t + 1) * kstep;
            const char* a2 = last ? nA : cA + (size_t)(t + 2) * kstep; const char* b2 = last ? nB : cB + (size_t)(t + 2) * kstep;
            const char* a3 = a2 + kstep; const char* b3 = b2 + kstep;
            if constexpr (SP2) {
            PG8_LDB(B0, 0, 0); PG8_LDB(B1, 0, 1); PG8_SCHED; PG8_LDA(At, 0, 0); PG8_STAGE(PG8_SA(1, 1), a1 + hstepA, voffA);
            PG8_WAIT_V(8); PG8_WAIT_L(0); PG8_BAR; PG8_MMA(0, 0, At, B0); PG8_MMA(0, 1, At, B1); PG8_BAR; PG8_SCHED;
            PG8_LDA(At, 0, 1); PG8_STAGE(PG8_SB(0, 0), b2, voffB); PG8_STAGE(PG8_SB(0, 1), b2 + hstepB, voffB); PG8_STAGE(PG8_SA(0, 0), a2, voffA);
            PG8_WAIT_V(8); PG8_WAIT_L(0); PG8_BAR; PG8_MMA(1, 0, At, B0); PG8_MMA(1, 1, At, B1); PG8_BAR; PG8_SCHED;
            PG8_LDB(B0, 1, 0); PG8_LDB(B1, 1, 1); PG8_SCHED; PG8_LDA(At, 1, 0); PG8_STAGE(PG8_SA(0, 1), a2 + hstepA, voffA);
            PG8_WAIT_V(8); PG8_WAIT_L(0); PG8_BAR; PG8_MMA(0, 0, At, B0); PG8_MMA(0, 1, At, B1); PG8_BAR; PG8_SCHED;
            PG8_LDA(At, 1, 1); PG8_STAGE(PG8_SB(1, 0), b3, voffB); PG8_STAGE(PG8_SB(1, 1), b3 + hstepB, voffB); PG8_STAGE(PG8_SA(1, 0), a3, voffA);
            PG8_WAIT_V(8); PG8_WAIT_L(0); PG8_BAR; PG8_MMA(1, 0, At, B0); PG8_MMA(1, 1, At, B1); PG8_BAR; PG8_SCHED;
            } else {
            PG8_LDB(B0, 0, 0); PG8_SCHED; PG8_LDA(At, 0, 0); PG8_STAGE(PG8_SA(1, 1), a1 + hstepA, voffA);
            PG8_WAIT_L(8); PG8_BAR; PG8_WAIT_L(0); PG8_MMA(0, 0, At, B0); PG8_BAR; PG8_SCHED;
            PG8_LDB(B1, 0, 1); PG8_STAGE(PG8_SB(0, 0), b2, voffB);
            PG8_BAR; PG8_WAIT_L(0); PG8_MMA(0, 1, At, B1); PG8_BAR;
            PG8_LDA(At, 0, 1); PG8_STAGE(PG8_SA(0, 0), a2, voffA);
            PG8_BAR; PG8_WAIT_L(0); PG8_MMA(1, 0, At, B0); PG8_BAR; PG8_SCHED;
            PG8_STAGE(PG8_SB(0, 1), b2 + hstepB, voffB);
            PG8_WAIT_V(6); PG8_BAR; PG8_MMA(1, 1, At, B1); PG8_BAR;
            PG8_LDB(B0, 1, 0); PG8_SCHED; PG8_LDA(At, 1, 0); PG8_STAGE(PG8_SA(0, 1), a2 + hstepA, voffA);
            PG8_WAIT_L(8); PG8_BAR; PG8_WAIT_L(0); PG8_MMA(0, 0, At, B0); PG8_BAR; PG8_SCHED;
            PG8_LDB(B1, 1, 1); PG8_STAGE(PG8_SB(1, 0), b3, voffB);
            PG8_BAR; PG8_WAIT_L(0); PG8_MMA(0, 1, At, B1); PG8_BAR;
            PG8_LDA(At, 1, 1); PG8_STAGE(PG8_SA(1, 0), a3, voffA);
            PG8_BAR; PG8_WAIT_L(0); PG8_MMA(1, 0, At, B0); PG8_BAR; PG8_SCHED;
            PG8_STAGE(PG8_SB(1, 1), b3 + hstepB, voffB);
            PG8_WAIT_V(6); PG8_BAR; PG8_MMA(1, 1, At, B1); PG8_BAR;
            }
        }
        if constexpr (ALIGN_EPI) { if (wr == 0) PG8_BAR; }
        E(acc, cur, wr, wc, fr, fq);
        if (!has_next) break;
#pragma unroll
        for (int a = 0; a < 2; ++a)
#pragma unroll
            for (int b = 0; b < 2; ++b)
#pragma unroll
                for (int m = 0; m < 4; ++m)
#pragma unroll
                    for (int n = 0; n < 2; ++n) acc[a][b][m][n] = (f32x4){0.f, 0.f, 0.f, 0.f};
        cur = nxt; cA = nA; cB = nB; ++ui;
        if constexpr (ALIGN_EPI) { if (wr == 1) PG8_BAR; }
    }
    PG8_WAIT_V(0);
    if constexpr (!ALIGN_EPI) { if (wr == 0) PG8_BAR; }
    PG8_BAR;
#undef PG8_SA
#undef PG8_SB
#undef PG8_STAGE
#undef PG8_LDA
#undef PG8_LDB
#undef PG8_MMA
#undef PG8_WAIT_V
#undef PG8_WAIT_L
#undef PG8_BAR
#undef PG8_SCHED
}
}
constexpr size_t MiB = 1u << 20;
constexpr size_t WS_CTL = 0, CTL_ZERO_BYTES = 1 * MiB;
constexpr size_t WS_SSQ = 1 * MiB;
constexpr size_t WS_GATES = 2 * MiB;
constexpr size_t WS_NST = 3 * MiB;
constexpr size_t WS_W = 4 * MiB;
constexpr size_t W_GU1 = 0, W_D1 = 11 * MiB, W_IN = W_D1 + 11 * MiB / 2, W_OUT = W_IN + 7 * MiB, W_GU2 = W_OUT + 2 * MiB, W_D2 = W_GU2 + 11 * MiB, W_LAYER = 42 * MiB;
static_assert(W_D2 + 11 * MiB / 2 == W_LAYER, "weights map");
constexpr size_t WS_XB = 88 * MiB;
constexpr size_t WS_CST = 120 * MiB;
constexpr size_t WS_SST = 128 * MiB;
constexpr size_t WS_PROJ = 144 * MiB;
constexpr size_t WS_END = 248 * MiB;
static_assert(WS_PROJ + (size_t)M_TOK * PLD * 2 <= WS_END, "ws map");

constexpr int CW_BAR = 4096;
constexpr int CW_Q = 16384;

constexpr int RING_BYTES = 131072;
constexpr int LDSCTL_OFF = RING_BYTES, MISC_OFF = LDSCTL_OFF + 320;
constexpr int LDS_BYTES = 147456;
constexpr int NWAVES = 8, NTHREADS = 512;

typedef GAS unsigned gu32;
#define RLX_AGENT __ATOMIC_RELAXED, __HIP_MEMORY_SCOPE_AGENT
#define LDS_WAIT() asm volatile("s_waitcnt lgkmcnt(0)" ::: "memory")
#define VM_WAIT() asm volatile("s_waitcnt vmcnt(0)" ::: "memory")

#define XB_TMO      128
#define XB_XCNT(j)  (256  + 64 * (j))
#define XB_XSUB(j)  (1280 + 64 * (j))
#define XB_XGEN(j)  (2304 + 64 * (j))
#define XB_TOP      3328
#define XB_TOPGEN   3392
#define XCD_BAR_WORDS 3456
#define XB_SPIN_CAP (1u << 22)
__device__ __forceinline__ unsigned xb_ld(unsigned* p)              { return __hip_atomic_load(p, __ATOMIC_RELAXED, __HIP_MEMORY_SCOPE_AGENT); }
__device__ __forceinline__ unsigned xb_add(unsigned* p, unsigned v) { return __hip_atomic_fetch_add(p, v, __ATOMIC_RELAXED, __HIP_MEMORY_SCOPE_AGENT); }
__device__ __forceinline__ unsigned xb_xcc_id() { return (unsigned)__builtin_amdgcn_s_getreg((3 << 11) | 20) & 0xFu; }
#define XB_SPIN(cond, bar) do { unsigned _sp = 0; while (cond) { __builtin_amdgcn_s_sleep(1); \
    if ((++_sp & 255u) == 0u) { if (xb_ld(&(bar)[XB_TMO])) break; if (_sp > XB_SPIN_CAP) { atomicAdd(&(bar)[XB_TMO], 1u); break; } } } } while (0)
struct XcdBarrier { unsigned* bar; unsigned x; volatile LAS unsigned* st; };
__device__ __forceinline__ XcdBarrier xcd_barrier_post(unsigned* bar, volatile LAS unsigned* st) {
    XcdBarrier b; b.bar = bar; b.x = xb_xcc_id(); b.st = st;
    if (threadIdx.x == 0) (void)xb_add(&bar[XB_XCNT(b.x)], 1u);
    return b;
}
__device__ __forceinline__ void xcd_barrier_complete(unsigned* bar, unsigned x, unsigned& nloc, unsigned& nx) {
    const unsigned G = gridDim.x * gridDim.y * gridDim.z;
    unsigned sum, cnt, mine, sp = 0u;
    for (;;) {
        sum = 0u; cnt = 0u; mine = 0u;
#pragma unroll
        for (unsigned j = 0; j < 16; ++j) { const unsigned c = xb_ld(&bar[XB_XCNT(j)]); sum += c; cnt += (c > 0u) ? 1u : 0u; mine = (j == x) ? c : mine; }
        if (sum == G) break;
        __builtin_amdgcn_s_sleep(1);
        if ((++sp & 255u) == 0u) { if (xb_ld(&bar[XB_TMO])) break; if (sp > XB_SPIN_CAP) { atomicAdd(&bar[XB_TMO], 1u); break; } }
    }
    nloc = mine > 0u ? mine : 1u; nx = cnt > 0u ? cnt : 1u;
}
__device__ __forceinline__ void xcd_barrier(const XcdBarrier& b) {
    asm volatile("s_waitcnt vmcnt(0)" ::: "memory");
    __syncthreads();
    if (threadIdx.x == 0) {
        unsigned* bar = b.bar;
        __builtin_amdgcn_s_waitcnt(0);
        unsigned nloc = b.st[0], nx = b.st[1];
        if (nloc == 0u) { xcd_barrier_complete(bar, b.x, nloc, nx); b.st[0] = nloc; b.st[1] = nx; }
        const unsigned old = xb_add(&bar[XB_XSUB(b.x)], 1u);
        const unsigned gen = old / nloc;
        if (old + 1u == (gen + 1u) * nloc) {
            __builtin_amdgcn_fence(__ATOMIC_RELEASE, "agent");
            asm volatile("s_waitcnt vmcnt(0)" ::: "memory");
            const unsigned og = xb_add(&bar[XB_TOP], 1u);
            const unsigned tg = og / nx;
            if (og + 1u == (tg + 1u) * nx) xb_add(&bar[XB_TOPGEN], 1u);
            else XB_SPIN(xb_ld(&bar[XB_TOPGEN]) == tg, bar);
            __builtin_amdgcn_fence(__ATOMIC_ACQUIRE, "agent");
            xb_add(&bar[XB_XGEN(b.x)], 1u);
            asm volatile("s_waitcnt vmcnt(0)" ::: "memory");
        } else {
            XB_SPIN(xb_ld(&bar[XB_XGEN(b.x)]) == gen, bar);
            __builtin_amdgcn_fence(__ATOMIC_ACQUIRE, "agent");
            asm volatile("s_waitcnt vmcnt(0)" ::: "memory");
        }
    }
    __syncthreads();
}

struct Args { const float* in[25]; float* out; unsigned char* ws; int ph_lo, ph_hi; };
typedef const float* fptr_t; typedef __attribute__((address_space(4))) const fptr_t* kinptr_t;
struct ArgView { kinptr_t in; };
struct Frame {
    LAS unsigned char* lds;
    volatile LAS unsigned* MISC;
    unsigned* ctl;
    int tid, lane, wave, vcu, G;
    kinptr_t in;
    unsigned char* ws;
};
__device__ __forceinline__ float wave_sum(float v) {
#pragma unroll
    for (int o = 1; o < 64; o <<= 1) v += __shfl_xor(v, o);
    return v;
}
__device__ __forceinline__ int q_next(Frame& F, int q) {
    __syncthreads();
    if (F.tid == 0) F.MISC[16] = xb_add(F.ctl + CW_Q + 64 * q, 1u);
    __syncthreads();
    return (int)F.MISC[16];
}

struct MapPlain { __device__ __forceinline__ int row(int n) const { return n; } __device__ __forceinline__ float scale(int) const { return 1.f; } };
struct MapGU { int off; __device__ __forceinline__ int row(int n) const { return 256 * (n >> 7) + off + (n & 127); } __device__ __forceinline__ float scale(int) const { return 1.f; } };
struct MapIn {
    __device__ __forceinline__ int row(int n) const {
        if (n < 1024) return n;
        if (n < 1032) return 13 * 256 + (n - 1024);
        if (n < 1544) return 4 * 256 + (n - 1032);
        if (n < 2568) return 6 * 256 + (n - 1544);
        if (n < 2576) return 13 * 256 + 8 + (n - 2568);
        return 10 * 256 + (n - 2576);
    }
    __device__ __forceinline__ float scale(int n) const { return (n >= 256 && n < 512) ? 0.125f : 1.f; }
};
template <class Map>
__device__ __forceinline__ void p0_transpose_item(const float* W, int K, int N, bf16_t* WT, int item, int lane, const float* gain, const Map map) {
    const int nblk = (N + 63) / 64, kb = item / nblk, nb = item % nblk, k0 = 64 * kb, n = 64 * nb + lane;
    if (n >= N) return;
    const float* src = W + (size_t)k0 * N + n;
    float v[64];
#pragma unroll
    for (int i = 0; i < 64; ++i) v[i] = src[(size_t)i * N];
    const float sc = map.scale(n);
    if (gain) {
#pragma unroll
        for (int i = 0; i < 64; i += 4) { const f32x4 g = *(const f32x4*)(gain + k0 + i); v[i] *= g.x; v[i + 1] *= g.y; v[i + 2] *= g.z; v[i + 3] *= g.w; }
    }
    u32x4* dst = (u32x4*)(WT + (size_t)map.row(n) * K + k0);
#pragma unroll
    for (int c = 0; c < 8; ++c) { u32x4 o; o.x = cvtpk(v[8 * c] * sc, v[8 * c + 1] * sc); o.y = cvtpk(v[8 * c + 2] * sc, v[8 * c + 3] * sc); o.z = cvtpk(v[8 * c + 4] * sc, v[8 * c + 5] * sc); o.w = cvtpk(v[8 * c + 6] * sc, v[8 * c + 7] * sc); dst[c] = o; }
}
constexpr int I_G = (DM / 64) * (FF / 64), I_D = (FF / 64) * (DM / 64), I_IN = (DM / 64) * ((3344 + 63) / 64), I_OUT = (DM / 64) * (DM / 64);
constexpr int R_GU1 = 0, R_D1 = 2 * I_G, R_IN = R_D1 + I_D, R_OUT = R_IN + I_IN, R_GU2 = R_OUT + I_OUT, R_D2 = R_GU2 + 2 * I_G, R_END = R_D2 + I_D;
__device__ __forceinline__ void convert_items(Frame& F, int l, int r_lo, int r_hi, int gw, int NGW) {
    bf16_t* WL = (bf16_t*)(F.ws + WS_W + (size_t)l * W_LAYER);
    for (int it = r_lo + gw; it < r_hi; it += NGW) {
        int r = it;
        if (r < I_G) { p0_transpose_item(F.in[2] + (size_t)l * DM * FF, DM, FF, (bf16_t*)((char*)WL + W_GU1), r, F.lane, F.in[1] + l * DM, MapGU{0}); continue; } r -= I_G;
        if (r < I_G) { p0_transpose_item(F.in[3] + (size_t)l * DM * FF, DM, FF, (bf16_t*)((char*)WL + W_GU1), r, F.lane, F.in[1] + l * DM, MapGU{128}); continue; } r -= I_G;
        if (r < I_D) { p0_transpose_item(F.in[4] + (size_t)l * FF * DM, FF, DM, (bf16_t*)((char*)WL + W_D1), r, F.lane, nullptr, MapPlain{}); continue; } r -= I_D;
        if (r < I_IN) { p0_transpose_item(F.in[6] + (size_t)l * DM * 3344, DM, 3344, (bf16_t*)((char*)WL + W_IN), r, F.lane, F.in[5] + l * DM, MapIn{}); continue; } r -= I_IN;
        if (r < I_OUT) { p0_transpose_item(F.in[20] + (size_t)l * DM * DM, DM, DM, (bf16_t*)((char*)WL + W_OUT), r, F.lane, nullptr, MapPlain{}); continue; } r -= I_OUT;
        if (r < I_G) { p0_transpose_item(F.in[22] + (size_t)l * DM * FF, DM, FF, (bf16_t*)((char*)WL + W_GU2), r, F.lane, F.in[21] + l * DM, MapGU{0}); continue; } r -= I_G;
        if (r < I_G) { p0_transpose_item(F.in[23] + (size_t)l * DM * FF, DM, FF, (bf16_t*)((char*)WL + W_GU2), r, F.lane, F.in[21] + l * DM, MapGU{128}); continue; } r -= I_G;
        p0_transpose_item(F.in[24] + (size_t)l * FF * DM, FF, DM, (bf16_t*)((char*)WL + W_D2), r, F.lane, nullptr, MapPlain{});
    }
    if (r_lo <= R_IN && R_IN < r_hi) {
        u32x4* z = (u32x4*)(F.ws + WS_W + (size_t)l * W_LAYER + W_IN + (size_t)(13 * 256 + 16) * DM * 2);
        const int n16 = 240 * DM * 2 / 16;
        unsigned z0 = 0u; asm volatile("" : "+v"(z0));
        for (int i = gw * 64 + F.lane; i < n16; i += NGW * 64) z[i] = (u32x4){z0, z0, z0, z0};
    }
}
__device__ __forceinline__ void side_convert(Frame& F, int l, int k) {
    if ((int)blockIdx.x < 128 || F.G != 256) return;
    const int gw = ((int)blockIdx.x - 128) * NWAVES + F.wave, NGW = 128 * NWAVES;
    if (l == 0 && k == 0) convert_items(F, 0, R_D1, R_OUT, gw, NGW);
    else if (l == 0 && k == 2) convert_items(F, 0, R_OUT, R_END, gw, NGW);
    else if (l == 0 && k == 7) convert_items(F, 1, R_GU1, R_D1, gw, NGW);
    else if (l == 1 && k == 0) convert_items(F, 1, R_D1, R_GU2, gw, NGW);
    else if (l == 1 && k == 2) convert_items(F, 1, R_GU2, R_D2, gw, NGW);
    else if (l == 1 && k == 7) convert_items(F, 1, R_D2, R_END, gw, NGW);
}
__device__ __forceinline__ void p0_prologue(Frame& F) {
    const int gw = F.vcu * NWAVES + F.wave, NGW = F.G * NWAVES;
    if (F.G == 256) convert_items(F, 0, R_GU1, R_D1, gw, NGW);
    else { convert_items(F, 0, 0, R_END, gw, NGW); convert_items(F, 1, 0, R_END, gw, NGW); }
    const float* x = F.in[0]; bf16_t* XB = (bf16_t*)(F.ws + WS_XB); float* SSQ = (float*)(F.ws + WS_SSQ);
    for (int m = gw; m < M_TOK; m += NGW) {
        const f32x4* xr = (const f32x4*)(x + (size_t)m * DM) + F.lane; float s = 0.f; f32x4 v[4];
#pragma unroll
        for (int j = 0; j < 4; ++j) { v[j] = xr[64 * j]; s += (v[j].x * v[j].x + v[j].y * v[j].y) + (v[j].z * v[j].z + v[j].w * v[j].w); }
        s = wave_sum(s);
        u32x2* o8 = (u32x2*)(XB + (size_t)m * DM) + F.lane;
#pragma unroll
        for (int j = 0; j < 4; ++j) o8[64 * j] = (u32x2){cvtpk(v[j].x, v[j].y), cvtpk(v[j].z, v[j].w)};
        if (F.lane < 16) SSQ[(size_t)m * 16 + F.lane] = (F.lane == 0) ? s : 0.f;
    }
}

__device__ __forceinline__ void rows_rs(const float* ssq, int rowbase, int fr, int fq, float (&rs)[8]) {
    f32x4 p[8];
#pragma unroll
    for (int i = 0; i < 8; ++i) { const int row = rowbase + (i >> 2) * 128 + (i & 3) * 16 + fr; p[i] = *(const f32x4*)(ssq + (size_t)row * 16 + 4 * fq); }
#pragma unroll
    for (int i = 0; i < 8; ++i) { float s = (p[i].x + p[i].y) + (p[i].z + p[i].w); s += __shfl_xor(s, 16); s += __shfl_xor(s, 32); rs[i] = rsqrtf(s * (1.0f / DM) + NORM_EPS); }
}
struct EpiNoInit { struct Raw {}; static constexpr bool HAS_INIT = false; __device__ __forceinline__ void init_load(Raw&, const pg8::Unit&, int, int, int, int) const {} };
struct EpiSwiglu : EpiNoInit {
    bf16_t* H; const float* ssq;
    __device__ __forceinline__ void operator()(const f32x4 (&acc)[2][2][4][2], const pg8::Unit& u, int wr, int wc, int fr, int fq) const {
        asm volatile("" : "+v"(fr), "+v"(fq));
        const int col0 = u.pn * 128 + wc * 32 + 8 * fq;
        float rs[8]; rows_rs(ssq, u.pm * 256 + wr * 64, fr, fq, rs);
#pragma unroll
        for (int ai = 0; ai < 2; ++ai)
#pragma unroll
            for (int m = 0; m < 4; ++m) {
                const int row = u.pm * 256 + ai * 128 + wr * 64 + m * 16 + fr; const float r = rs[ai * 4 + m];
                float hv[8];
#pragma unroll
                for (int n = 0; n < 2; ++n)
#pragma unroll
                    for (int j = 0; j < 4; ++j) { const float g = acc[ai][0][m][n][j] * r, up = acc[ai][1][m][n][j] * r; hv[4 * n + j] = siluf_(g) * up; }
                u32x4 w; w.x = cvtpk(hv[0], hv[1]); w.y = cvtpk(hv[2], hv[3]); w.z = cvtpk(hv[4], hv[5]); w.w = cvtpk(hv[6], hv[7]);
                st16_wt(H + (size_t)row * FF + col0, w);
                if (m & 1) asm volatile("" ::: "memory");
            }
    }
};
template <bool FINAL>
struct EpiResid {
    struct Raw { u32x4 r[2][4][2]; };
    static constexpr bool HAS_INIT = true;
    float* xout; bf16_t* XB; float* ssq; float alpha, ralpha;
    __device__ __forceinline__ void init_load(Raw& raw, const pg8::Unit& u, int wr, int wc, int fr, int fq) const {
        const int col0 = u.pn * 256 + wc * 32 + 8 * fq;
#pragma unroll
        for (int ai = 0; ai < 2; ++ai)
#pragma unroll
            for (int m = 0; m < 4; ++m) { const int row = u.pm * 256 + ai * 128 + wr * 64 + m * 16 + fr;
#pragma unroll
                for (int bj = 0; bj < 2; ++bj) raw.r[ai][m][bj] = *(const u32x4*)(XB + (size_t)row * DM + col0 + bj * 128); }
    }
    __device__ __forceinline__ void init_finish(const Raw& raw, f32x4 (&acc)[2][2][4][2]) const {
#pragma unroll
        for (int ai = 0; ai < 2; ++ai)
#pragma unroll
            for (int m = 0; m < 4; ++m)
#pragma unroll
                for (int bj = 0; bj < 2; ++bj) { const u32x4 w = raw.r[ai][m][bj];
                    acc[ai][bj][m][0] = (f32x4){bflo(w.x), bfhi(w.x), bflo(w.y), bfhi(w.y)} * ralpha; acc[ai][bj][m][1] = (f32x4){bflo(w.z), bfhi(w.z), bflo(w.w), bfhi(w.w)} * ralpha; }
    }
    __device__ __forceinline__ void operator()(const f32x4 (&acc)[2][2][4][2], const pg8::Unit& u, int wr, int wc, int fr, int fq) const {
        asm volatile("" : "+v"(fr), "+v"(fq));
        const int col0 = u.pn * 256 + wc * 32 + 8 * fq;
#pragma unroll
        for (int ai = 0; ai < 2; ++ai)
#pragma unroll
            for (int m = 0; m < 4; ++m) {
                const int row = u.pm * 256 + ai * 128 + wr * 64 + m * 16 + fr; float ss = 0.f;
#pragma unroll
                for (int bj = 0; bj < 2; ++bj) {
                    const size_t off = (size_t)row * DM + col0 + bj * 128;
                    const f32x4 y0 = acc[ai][bj][m][0] * alpha, y1 = acc[ai][bj][m][1] * alpha;
                    if (FINAL) { *(f32x4*)(xout + off) = y0; *(f32x4*)(xout + off + 4) = y1; }
                    else {
                        ss += (y0.x * y0.x + y0.y * y0.y) + (y0.z * y0.z + y0.w * y0.w) + (y1.x * y1.x + y1.y * y1.y) + (y1.z * y1.z + y1.w * y1.w);
                        u32x4 w; w.x = cvtpk(y0.x, y0.y); w.y = cvtpk(y0.z, y0.w); w.z = cvtpk(y1.x, y1.y); w.w = cvtpk(y1.z, y1.w);
                        st16_wt(XB + off, w); }
                }
                if (!FINAL) { ss += __shfl_xor(ss, 16); ss += __shfl_xor(ss, 32);
                    if (fq == 0) ssq[(size_t)row * 16 + u.pn * 4 + wc] = ss; }
                if (m & 1) asm volatile("" ::: "memory");
            }
    }
};
struct EpiInProj : EpiNoInit {
    bf16_t* PROJ; float* GATES; const float* ssq; const float* qnw; const float* knw; const float* gbias; const float* dtb;
    template <int KIND>
    __device__ __forceinline__ void body(const f32x4 (&acc)[2][2][4][2], const pg8::Unit& u, int wr, int wc, int fr, int fq, const float (&rs)[8]) const {
        const int t = u.pn, colw = wc * 32 + 8 * fq;
        float nw[8];
        if (KIND == 3) { const float* w = (t == 10 ? qnw : knw) + (wc & 1) * 32 + 8 * fq; const float sc = (t == 10) ? (0.17677669529663687f * LOG2E) : 1.f;
#pragma unroll
            for (int i = 0; i < 8; ++i) nw[i] = w[i] * sc; }
#pragma unroll
        for (int ai = 0; ai < 2; ++ai)
#pragma unroll
            for (int m = 0; m < 4; ++m) {
                const int row = u.pm * 256 + ai * 128 + wr * 64 + m * 16 + fr; const float r = rs[ai * 4 + m];
#pragma unroll
                for (int bj = 0; bj < 2; ++bj) {
                    float v[8];
#pragma unroll
                    for (int n = 0; n < 2; ++n)
#pragma unroll
                        for (int j = 0; j < 4; ++j) v[4 * n + j] = acc[ai][bj][m][n][j] * r;
                    if (KIND == 1) {
#pragma unroll
                        for (int i = 0; i < 8; ++i) v[i] = sigmoidf_(v[i]);
                    } else if (KIND == 2) {
#pragma unroll
                        for (int i = 0; i < 8; ++i) v[i] = siluf_(v[i]);
                    } else if (KIND == 3) {
                        float ss = 0.f;
#pragma unroll
                        for (int i = 0; i < 8; ++i) ss += v[i] * v[i];
                        ss += __shfl_xor(ss, 16); ss += __shfl_xor(ss, 32);
                        const float q = rsqrtf(ss * (1.0f / 32.0f) + NORM_EPS);
#pragma unroll
                        for (int i = 0; i < 8; ++i) v[i] = v[i] * q * nw[i];
                    }
                    u32x4 w; w.x = cvtpk(v[0], v[1]); w.y = cvtpk(v[2], v[3]); w.z = cvtpk(v[4], v[5]); w.w = cvtpk(v[6], v[7]);
                    st16_wt(PROJ + (size_t)row * PLD + t * 256 + bj * 128 + colw, w);
                }
                if (m & 1) asm volatile("" ::: "memory");
            }
    }
    __device__ __forceinline__ void gates(const f32x4 (&acc)[2][2][4][2], const pg8::Unit& u, int wr, int wc, int fr, int fq, const float (&rs)[8]) const {
        if (wc != 0 || fq >= 2) return;
#pragma unroll
        for (int ai = 0; ai < 2; ++ai)
#pragma unroll
            for (int m = 0; m < 4; ++m) {
                const int row = u.pm * 256 + ai * 128 + wr * 64 + m * 16 + fr; const float r = rs[ai * 4 + m];
                float v[8], o[8];
#pragma unroll
                for (int n = 0; n < 2; ++n)
#pragma unroll
                    for (int j = 0; j < 4; ++j) v[4 * n + j] = acc[ai][0][m][n][j] * r;
                if (fq == 0) {
#pragma unroll
                    for (int j = 0; j < 4; ++j) { o[j] = v[j] + gbias[j]; const float z = v[4 + j] + gbias[4 + j]; o[4 + j] = fminf(z, 0.f) - fast_log1pexp(-fabsf(z)); }
                } else {
#pragma unroll
                    for (int j = 0; j < 8; ++j) { const float z = v[j] + dtb[j]; o[j] = fmaxf(z, 0.f) + fast_log1pexp(-fabsf(z)); }
                }
                float* gp = GATES + (size_t)row * 16 + 8 * fq;
                *(f32x4*)gp = (f32x4){o[0], o[1], o[2], o[3]}; *(f32x4*)(gp + 4) = (f32x4){o[4], o[5], o[6], o[7]};
                asm volatile("" ::: "memory");
            }
    }
    __device__ __forceinline__ void operator()(const f32x4 (&acc)[2][2][4][2], const pg8::Unit& u, int wr, int wc, int fr, int fq) const {
        asm volatile("" : "+v"(fr), "+v"(fq));
        float rs[8]; rows_rs(ssq, u.pm * 256 + wr * 64, fr, fq, rs);
        const int t = u.pn;
        if (t == 13) gates(acc, u, wr, wc, fr, fq, rs);
        else if (t == 3) body<1>(acc, u, wr, wc, fr, fq, rs);
        else if (t == 4 || t == 5) body<2>(acc, u, wr, wc, fr, fq, rs);
        else if (t == 10 || t == 11) body<3>(acc, u, wr, wc, fr, fq, rs);
        else body<0>(acc, u, wr, wc, fr, fq, rs);
    }
};
#define MFMA16(a, b, c) __builtin_amdgcn_mfma_f32_16x16x32_bf16((a), (b), (c), 0, 0, 0)
#define WAVE_SYNC() do { asm volatile("s_waitcnt lgkmcnt(0)" ::: "memory"); __builtin_amdgcn_wave_barrier(); } while (0)
#define LDS_BARRIER() do { asm volatile("s_waitcnt lgkmcnt(0)" ::: "memory"); __builtin_amdgcn_s_barrier(); asm volatile("" ::: "memory"); } while (0)
__device__ __forceinline__ bf16x8 ld_g8(const bf16_t* p) { return *(const bf16x8*)p; }
__device__ __forceinline__ bf16x8 ld_l8(const LAS bf16_t* p) { return *(const LAS bf16x8*)p; }
__device__ __forceinline__ bf16x8 ld_l44(const LAS bf16_t* p0, const LAS bf16_t* p1) { const bf16x4 a = *(const LAS bf16x4*)p0, b = *(const LAS bf16x4*)p1; return (bf16x8){a[0], a[1], a[2], a[3], b[0], b[1], b[2], b[3]}; }
__device__ __forceinline__ bf16x8 pack8(const f32x4 a, const f32x4 b) { u32x4 w; w.x = cvtpk(a[0], a[1]); w.y = cvtpk(a[2], a[3]); w.z = cvtpk(b[0], b[1]); w.w = cvtpk(b[2], b[3]); return __builtin_bit_cast(bf16x8, w); }
__device__ __forceinline__ float wave_scan_incl(float v, int lane) {
#pragma unroll
    for (int o = 1; o < 64; o <<= 1) { const float t = __shfl_up(v, o); if (lane >= o) v += t; }
    return v;
}

typedef short v4i16_t __attribute__((ext_vector_type(4)));
__device__ __forceinline__ bf16x8 ld_tr8(const LAS bf16_t* T, int pitch, int k0, int c0, int lane) {
    const int i = lane & 15, fq = lane >> 4;
    const LAS bf16_t* p = T + (k0 + 8 * fq + (i >> 2)) * pitch + c0 + 4 * (i & 3);
    const v4i16_t lo = __builtin_amdgcn_ds_read_tr16_b64_v4i16((LAS v4i16_t*)p), hi = __builtin_amdgcn_ds_read_tr16_b64_v4i16((LAS v4i16_t*)(p + 4 * pitch));
    return (bf16x8){lo[0], lo[1], lo[2], lo[3], hi[0], hi[1], hi[2], hi[3]};
}
__device__ __forceinline__ bf16x8 ld_tr8p(const LAS bf16_t* T, int pitch, int k0, int c0, int lane) {
    const int i = lane & 15, fq = lane >> 4;
    const LAS bf16_t* p = T + (k0 + 4 * fq + (i >> 2)) * pitch + c0 + 4 * (i & 3);
    const v4i16_t lo = __builtin_amdgcn_ds_read_tr16_b64_v4i16((LAS v4i16_t*)p), hi = __builtin_amdgcn_ds_read_tr16_b64_v4i16((LAS v4i16_t*)(p + 16 * pitch));
    return (bf16x8){lo[0], lo[1], lo[2], lo[3], hi[0], hi[1], hi[2], hi[3]};
}

__device__ __forceinline__ void conv_phase(Frame& F, int l) {
    const bf16_t* PROJ = (const bf16_t*)(F.ws + WS_PROJ); bf16_t* XACT = (bf16_t*)F.in[25];
    const float* cw = F.in[9] + (size_t)l * 4 * 1024; const float* cb = F.in[10] + (size_t)l * 1024;
    for (int g = F.vcu * NTHREADS + F.tid; g < 1024 * 128; g += F.G * NTHREADS) {
        const int cg = g & 127, rb = g >> 7, ch0 = cg * 8, row0 = rb * 16;
        float w[4][8], bs[8];
#pragma unroll
        for (int j = 0; j < 4; ++j) { const f32x4 a = *(const f32x4*)(cw + j * 1024 + ch0), b = *(const f32x4*)(cw + j * 1024 + ch0 + 4);
            w[j][0] = a.x; w[j][1] = a.y; w[j][2] = a.z; w[j][3] = a.w; w[j][4] = b.x; w[j][5] = b.y; w[j][6] = b.z; w[j][7] = b.w; }
        { const f32x4 a = *(const f32x4*)(cb + ch0), b = *(const f32x4*)(cb + ch0 + 4); bs[0] = a.x; bs[1] = a.y; bs[2] = a.z; bs[3] = a.w; bs[4] = b.x; bs[5] = b.y; bs[6] = b.z; bs[7] = b.w; }
        float h3[8], h2[8], h1[8];
        const bool first = (row0 % SEQ) == 0;
        const bf16_t* src = PROJ + (size_t)row0 * PLD + PX + ch0;
        if (first) {
#pragma unroll
            for (int e = 0; e < 8; ++e) { h3[e] = 0.f; h2[e] = 0.f; h1[e] = 0.f; }
        } else {
            const u32x4 a = *(const u32x4*)(src - 3 * (size_t)PLD), b = *(const u32x4*)(src - 2 * (size_t)PLD), c = *(const u32x4*)(src - (size_t)PLD);
#pragma unroll
            for (int e = 0; e < 4; ++e) { h3[2 * e] = bflo(a[e]); h3[2 * e + 1] = bfhi(a[e]); h2[2 * e] = bflo(b[e]); h2[2 * e + 1] = bfhi(b[e]); h1[2 * e] = bflo(c[e]); h1[2 * e + 1] = bfhi(c[e]); }
        }
        u32x4 dr[16];
#pragma unroll
        for (int i = 0; i < 16; ++i) dr[i] = *(const u32x4*)(src + (size_t)i * PLD);
#pragma unroll
        for (int i = 0; i < 16; ++i) {
            const u32x4 d = dr[i]; float cur[8], o[8];
#pragma unroll
            for (int e = 0; e < 4; ++e) { cur[2 * e] = bflo(d[e]); cur[2 * e + 1] = bfhi(d[e]); }
#pragma unroll
            for (int e = 0; e < 8; ++e) { const float s = bs[e] + w[0][e] * h3[e] + w[1][e] * h2[e] + w[2][e] * h1[e] + w[3][e] * cur[e]; o[e] = siluf_(s); h3[e] = h2[e]; h2[e] = h1[e]; h1[e] = cur[e]; }
            u32x4 ow; ow.x = cvtpk(o[0], o[1]); ow.y = cvtpk(o[2], o[3]); ow.z = cvtpk(o[4], o[5]); ow.w = cvtpk(o[6], o[7]);
            *(u32x4*)(XACT + (size_t)(row0 + i) * 1024 + ch0) = ow;
        }
    }
}

__device__ __forceinline__ void mlstm_state_item(Frame& F, int bh) {
    const int b = bh >> 2, h = bh & 3, w = F.wave, vq = w & 3, dh = w >> 2, lane = F.lane, fr = lane & 15, fq = lane >> 4, tid = F.tid;
    constexpr int MP = 72, MBUF = 2 * 64 * MP * 2 + 128;
    LAS float* WG = (LAS float*)(F.lds + 2 * MBUF); LAS float* DEC = WG + 4096;
    const bf16_t* PROJ = (const bf16_t*)(F.ws + WS_PROJ); const float* GATES = (const float*)(F.ws + WS_GATES);
    bf16_t* CST = (bf16_t*)(F.ws + WS_CST); float* NST = (float*)(F.ws + WS_NST);
    const size_t rowb = (size_t)b * SEQ;
    {
        float igv[8], lfv[8];
#pragma unroll
        for (int i = 0; i < 8; ++i) { const float* gq = GATES + (rowb + 64 * (w + 8 * i) + lane) * 16 + h; igv[i] = gq[0]; lfv[i] = gq[4]; }
#pragma unroll
        for (int i = 0; i < 8; ++i) { const int c = w + 8 * i;
            const float bs = wave_scan_incl(lfv[i], lane); const float bl = __shfl(bs, 63);
            WG[64 * c + lane] = fast_exp(bl - bs + igv[i]); if (lane == 0) DEC[c] = fast_exp(bl); }
    }
    f32x4 acc[2], nacc[2];
    acc[0] = acc[1] = nacc[0] = nacc[1] = (f32x4){0.f, 0.f, 0.f, 0.f};
    const int ls = tid >> 3, lc = tid & 7;
    const bf16_t* kp = PROJ + (rowb + ls) * PLD + PK + h * 64 + 8 * lc; const bf16_t* vp = PROJ + (rowb + ls) * PLD + PV + h * 64 + 8 * lc;
    u32x4 k0, v0, k1, v1, k2, v2;
#define ML_LOAD(kr_, vr_, c_) do { const size_t o_ = (size_t)(c_) * 64 * PLD; kr_ = *(const u32x4*)(kp + o_); vr_ = *(const u32x4*)(vp + o_); } while (0)
#define ML_WRITE(kr_, vr_, c_) do { LAS bf16_t* KL_ = (LAS bf16_t*)(F.lds + ((c_) & 1) * MBUF); LAS bf16_t* VL_ = KL_ + 64 * MP; const float wg_ = WG[64 * (c_) + ls]; \
        *(LAS u32x4*)(KL_ + ls * MP + 8 * lc) = kr_; u32x4 o_; _Pragma("unroll") for (int e_ = 0; e_ < 4; ++e_) o_[e_] = cvtpk(wg_ * bflo(vr_[e_]), wg_ * bfhi(vr_[e_])); \
        *(LAS u32x4*)(VL_ + ls * MP + 8 * lc) = o_; if (lc == 0) (VL_ + 64 * MP)[ls] = f2bf(wg_); } while (0)
    LAS bf16_t* STG = (LAS bf16_t*)(F.lds + 2 * MBUF + 16384 + 256); LAS float* NSTG = (LAS float*)(STG + 2 * 4096);
#define ML_STAGE(c_) do { LAS bf16_t* sg_ = STG + ((c_) & 1) * 4096; \
        _Pragma("unroll") for (int dt = 0; dt < 2; ++dt) _Pragma("unroll") for (int r = 0; r < 4; ++r) sg_[(vq * 16 + 4 * fq + r) * 64 + dh * 32 + dt * 16 + fr] = f2bf(acc[dt][r]); \
        if (vq == 0 && fq == 0) { NSTG[((c_) & 1) * 64 + dh * 32 + fr] = nacc[0][0]; NSTG[((c_) & 1) * 64 + dh * 32 + 16 + fr] = nacc[1][0]; } } while (0)
    ML_LOAD(k0, v0, 0); ML_LOAD(k1, v1, 1); ML_LOAD(k2, v2, 2);
    __syncthreads();
    ML_WRITE(k0, v0, 0);
    ML_STAGE(0);
    LDS_BARRIER();
#define ML_STEP(KW, VW, KN, VN, c_) do { const int cc_ = (c_); const size_t ci = (size_t)bh * 64 + cc_; \
          \
        { const u32x4 st_ = *(const LAS u32x4*)(STG + ((cc_) & 1) * 4096 + tid * 8); *(u32x4*)(CST + ci * 4096 + tid * 8) = st_; \
          NST[ci * 64 + (tid & 63)] = NSTG[((cc_) & 1) * 64 + (tid & 63)]; }     \
        asm volatile("" ::: "memory"); \
        if (cc_ + 1 < 64) ML_WRITE(KW, VW, cc_ + 1); \
        asm volatile("" ::: "memory"); \
        ML_LOAD(KN, VN, (cc_ + 3 < 64 ? cc_ + 3 : 63)); \
        asm volatile("" ::: "memory"); \
        const float decay = DEC[cc_]; \
        const LAS bf16_t* KL = (const LAS bf16_t*)(F.lds + (cc_ & 1) * MBUF); const LAS bf16_t* VL = KL + 64 * MP; const LAS bf16_t* WV = VL + 64 * MP; \
        _Pragma("unroll") for (int dt = 0; dt < 2; ++dt) { acc[dt] = acc[dt] * decay; nacc[dt] = nacc[dt] * decay; } \
        _Pragma("unroll") for (int ks = 0; ks < 2; ++ks) { \
            const bf16x8 A = ld_tr8(VL, MP, 32 * ks, 16 * vq, lane); \
            bf16x8 An = ld_l8(WV + 32 * ks + 8 * fq); if (fr != 0) An = (bf16x8){0, 0, 0, 0, 0, 0, 0, 0}; \
            _Pragma("unroll") for (int dt = 0; dt < 2; ++dt) { const bf16x8 B = ld_tr8(KL, MP, 32 * ks, 32 * dh + 16 * dt, lane); \
                acc[dt] = MFMA16(A, B, acc[dt]); if (vq == 0) nacc[dt] = MFMA16(An, B, nacc[dt]); } } \
        ML_STAGE(cc_ + 1); \
        LDS_BARRIER(); } while (0)
    for (int c = 0; c < 63; c += 3) { ML_STEP(k1, v1, k0, v0, c); ML_STEP(k2, v2, k1, v1, c + 1); ML_STEP(k0, v0, k2, v2, c + 2); }
    ML_STEP(k1, v1, k0, v0, 63);
#undef ML_STEP
#undef ML_LOAD
#undef ML_WRITE
#undef ML_STAGE
}

template <int TH>
__device__ __forceinline__ void mlstm_out_wave(Frame& F, int l, int bc, int h) {
    const int b = bc >> 6, c = bc & 63, w = F.wave, lane = F.lane, fr = lane & 15, fq = lane >> 4;
    constexpr int VP = 72;
    LAS bf16_t* VL = (LAS bf16_t*)(F.lds + w * 12288); LAS float* BT_ = (LAS float*)(F.lds + w * 12288 + 9216); LAS float* GS = BT_ + 64;
    LAS bf16_t* YS = VL;
    const bf16_t* PROJ = (const bf16_t*)(F.ws + WS_PROJ); const float* GATES = (const float*)(F.ws + WS_GATES);
    const bf16_t* CST = (const bf16_t*)(F.ws + WS_CST); const float* NST = (const float*)(F.ws + WS_NST);
    bf16_t* Y = (bf16_t*)(F.ws + WS_PROJ) + PX;
    const size_t row0 = (size_t)b * SEQ + 64 * c; const size_t ci = (size_t)(b * 4 + h) * 64 + c;
    constexpr int NST_ = 2 * TH + 2, NKK = TH + 1;
    {
        const size_t row = row0 + lane;
        const float ig = GATES[row * 16 + h], lf = GATES[row * 16 + 4 + h];
        const bf16_t* vp = PROJ + row * PLD + PV + h * 64;
        u32x4 vr[8];
#pragma unroll
        for (int i = 0; i < 8; ++i) vr[i] = *(const u32x4*)(vp + 8 * i);
        const float bs = wave_scan_incl(lf, lane);
        BT_[lane] = bs; GS[lane] = ig - bs;
#pragma unroll
        for (int i = 0; i < 8; ++i) *(LAS u32x4*)(VL + lane * VP + 8 * i) = vr[i];
    }
    bf16x8 Qf[2][2], Kf[NST_][2];
#pragma unroll
    for (int tt = 0; tt < 2; ++tt)
#pragma unroll
        for (int ks = 0; ks < 2; ++ks) Qf[tt][ks] = ld_g8(PROJ + (row0 + 32 * TH + 16 * tt + fr) * PLD + PQ + h * 64 + 32 * ks + 8 * fq);
#pragma unroll
    for (int st = 0; st < NST_; ++st)
#pragma unroll
        for (int ks = 0; ks < 2; ++ks) Kf[st][ks] = ld_g8(PROJ + (row0 + 16 * st + fr) * PLD + PK + h * 64 + 32 * ks + 8 * fq);
    bf16x8 Cf[4][2];
#pragma unroll
    for (int vt = 0; vt < 4; ++vt)
#pragma unroll
        for (int ks = 0; ks < 2; ++ks) Cf[vt][ks] = ld_g8(CST + ci * 4096 + (16 * vt + fr) * 64 + 32 * ks + 8 * fq);
    u32x4 ogv[4];
#pragma unroll
    for (int i = 0; i < 4; ++i) ogv[i] = *(const u32x4*)(PROJ + (row0 + 32 * TH + (lane >> 3) + 8 * i) * PLD + PO + h * 64 + 8 * (lane & 7));
    f32x4 nv[2][2];
#pragma unroll
    for (int ks = 0; ks < 2; ++ks) { nv[ks][0] = *(const f32x4*)(NST + ci * 64 + 32 * ks + 8 * fq); nv[ks][1] = *(const f32x4*)(NST + ci * 64 + 32 * ks + 8 * fq + 4); }
    WAVE_SYNC();
    f32x4 P[2][NST_]; float den[2];
#pragma unroll
    for (int tt = 0; tt < 2; ++tt) {
        const int t = 32 * TH + 16 * tt + fr; const float bt = BT_[t]; float d1 = 0.f;
#pragma unroll
        for (int st = 0; st < NST_; ++st) {
            f32x4 s = (f32x4){0.f, 0.f, 0.f, 0.f};
#pragma unroll
            for (int ks = 0; ks < 2; ++ks) s = MFMA16(Kf[st][ks], Qf[tt][ks], s);
#pragma unroll
            for (int r = 0; r < 4; ++r) { const int sidx = 16 * st + 4 * fq + r; const float wv = (sidx <= t) ? s[r] * fast_exp(bt + GS[sidx]) : 0.f; s[r] = wv; d1 += wv; }
            P[tt][st] = s;
        }
        d1 += __shfl_xor(d1, 16); d1 += __shfl_xor(d1, 32);
        float d2 = 0.f;
#pragma unroll
        for (int ks = 0; ks < 2; ++ks) { const f32x4 n0 = nv[ks][0], n1 = nv[ks][1];
            const u32x4 qw = __builtin_bit_cast(u32x4, Qf[tt][ks]);
            d2 += bflo(qw.x) * n0.x + bfhi(qw.x) * n0.y + bflo(qw.y) * n0.z + bfhi(qw.y) * n0.w + bflo(qw.z) * n1.x + bfhi(qw.z) * n1.y + bflo(qw.w) * n1.z + bfhi(qw.w) * n1.w; }
        d2 += __shfl_xor(d2, 16); d2 += __shfl_xor(d2, 32);
        den[tt] = d1 + fast_exp(bt) * d2;
    }
    const float* nw = F.in[8] + (size_t)l * 256 + h * 64;
    f32x4 acc[2][4];
#pragma unroll
    for (int tt = 0; tt < 2; ++tt) {
#pragma unroll
        for (int vt = 0; vt < 4; ++vt) { acc[tt][vt] = (f32x4){0.f, 0.f, 0.f, 0.f};
#pragma unroll
            for (int ks = 0; ks < 2; ++ks) acc[tt][vt] = MFMA16(Qf[tt][ks], Cf[vt][ks], acc[tt][vt]); }
        float eb[4], dr[4];
#pragma unroll
        for (int r = 0; r < 4; ++r) { eb[r] = fast_exp(BT_[32 * TH + 16 * tt + 4 * fq + r]); dr[r] = __shfl(den[tt], 4 * fq + r); }
#pragma unroll
        for (int vt = 0; vt < 4; ++vt)
#pragma unroll
            for (int r = 0; r < 4; ++r) acc[tt][vt][r] *= eb[r];
#pragma unroll
        for (int kk = 0; kk < NKK; ++kk) { const bf16x8 PA = pack8(P[tt][2 * kk], P[tt][2 * kk + 1]);
            bf16x8 Bv[4];
#pragma unroll
            for (int vt = 0; vt < 4; ++vt) Bv[vt] = ld_tr8p(VL, VP, 32 * kk, 16 * vt, lane);
#pragma unroll
            for (int vt = 0; vt < 4; ++vt) acc[tt][vt] = MFMA16(PA, Bv[vt], acc[tt][vt]); }
#pragma unroll
        for (int r = 0; r < 4; ++r) { const float inv = fast_rcp(fmaxf(fabsf(dr[r]), 1.0f)); float s = 0.f;
#pragma unroll
            for (int vt = 0; vt < 4; ++vt) { acc[tt][vt][r] *= inv; s += acc[tt][vt][r] * acc[tt][vt][r]; }
            s += __shfl_xor(s, 1); s += __shfl_xor(s, 2); s += __shfl_xor(s, 4); s += __shfl_xor(s, 8); const float rs = rsqrtf(s * (1.0f / 64.0f) + NORM_EPS);
#pragma unroll
            for (int vt = 0; vt < 4; ++vt) acc[tt][vt][r] *= rs * nw[16 * vt + fr]; }
    }
    WAVE_SYNC();
#pragma unroll
    for (int tt = 0; tt < 2; ++tt)
#pragma unroll
        for (int vt = 0; vt < 4; ++vt)
#pragma unroll
            for (int r = 0; r < 4; ++r) YS[(16 * tt + 4 * fq + r) * VP + 16 * vt + fr] = f2bf(acc[tt][vt][r]);
    WAVE_SYNC();
#pragma unroll
    for (int i = 0; i < 4; ++i) { const int tr_ = (lane >> 3) + 8 * i, ch = lane & 7; const size_t row = row0 + 32 * TH + tr_;
        const u32x4 yv = *(const LAS u32x4*)(YS + tr_ * VP + 8 * ch); const u32x4 gv = ogv[i]; u32x4 o;
#pragma unroll
        for (int e = 0; e < 4; ++e) o[e] = cvtpk(bflo(yv[e]) * bflo(gv[e]), bfhi(yv[e]) * bfhi(gv[e]));
        *(u32x4*)(Y + row * PLD + h * 64 + 8 * ch) = o; }
    WAVE_SYNC();
}
__device__ __forceinline__ void mlstm_out_item(Frame& F, int l, int bc) {
    const int h = F.wave >> 1;
    if (F.wave & 1) mlstm_out_wave<1>(F, l, bc, h); else mlstm_out_wave<0>(F, l, bc, h);
}
typedef float f32x16 __attribute__((ext_vector_type(16)));
#define MFMA32(a, b, c) __builtin_amdgcn_mfma_f32_32x32x16_bf16((a), (b), (c), 0, 0, 0)
constexpr int AK_STR = 72, AV_STR = 96;
constexpr int ATT_KB = 128 * AK_STR * 2, ATT_VB = 128 * AV_STR * 2, ATT_BUF = ATT_KB + ATT_VB;
constexpr int ATT_TAB_OFF = 2 * ATT_BUF;
__device__ __forceinline__ int t5_bucket(int n) {
    if (n < 16) return n;
    int bk = 16;
    bk += (n >= 19); bk += (n >= 21); bk += (n >= 24); bk += (n >= 27); bk += (n >= 31); bk += (n >= 35); bk += (n >= 40); bk += (n >= 46);
    bk += (n >= 52); bk += (n >= 59); bk += (n >= 67); bk += (n >= 77); bk += (n >= 87); bk += (n >= 99); bk += (n >= 113);
    return bk;
}
__device__ __forceinline__ int crow16(int reg, int hi) { return (reg & 3) + 8 * (reg >> 2) + 4 * hi; }
__device__ __forceinline__ bf16x8 pack8r(const f32x16& p, const int s) { u32x4 w; w.x = cvtpk(p[8 * s], p[8 * s + 1]); w.y = cvtpk(p[8 * s + 2], p[8 * s + 3]); w.z = cvtpk(p[8 * s + 4], p[8 * s + 5]); w.w = cvtpk(p[8 * s + 6], p[8 * s + 7]); return __builtin_bit_cast(bf16x8, w); }
__device__ __forceinline__ void epilogue_attn(Frame& F, int l, int bh, int qi, f32x16 (&O1)[2], f32x16 (&O2)[2], float l1, float l2);
__device__ __forceinline__ void attn_item(Frame& F, int l, int bh, int qi, const bool prefetch_next) {
    const int b = bh >> 2, h = bh & 3, w = F.wave, lane = F.lane, tid = F.tid, r32 = lane & 31, hi = lane >> 5, qq = w & 3, kh = w >> 2;
#ifdef PROBE_A
    const unsigned long long tp0_ = __builtin_amdgcn_s_memrealtime();
#endif
    const bf16_t* PROJ = (const bf16_t*)(F.ws + WS_PROJ); bf16_t* Y = (bf16_t*)(F.ws + WS_PROJ) + PX;
    LAS float* TAB = (LAS float*)(F.lds + ATT_TAB_OFF);
    LAS bf16_t* QL = (LAS bf16_t*)(F.lds + ATT_TAB_OFF + 2048);
    const size_t row0 = (size_t)b * SEQ; const int q0 = qi * 128;
    unsigned nxq_ = 0u; if (prefetch_next && qi < 2 && tid == 0) nxq_ = xb_add(F.ctl + CW_Q + 64 * (2 * l), 1u);
    if (tid < 384) { const int rel = tid - 128; const float cf = F.in[19][31 * 4 + h]; TAB[tid] = rel < 0 ? -1e30f : (F.in[19][t5_bucket(rel) * 4 + h] - cf) * LOG2E; }
    const int npairs = qi + 1;
    const int lk = tid >> 3, lc = tid & 7;
    const bf16_t* kg = PROJ + (row0 + lk) * PLD + PDK + h * 64 + 8 * lc; const bf16_t* vg = PROJ + (row0 + lk) * PLD + PDV + h * 64 + 8 * lc;
    u32x4 ka0, ka1, va0, va1;
#define ATT_WRITE(k0_, k1_, v0_, v1_, buf) do { LAS bf16_t* KL_ = (LAS bf16_t*)(F.lds + (buf) * ATT_BUF); LAS bf16_t* VL_ = (LAS bf16_t*)(F.lds + (buf) * ATT_BUF + ATT_KB); \
        *(LAS u32x4*)(KL_ + lk * AK_STR + 8 * lc) = k0_; *(LAS u32x4*)(KL_ + (lk + 64) * AK_STR + 8 * lc) = k1_; \
        *(LAS u32x4*)(VL_ + lk * AV_STR + 8 * lc) = v0_; *(LAS u32x4*)(VL_ + (lk + 64) * AV_STR + 8 * lc) = v1_; } while (0)
#define ATT_LOAD(k0_, k1_, v0_, v1_, p) do { const size_t o_ = (size_t)(p) * 128 * PLD; k0_ = *(const u32x4*)(kg + o_); k1_ = *(const u32x4*)(kg + o_ + (size_t)64 * PLD); v0_ = *(const u32x4*)(vg + o_); v1_ = *(const u32x4*)(vg + o_ + (size_t)64 * PLD); } while (0)
    ATT_LOAD(ka0, ka1, va0, va1, 0);
    {
        const bf16_t* qg = PROJ + (row0 + q0 + lk) * PLD + PDQ + h * 64 + 8 * lc;
        const u32x4 q0r = *(const u32x4*)qg, q1r = *(const u32x4*)(qg + (size_t)64 * PLD);
        *(LAS u32x4*)(QL + lk * AK_STR + 8 * lc) = q0r; *(LAS u32x4*)(QL + (lk + 64) * AK_STR + 8 * lc) = q1r; }
    ATT_WRITE(ka0, ka1, va0, va1, 0);
    if (npairs > 1) ATT_LOAD(ka0, ka1, va0, va1, 1);
    const int qrow = q0 + 32 * qq + r32;
    f32x16 O1[2], O2[2];
#pragma unroll
    for (int i = 0; i < 16; ++i) { O1[0][i] = 0.f; O1[1][i] = 0.f; O2[0][i] = 0.f; O2[1][i] = 0.f; }
    f32x4 L1 = {0.f, 0.f, 0.f, 0.f}, L2 = {0.f, 0.f, 0.f, 0.f};
    __syncthreads();
    const f32x16 cinit = {0.f, 0.f, 0.f, 0.f, 0.f, 0.f, 0.f, 0.f, 0.f, 0.f, 0.f, 0.f, 0.f, 0.f, 0.f, 0.f};
    const int vlane = (4 * hi + ((lane & 15) >> 2)) * AV_STR + 16 * ((lane >> 4) & 1) + 4 * (lane & 3);
    const LAS bf16_t* qlp = QL + (32 * qq + r32) * AK_STR + 8 * hi;
#ifdef PROBE_SECTIONS
    unsigned long long dA_ = 0, dB_ = 0, dC_ = 0;
#define ATT_T(x_) const unsigned long long x_ = __builtin_amdgcn_s_memtime()
#define ATT_TW(x_) asm volatile("s_waitcnt lgkmcnt(0)" ::: "memory"); const unsigned long long x_ = __builtin_amdgcn_s_memtime()
#define ATT_TACC() do { dA_ += tb_ - ta_; dB_ += tc_ - tb_; dC_ += td_ - tc_; } while (0)
#else
#define ATT_T(x_) do {} while (0)
#define ATT_TW(x_) do {} while (0)
#define ATT_TACC() do {} while (0)
#endif
#define ATT_EXP(S1_, S2_, sub_, NEAR_) do { \
        _Pragma("unroll") for (int r = 0; r < 16; ++r) { S1_[r] = __builtin_amdgcn_exp2f(S1_[r]); S2_[r] = __builtin_amdgcn_exp2f(S2_[r]); } \
        _Pragma("unroll") for (int r = 0; r < 16; r += 4) { L1 += (f32x4){S1_[r], S1_[r + 1], S1_[r + 2], S1_[r + 3]}; L2 += (f32x4){S2_[r], S2_[r + 1], S2_[r + 2], S2_[r + 3]}; } } while (0)
#define ATT_VLOAD(Vf_, sub_) do { _Pragma("unroll") for (int s = 0; s < 2; ++s) _Pragma("unroll") for (int vt = 0; vt < 2; ++vt) { const LAS bf16_t* vp = VL + (32 * (sub_) + 16 * s) * AV_STR + 32 * vt + vlane; \
            const v4i16_t lo = __builtin_amdgcn_ds_read_tr16_b64_v4i16((LAS v4i16_t*)vp), hi4 = __builtin_amdgcn_ds_read_tr16_b64_v4i16((LAS v4i16_t*)(vp + 8 * AV_STR)); \
            Vf_[s][vt] = (bf16x8){lo[0], lo[1], lo[2], lo[3], hi4[0], hi4[1], hi4[2], hi4[3]}; } } while (0)
#define ATT_PV(S1_, S2_, Vf_) do { _Pragma("unroll") for (int s = 0; s < 2; ++s) { const bf16x8 PA1 = pack8r(S1_, s), PA2 = pack8r(S2_, s); \
            _Pragma("unroll") for (int vt = 0; vt < 2; ++vt) { O1[vt] = MFMA32(PA1, Vf_[s][vt], O1[vt]); O2[vt] = MFMA32(PA2, Vf_[s][vt], O2[vt]); } } } while (0)
#define ATT_ITER(k0_, k1_, v0_, v1_, p_, NEAR_) do { const int p = (p_); ATT_T(ta_); \
        if (kh == 0 && p + 1 < npairs) { ATT_WRITE(k0_, k1_, v0_, v1_, (p + 1) & 1); }     \
        if (!(NEAR_) && prefetch_next && p + 2 == qi && tid == 0) nxq_ = xb_add(F.ctl + CW_Q + 64 * (2 * l), 1u);     \
        if (kh == 0 && p + 2 < npairs) { ATT_LOAD(k0_, k1_, v0_, v1_, p + 2); } \
        ATT_TW(tb_); \
        const int k0 = 128 * p + 64 * kh; \
        if (!(NEAR_) || k0 <= q0 + 32 * qq + 31) { \
            const LAS bf16_t* KL = (const LAS bf16_t*)(F.lds + (p & 1) * ATT_BUF) + 64 * kh * AK_STR; const LAS bf16_t* VL = (const LAS bf16_t*)(F.lds + (p & 1) * ATT_BUF + ATT_KB) + 64 * kh * AV_STR; \
            f32x16 SA1, SA2, SB1, SB2, CA = cinit, CB = cinit; \
            if (NEAR_) { const LAS float* tb_ = TAB + (qrow - 4 * hi - k0 + 101);     \
                _Pragma("unroll") for (int r = 0; r < 16; ++r) { CA[r] = tb_[27 - ((r & 3) + 8 * (r >> 2))]; CB[r] = tb_[27 - 32 - ((r & 3) + 8 * (r >> 2))]; } } \
            {   const bf16x8 Q00 = ld_l8(qlp), Q01 = ld_l8(qlp + 16), Q10 = ld_l8(qlp + 32), Q11 = ld_l8(qlp + 48); \
                const LAS bf16_t* kp = KL + r32 * AK_STR + 8 * hi; \
                const bf16x8 a10 = ld_l8(kp), a11 = ld_l8(kp + 16), a20 = ld_l8(kp + 32), a21 = ld_l8(kp + 48); \
                const bf16x8 b10 = ld_l8(kp + 32 * AK_STR), b11 = ld_l8(kp + 32 * AK_STR + 16), b20 = ld_l8(kp + 32 * AK_STR + 32), b21 = ld_l8(kp + 32 * AK_STR + 48); \
                SA1 = MFMA32(a10, Q00, CA); SA2 = MFMA32(a20, Q10, CA); SA1 = MFMA32(a11, Q01, SA1); SA2 = MFMA32(a21, Q11, SA2); \
                SB1 = MFMA32(b10, Q00, CB); SB2 = MFMA32(b20, Q10, CB); SB1 = MFMA32(b11, Q01, SB1); SB2 = MFMA32(b21, Q11, SB2); } \
            bf16x8 Vf[2][2], Vg[2][2]; \
            ATT_VLOAD(Vf, 0); ATT_VLOAD(Vg, 1); \
            ATT_EXP(SA1, SA2, 0, NEAR_); \
            ATT_PV(SA1, SA2, Vf); \
            ATT_EXP(SB1, SB2, 1, NEAR_); \
            ATT_PV(SB1, SB2, Vg); \
            {   \
                __builtin_amdgcn_sched_group_barrier(0x8, 4, 0); \
                _Pragma("unroll") for (int g_ = 0; g_ < 4; ++g_) { __builtin_amdgcn_sched_group_barrier(0x8, 1, 0); __builtin_amdgcn_sched_group_barrier(0x400, 8, 0); } \
                __builtin_amdgcn_sched_group_barrier(0x2, 24, 0); \
                _Pragma("unroll") for (int g_ = 0; g_ < 8; ++g_) { __builtin_amdgcn_sched_group_barrier(0x8, 1, 0); __builtin_amdgcn_sched_group_barrier(0x400, 4, 0); __builtin_amdgcn_sched_group_barrier(0x2, 2, 0); } } \
        } \
        ATT_T(tc_); \
        if (kh == 1 && p + 1 < npairs) { ATT_WRITE(k0_, k1_, v0_, v1_, (p + 1) & 1); } \
        if (kh == 1 && p + 2 < npairs) { ATT_LOAD(k0_, k1_, v0_, v1_, p + 2); } \
        LDS_BARRIER(); ATT_T(td_); ATT_TACC(); } while (0)
#ifdef PROBE_A
    if (lane == 0) atomicMax(F.ctl + 32768 + 64 * (11 + 16 * l), (unsigned)(__builtin_amdgcn_s_memrealtime() - tp0_));
#endif
    int pp = 0;
    for (; pp + 1 < qi; ++pp) ATT_ITER(ka0, ka1, va0, va1, pp, 0);
    for (; pp < npairs; ++pp) ATT_ITER(ka0, ka1, va0, va1, pp, 1);
    if (prefetch_next && tid == 0) F.MISC[17] = nxq_;
#undef ATT_EXP
#undef ATT_VLOAD
#undef ATT_PV
#undef ATT_ITER
#ifdef PROBE_SECTIONS
    if (qi == 31 && lane == 0) { atomicMax(F.ctl + 32768 + 64 * (8 + 16 * l), (unsigned)(dA_ / 32) * 10u); atomicMax(F.ctl + 32768 + 64 * (9 + 16 * l), (unsigned)(dB_ / 32) * 10u); atomicMax(F.ctl + 32768 + 64 * (10 + 16 * l), (unsigned)(dC_ / 32) * 10u); }
#endif
#undef ATT_WRITE
#undef ATT_LOAD
    float l1 = (L1.x + L1.y) + (L1.z + L1.w), l2 = (L2.x + L2.y) + (L2.z + L2.w);
    epilogue_attn(F, l, bh, qi, O1, O2, l1, l2);
}
__device__ __forceinline__ void epilogue_attn(Frame& F, int l, int bh, int qi, f32x16 (&O1)[2], f32x16 (&O2)[2], float l1, float l2) {
    int t3 = threadIdx.x; asm volatile("" : "+v"(t3));
    const int lane = t3 & 63, w = __builtin_amdgcn_readfirstlane(t3 >> 6), r32 = lane & 31, hi = lane >> 5, qq = w & 3, kh = w >> 2, b = bh >> 2, h = bh & 3;
    bf16_t* Y = (bf16_t*)(F.ws + WS_PROJ) + PX;
    const size_t row0 = (size_t)b * SEQ; const int q0 = qi * 128;
    LAS float* XCH = (LAS float*)F.lds + (size_t)qq * 66 * 64 + lane;
    if (kh == 1) {
#pragma unroll
        for (int vt = 0; vt < 2; ++vt)
#pragma unroll
            for (int r = 0; r < 16; ++r) { XCH[(vt * 16 + r) * 64] = O1[vt][r]; XCH[(32 + vt * 16 + r) * 64] = O2[vt][r]; }
        XCH[64 * 64] = l1; XCH[65 * 64] = l2;
    }
    __syncthreads();
    if (kh == 0) {
        const float* lm = F.in[17] + (size_t)l * 128;
        float d1 = (lane < 32) ? lm[lane] * lm[32 + lane] : 0.f, d2 = (lane < 32) ? lm[64 + lane] * lm[96 + lane] : 0.f;
        d1 = wave_sum(d1); d2 = wave_sum(d2);
        int lq = l; asm volatile("" : "+s"(lq));
        const float lam_init = (lq == 0) ? 0.2f : 0.35550906759f;
        const float lam = __int_as_float(__builtin_amdgcn_readfirstlane(__float_as_int(fast_exp(d1) - fast_exp(d2) + lam_init)));
#pragma unroll
        for (int vt = 0; vt < 2; ++vt)
#pragma unroll
            for (int r = 0; r < 16; ++r) { O1[vt][r] += XCH[(vt * 16 + r) * 64]; O2[vt][r] += XCH[(32 + vt * 16 + r) * 64]; }
        l1 += XCH[64 * 64]; l2 += XCH[65 * 64];
        l1 += __shfl_xor(l1, 32); l2 += __shfl_xor(l2, 32);
        const float i1 = fast_rcp(l1), i2 = lam * fast_rcp(l2);
        const float* sw = F.in[18] + (size_t)l * 64; const float osc = 1.0f - lam_init;
        const float sw0 = sw[r32], sw1 = sw[32 + r32];
#pragma unroll
        for (int r = 0; r < 16; ++r) {
            const int qr = crow16(r, hi);
            const float a1 = __shfl(i1, qr), a2 = __shfl(i2, qr);
            const float o0 = O1[0][r] * a1 - O2[0][r] * a2, o1 = O1[1][r] * a1 - O2[1][r] * a2;
            float s = o0 * o0 + o1 * o1;
            s += __shfl_xor(s, 1); s += __shfl_xor(s, 2); s += __shfl_xor(s, 4); s += __shfl_xor(s, 8); s += __shfl_xor(s, 16);
            const float rs = rsqrtf(s * (1.0f / 64.0f) + NORM_EPS) * osc;
            const size_t row = row0 + q0 + 32 * qq + qr;
            Y[row * PLD + 768 + h * 64 + r32] = f2bf(o0 * rs * sw0); Y[row * PLD + 768 + h * 64 + 32 + r32] = f2bf(o1 * rs * sw1);
        }
    }
}

constexpr int SSD_STR = 136;
constexpr int SX_P = 72, SB_P = 136, SS_BUF = 128 * SX_P * 2 + 128 * SB_P * 2;
__device__ __forceinline__ void ssd_state_item(Frame& F, int l, int bhh) {
    const int b = bhh >> 3, hh = bhh & 7, g = hh >> 2, w = F.wave, lane = F.lane, fr = lane & 15, fq = lane >> 4, tid = F.tid;
    LAS float* XS = (LAS float*)(F.lds + 2 * SS_BUF); LAS float* CD = XS + 4096;
    const bf16_t* XACT = (const bf16_t*)F.in[25]; const float* GATES = (const float*)(F.ws + WS_GATES); bf16_t* SST = (bf16_t*)(F.ws + WS_SST);
    const float Ah = -expf(F.in[12][l * 8 + hh]);
    {   float d0v[4], d1v[4];
#pragma unroll
        for (int i = 0; i < 4; ++i) { const size_t r0 = (size_t)b * SEQ + 128 * (w + 8 * i); d0v[i] = GATES[(r0 + lane) * 16 + 8 + hh]; d1v[i] = GATES[(r0 + 64 + lane) * 16 + 8 + hh]; }
#pragma unroll
        for (int i = 0; i < 4; ++i) { const int c = w + 8 * i; const float dt0 = d0v[i], dt1 = d1v[i];
            const float s0 = wave_scan_incl(dt0 * Ah, lane); const float t0 = __shfl(s0, 63);
            const float s1 = wave_scan_incl(dt1 * Ah, lane) + t0; const float last = __shfl(s1, 63);
            XS[128 * c + lane] = dt0 * fast_exp(last - s0); XS[128 * c + 64 + lane] = dt1 * fast_exp(last - s1);
            if (lane == 0) CD[c] = fast_exp(last); }
    }
    const int pt = w & 3, nh = w >> 2;
    f32x4 acc[4];
#pragma unroll
    for (int j = 0; j < 4; ++j) acc[j] = (f32x4){0.f, 0.f, 0.f, 0.f};
    const bf16_t* xg = XACT + ((size_t)b * SEQ + (tid >> 3)) * 1024 + hh * 64 + 8 * (tid & 7);
    const bf16_t* bg = XACT + ((size_t)b * SEQ + (tid >> 4)) * 1024 + 512 + g * 128 + 8 * (tid & 15);
    u32x4 xa[2], ba[4], xb[2], bb[4], xc[2], bc[4];
#define SS_LOAD(xr, br, c_) do { const size_t o_ = (size_t)(c_) * 128 * 1024; xr[0] = *(const u32x4*)(xg + o_); xr[1] = *(const u32x4*)(xg + o_ + 64 * 1024); \
        _Pragma("unroll") for (int i_ = 0; i_ < 4; ++i_) br[i_] = *(const u32x4*)(bg + o_ + (size_t)i_ * 32 * 1024); } while (0)
#define SS_WRITE(xr, br, c_) do { LAS bf16_t* XL_ = (LAS bf16_t*)(F.lds + ((c_) & 1) * SS_BUF); LAS bf16_t* BL_ = XL_ + 128 * SX_P; \
        _Pragma("unroll") for (int i_ = 0; i_ < 2; ++i_) { const int s_ = (tid >> 3) + 64 * i_; const float sc_ = XS[128 * (c_) + s_]; u32x4 o_; \
            _Pragma("unroll") for (int e_ = 0; e_ < 4; ++e_) o_[e_] = cvtpk(sc_ * bflo(xr[i_][e_]), sc_ * bfhi(xr[i_][e_])); \
            *(LAS u32x4*)(XL_ + s_ * SX_P + 8 * (tid & 7)) = o_; } \
        _Pragma("unroll") for (int i_ = 0; i_ < 4; ++i_) *(LAS u32x4*)(BL_ + ((tid >> 4) + 32 * i_) * SB_P + 8 * (tid & 15)) = br[i_]; } while (0)
    LAS bf16_t* SSTG = (LAS bf16_t*)(F.lds + 2 * SS_BUF + 16384 + 128);
#define SS_STAGE(c_) do { LAS bf16_t* sg_ = SSTG + ((c_) & 1) * 8192; \
        _Pragma("unroll") for (int j = 0; j < 4; ++j) _Pragma("unroll") for (int r = 0; r < 4; ++r) sg_[(16 * pt + 4 * fq + r) * 128 + 16 * (4 * nh + j) + fr] = f2bf(acc[j][r]); } while (0)
    SS_LOAD(xa, ba, 0); SS_LOAD(xb, bb, 1); SS_LOAD(xc, bc, 2);
    __syncthreads();
    SS_WRITE(xa, ba, 0);
    SS_LOAD(xa, ba, 3);
    LDS_BARRIER();
#define SS_STEP(XW, BW, c_) do { const int cc_ = (c_); const size_t si = ((size_t)(b * 32 + cc_) * 8 + hh) * 8192; \
        _Pragma("unroll") for (int j = 0; j < 4; ++j) _Pragma("unroll") for (int r = 0; r < 4; ++r) SST[si + (16 * pt + 4 * fq + r) * 128 + 16 * (4 * nh + j) + fr] = f2bf(acc[j][r]); \
        asm volatile("" ::: "memory"); \
        if (cc_ + 1 < 32) { SS_WRITE(XW, BW, cc_ + 1); } \
        asm volatile("" ::: "memory"); \
        SS_LOAD(XW, BW, (cc_ + 4 < 32 ? cc_ + 4 : 31)); \
        asm volatile("" ::: "memory"); \
        const float cd = CD[cc_]; \
        _Pragma("unroll") for (int j = 0; j < 4; ++j) acc[j] = acc[j] * cd; \
        const LAS bf16_t* XL = (const LAS bf16_t*)(F.lds + (cc_ & 1) * SS_BUF); const LAS bf16_t* BL = XL + 128 * SX_P; \
        bf16x8 Af[4], Bf[4][4]; \
        _Pragma("unroll") for (int ks = 0; ks < 4; ++ks) { Af[ks] = ld_tr8(XL, SX_P, 32 * ks, 16 * pt, lane); \
            _Pragma("unroll") for (int j = 0; j < 4; ++j) Bf[ks][j] = ld_tr8(BL, SB_P, 32 * ks, 16 * (4 * nh + j), lane); } \
        asm volatile("s_waitcnt lgkmcnt(0)" ::: "memory"); __builtin_amdgcn_sched_barrier(0); \
        _Pragma("unroll") for (int ks = 0; ks < 4; ++ks) _Pragma("unroll") for (int j = 0; j < 4; ++j) acc[j] = MFMA16(Af[ks], Bf[ks][j], acc[j]); \
        LDS_BARRIER(); } while (0)
    for (int c = 0; c < 30; c += 3) { SS_STEP(xb, bb, c); SS_STEP(xc, bc, c + 1); SS_STEP(xa, ba, c + 2); }
    SS_STEP(xb, bb, 30); SS_STEP(xc, bc, 31);
#undef SS_STEP
#undef SS_STAGE
#undef SS_LOAD
#undef SS_WRITE
}

constexpr int SO_BP = 136, SO_XP = 72, SO_SP = 136, SO_YP = 264;
constexpr int SO_B_BYTES = 128 * SO_BP * 2, SO_H_BYTES = 128 * SO_XP * 2 + 64 * SO_SP * 2, SO_ACS_OFF = SO_B_BYTES + 2 * SO_H_BYTES;
__device__ __forceinline__ void ssd_out_item(Frame& F, int l, int it) {
    const int g = it & 1, c = (it >> 1) & 31, b = it >> 6, w = F.wave, lane = F.lane, fr = lane & 15, fq = lane >> 4, tid = F.tid;
    LAS bf16_t* BL = (LAS bf16_t*)F.lds;
    LAS float* ACS = (LAS float*)(F.lds + SO_ACS_OFF); LAS float* DTS = ACS + 512; LAS float* ETAB = DTS + 512; LAS float* REFS = ETAB + 512;
    const bf16_t* XACT = (const bf16_t*)F.in[25]; const float* GATES = (const float*)(F.ws + WS_GATES); const bf16_t* SST = (const bf16_t*)(F.ws + WS_SST);
    const bf16_t* PROJ = (const bf16_t*)(F.ws + WS_PROJ); bf16_t* Y = (bf16_t*)(F.ws + WS_PROJ) + PX;
    const size_t r0 = (size_t)b * SEQ + 128 * c;
    const float gdt0 = GATES[(r0 + lane) * 16 + 8 + g * 4 + (w & 3)], gdt1 = GATES[(r0 + 64 + lane) * 16 + 8 + g * 4 + (w & 3)];
    const bf16_t* bgp = XACT + (r0 + (tid >> 4)) * 1024 + 512 + g * 128 + 8 * (tid & 15);
    const bf16_t* xgp = XACT + (r0 + (tid >> 3)) * 1024 + g * 256 + 8 * (tid & 7);
    const bf16_t* sgp = SST + ((size_t)(b * 32 + c) * 8 + g * 4) * 8192 + (tid >> 4) * 128 + 8 * (tid & 15);
    u32x4 xr[2], sr[2];
#define SO_LOADH(hd_) do { xr[0] = *(const u32x4*)(xgp + (hd_) * 64); xr[1] = *(const u32x4*)(xgp + (hd_) * 64 + 64 * 1024); \
        sr[0] = *(const u32x4*)(sgp + (size_t)(hd_) * 8192); sr[1] = *(const u32x4*)(sgp + (size_t)(hd_) * 8192 + 32 * 128); } while (0)
#define SO_WRITEH(hd_) do { LAS bf16_t* XL_ = (LAS bf16_t*)(F.lds + SO_B_BYTES + ((hd_) & 1) * SO_H_BYTES); LAS bf16_t* SL_ = XL_ + 128 * SO_XP; \
        *(LAS u32x4*)(XL_ + (tid >> 3) * SO_XP + 8 * (tid & 7)) = xr[0]; *(LAS u32x4*)(XL_ + ((tid >> 3) + 64) * SO_XP + 8 * (tid & 7)) = xr[1]; \
        *(LAS u32x4*)(SL_ + (tid >> 4) * SO_SP + 8 * (tid & 15)) = sr[0]; *(LAS u32x4*)(SL_ + ((tid >> 4) + 32) * SO_SP + 8 * (tid & 15)) = sr[1]; } while (0)
    {   u32x4 br[4];
#pragma unroll
        for (int i = 0; i < 4; ++i) br[i] = *(const u32x4*)(bgp + (size_t)i * 32 * 1024);
        SO_LOADH(0);
#pragma unroll
        for (int i = 0; i < 4; ++i) *(LAS u32x4*)(BL + ((tid >> 4) + 32 * i) * SO_BP + 8 * (tid & 15)) = br[i];
        SO_WRITEH(0);
    }
    if (w < 4) {
        const int hh = g * 4 + w; const float Ah = -expf(F.in[12][l * 8 + hh]);
        const float dt0 = gdt0, dt1 = gdt1;
        const float s0 = wave_scan_incl(dt0 * Ah, lane); const float t0 = __shfl(s0, 63);
        const float s1 = wave_scan_incl(dt1 * Ah, lane) + t0;
        ACS[128 * w + lane] = s0; ACS[128 * w + 64 + lane] = s1; DTS[128 * w + lane] = dt0; DTS[128 * w + 64 + lane] = dt1;
        const float e0 = __shfl(s0, 31), e2 = __shfl(s1, 31), e3 = __shfl(s1, 63);
        ETAB[128 * w + lane] = fast_exp((lane < 32 ? e0 : t0) - s0) * dt0; ETAB[128 * w + 64 + lane] = fast_exp((lane < 32 ? e2 : e3) - s1) * dt1;
        if (lane == 0) { REFS[4 * w + 0] = e0; REFS[4 * w + 1] = t0; REFS[4 * w + 2] = e2; REFS[4 * w + 3] = e3; }
    }
    SO_LOADH(1);
    const int lrow = 16 * w + fr, nkk = (w >> 1) + 1;
    bf16x8 Cf[4];
#pragma unroll
    for (int ks = 0; ks < 4; ++ks) Cf[ks] = ld_g8(XACT + (r0 + lrow) * 1024 + 768 + g * 128 + 32 * ks + 8 * fq);
    asm volatile("" : "+v"(Cf[0]), "+v"(Cf[1]), "+v"(Cf[2]), "+v"(Cf[3]));
    LDS_BARRIER();
    f32x4 G[4][2];
#pragma unroll
    for (int kk = 0; kk < 4; ++kk) { G[kk][0] = (f32x4){0.f, 0.f, 0.f, 0.f}; G[kk][1] = (f32x4){0.f, 0.f, 0.f, 0.f};
        if (kk < nkk) {
            bf16x8 b0[4], b1[4];
#pragma unroll
            for (int ks = 0; ks < 4; ++ks) { b0[ks] = ld_l8(BL + (32 * kk + fr) * SO_BP + 32 * ks + 8 * fq); b1[ks] = ld_l8(BL + (32 * kk + 16 + fr) * SO_BP + 32 * ks + 8 * fq); }
#pragma unroll
            for (int ks = 0; ks < 4; ++ks) { G[kk][0] = MFMA16(b0[ks], Cf[ks], G[kk][0]); G[kk][1] = MFMA16(b1[ks], Cf[ks], G[kk][1]); } } }
    const float* Dk = F.in[13] + l * 8 + g * 4;
    f32x4 yacc[4][4];
#pragma unroll
    for (int hd = 0; hd < 4; ++hd) {
        const LAS bf16_t* XL = (const LAS bf16_t*)(F.lds + SO_B_BYTES + (hd & 1) * SO_H_BYTES); const LAS bf16_t* SL = XL + 128 * SO_XP;
        bf16x8 Sf[4][4];
#pragma unroll
        for (int pt = 0; pt < 4; ++pt)
#pragma unroll
            for (int ks = 0; ks < 4; ++ks) Sf[pt][ks] = ld_l8(SL + (16 * pt + fr) * SO_SP + 32 * ks + 8 * fq);
        float ea[4], xv[4][4];
#pragma unroll
        for (int r = 0; r < 4; ++r) ea[r] = fast_exp(ACS[128 * hd + 16 * w + 4 * fq + r]);
#pragma unroll
        for (int pt = 0; pt < 4; ++pt)
#pragma unroll
            for (int r = 0; r < 4; ++r) xv[pt][r] = bf2f(XL[(16 * w + 4 * fq + r) * SO_XP + 16 * pt + fr]);
        const float dsk = Dk[hd];
#pragma unroll
        for (int pt = 0; pt < 4; ++pt) { f32x4 a = (f32x4){0.f, 0.f, 0.f, 0.f};
#pragma unroll
            for (int ks = 0; ks < 4; ++ks) a = MFMA16(Cf[ks], Sf[pt][ks], a);
#pragma unroll
            for (int r = 0; r < 4; ++r) a[r] = a[r] * ea[r] + dsk * xv[pt][r];
            yacc[hd][pt] = a; }
        const float al = ACS[128 * hd + lrow];
#pragma unroll
        for (int kk = 0; kk < 4; ++kk) if (kk < nkk) {
            f32x4 P0, P1;
            if (kk + 1 < nkk) {
                const float fk = fast_exp(al - REFS[4 * hd + kk]);
#pragma unroll
                for (int r = 0; r < 4; ++r) { const int s0 = 32 * kk + 4 * fq + r; P0[r] = G[kk][0][r] * fk * ETAB[128 * hd + s0]; P1[r] = G[kk][1][r] * fk * ETAB[128 * hd + s0 + 16]; }
            } else {
#pragma unroll
                for (int r = 0; r < 4; ++r) { const int s0 = 32 * kk + 4 * fq + r, s1 = s0 + 16;
                    P0[r] = (s0 <= lrow) ? G[kk][0][r] * fast_exp(al - ACS[128 * hd + s0]) * DTS[128 * hd + s0] : 0.f;
                    P1[r] = (s1 <= lrow) ? G[kk][1][r] * fast_exp(al - ACS[128 * hd + s1]) * DTS[128 * hd + s1] : 0.f; }
            }
            const bf16x8 PA = pack8(P0, P1);
            bf16x8 Bx[4];
#pragma unroll
            for (int pt = 0; pt < 4; ++pt) Bx[pt] = ld_tr8p(XL, SO_XP, 32 * kk, 16 * pt, lane);
#pragma unroll
            for (int pt = 0; pt < 4; ++pt) yacc[hd][pt] = MFMA16(PA, Bx[pt], yacc[hd][pt]);
        }
        if (hd + 1 < 4) { SO_WRITEH(hd + 1); if (hd + 2 < 4) SO_LOADH(hd + 2); }
        LDS_BARRIER();
    }
#undef SO_LOADH
#undef SO_WRITEH
    const float* nw = F.in[14] + (size_t)l * 512 + g * 256; const int ch8 = 8 * (tid & 31);
    const f32x4 nw0 = *(const f32x4*)(nw + ch8), nw1 = *(const f32x4*)(nw + ch8 + 4);
    u32x4 zv8[8];
#pragma unroll
    for (int i = 0; i < 8; ++i) zv8[i] = *(const u32x4*)(PROJ + (r0 + (tid >> 5) + 16 * i) * PLD + PZ + g * 256 + ch8);
    LAS bf16_t* YL = (LAS bf16_t*)F.lds;
#pragma unroll
    for (int hd = 0; hd < 4; ++hd)
#pragma unroll
        for (int pt = 0; pt < 4; ++pt)
#pragma unroll
            for (int r = 0; r < 4; ++r) YL[(16 * w + 4 * fq + r) * SO_YP + hd * 64 + 16 * pt + fr] = f2bf(yacc[hd][pt][r]);
    LDS_BARRIER();
#pragma unroll
    for (int i = 0; i < 8; ++i) {
        const int lr = (tid >> 5) + 16 * i; const size_t row = r0 + lr;
        const u32x4 yv = *(const LAS u32x4*)(YL + lr * SO_YP + ch8); const u32x4 zv = zv8[i];
        float v[8]; float ss = 0.f;
#pragma unroll
        for (int e = 0; e < 4; ++e) { v[2 * e] = bflo(yv[e]) * bflo(zv[e]); v[2 * e + 1] = bfhi(yv[e]) * bfhi(zv[e]); ss += v[2 * e] * v[2 * e] + v[2 * e + 1] * v[2 * e + 1]; }
        ss += __shfl_xor(ss, 1); ss += __shfl_xor(ss, 2); ss += __shfl_xor(ss, 4); ss += __shfl_xor(ss, 8); ss += __shfl_xor(ss, 16);
        const float rs = rsqrtf(ss * (1.0f / 256.0f) + NORM_EPS);
        u32x4 o; o.x = cvtpk(v[0] * rs * nw0.x, v[1] * rs * nw0.y); o.y = cvtpk(v[2] * rs * nw0.z, v[3] * rs * nw0.w); o.z = cvtpk(v[4] * rs * nw1.x, v[5] * rs * nw1.y); o.w = cvtpk(v[6] * rs * nw1.z, v[7] * rs * nw1.w);
        *(u32x4*)(Y + row * PLD + 256 + g * 256 + ch8) = o;
    }
}
#ifndef PH_EN
#define PH_EN 1023
#endif
#ifndef MK_N_LAUNCHES
#define MK_N_LAUNCHES 1
#endif
constexpr int N_PHASES = 1 + 9 * DEPTH;
constexpr int NA1 = 512;
constexpr int CW_STAT = 32768;
#ifdef PROBE_A
#define ITEM_T0() const unsigned long long it0_ = __builtin_amdgcn_s_memrealtime()
#define ITEM_T1(k_) do { __syncthreads(); if (threadIdx.x == 0) atomicMax(F.ctl + CW_STAT + 64 * ((k_) + 16 * l), (unsigned)(__builtin_amdgcn_s_memrealtime() - it0_)); } while (0)
#define ITEM_TSUM(k_) do { if (threadIdx.x == 0) atomicAdd(F.ctl + CW_STAT + 64 * ((k_) + 16 * l), (unsigned)(__builtin_amdgcn_s_memrealtime() - it0_)); } while (0)
#else
#define ITEM_T0() do {} while (0)
#define ITEM_T1(k_) do {} while (0)
#define ITEM_TSUM(k_) do {} while (0)
#endif

__global__ void __launch_bounds__(NTHREADS, 2) hyb_fwd(Args args) {
    extern __shared__ __attribute__((aligned(16))) unsigned char lds_raw[];
    {   const int t0 = threadIdx.x;
        for (int u = t0; u < (LDS_BYTES - LDSCTL_OFF) / 4; u += NTHREADS) ((LAS unsigned*)((LAS unsigned char*)lds_raw + LDSCTL_OFF))[u] = 0u; }
    __syncthreads();
    const int ph_lo = args.ph_lo, ph_hi = args.ph_hi;
    const bool one_launch = (ph_hi - ph_lo) > 1;
    if (one_launch) { XcdBarrier b0 = xcd_barrier_post((unsigned*)(args.ws + WS_CTL) + CW_BAR, (volatile LAS unsigned*)((LAS unsigned char*)lds_raw + MISC_OFF) + 8); (void)b0; }
#ifdef PROBE_A
    unsigned long long t_prev = __builtin_amdgcn_s_memrealtime();
#endif
    for (int ph = ph_lo; ph < ph_hi; ++ph) {
        int tid_ = threadIdx.x; asm volatile("" : "+v"(tid_));
        kinptr_t kin = (kinptr_t)__builtin_amdgcn_kernarg_segment_ptr(); asm volatile("" : "+s"(kin));
        Frame F;
        F.lds = (LAS unsigned char*)lds_raw; F.MISC = (volatile LAS unsigned*)(F.lds + MISC_OFF);
        F.tid = tid_; F.lane = tid_ & 63; F.wave = __builtin_amdgcn_readfirstlane(tid_ >> 6);
        F.G = gridDim.x; { const int bx = blockIdx.x; F.vcu = (F.G % 8 == 0) ? (bx % 8) * (F.G / 8) + bx / 8 : bx; }
        F.in = kin;
        float* const outp = (float*)kin[25]; unsigned char* ws = (unsigned char*)kin[26];
        F.ws = ws; F.ctl = (unsigned*)(ws + WS_CTL);
        bf16_t* XB = (bf16_t*)(ws + WS_XB); bf16_t* PROJ = (bf16_t*)(ws + WS_PROJ); float* SSQ = (float*)(ws + WS_SSQ); float* GATES = (float*)(ws + WS_GATES);
        if (ph == 0) { if (PH_EN & 1) p0_prologue(F); }
        else {
            const int l = (ph - 1) / 9, k = (ph - 1) % 9;
            const unsigned char* WL = ws + WS_W + (size_t)l * W_LAYER;
            if ((PH_EN & 2) && (k == 0 || k == 7)) {
                pg8::Gemm g{XB, (const bf16_t*)(WL + (k == 0 ? W_GU1 : W_GU2)), M_TOK, NGU, DM, DM}; pg8::StaticOrder S; S.init(M_TOK, NGU, F.G, (int)blockIdx.x);
                EpiSwiglu E{{}, PROJ, SSQ};
                pg8::gemm_phase<EpiSwiglu, true, true>(F.lds, g, S, E, F.tid);
                { int t2 = threadIdx.x; asm volatile("" : "+v"(t2)); F.tid = t2; F.lane = t2 & 63; F.wave = __builtin_amdgcn_readfirstlane(t2 >> 6); side_convert(F, l, k); }
            } else if ((PH_EN & 4) && (k == 1 || k == 8 || k == 6)) {
                pg8::Gemm g; float alpha = 0.5f;
                if (k == 6) { g = pg8::Gemm{PROJ + PX, (const bf16_t*)(WL + W_OUT), M_TOK, DM, DM, PLD}; alpha = 1.0f; }
                else { g = pg8::Gemm{PROJ, (const bf16_t*)(WL + (k == 1 ? W_D1 : W_D2)), M_TOK, DM, FF, FF}; }
                pg8::StaticOrder S; S.init(M_TOK, DM, F.G, (int)blockIdx.x);
                if (ph == N_PHASES - 1) { EpiResid<true> E{outp, XB, SSQ, alpha, 1.0f / alpha}; pg8::gemm_phase<EpiResid<true>, false, true>(F.lds, g, S, E, F.tid); }
                else { EpiResid<false> E{outp, XB, SSQ, alpha, 1.0f / alpha}; pg8::gemm_phase<EpiResid<false>, false, true>(F.lds, g, S, E, F.tid); }
            } else if ((PH_EN & 8) && k == 2) {
                pg8::Gemm g{XB, (const bf16_t*)(WL + W_IN), M_TOK, NIN, DM, DM}; pg8::StaticOrder S; S.init(M_TOK, NIN, F.G, (int)blockIdx.x);
                EpiInProj E{{}, PROJ, GATES, SSQ, kin[15] + l * 64, kin[16] + l * 64, kin[7] + l * 8, kin[11] + l * 8};
                pg8::gemm_phase<EpiInProj, true, true>(F.lds, g, S, E, F.tid);
                { int t2 = threadIdx.x; asm volatile("" : "+v"(t2)); F.tid = t2; F.lane = t2 & 63; F.wave = __builtin_amdgcn_readfirstlane(t2 >> 6); side_convert(F, l, k); }
            } else if ((PH_EN & 16) && k == 3) {
                conv_phase(F, l);
            } else if (k == 4) {
                const int qoff_ = (F.G == 256) ? 256 : 0;
                for (int it = (F.G == 256) ? (int)blockIdx.x : q_next(F, 2 * l);;) {
                    if (it >= 48 + NA1) break;
                    { int t2 = threadIdx.x; asm volatile("" : "+v"(t2)); F.tid = t2; F.lane = t2 & 63; F.wave = __builtin_amdgcn_readfirstlane(t2 >> 6); }
                    ITEM_T0();
                    if (it < 16) { if (PH_EN & 32) mlstm_state_item(F, it); ITEM_T1(0); it = q_next(F, 2 * l) + qoff_; }
                    else if (it < 48) { if (PH_EN & 64) ssd_state_item(F, l, it - 16); ITEM_T1(1); it = q_next(F, 2 * l) + qoff_; }
                    else { const int r = it - 48; attn_item(F, l, r & 15, 31 - (r >> 4), true); ITEM_T1(2); ITEM_TSUM(12);
                        __syncthreads(); it = (int)F.MISC[17] + qoff_; } }
#ifdef PROBE_A
                if (threadIdx.x == 0) atomicAdd(F.ctl + CW_STAT + 64 * (13 + 16 * l), (unsigned)(__builtin_amdgcn_s_memrealtime() - t_prev));
#endif
            } else if (k == 5 && NA1 == 512 && F.G == 256) {
                { int t2 = threadIdx.x; asm volatile("" : "+v"(t2)); F.tid = t2; F.lane = t2 & 63; F.wave = __builtin_amdgcn_readfirstlane(t2 >> 6); }
                ssd_out_item(F, l, F.vcu);
                __syncthreads();
                { int t2 = threadIdx.x; asm volatile("" : "+v"(t2)); F.tid = t2; F.lane = t2 & 63; F.wave = __builtin_amdgcn_readfirstlane(t2 >> 6); }
                mlstm_out_item(F, l, F.vcu);
            } else if (k == 5) {
                for (;;) { const int it = q_next(F, 2 * l + 1); if (it >= 512 + (512 - NA1)) break;
                    { int t2 = threadIdx.x; asm volatile("" : "+v"(t2)); F.tid = t2; F.lane = t2 & 63; F.wave = __builtin_amdgcn_readfirstlane(t2 >> 6); }
                    ITEM_T0();
                    if (it < 256) { if (PH_EN & 256) ssd_out_item(F, l, it); ITEM_T1(3); }
                    else if (it < 512) { if (PH_EN & 512) mlstm_out_item(F, l, it - 256); ITEM_T1(4); }
                    else { const int r = NA1 + it - 512; if (PH_EN & 128) attn_item(F, l, r & 15, 31 - (r >> 4), false); } }
            }
        }
#ifdef PROBE_A
        if (ph + 1 < ph_hi) { XcdBarrier bar; bar.bar = F.ctl + CW_BAR; bar.x = xb_xcc_id(); bar.st = F.MISC + 8; xcd_barrier(bar); }
        { const unsigned long long t_now = __builtin_amdgcn_s_memrealtime(); if (threadIdx.x == 0) F.MISC[24 + ph] += (unsigned)(t_now - t_prev); t_prev = t_now; }
        if (ph + 1 == ph_hi && blockIdx.x == 0) { __syncthreads();
            unsigned va = (PROBE_A < 32) ? F.MISC[24 + PROBE_A] : xb_ld(F.ctl + CW_STAT + 64 * (PROBE_A - 32)), vb = (PROBE_B < 32) ? F.MISC[24 + PROBE_B] : xb_ld(F.ctl + CW_STAT + 64 * (PROBE_B - 32));
            if (PROBE_A == 44 || PROBE_A == 45) va = va / 256u * 5u; if (PROBE_B == 44 || PROBE_B == 45) vb = vb / 256u * 5u;
            unsigned qa = (va + 500u) / 1000u, qb = (vb + 500u) / 1000u; if (qa > 63u) qa = 63u; if (qb > 63u) qb = 63u;
            const unsigned long long wait = (unsigned long long)(qa * 6400u + qb * 409600u); const unsigned long long t0 = __builtin_amdgcn_s_memrealtime();
            while (__builtin_amdgcn_s_memrealtime() - t0 < wait) __builtin_amdgcn_s_sleep(8); }
        continue;
#endif
        if (ph + 1 < ph_hi) { XcdBarrier bar; bar.bar = F.ctl + CW_BAR; bar.x = xb_xcc_id(); bar.st = F.MISC + 8; xcd_barrier(bar); }
    }
}

extern "C" void kernel_launch(void* const* d_in, const int* in_sizes, int n_in, void* d_out, int out_size, void* d_ws, size_t ws_size, hipStream_t stream) {
    static int grid = 0;
    if (grid == 0) {
        if (n_in != 25 || in_sizes[0] != M_TOK * DM || out_size != M_TOK * DM || ws_size < WS_END) { fprintf(stderr, "kernel_launch: unexpected shapes (n_in %d, in0 %d, out %d, ws %zu)\n", n_in, n_in > 0 ? in_sizes[0] : -1, out_size, ws_size); grid = -1; return; }
        int dev = 0, cus = 0, per_cu = 0;
        if (hipGetDevice(&dev) != hipSuccess || hipDeviceGetAttribute(&cus, hipDeviceAttributeMultiprocessorCount, dev) != hipSuccess) { grid = -1; return; }
        if (hipFuncSetAttribute((const void*)hyb_fwd, hipFuncAttributeMaxDynamicSharedMemorySize, LDS_BYTES) != hipSuccess) { fprintf(stderr, "kernel_launch: hipFuncSetAttribute failed\n"); grid = -1; return; }
        if (hipOccupancyMaxActiveBlocksPerMultiprocessor(&per_cu, (const void*)hyb_fwd, NTHREADS, LDS_BYTES) != hipSuccess || per_cu < 1)
            fprintf(stderr, "kernel_launch: note: occupancy query reports %d workgroups per CU\n", per_cu);
        (void)hipGetLastError();
        grid = cus;
    }
    if (grid < 0) return;
    if (hipMemsetAsync((char*)d_ws + WS_CTL, 0, CTL_ZERO_BYTES, stream) != hipSuccess) { fprintf(stderr, "kernel_launch: memset failed\n"); return; }
    Args a{};
    for (int i = 0; i < 25; ++i) a.in[i] = (const float*)d_in[i];
    a.out = (float*)d_out; a.ws = (unsigned char*)d_ws;
#if MK_N_LAUNCHES == 1
    a.ph_lo = 0; a.ph_hi = N_PHASES;
    hipLaunchKernelGGL(hyb_fwd, dim3(grid), dim3(NTHREADS), LDS_BYTES, stream, a);
#else
    for (int p = 0; p < N_PHASES; ++p) { a.ph_lo = p; a.ph_hi = p + 1; hipLaunchKernelGGL(hyb_fwd, dim3(grid), dim3(NTHREADS), LDS_BYTES, stream, a); }
#endif
    const hipError_t le = hipPeekAtLastError();
    if (le != hipSuccess) fprintf(stderr, "kernel_launch: launch failed: %s\n", hipGetErrorName(le));
}
```

```cpp
#include <hip/hip_runtime.h>
#include <cstdio>
#include <cstdint>

#define LAS __attribute__((address_space(3)))
#define GAS __attribute__((address_space(1)))
typedef unsigned short bf16_t;
typedef short bf16x8 __attribute__((ext_vector_type(8)));
typedef short bf16x4 __attribute__((ext_vector_type(4)));
typedef float f32x4 __attribute__((ext_vector_type(4)));
typedef float f32x2 __attribute__((ext_vector_type(2)));
typedef unsigned u32x4 __attribute__((ext_vector_type(4)));
typedef unsigned u32x2 __attribute__((ext_vector_type(2)));
typedef __bf16 bf16x2_t __attribute__((ext_vector_type(2)));

constexpr int M_TOK = 16384, SEQ = 4096, NBATCH = 4, DM = 1024, FF = 2816, NGU = 2 * FF, NIN = 3584, DEPTH = 2;
constexpr int PLD = 3328;
constexpr int PQ = 0, PK = 256, PV = 512, PO = 768, PZ = 1024, PX = 1536, PDQ = 2560, PDK = 2816, PDV = 3072;
constexpr float NORM_EPS = 1e-6f;
constexpr float LOG2E = 1.4426950408889634f;

__device__ __forceinline__ unsigned cvtpk(float lo, float hi) { f32x2 v = {lo, hi}; bf16x2_t b = __builtin_convertvector(v, bf16x2_t); return __builtin_bit_cast(unsigned, b); }
__device__ __forceinline__ bf16_t f2bf(float f) { return (bf16_t)(cvtpk(f, 0.f) & 0xffffu); }
__device__ __forceinline__ float bf2f(bf16_t h) { return __uint_as_float(((unsigned)h) << 16); }
__device__ __forceinline__ float bflo(unsigned w) { return __uint_as_float(w << 16); }
__device__ __forceinline__ float bfhi(unsigned w) { return __uint_as_float(w & 0xffff0000u); }
__device__ __forceinline__ float fast_exp(float x) { return __builtin_amdgcn_exp2f(x * LOG2E); }
__device__ __forceinline__ float fast_rcp(float x) { return __builtin_amdgcn_rcpf(x); }
__device__ __forceinline__ float fast_log1pexp(float x) { const float e = __builtin_amdgcn_exp2f(x * LOG2E); return __builtin_amdgcn_logf(1.0f + e) * 0.6931471805599453f; }
__device__ __forceinline__ float sigmoidf_(float x) { return fast_rcp(1.f + fast_exp(-x)); }
__device__ __forceinline__ float siluf_(float x) { return x * sigmoidf_(x); }

__device__ __forceinline__ void st16_wt(void* p, u32x4 v) { asm volatile("global_store_dwordx4 %0, %1, off sc1\n\ts_nop 1" :: "v"(p), "v"(v) : "memory"); }

namespace pg8 {
constexpr int BM = 256, BK = 64, HALF = 128, HTB = HALF * BK * 2, STAGE_BYTES = 8 * HTB, NXCD = 8, WGM = 8;
__host__ __device__ __forceinline__ int lds_byte(int r, int c) { const int st = (r >> 4) * 2 + (c >> 5), rr = r & 15, cc = c & 31, ob = rr * 64 + cc * 2; return st * 1024 + (ob ^ (((ob >> 9) & 1) << 5)); }
__host__ __device__ __forceinline__ void stage_rc(int b, int& R, int& C) { const int st = b / 1024, sb = b % 1024, swz = sb ^ (((sb >> 9) & 1) << 5); R = (st >> 1) * 16 + swz / 64; C = (st & 1) * 32 + (swz % 64) / 2; }
__host__ __device__ __forceinline__ int perm32(int rho) { const int n = rho >> 4, i = rho & 15; return 8 * (i >> 2) + 4 * n + (i & 3); }

struct Unit { int pm, pn; };
struct Gemm { const bf16_t* A; const bf16_t* Bt; int M, N, K, lda; };

struct StaticOrder {
    int nM, nN, nwg, G, c;
    __device__ void init(int M, int N, int G_, int c_) { nM = M / BM; nN = N / BM; nwg = nM * nN; G = G_; c = c_; }
    __device__ bool next(int i, Unit& u) const {
        const long L = (long)i * G + c; if (L >= nwg) return false;
        int wgid = (int)L; { const int q = nwg / NXCD, r = nwg % NXCD, xcd = wgid % NXCD, off = wgid / NXCD; wgid = (xcd < r ? xcd * (q + 1) : r * (q + 1) + (xcd - r) * q) + off; }
        const int nig = WGM * nN, gid = wgid / nig, fm = gid * WGM, gsz = (nM - fm) < WGM ? (nM - fm) : WGM;
        u.pm = fm + ((wgid % nig) % gsz); u.pn = (wgid % nig) / gsz; return true;
    }
};

template <class Epi, bool ALIGN_EPI, bool SP2>
__device__ __forceinline__ void gemm_phase(LAS unsigned char* lds, const Gemm g, const StaticOrder& S, const Epi& E, const int tid) {
    const int wid = __builtin_amdgcn_readfirstlane(tid >> 6), lane = tid & 63, wr = wid >> 2, wc = wid & 3, fr = lane & 15, fq = lane >> 4;
    const int K = g.K, nt = K / BK, lda = g.lda;
    unsigned voffA[2], voffB[2];
#pragma unroll
    for (int i = 0; i < 2; ++i) { int R, C; stage_rc(tid * 16 + i * 8192, R, C); const int Rb = (R & ~31) + perm32(R & 31);
        voffA[i] = (unsigned)(R * lda + C) * 2u; voffB[i] = (unsigned)(Rb * K + C) * 2u; }
    const size_t kstep = (size_t)(BK * 2);
    const size_t hstepA = (size_t)HALF * lda * 2, hstepB = (size_t)HALF * K * 2;
    const size_t tstepA = 2 * hstepA, tstepB = 2 * hstepB;
    const unsigned ldsw = (unsigned)wid * 1024u;
    const int aoff = lds_byte(wr * 64 + fr, fq * 8), boff = lds_byte(wc * 32 + fr, fq * 8);
#define PG8_SA(b, h) (((b) * 2 + (h)) * HTB)
#define PG8_SB(b, h) ((4 + (b) * 2 + (h)) * HTB)
#define PG8_STAGE(bufoff, gbase, voff) do { _Pragma("unroll") for (int _i = 0; _i < 2; ++_i) \
        __builtin_amdgcn_global_load_lds((const unsigned*)((const char*)(gbase) + (voff)[_i]), (LAS unsigned*)(lds + (bufoff) + ldsw + _i * 8192), 16, 0, 0); } while (0)
#define PG8_LDA(dst, b, h) do { _Pragma("unroll") for (int m = 0; m < 4; ++m) _Pragma("unroll") for (int k = 0; k < 2; ++k) dst[m][k] = *(const LAS bf16x8*)(lds + PG8_SA(b, h) + aoff + m * 2048 + k * 1024); } while (0)
#define PG8_LDB(dst, b, h) do { _Pragma("unroll") for (int n = 0; n < 2; ++n) _Pragma("unroll") for (int k = 0; k < 2; ++k) dst[n][k] = *(const LAS bf16x8*)(lds + PG8_SB(b, h) + boff + n * 2048 + k * 1024); } while (0)
#define PG8_MMA(ai, bj, At, Bt) do { __builtin_amdgcn_s_setprio(1); _Pragma("unroll") for (int m = 0; m < 4; ++m) _Pragma("unroll") for (int n = 0; n < 2; ++n) _Pragma("unroll") for (int k = 0; k < 2; ++k) \
        acc[ai][bj][m][n] = __builtin_amdgcn_mfma_f32_16x16x32_bf16(Bt[n][k], At[m][k], acc[ai][bj][m][n], 0, 0, 0); __builtin_amdgcn_s_setprio(0); } while (0)
#define PG8_WAIT_V(n) asm volatile("s_waitcnt vmcnt(" #n ")" ::: "memory")
#define PG8_WAIT_L(n) asm volatile("s_waitcnt lgkmcnt(" #n ")" ::: "memory")
#define PG8_BAR __builtin_amdgcn_s_barrier()
#define PG8_SCHED __builtin_amdgcn_sched_barrier(0)
    Unit cur, nxt; int ui = 0;
    if (!S.next(0, cur)) return;
    f32x4 acc[2][2][4][2];
    typename Epi::Raw raw; E.init_load(raw, cur, wr, wc, fr, fq);
    typename Epi::Pre pre; E.pre_load(pre, cur, wr, fr, fq);
    if constexpr (!Epi::HAS_INIT) {
#pragma unroll
    for (int a = 0; a < 2; ++a)
#pragma unroll
        for (int b = 0; b < 2; ++b)
#pragma unroll
            for (int m = 0; m < 4; ++m)
#pragma unroll
                for (int n = 0; n < 2; ++n) acc[a][b][m][n] = (f32x4){0.f, 0.f, 0.f, 0.f};
    }
    bf16x8 At[4][2], B0[2][2], B1[2][2];
    const char* cA = (const char*)g.A + (size_t)cur.pm * tstepA; const char* cB = (const char*)g.Bt + (size_t)cur.pn * tstepB;
    if constexpr (SP2) {
        PG8_STAGE(PG8_SB(0, 0), cB, voffB); PG8_STAGE(PG8_SB(0, 1), cB + hstepB, voffB); PG8_STAGE(PG8_SA(0, 0), cA, voffA); PG8_STAGE(PG8_SA(0, 1), cA + hstepA, voffA);
        if constexpr (Epi::HAS_INIT) E.init_finish(raw, acc);
        E.pre_finish(pre);
        if (wr == 1) PG8_BAR;
        PG8_WAIT_V(2); PG8_BAR;
        PG8_STAGE(PG8_SB(1, 0), cB + kstep, voffB); PG8_STAGE(PG8_SA(1, 0), cA + kstep, voffA); PG8_STAGE(PG8_SB(1, 1), cB + hstepB + kstep, voffB);
        PG8_WAIT_V(6); PG8_BAR;
    } else {
        PG8_STAGE(PG8_SB(0, 0), cB, voffB); PG8_STAGE(PG8_SA(0, 0), cA, voffA); PG8_STAGE(PG8_SB(0, 1), cB + hstepB, voffB); PG8_STAGE(PG8_SA(0, 1), cA + hstepA, voffA);
        E.pre_finish(pre);
        if (wr == 1) PG8_BAR;
        PG8_WAIT_V(4); PG8_BAR;
        PG8_STAGE(PG8_SB(1, 0), cB + kstep, voffB); PG8_STAGE(PG8_SA(1, 0), cA + kstep, voffA); PG8_STAGE(PG8_SB(1, 1), cB + hstepB + kstep, voffB);
        PG8_WAIT_V(6); PG8_BAR;
    }
    for (;;) {
        const bool has_next = S.next(ui + 1, nxt);
        const char* nA = has_next ? (const char*)g.A + (size_t)nxt.pm * tstepA : cA; const char* nB = has_next ? (const char*)g.Bt + (size_t)nxt.pn * tstepB : cB;
        for (int t = 0; t < nt; t += 2) {
            const bool last = (t == nt - 2);
            const char* a1 = cA + (size_t)(t + 1) * kstep;
            const char* a2 = last ? nA : cA + (size_t)(t + 2) * kstep; const char* b2 = last ? nB : cB + (size_t)(t + 2) * kstep;
            const char* a3 = a2 + kstep; const char* b3 = b2 + kstep;
            if constexpr (SP2) {
            PG8_LDB(B0, 0, 0); PG8_LDB(B1, 0, 1); PG8_SCHED; PG8_LDA(At, 0, 0); PG8_STAGE(PG8_SA(1, 1), a1 + hstepA, voffA);
            PG8_WAIT_V(8); PG8_WAIT_L(0); PG8_BAR; PG8_MMA(0, 0, At, B0); PG8_MMA(0, 1, At, B1); PG8_BAR; PG8_SCHED;
            PG8_LDA(At, 0, 1); PG8_STAGE(PG8_SB(0, 0), b2, voffB); PG8_STAGE(PG8_SB(0, 1), b2 + hstepB, voffB); PG8_STAGE(PG8_SA(0, 0), a2, voffA);
            PG8_WAIT_V(8); PG8_WAIT_L(0); PG8_BAR; PG8_MMA(1, 0, At, B0); PG8_MMA(1, 1, At, B1); PG8_BAR; PG8_SCHED;
            PG8_LDB(B0, 1, 0); PG8_LDB(B1, 1, 1); PG8_SCHED; PG8_LDA(At, 1, 0); PG8_STAGE(PG8_SA(0, 1), a2 + hstepA, voffA);
            PG8_WAIT_V(8); PG8_WAIT_L(0); PG8_BAR; PG8_MMA(0, 0, At, B0); PG8_MMA(0, 1, At, B1); PG8_BAR; PG8_SCHED;
            PG8_LDA(At, 1, 1); PG8_STAGE(PG8_SB(1, 0), b3, voffB); PG8_STAGE(PG8_SB(1, 1), b3 + hstepB, voffB); PG8_STAGE(PG8_SA(1, 0), a3, voffA);
            PG8_WAIT_V(8); PG8_WAIT_L(0); PG8_BAR; PG8_MMA(1, 0, At, B0); PG8_MMA(1, 1, At, B1); PG8_BAR; PG8_SCHED;
            } else {
            PG8_LDB(B0, 0, 0); PG8_SCHED; PG8_LDA(At, 0, 0); PG8_STAGE(PG8_SA(1, 1), a1 + hstepA, voffA);
            PG8_WAIT_L(8); PG8_BAR; PG8_WAIT_L(0); PG8_MMA(0, 0, At, B0); PG8_BAR; PG8_SCHED;
            PG8_LDB(B1, 0, 1); PG8_STAGE(PG8_SB(0, 0), b2, voffB);
            PG8_BAR; PG8_WAIT_L(0); PG8_MMA(0, 1, At, B1); PG8_BAR;
            PG8_LDA(At, 0, 1); PG8_STAGE(PG8_SA(0, 0), a2, voffA);
            PG8_BAR; PG8_WAIT_L(0); PG8_MMA(1, 0, At, B0); PG8_BAR; PG8_SCHED;
            PG8_STAGE(PG8_SB(0, 1), b2 + hstepB, voffB);
            PG8_WAIT_V(6); PG8_BAR; PG8_MMA(1, 1, At, B1); PG8_BAR;
            PG8_LDB(B0, 1, 0); PG8_SCHED; PG8_LDA(At, 1, 0); PG8_STAGE(PG8_SA(0, 1), a2 + hstepA, voffA);
            PG8_WAIT_L(8); PG8_BAR; PG8_WAIT_L(0); PG8_MMA(0, 0, At, B0); PG8_BAR; PG8_SCHED;
            PG8_LDB(B1, 1, 1); PG8_STAGE(PG8_SB(1, 0), b3, voffB);
            PG8_BAR; PG8_WAIT_L(0); PG8_MMA(0, 1, At, B1); PG8_BAR;
            PG8_LDA(At, 1, 1); PG8_STAGE(PG8_SA(1, 0), a3, voffA);
            PG8_BAR; PG8_WAIT_L(0); PG8_MMA(1, 0, At, B0); PG8_BAR; PG8_SCHED;
            PG8_STAGE(PG8_SB(1, 1), b3 + hstepB, voffB);
            PG8_WAIT_V(6); PG8_BAR; PG8_MMA(1, 1, At, B1); PG8_BAR;
            }
        }
        if constexpr (ALIGN_EPI) { if (wr == 0) PG8_BAR; }
        E(acc, cur, wr, wc, fr, fq, pre);
        if (!has_next) break;
#pragma unroll
        for (int a = 0; a < 2; ++a)
#pragma unroll
            for (int b = 0; b < 2; ++b)
#pragma unroll
                for (int m = 0; m < 4; ++m)
#pragma unroll
                    for (int n = 0; n < 2; ++n) acc[a][b][m][n] = (f32x4){0.f, 0.f, 0.f, 0.f};
        cur = nxt; cA = nA; cB = nB; ++ui;
        if constexpr (ALIGN_EPI) { if (wr == 1) PG8_BAR; }
    }
    PG8_WAIT_V(0);
    if constexpr (!ALIGN_EPI) { if (wr == 0) PG8_BAR; }
    PG8_BAR;
#undef PG8_SA
#undef PG8_SB
#undef PG8_STAGE
#undef PG8_LDA
#undef PG8_LDB
#undef PG8_MMA
#undef PG8_WAIT_V
#undef PG8_WAIT_L
#undef PG8_BAR
#undef PG8_SCHED
}
}
constexpr size_t MiB = 1u << 20;
constexpr size_t WS_CTL = 0, CTL_ZERO_BYTES = 1 * MiB;
constexpr size_t WS_SSQ = 1 * MiB;
constexpr size_t WS_GATES = 2 * MiB;
constexpr size_t WS_NST = 3 * MiB;
constexpr size_t WS_W = 4 * MiB;
constexpr size_t W_GU1 = 0, W_D1 = 11 * MiB, W_IN = W_D1 + 11 * MiB / 2, W_OUT = W_IN + 7 * MiB, W_GU2 = W_OUT + 2 * MiB, W_D2 = W_GU2 + 11 * MiB, W_LAYER = 42 * MiB;
static_assert(W_D2 + 11 * MiB / 2 == W_LAYER, "weights map");
constexpr size_t WS_XB = 88 * MiB;
constexpr size_t WS_CST = 120 * MiB;
constexpr size_t WS_SST = 128 * MiB;
constexpr size_t WS_PROJ = 144 * MiB;
constexpr size_t WS_END = 248 * MiB;
static_assert(WS_PROJ + (size_t)M_TOK * PLD * 2 <= WS_END, "ws map");

constexpr int CW_BAR = 4096;
constexpr int CW_Q = 16384;

constexpr int RING_BYTES = 131072;
constexpr int LDSCTL_OFF = RING_BYTES, MISC_OFF = LDSCTL_OFF + 320;
constexpr int LDS_BYTES = 147456;
constexpr int NWAVES = 8, NTHREADS = 512;

typedef GAS unsigned gu32;
#define RLX_AGENT __ATOMIC_RELAXED, __HIP_MEMORY_SCOPE_AGENT
#define LDS_WAIT() asm volatile("s_waitcnt lgkmcnt(0)" ::: "memory")
#define VM_WAIT() asm volatile("s_waitcnt vmcnt(0)" ::: "memory")

#define XB_TMO      128
#define XB_XCNT(j)  (256  + 64 * (j))
#define XB_XSUB(j)  (1280 + 64 * (j))
#define XB_XGEN(j)  (2304 + 64 * (j))
#define XB_TOP      3328
#define XB_TOPGEN   3392
#define XCD_BAR_WORDS 3456
#define XB_SPIN_CAP (1u << 22)
__device__ __forceinline__ unsigned xb_ld(unsigned* p)              { return __hip_atomic_load(p, __ATOMIC_RELAXED, __HIP_MEMORY_SCOPE_AGENT); }
__device__ __forceinline__ unsigned xb_add(unsigned* p, unsigned v) { return __hip_atomic_fetch_add(p, v, __ATOMIC_RELAXED, __HIP_MEMORY_SCOPE_AGENT); }
__device__ __forceinline__ unsigned xb_xcc_id() { return (unsigned)__builtin_amdgcn_s_getreg((3 << 11) | 20) & 0xFu; }
#define XB_SPIN(cond, bar) do { unsigned _sp = 0; while (cond) { __builtin_amdgcn_s_sleep(1); \
    if ((++_sp & 255u) == 0u) { if (xb_ld(&(bar)[XB_TMO])) break; if (_sp > XB_SPIN_CAP) { atomicAdd(&(bar)[XB_TMO], 1u); break; } } } } while (0)
struct XcdBarrier { unsigned* bar; unsigned x; volatile LAS unsigned* st; };
__device__ __forceinline__ XcdBarrier xcd_barrier_post(unsigned* bar, volatile LAS unsigned* st) {
    XcdBarrier b; b.bar = bar; b.x = xb_xcc_id(); b.st = st;
    if (threadIdx.x == 0) (void)xb_add(&bar[XB_XCNT(b.x)], 1u);
    return b;
}
__device__ __forceinline__ void xcd_barrier_complete(unsigned* bar, unsigned x, unsigned& nloc, unsigned& nx) {
    const unsigned G = gridDim.x * gridDim.y * gridDim.z;
    unsigned sum, cnt, mine, sp = 0u;
    for (;;) {
        sum = 0u; cnt = 0u; mine = 0u;
#pragma unroll
        for (unsigned j = 0; j < 16; ++j) { const unsigned c = xb_ld(&bar[XB_XCNT(j)]); sum += c; cnt += (c > 0u) ? 1u : 0u; mine = (j == x) ? c : mine; }
        if (sum == G) break;
        __builtin_amdgcn_s_sleep(1);
        if ((++sp & 255u) == 0u) { if (xb_ld(&bar[XB_TMO])) break; if (sp > XB_SPIN_CAP) { atomicAdd(&bar[XB_TMO], 1u); break; } }
    }
    nloc = mine > 0u ? mine : 1u; nx = cnt > 0u ? cnt : 1u;
}
__device__ __forceinline__ void xcd_barrier(const XcdBarrier& b) {
    asm volatile("s_waitcnt vmcnt(0)" ::: "memory");
    __syncthreads();
    if (threadIdx.x == 0) {
        unsigned* bar = b.bar;
        __builtin_amdgcn_s_waitcnt(0);
        unsigned nloc = b.st[0], nx = b.st[1];
        if (nloc == 0u) { xcd_barrier_complete(bar, b.x, nloc, nx); b.st[0] = nloc; b.st[1] = nx; }
        const unsigned old = xb_add(&bar[XB_XSUB(b.x)], 1u);
        const unsigned gen = old / nloc;
        if (old + 1u == (gen + 1u) * nloc) {
            __builtin_amdgcn_fence(__ATOMIC_RELEASE, "agent");
            asm volatile("s_waitcnt vmcnt(0)" ::: "memory");
            const unsigned og = xb_add(&bar[XB_TOP], 1u);
            const unsigned tg = og / nx;
            if (og + 1u == (tg + 1u) * nx) xb_add(&bar[XB_TOPGEN], 1u);
            else XB_SPIN(xb_ld(&bar[XB_TOPGEN]) == tg, bar);
            __builtin_amdgcn_fence(__ATOMIC_ACQUIRE, "agent");
            xb_add(&bar[XB_XGEN(b.x)], 1u);
            asm volatile("s_waitcnt vmcnt(0)" ::: "memory");
        } else {
            XB_SPIN(xb_ld(&bar[XB_XGEN(b.x)]) == gen, bar);
            __builtin_amdgcn_fence(__ATOMIC_ACQUIRE, "agent");
            asm volatile("s_waitcnt vmcnt(0)" ::: "memory");
        }
    }
    __syncthreads();
}

struct Args { const float* in[25]; float* out; unsigned char* ws; int ph_lo, ph_hi; };
typedef const float* fptr_t; typedef __attribute__((address_space(4))) const fptr_t* kinptr_t;
struct ArgView { kinptr_t in; };
struct Frame {
    LAS unsigned char* lds;
    volatile LAS unsigned* MISC;
    unsigned* ctl;
    int tid, lane, wave, vcu, G;
    kinptr_t in;
    unsigned char* ws;
};
__device__ __forceinline__ float wave_sum(float v) {
#pragma unroll
    for (int o = 1; o < 64; o <<= 1) v += __shfl_xor(v, o);
    return v;
}
__device__ __forceinline__ int q_next(Frame& F, int q) {
    __syncthreads();
    if (F.tid == 0) F.MISC[16] = xb_add(F.ctl + CW_Q + 64 * q, 1u);
    __syncthreads();
    return (int)F.MISC[16];
}

struct MapPlain { __device__ __forceinline__ int row(int n) const { return n; } __device__ __forceinline__ float scale(int) const { return 1.f; } };
struct MapGU { int off; __device__ __forceinline__ int row(int n) const { return 256 * (n >> 7) + off + (n & 127); } __device__ __forceinline__ float scale(int) const { return 1.f; } };
struct MapIn {
    __device__ __forceinline__ int row(int n) const {
        if (n < 1024) return n;
        if (n < 1032) return 13 * 256 + (n - 1024);
        if (n < 1544) return 4 * 256 + (n - 1032);
        if (n < 2568) return 6 * 256 + (n - 1544);
        if (n < 2576) return 13 * 256 + 8 + (n - 2568);
        return 10 * 256 + (n - 2576);
    }
    __device__ __forceinline__ float scale(int n) const { return (n >= 256 && n < 512) ? 0.125f : 1.f; }
};
template <class Map>
__device__ __forceinline__ void p0_transpose_item(const float* W, int K, int N, bf16_t* WT, int item, int lane, const float* gain, const Map map) {
    const int nblk = (N + 63) / 64, kb = item / nblk, nb = item % nblk, k0 = 64 * kb, n = 64 * nb + lane;
    if (n >= N) return;
    const float* src = W + (size_t)k0 * N + n;
    float v[64];
#pragma unroll
    for (int i = 0; i < 64; ++i) v[i] = src[(size_t)i * N];
    const float sc = map.scale(n);
    if (gain) {
#pragma unroll
        for (int i = 0; i < 64; i += 4) { const f32x4 g = *(const f32x4*)(gain + k0 + i); v[i] *= g.x; v[i + 1] *= g.y; v[i + 2] *= g.z; v[i + 3] *= g.w; }
    }
    u32x4* dst = (u32x4*)(WT + (size_t)map.row(n) * K + k0);
#pragma unroll
    for (int c = 0; c < 8; ++c) { u32x4 o; o.x = cvtpk(v[8 * c] * sc, v[8 * c + 1] * sc); o.y = cvtpk(v[8 * c + 2] * sc, v[8 * c + 3] * sc); o.z = cvtpk(v[8 * c + 4] * sc, v[8 * c + 5] * sc); o.w = cvtpk(v[8 * c + 6] * sc, v[8 * c + 7] * sc); dst[c] = o; }
}
constexpr int I_G = (DM / 64) * (FF / 64), I_D = (FF / 64) * (DM / 64), I_IN = (DM / 64) * ((3344 + 63) / 64), I_OUT = (DM / 64) * (DM / 64);
constexpr int R_GU1 = 0, R_D1 = 2 * I_G, R_IN = R_D1 + I_D, R_OUT = R_IN + I_IN, R_GU2 = R_OUT + I_OUT, R_D2 = R_GU2 + 2 * I_G, R_END = R_D2 + I_D;
__device__ __forceinline__ void convert_items(Frame& F, int l, int r_lo, int r_hi, int gw, int NGW) {
    bf16_t* WL = (bf16_t*)(F.ws + WS_W + (size_t)l * W_LAYER);
    for (int it = r_lo + gw; it < r_hi; it += NGW) {
        int r = it;
        if (r < I_G) { p0_transpose_item(F.in[2] + (size_t)l * DM * FF, DM, FF, (bf16_t*)((char*)WL + W_GU1), r, F.lane, F.in[1] + l * DM, MapGU{0}); continue; } r -= I_G;
        if (r < I_G) { p0_transpose_item(F.in[3] + (size_t)l * DM * FF, DM, FF, (bf16_t*)((char*)WL + W_GU1), r, F.lane, F.in[1] + l * DM, MapGU{128}); continue; } r -= I_G;
        if (r < I_D) { p0_transpose_item(F.in[4] + (size_t)l * FF * DM, FF, DM, (bf16_t*)((char*)WL + W_D1), r, F.lane, nullptr, MapPlain{}); continue; } r -= I_D;
        if (r < I_IN) { p0_transpose_item(F.in[6] + (size_t)l * DM * 3344, DM, 3344, (bf16_t*)((char*)WL + W_IN), r, F.lane, F.in[5] + l * DM, MapIn{}); continue; } r -= I_IN;
        if (r < I_OUT) { p0_transpose_item(F.in[20] + (size_t)l * DM * DM, DM, DM, (bf16_t*)((char*)WL + W_OUT), r, F.lane, nullptr, MapPlain{}); continue; } r -= I_OUT;
        if (r < I_G) { p0_transpose_item(F.in[22] + (size_t)l * DM * FF, DM, FF, (bf16_t*)((char*)WL + W_GU2), r, F.lane, F.in[21] + l * DM, MapGU{0}); continue; } r -= I_G;
        if (r < I_G) { p0_transpose_item(F.in[23] + (size_t)l * DM * FF, DM, FF, (bf16_t*)((char*)WL + W_GU2), r, F.lane, F.in[21] + l * DM, MapGU{128}); continue; } r -= I_G;
        p0_transpose_item(F.in[24] + (size_t)l * FF * DM, FF, DM, (bf16_t*)((char*)WL + W_D2), r, F.lane, nullptr, MapPlain{});
    }
    if (r_lo <= R_IN && R_IN < r_hi) {
        u32x4* z = (u32x4*)(F.ws + WS_W + (size_t)l * W_LAYER + W_IN + (size_t)(13 * 256 + 16) * DM * 2);
        const int n16 = 240 * DM * 2 / 16;
        unsigned z0 = 0u; asm volatile("" : "+v"(z0));
        for (int i = gw * 64 + F.lane; i < n16; i += NGW * 64) z[i] = (u32x4){z0, z0, z0, z0};
    }
}
__device__ __forceinline__ void side_convert(Frame& F, int l, int k) {
    if ((int)blockIdx.x < 128 || F.G != 256) return;
    const int gw = ((int)blockIdx.x - 128) * NWAVES + F.wave, NGW = 128 * NWAVES;
    if (l == 0 && k == 0) convert_items(F, 0, R_D1, R_OUT, gw, NGW);
    else if (l == 0 && k == 2) convert_items(F, 0, R_OUT, R_END, gw, NGW);
    else if (l == 0 && k == 7) convert_items(F, 1, R_GU1, R_D1, gw, NGW);
    else if (l == 1 && k == 0) convert_items(F, 1, R_D1, R_GU2, gw, NGW);
    else if (l == 1 && k == 2) convert_items(F, 1, R_GU2, R_D2, gw, NGW);
    else if (l == 1 && k == 7) convert_items(F, 1, R_D2, R_END, gw, NGW);
}
__device__ __forceinline__ void p0_prologue(Frame& F) {
    const int gw = F.vcu * NWAVES + F.wave, NGW = F.G * NWAVES;
    if (F.G == 256) convert_items(F, 0, R_GU1, R_D1, gw, NGW);
    else { convert_items(F, 0, 0, R_END, gw, NGW); convert_items(F, 1, 0, R_END, gw, NGW); }
    const float* x = F.in[0]; bf16_t* XB = (bf16_t*)(F.ws + WS_XB); float* SSQ = (float*)(F.ws + WS_SSQ);
    for (int m = gw; m < M_TOK; m += NGW) {
        const f32x4* xr = (const f32x4*)(x + (size_t)m * DM) + F.lane; float s = 0.f; f32x4 v[4];
#pragma unroll
        for (int j = 0; j < 4; ++j) { v[j] = xr[64 * j]; s += (v[j].x * v[j].x + v[j].y * v[j].y) + (v[j].z * v[j].z + v[j].w * v[j].w); }
        s = wave_sum(s);
        u32x2* o8 = (u32x2*)(XB + (size_t)m * DM) + F.lane;
#pragma unroll
        for (int j = 0; j < 4; ++j) o8[64 * j] = (u32x2){cvtpk(v[j].x, v[j].y), cvtpk(v[j].z, v[j].w)};
        if (F.lane < 16) SSQ[(size_t)m * 16 + F.lane] = (F.lane == 0) ? s : 0.f;
    }
}

__device__ __forceinline__ void rows_rs(const float* ssq, int rowbase, int fr, int fq, float (&rs)[8]) {
    f32x4 p[8];
#pragma unroll
    for (int i = 0; i < 8; ++i) { const int row = rowbase + (i >> 2) * 128 + (i & 3) * 16 + fr; p[i] = *(const f32x4*)(ssq + (size_t)row * 16 + 4 * fq); }
#pragma unroll
    for (int i = 0; i < 8; ++i) { float s = (p[i].x + p[i].y) + (p[i].z + p[i].w); s += __shfl_xor(s, 16); s += __shfl_xor(s, 32); rs[i] = rsqrtf(s * (1.0f / DM) + NORM_EPS); }
}
struct RowScale { f32x4 p[8]; float rs[8]; int pm; };
__device__ __forceinline__ void rowscale_load(RowScale& R, const float* ssq, const pg8::Unit& u, int wr, int fr, int fq) {
    R.pm = u.pm;
#pragma unroll
    for (int i = 0; i < 8; ++i) { const int row = u.pm * 256 + wr * 64 + (i >> 2) * 128 + (i & 3) * 16 + fr; R.p[i] = *(const f32x4*)(ssq + (size_t)row * 16 + 4 * fq); }
}
__device__ __forceinline__ void rowscale_finish(RowScale& R) {
#pragma unroll
    for (int i = 0; i < 8; ++i) { float s = (R.p[i].x + R.p[i].y) + (R.p[i].z + R.p[i].w); s += __shfl_xor(s, 16); s += __shfl_xor(s, 32); R.rs[i] = rsqrtf(s * (1.0f / DM) + NORM_EPS); asm volatile("" : "+v"(R.rs[i])); }
}
struct EpiNoInit { struct Raw {}; static constexpr bool HAS_INIT = false; __device__ __forceinline__ void init_load(Raw&, const pg8::Unit&, int, int, int, int) const {}
    struct Pre {}; __device__ __forceinline__ void pre_load(Pre&, const pg8::Unit&, int, int, int) const {} __device__ __forceinline__ void pre_finish(Pre&) const {} };
struct EpiSwiglu : EpiNoInit {
    bf16_t* H; const float* ssq;
    typedef RowScale Pre;
    __device__ __forceinline__ void pre_load(Pre& R, const pg8::Unit& u, int wr, int fr, int fq) const { rowscale_load(R, ssq, u, wr, fr, fq); }
    __device__ __forceinline__ void pre_finish(Pre& R) const { rowscale_finish(R); }
    __device__ __forceinline__ void operator()(const f32x4 (&acc)[2][2][4][2], const pg8::Unit& u, int wr, int wc, int fr, int fq, Pre& R) const {
        asm volatile("" : "+v"(fr), "+v"(fq));
        const int col0 = u.pn * 128 + wc * 32 + 8 * fq;
        if (u.pm != R.pm) { rowscale_load(R, ssq, u, wr, fr, fq); rowscale_finish(R); }
        const float (&rs)[8] = R.rs;
#pragma unroll
        for (int ai = 0; ai < 2; ++ai)
#pragma unroll
            for (int m = 0; m < 4; ++m) {
                const int row = u.pm * 256 + ai * 128 + wr * 64 + m * 16 + fr; const float r = rs[ai * 4 + m];
                float hv[8];
#pragma unroll
                for (int n = 0; n < 2; ++n)
#pragma unroll
                    for (int j = 0; j < 4; ++j) { const float g = acc[ai][0][m][n][j] * r, up = acc[ai][1][m][n][j] * r; hv[4 * n + j] = siluf_(g) * up; }
                u32x4 w; w.x = cvtpk(hv[0], hv[1]); w.y = cvtpk(hv[2], hv[3]); w.z = cvtpk(hv[4], hv[5]); w.w = cvtpk(hv[6], hv[7]);
                st16_wt(H + (size_t)row * FF + col0, w);
                if (m & 1) asm volatile("" ::: "memory");
            }
    }
};
template <bool FINAL>
struct EpiResid {
    struct Raw { u32x4 r[2][4][2]; };
    static constexpr bool HAS_INIT = true;
    struct Pre {}; __device__ __forceinline__ void pre_load(Pre&, const pg8::Unit&, int, int, int) const {} __device__ __forceinline__ void pre_finish(Pre&) const {}
    float* xout; bf16_t* XB; float* ssq; float alpha, ralpha;
    __device__ __forceinline__ void init_load(Raw& raw, const pg8::Unit& u, int wr, int wc, int fr, int fq) const {
        const int col0 = u.pn * 256 + wc * 32 + 8 * fq;
#pragma unroll
        for (int ai = 0; ai < 2; ++ai)
#pragma unroll
            for (int m = 0; m < 4; ++m) { const int row = u.pm * 256 + ai * 128 + wr * 64 + m * 16 + fr;
#pragma unroll
                for (int bj = 0; bj < 2; ++bj) raw.r[ai][m][bj] = *(const u32x4*)(XB + (size_t)row * DM + col0 + bj * 128); }
    }
    __device__ __forceinline__ void init_finish(const Raw& raw, f32x4 (&acc)[2][2][4][2]) const {
#pragma unroll
        for (int ai = 0; ai < 2; ++ai)
#pragma unroll
            for (int m = 0; m < 4; ++m)
#pragma unroll
                for (int bj = 0; bj < 2; ++bj) { const u32x4 w = raw.r[ai][m][bj];
                    acc[ai][bj][m][0] = (f32x4){bflo(w.x), bfhi(w.x), bflo(w.y), bfhi(w.y)} * ralpha; acc[ai][bj][m][1] = (f32x4){bflo(w.z), bfhi(w.z), bflo(w.w), bfhi(w.w)} * ralpha; }
    }
    __device__ __forceinline__ void operator()(const f32x4 (&acc)[2][2][4][2], const pg8::Unit& u, int wr, int wc, int fr, int fq, Pre&) const {
        asm volatile("" : "+v"(fr), "+v"(fq));
        const int col0 = u.pn * 256 + wc * 32 + 8 * fq;
#pragma unroll
        for (int ai = 0; ai < 2; ++ai)
#pragma unroll
            for (int m = 0; m < 4; ++m) {
                const int row = u.pm * 256 + ai * 128 + wr * 64 + m * 16 + fr; float ss = 0.f;
#pragma unroll
                for (int bj = 0; bj < 2; ++bj) {
                    const size_t off = (size_t)row * DM + col0 + bj * 128;
                    const f32x4 y0 = acc[ai][bj][m][0] * alpha, y1 = acc[ai][bj][m][1] * alpha;
                    if (FINAL) { *(f32x4*)(xout + off) = y0; *(f32x4*)(xout + off + 4) = y1; }
                    else {
                        ss += (y0.x * y0.x + y0.y * y0.y) + (y0.z * y0.z + y0.w * y0.w) + (y1.x * y1.x + y1.y * y1.y) + (y1.z * y1.z + y1.w * y1.w);
                        u32x4 w; w.x = cvtpk(y0.x, y0.y); w.y = cvtpk(y0.z, y0.w); w.z = cvtpk(y1.x, y1.y); w.w = cvtpk(y1.z, y1.w);
                        st16_wt(XB + off, w); }
                }
                if (!FINAL) { ss += __shfl_xor(ss, 16); ss += __shfl_xor(ss, 32);
                    if (fq == 0) ssq[(size_t)row * 16 + u.pn * 4 + wc] = ss; }
                if (m & 1) asm volatile("" ::: "memory");
            }
    }
};
struct EpiInProj : EpiNoInit {
    bf16_t* PROJ; float* GATES; const float* ssq; const float* qnw; const float* knw; const float* gbias; const float* dtb;
    template <int KIND>
    __device__ __forceinline__ void body(const f32x4 (&acc)[2][2][4][2], const pg8::Unit& u, int wr, int wc, int fr, int fq, const float (&rs)[8]) const {
        const int t = u.pn, colw = wc * 32 + 8 * fq;
        float nw[8];
        if (KIND == 3) { const float* w = (t == 10 ? qnw : knw) + (wc & 1) * 32 + 8 * fq; const float sc = (t == 10) ? (0.17677669529663687f * LOG2E) : 1.f;
#pragma unroll
            for (int i = 0; i < 8; ++i) nw[i] = w[i] * sc; }
#pragma unroll
        for (int ai = 0; ai < 2; ++ai)
#pragma unroll
            for (int m = 0; m < 4; ++m) {
                const int row = u.pm * 256 + ai * 128 + wr * 64 + m * 16 + fr; const float r = rs[ai * 4 + m];
#pragma unroll
                for (int bj = 0; bj < 2; ++bj) {
                    float v[8];
#pragma unroll
                    for (int n = 0; n < 2; ++n)
#pragma unroll
                        for (int j = 0; j < 4; ++j) v[4 * n + j] = acc[ai][bj][m][n][j] * r;
                    if (KIND == 1) {
#pragma unroll
                        for (int i = 0; i < 8; ++i) v[i] = sigmoidf_(v[i]);
                    } else if (KIND == 2) {
#pragma unroll
                        for (int i = 0; i < 8; ++i) v[i] = siluf_(v[i]);
                    } else if (KIND == 3) {
                        float ss = 0.f;
#pragma unroll
                        for (int i = 0; i < 8; ++i) ss += v[i] * v[i];
                        ss += __shfl_xor(ss, 16); ss += __shfl_xor(ss, 32);
                        const float q = rsqrtf(ss * (1.0f / 32.0f) + NORM_EPS);
#pragma unroll
                        for (int i = 0; i < 8; ++i) v[i] = v[i] * q * nw[i];
                    }
                    u32x4 w; w.x = cvtpk(v[0], v[1]); w.y = cvtpk(v[2], v[3]); w.z = cvtpk(v[4], v[5]); w.w = cvtpk(v[6], v[7]);
                    st16_wt(PROJ + (size_t)row * PLD + t * 256 + bj * 128 + colw, w);
                }
                if (m & 1) asm volatile("" ::: "memory");
            }
    }
    __device__ __forceinline__ void gates(const f32x4 (&acc)[2][2][4][2], const pg8::Unit& u, int wr, int wc, int fr, int fq, const float (&rs)[8]) const {
        if (wc != 0 || fq >= 2) return;
#pragma unroll
        for (int ai = 0; ai < 2; ++ai)
#pragma unroll
            for (int m = 0; m < 4; ++m) {
                const int row = u.pm * 256 + ai * 128 + wr * 64 + m * 16 + fr; const float r = rs[ai * 4 + m];
                float v[8], o[8];
#pragma unroll
                for (int n = 0; n < 2; ++n)
#pragma unroll
                    for (int j = 0; j < 4; ++j) v[4 * n + j] = acc[ai][0][m][n][j] * r;
                if (fq == 0) {
#pragma unroll
                    for (int j = 0; j < 4; ++j) { o[j] = v[j] + gbias[j]; const float z = v[4 + j] + gbias[4 + j]; o[4 + j] = fminf(z, 0.f) - fast_log1pexp(-fabsf(z)); }
                } else {
#pragma unroll
                    for (int j = 0; j < 8; ++j) { const float z = v[j] + dtb[j]; o[j] = fmaxf(z, 0.f) + fast_log1pexp(-fabsf(z)); }
                }
                float* gp = GATES + (size_t)row * 16 + 8 * fq;
                *(f32x4*)gp = (f32x4){o[0], o[1], o[2], o[3]}; *(f32x4*)(gp + 4) = (f32x4){o[4], o[5], o[6], o[7]};
                asm volatile("" ::: "memory");
            }
    }
    typedef RowScale Pre;
    __device__ __forceinline__ void pre_load(Pre& R, const pg8::Unit& u, int wr, int fr, int fq) const { rowscale_load(R, ssq, u, wr, fr, fq); }
    __device__ __forceinline__ void pre_finish(Pre& R) const { rowscale_finish(R); }
    __device__ __forceinline__ void operator()(const f32x4 (&acc)[2][2][4][2], const pg8::Unit& u, int wr, int wc, int fr, int fq, Pre& R) const {
        asm volatile("" : "+v"(fr), "+v"(fq));
        if (u.pm != R.pm) { rowscale_load(R, ssq, u, wr, fr, fq); rowscale_finish(R); }
        const float (&rs)[8] = R.rs;
        const int t = u.pn;
        if (t == 13) gates(acc, u, wr, wc, fr, fq, rs);
        else if (t == 3) body<1>(acc, u, wr, wc, fr, fq, rs);
        else if (t == 4 || t == 5) body<2>(acc, u, wr, wc, fr, fq, rs);
        else if (t == 10 || t == 11) body<3>(acc, u, wr, wc, fr, fq, rs);
        else body<0>(acc, u, wr, wc, fr, fq, rs);
    }
};
#define MFMA16(a, b, c) __builtin_amdgcn_mfma_f32_16x16x32_bf16((a), (b), (c), 0, 0, 0)
#define WAVE_SYNC() do { asm volatile("s_waitcnt lgkmcnt(0)" ::: "memory"); __builtin_amdgcn_wave_barrier(); } while (0)
#define LDS_BARRIER() do { asm volatile("s_waitcnt lgkmcnt(0)" ::: "memory"); __builtin_amdgcn_s_barrier(); asm volatile("" ::: "memory"); } while (0)
__device__ __forceinline__ bf16x8 ld_g8(const bf16_t* p) { return *(const bf16x8*)p; }
__device__ __forceinline__ bf16x8 ld_l8(const LAS bf16_t* p) { return *(const LAS bf16x8*)p; }
__device__ __forceinline__ bf16x8 ld_l44(const LAS bf16_t* p0, const LAS bf16_t* p1) { const bf16x4 a = *(const LAS bf16x4*)p0, b = *(const LAS bf16x4*)p1; return (bf16x8){a[0], a[1], a[2], a[3], b[0], b[1], b[2], b[3]}; }
__device__ __forceinline__ bf16x8 pack8(const f32x4 a, const f32x4 b) { u32x4 w; w.x = cvtpk(a[0], a[1]); w.y = cvtpk(a[2], a[3]); w.z = cvtpk(b[0], b[1]); w.w = cvtpk(b[2], b[3]); return __builtin_bit_cast(bf16x8, w); }
__device__ __forceinline__ float wave_scan_incl(float v, int lane) {
#pragma unroll
    for (int o = 1; o < 64; o <<= 1) { const float t = __shfl_up(v, o); if (lane >= o) v += t; }
    return v;
}

typedef short v4i16_t __attribute__((ext_vector_type(4)));
__device__ __forceinline__ bf16x8 ld_tr8(const LAS bf16_t* T, int pitch, int k0, int c0, int lane) {
    const int i = lane & 15, fq = lane >> 4;
    const LAS bf16_t* p = T + (k0 + 8 * fq + (i >> 2)) * pitch + c0 + 4 * (i & 3);
    const v4i16_t lo = __builtin_amdgcn_ds_read_tr16_b64_v4i16((LAS v4i16_t*)p), hi = __builtin_amdgcn_ds_read_tr16_b64_v4i16((LAS v4i16_t*)(p + 4 * pitch));
    return (bf16x8){lo[0], lo[1], lo[2], lo[3], hi[0], hi[1], hi[2], hi[3]};
}
__device__ __forceinline__ bf16x8 ld_tr8p(const LAS bf16_t* T, int pitch, int k0, int c0, int lane) {
    const int i = lane & 15, fq = lane >> 4;
    const LAS bf16_t* p = T + (k0 + 4 * fq + (i >> 2)) * pitch + c0 + 4 * (i & 3);
    const v4i16_t lo = __builtin_amdgcn_ds_read_tr16_b64_v4i16((LAS v4i16_t*)p), hi = __builtin_amdgcn_ds_read_tr16_b64_v4i16((LAS v4i16_t*)(p + 16 * pitch));
    return (bf16x8){lo[0], lo[1], lo[2], lo[3], hi[0], hi[1], hi[2], hi[3]};
}

__device__ __forceinline__ void conv_phase(Frame& F, int l) {
    const bf16_t* PROJ = (const bf16_t*)(F.ws + WS_PROJ); bf16_t* XACT = (bf16_t*)F.in[25];
    const float* cw = F.in[9] + (size_t)l * 4 * 1024; const float* cb = F.in[10] + (size_t)l * 1024;
    for (int g = F.vcu * NTHREADS + F.tid; g < 1024 * 128; g += F.G * NTHREADS) {
        const int cg = g & 127, rb = g >> 7, ch0 = cg * 8, row0 = rb * 16;
        float w[4][8], bs[8];
#pragma unroll
        for (int j = 0; j < 4; ++j) { const f32x4 a = *(const f32x4*)(cw + j * 1024 + ch0), b = *(const f32x4*)(cw + j * 1024 + ch0 + 4);
            w[j][0] = a.x; w[j][1] = a.y; w[j][2] = a.z; w[j][3] = a.w; w[j][4] = b.x; w[j][5] = b.y; w[j][6] = b.z; w[j][7] = b.w; }
        { const f32x4 a = *(const f32x4*)(cb + ch0), b = *(const f32x4*)(cb + ch0 + 4); bs[0] = a.x; bs[1] = a.y; bs[2] = a.z; bs[3] = a.w; bs[4] = b.x; bs[5] = b.y; bs[6] = b.z; bs[7] = b.w; }
        float h3[8], h2[8], h1[8];
        const bool first = (row0 % SEQ) == 0;
        const bf16_t* src = PROJ + (size_t)row0 * PLD + PX + ch0;
        if (first) {
#pragma unroll
            for (int e = 0; e < 8; ++e) { h3[e] = 0.f; h2[e] = 0.f; h1[e] = 0.f; }
        } else {
            const u32x4 a = *(const u32x4*)(src - 3 * (size_t)PLD), b = *(const u32x4*)(src - 2 * (size_t)PLD), c = *(const u32x4*)(src - (size_t)PLD);
#pragma unroll
            for (int e = 0; e < 4; ++e) { h3[2 * e] = bflo(a[e]); h3[2 * e + 1] = bfhi(a[e]); h2[2 * e] = bflo(b[e]); h2[2 * e + 1] = bfhi(b[e]); h1[2 * e] = bflo(c[e]); h1[2 * e + 1] = bfhi(c[e]); }
        }
        u32x4 dr[16];
#pragma unroll
        for (int i = 0; i < 16; ++i) dr[i] = *(const u32x4*)(src + (size_t)i * PLD);
#pragma unroll
        for (int i = 0; i < 16; ++i) {
            const u32x4 d = dr[i]; float cur[8], o[8];
#pragma unroll
            for (int e = 0; e < 4; ++e) { cur[2 * e] = bflo(d[e]); cur[2 * e + 1] = bfhi(d[e]); }
#pragma unroll
            for (int e = 0; e < 8; ++e) { const float s = bs[e] + w[0][e] * h3[e] + w[1][e] * h2[e] + w[2][e] * h1[e] + w[3][e] * cur[e]; o[e] = siluf_(s); h3[e] = h2[e]; h2[e] = h1[e]; h1[e] = cur[e]; }
            u32x4 ow; ow.x = cvtpk(o[0], o[1]); ow.y = cvtpk(o[2], o[3]); ow.z = cvtpk(o[4], o[5]); ow.w = cvtpk(o[6], o[7]);
            *(u32x4*)(XACT + (size_t)(row0 + i) * 1024 + ch0) = ow;
        }
    }
}

__device__ __forceinline__ void mlstm_state_item(Frame& F, int bh) {
    const int b = bh >> 2, h = bh & 3, w = F.wave, vq = w & 3, dh = w >> 2, lane = F.lane, fr = lane & 15, fq = lane >> 4, tid = F.tid;
    constexpr int MP = 72, MBUF = 2 * 64 * MP * 2 + 128;
    LAS float* WG = (LAS float*)(F.lds + 2 * MBUF); LAS float* DEC = WG + 4096;
    const bf16_t* PROJ = (const bf16_t*)(F.ws + WS_PROJ); const float* GATES = (const float*)(F.ws + WS_GATES);
    bf16_t* CST = (bf16_t*)(F.ws + WS_CST); float* NST = (float*)(F.ws + WS_NST);
    const size_t rowb = (size_t)b * SEQ;
    {
        float igv[8], lfv[8];
#pragma unroll
        for (int i = 0; i < 8; ++i) { const float* gq = GATES + (rowb + 64 * (w + 8 * i) + lane) * 16 + h; igv[i] = gq[0]; lfv[i] = gq[4]; }
#pragma unroll
        for (int i = 0; i < 8; ++i) { const int c = w + 8 * i;
            const float bs = wave_scan_incl(lfv[i], lane); const float bl = __shfl(bs, 63);
            WG[64 * c + lane] = fast_exp(bl - bs + igv[i]); if (lane == 0) DEC[c] = fast_exp(bl); }
    }
    f32x4 acc[2], nacc[2];
    acc[0] = acc[1] = nacc[0] = nacc[1] = (f32x4){0.f, 0.f, 0.f, 0.f};
    const int ls = tid >> 3, lc = tid & 7;
    const bf16_t* kp = PROJ + (rowb + ls) * PLD + PK + h * 64 + 8 * lc; const bf16_t* vp = PROJ + (rowb + ls) * PLD + PV + h * 64 + 8 * lc;
    u32x4 k0, v0, k1, v1, k2, v2;
#define ML_LOAD(kr_, vr_, c_) do { const size_t o_ = (size_t)(c_) * 64 * PLD; kr_ = *(const u32x4*)(kp + o_); vr_ = *(const u32x4*)(vp + o_); } while (0)
#define ML_WRITE(kr_, vr_, c_) do { LAS bf16_t* KL_ = (LAS bf16_t*)(F.lds + ((c_) & 1) * MBUF); LAS bf16_t* VL_ = KL_ + 64 * MP; const float wg_ = WG[64 * (c_) + ls]; \
        *(LAS u32x4*)(KL_ + ls * MP + 8 * lc) = kr_; u32x4 o_; _Pragma("unroll") for (int e_ = 0; e_ < 4; ++e_) o_[e_] = cvtpk(wg_ * bflo(vr_[e_]), wg_ * bfhi(vr_[e_])); \
        *(LAS u32x4*)(VL_ + ls * MP + 8 * lc) = o_; if (lc == 0) (VL_ + 64 * MP)[ls] = f2bf(wg_); } while (0)
    LAS bf16_t* STG = (LAS bf16_t*)(F.lds + 2 * MBUF + 16384 + 256); LAS float* NSTG = (LAS float*)(STG + 2 * 4096);
#define ML_STAGE(c_) do { LAS bf16_t* sg_ = STG + ((c_) & 1) * 4096; \
        _Pragma("unroll") for (int dt = 0; dt < 2; ++dt) _Pragma("unroll") for (int r = 0; r < 4; ++r) sg_[(vq * 16 + 4 * fq + r) * 64 + dh * 32 + dt * 16 + fr] = f2bf(acc[dt][r]); \
        if (vq == 0 && fq == 0) { NSTG[((c_) & 1) * 64 + dh * 32 + fr] = nacc[0][0]; NSTG[((c_) & 1) * 64 + dh * 32 + 16 + fr] = nacc[1][0]; } } while (0)
    ML_LOAD(k0, v0, 0); ML_LOAD(k1, v1, 1); ML_LOAD(k2, v2, 2);
    __syncthreads();
    ML_WRITE(k0, v0, 0);
    ML_STAGE(0);
    LDS_BARRIER();
#define ML_STEP(KW, VW, KN, VN, c_) do { const int cc_ = (c_); const size_t ci = (size_t)bh * 64 + cc_; \
          \
        { const u32x4 st_ = *(const LAS u32x4*)(STG + ((cc_) & 1) * 4096 + tid * 8); *(u32x4*)(CST + ci * 4096 + tid * 8) = st_; \
          NST[ci * 64 + (tid & 63)] = NSTG[((cc_) & 1) * 64 + (tid & 63)]; }     \
        asm volatile("" ::: "memory"); \
        if (cc_ + 1 < 64) ML_WRITE(KW, VW, cc_ + 1); \
        asm volatile("" ::: "memory"); \
        ML_LOAD(KN, VN, (cc_ + 3 < 64 ? cc_ + 3 : 63)); \
        asm volatile("" ::: "memory"); \
        const float decay = DEC[cc_]; \
        const LAS bf16_t* KL = (const LAS bf16_t*)(F.lds + (cc_ & 1) * MBUF); const LAS bf16_t* VL = KL + 64 * MP; const LAS bf16_t* WV = VL + 64 * MP; \
        _Pragma("unroll") for (int dt = 0; dt < 2; ++dt) { acc[dt] = acc[dt] * decay; nacc[dt] = nacc[dt] * decay; } \
        _Pragma("unroll") for (int ks = 0; ks < 2; ++ks) { \
            const bf16x8 A = ld_tr8(VL, MP, 32 * ks, 16 * vq, lane); \
            bf16x8 An = ld_l8(WV + 32 * ks + 8 * fq); if (fr != 0) An = (bf16x8){0, 0, 0, 0, 0, 0, 0, 0}; \
            _Pragma("unroll") for (int dt = 0; dt < 2; ++dt) { const bf16x8 B = ld_tr8(KL, MP, 32 * ks, 32 * dh + 16 * dt, lane); \
                acc[dt] = MFMA16(A, B, acc[dt]); if (vq == 0) nacc[dt] = MFMA16(An, B, nacc[dt]); } } \
        ML_STAGE(cc_ + 1); \
        LDS_BARRIER(); } while (0)
    for (int c = 0; c < 63; c += 3) { ML_STEP(k1, v1, k0, v0, c); ML_STEP(k2, v2, k1, v1, c + 1); ML_STEP(k0, v0, k2, v2, c + 2); }
    ML_STEP(k1, v1, k0, v0, 63);
#undef ML_STEP
#undef ML_LOAD
#undef ML_WRITE
#undef ML_STAGE
}

template <int TH>
__device__ __forceinline__ void mlstm_out_wave(Frame& F, int l, int bc, int h) {
    const int b = bc >> 6, c = bc & 63, w = F.wave, lane = F.lane, fr = lane & 15, fq = lane >> 4;
    constexpr int VP = 72;
    LAS bf16_t* VL = (LAS bf16_t*)(F.lds + w * 12288); LAS float* BT_ = (LAS float*)(F.lds + w * 12288 + 9216); LAS float* GS = BT_ + 64;
    LAS bf16_t* YS = VL;
    const bf16_t* PROJ = (const bf16_t*)(F.ws + WS_PROJ); const float* GATES = (const float*)(F.ws + WS_GATES);
    const bf16_t* CST = (const bf16_t*)(F.ws + WS_CST); const float* NST = (const float*)(F.ws + WS_NST);
    bf16_t* Y = (bf16_t*)(F.ws + WS_PROJ) + PX;
    const size_t row0 = (size_t)b * SEQ + 64 * c; const size_t ci = (size_t)(b * 4 + h) * 64 + c;
    constexpr int NST_ = 2 * TH + 2, NKK = TH + 1;
    {
        const size_t row = row0 + lane;
        const float ig = GATES[row * 16 + h], lf = GATES[row * 16 + 4 + h];
        const bf16_t* vp = PROJ + row * PLD + PV + h * 64;
        u32x4 vr[8];
#pragma unroll
        for (int i = 0; i < 8; ++i) vr[i] = *(const u32x4*)(vp + 8 * i);
        const float bs = wave_scan_incl(lf, lane);
        BT_[lane] = bs; GS[lane] = ig - bs;
#pragma unroll
        for (int i = 0; i < 8; ++i) *(LAS u32x4*)(VL + lane * VP + 8 * i) = vr[i];
    }
    bf16x8 Qf[2][2], Kf[NST_][2];
#pragma unroll
    for (int tt = 0; tt < 2; ++tt)
#pragma unroll
        for (int ks = 0; ks < 2; ++ks) Qf[tt][ks] = ld_g8(PROJ + (row0 + 32 * TH + 16 * tt + fr) * PLD + PQ + h * 64 + 32 * ks + 8 * fq);
#pragma unroll
    for (int st = 0; st < NST_; ++st)
#pragma unroll
        for (int ks = 0; ks < 2; ++ks) Kf[st][ks] = ld_g8(PROJ + (row0 + 16 * st + fr) * PLD + PK + h * 64 + 32 * ks + 8 * fq);
    bf16x8 Cf[4][2];
#pragma unroll
    for (int vt = 0; vt < 4; ++vt)
#pragma unroll
        for (int ks = 0; ks < 2; ++ks) Cf[vt][ks] = ld_g8(CST + ci * 4096 + (16 * vt + fr) * 64 + 32 * ks + 8 * fq);
    u32x4 ogv[4];
#pragma unroll
    for (int i = 0; i < 4; ++i) ogv[i] = *(const u32x4*)(PROJ + (row0 + 32 * TH + (lane >> 3) + 8 * i) * PLD + PO + h * 64 + 8 * (lane & 7));
    f32x4 nv[2][2];
#pragma unroll
    for (int ks = 0; ks < 2; ++ks) { nv[ks][0] = *(const f32x4*)(NST + ci * 64 + 32 * ks + 8 * fq); nv[ks][1] = *(const f32x4*)(NST + ci * 64 + 32 * ks + 8 * fq + 4); }
    WAVE_SYNC();
    f32x4 P[2][NST_]; float den[2];
#pragma unroll
    for (int tt = 0; tt < 2; ++tt) {
        const int t = 32 * TH + 16 * tt + fr; const float bt = BT_[t]; float d1 = 0.f;
#pragma unroll
        for (int st = 0; st < NST_; ++st) {
            f32x4 s = (f32x4){0.f, 0.f, 0.f, 0.f};
#pragma unroll
            for (int ks = 0; ks < 2; ++ks) s = MFMA16(Kf[st][ks], Qf[tt][ks], s);
#pragma unroll
            for (int r = 0; r < 4; ++r) { const int sidx = 16 * st + 4 * fq + r; const float wv = (sidx <= t) ? s[r] * fast_exp(bt + GS[sidx]) : 0.f; s[r] = wv; d1 += wv; }
            P[tt][st] = s;
        }
        d1 += __shfl_xor(d1, 16); d1 += __shfl_xor(d1, 32);
        float d2 = 0.f;
#pragma unroll
        for (int ks = 0; ks < 2; ++ks) { const f32x4 n0 = nv[ks][0], n1 = nv[ks][1];
            const u32x4 qw = __builtin_bit_cast(u32x4, Qf[tt][ks]);
            d2 += bflo(qw.x) * n0.x + bfhi(qw.x) * n0.y + bflo(qw.y) * n0.z + bfhi(qw.y) * n0.w + bflo(qw.z) * n1.x + bfhi(qw.z) * n1.y + bflo(qw.w) * n1.z + bfhi(qw.w) * n1.w; }
        d2 += __shfl_xor(d2, 16); d2 += __shfl_xor(d2, 32);
        den[tt] = d1 + fast_exp(bt) * d2;
    }
    const float* nw = F.in[8] + (size_t)l * 256 + h * 64;
    f32x4 acc[2][4];
#pragma unroll
    for (int tt = 0; tt < 2; ++tt) {
#pragma unroll
        for (int vt = 0; vt < 4; ++vt) { acc[tt][vt] = (f32x4){0.f, 0.f, 0.f, 0.f};
#pragma unroll
            for (int ks = 0; ks < 2; ++ks) acc[tt][vt] = MFMA16(Qf[tt][ks], Cf[vt][ks], acc[tt][vt]); }
        float eb[4], dr[4];
#pragma unroll
        for (int r = 0; r < 4; ++r) { eb[r] = fast_exp(BT_[32 * TH + 16 * tt + 4 * fq + r]); dr[r] = __shfl(den[tt], 4 * fq + r); }
#pragma unroll
        for (int vt = 0; vt < 4; ++vt)
#pragma unroll
            for (int r = 0; r < 4; ++r) acc[tt][vt][r] *= eb[r];
#pragma unroll
        for (int kk = 0; kk < NKK; ++kk) { const bf16x8 PA = pack8(P[tt][2 * kk], P[tt][2 * kk + 1]);
            bf16x8 Bv[4];
#pragma unroll
            for (int vt = 0; vt < 4; ++vt) Bv[vt] = ld_tr8p(VL, VP, 32 * kk, 16 * vt, lane);
#pragma unroll
            for (int vt = 0; vt < 4; ++vt) acc[tt][vt] = MFMA16(PA, Bv[vt], acc[tt][vt]); }
#pragma unroll
        for (int r = 0; r < 4; ++r) { const float inv = fast_rcp(fmaxf(fabsf(dr[r]), 1.0f)); float s = 0.f;
#pragma unroll
            for (int vt = 0; vt < 4; ++vt) { acc[tt][vt][r] *= inv; s += acc[tt][vt][r] * acc[tt][vt][r]; }
            s += __shfl_xor(s, 1); s += __shfl_xor(s, 2); s += __shfl_xor(s, 4); s += __shfl_xor(s, 8); const float rs = rsqrtf(s * (1.0f / 64.0f) + NORM_EPS);
#pragma unroll
            for (int vt = 0; vt < 4; ++vt) acc[tt][vt][r] *= rs * nw[16 * vt + fr]; }
    }
    WAVE_SYNC();
#pragma unroll
    for (int tt = 0; tt < 2; ++tt)
#pragma unroll
        for (int vt = 0; vt < 4; ++vt)
#pragma unroll
            for (int r = 0; r < 4; ++r) YS[(16 * tt + 4 * fq + r) * VP + 16 * vt + fr] = f2bf(acc[tt][vt][r]);
    WAVE_SYNC();
#pragma unroll
    for (int i = 0; i < 4; ++i) { const int tr_ = (lane >> 3) + 8 * i, ch = lane & 7; const size_t row = row0 + 32 * TH + tr_;
        const u32x4 yv = *(const LAS u32x4*)(YS + tr_ * VP + 8 * ch); const u32x4 gv = ogv[i]; u32x4 o;
#pragma unroll
        for (int e = 0; e < 4; ++e) o[e] = cvtpk(bflo(yv[e]) * bflo(gv[e]), bfhi(yv[e]) * bfhi(gv[e]));
        *(u32x4*)(Y + row * PLD + h * 64 + 8 * ch) = o; }
    WAVE_SYNC();
}
__device__ __forceinline__ void mlstm_out_item(Frame& F, int l, int bc) {
    const int h = F.wave >> 1;
    if (F.wave & 1) mlstm_out_wave<1>(F, l, bc, h); else mlstm_out_wave<0>(F, l, bc, h);
}
typedef float f32x16 __attribute__((ext_vector_type(16)));
#define MFMA32(a, b, c) __builtin_amdgcn_mfma_f32_32x32x16_bf16((a), (b), (c), 0, 0, 0)
constexpr int AK_STR = 72, AV_STR = 96;
constexpr int ATT_KB = 128 * AK_STR * 2, ATT_VB = 128 * AV_STR * 2, ATT_BUF = ATT_KB + ATT_VB;
constexpr int ATT_TAB_OFF = 2 * ATT_BUF;
__device__ __forceinline__ int t5_bucket(int n) {
    if (n < 16) return n;
    int bk = 16;
    bk += (n >= 19); bk += (n >= 21); bk += (n >= 24); bk += (n >= 27); bk += (n >= 31); bk += (n >= 35); bk += (n >= 40); bk += (n >= 46);
    bk += (n >= 52); bk += (n >= 59); bk += (n >= 67); bk += (n >= 77); bk += (n >= 87); bk += (n >= 99); bk += (n >= 113);
    return bk;
}
__device__ __forceinline__ int crow16(int reg, int hi) { return (reg & 3) + 8 * (reg >> 2) + 4 * hi; }
__device__ __forceinline__ bf16x8 pack8r(const f32x16& p, const int s) { u32x4 w; w.x = cvtpk(p[8 * s], p[8 * s + 1]); w.y = cvtpk(p[8 * s + 2], p[8 * s + 3]); w.z = cvtpk(p[8 * s + 4], p[8 * s + 5]); w.w = cvtpk(p[8 * s + 6], p[8 * s + 7]); return __builtin_bit_cast(bf16x8, w); }
__device__ __forceinline__ void epilogue_attn(Frame& F, int l, int bh, int qi, f32x16 (&O1)[2], f32x16 (&O2)[2], float l1, float l2);
__device__ __forceinline__ void attn_item(Frame& F, int l, int bh, int qi, const bool prefetch_next) {
    const int b = bh >> 2, h = bh & 3, w = F.wave, lane = F.lane, tid = F.tid, r32 = lane & 31, hi = lane >> 5, qq = w & 3, kh = w >> 2;
#ifdef PROBE_A
    const unsigned long long tp0_ = __builtin_amdgcn_s_memrealtime();
#endif
    const bf16_t* PROJ = (const bf16_t*)(F.ws + WS_PROJ); bf16_t* Y = (bf16_t*)(F.ws + WS_PROJ) + PX;
    LAS float* TAB = (LAS float*)(F.lds + ATT_TAB_OFF);
    LAS bf16_t* QL = (LAS bf16_t*)(F.lds + ATT_TAB_OFF + 2048);
    const size_t row0 = (size_t)b * SEQ; const int q0 = qi * 128;
    unsigned nxq_ = 0u; if (prefetch_next && qi < 2 && tid == 0) nxq_ = xb_add(F.ctl + CW_Q + 64 * (2 * l), 1u);
    if (tid < 384) { const int rel = tid - 128; const float cf = F.in[19][31 * 4 + h]; TAB[tid] = rel < 0 ? -1e30f : (F.in[19][t5_bucket(rel) * 4 + h] - cf) * LOG2E; }
    const int npairs = qi + 1;
    const int lk = tid >> 3, lc = tid & 7;
    const bf16_t* kg = PROJ + (row0 + lk) * PLD + PDK + h * 64 + 8 * lc; const bf16_t* vg = PROJ + (row0 + lk) * PLD + PDV + h * 64 + 8 * lc;
    u32x4 ka0, ka1, va0, va1;
#define ATT_WRITE(k0_, k1_, v0_, v1_, buf) do { LAS bf16_t* KL_ = (LAS bf16_t*)(F.lds + (buf) * ATT_BUF); LAS bf16_t* VL_ = (LAS bf16_t*)(F.lds + (buf) * ATT_BUF + ATT_KB); \
        *(LAS u32x4*)(KL_ + lk * AK_STR + 8 * lc) = k0_; *(LAS u32x4*)(KL_ + (lk + 64) * AK_STR + 8 * lc) = k1_; \
        *(LAS u32x4*)(VL_ + lk * AV_STR + 8 * lc) = v0_; *(LAS u32x4*)(VL_ + (lk + 64) * AV_STR + 8 * lc) = v1_; } while (0)
#define ATT_LOAD(k0_, k1_, v0_, v1_, p) do { const size_t o_ = (size_t)(p) * 128 * PLD; k0_ = *(const u32x4*)(kg + o_); k1_ = *(const u32x4*)(kg + o_ + (size_t)64 * PLD); v0_ = *(const u32x4*)(vg + o_); v1_ = *(const u32x4*)(vg + o_ + (size_t)64 * PLD); } while (0)
    ATT_LOAD(ka0, ka1, va0, va1, 0);
    {
        const bf16_t* qg = PROJ + (row0 + q0 + lk) * PLD + PDQ + h * 64 + 8 * lc;
        const u32x4 q0r = *(const u32x4*)qg, q1r = *(const u32x4*)(qg + (size_t)64 * PLD);
        *(LAS u32x4*)(QL + lk * AK_STR + 8 * lc) = q0r; *(LAS u32x4*)(QL + (lk + 64) * AK_STR + 8 * lc) = q1r; }
    ATT_WRITE(ka0, ka1, va0, va1, 0);
    if (npairs > 1) ATT_LOAD(ka0, ka1, va0, va1, 1);
    const int qrow = q0 + 32 * qq + r32;
    f32x16 O1[2], O2[2];
#pragma unroll
    for (int i = 0; i < 16; ++i) { O1[0][i] = 0.f; O1[1][i] = 0.f; O2[0][i] = 0.f; O2[1][i] = 0.f; }
    f32x4 L1 = {0.f, 0.f, 0.f, 0.f}, L2 = {0.f, 0.f, 0.f, 0.f};
    __syncthreads();
    const f32x16 cinit = {0.f, 0.f, 0.f, 0.f, 0.f, 0.f, 0.f, 0.f, 0.f, 0.f, 0.f, 0.f, 0.f, 0.f, 0.f, 0.f};
    const int vlane = (4 * hi + ((lane & 15) >> 2)) * AV_STR + 16 * ((lane >> 4) & 1) + 4 * (lane & 3);
    const LAS bf16_t* qlp = QL + (32 * qq + r32) * AK_STR + 8 * hi;
#ifdef PROBE_SECTIONS
    unsigned long long dA_ = 0, dB_ = 0, dC_ = 0;
#define ATT_T(x_) const unsigned long long x_ = __builtin_amdgcn_s_memtime()
#define ATT_TW(x_) asm volatile("s_waitcnt lgkmcnt(0)" ::: "memory"); const unsigned long long x_ = __builtin_amdgcn_s_memtime()
#define ATT_TACC() do { dA_ += tb_ - ta_; dB_ += tc_ - tb_; dC_ += td_ - tc_; } while (0)
#else
#define ATT_T(x_) do {} while (0)
#define ATT_TW(x_) do {} while (0)
#define ATT_TACC() do {} while (0)
#endif
#define ATT_EXP(S1_, S2_, sub_, NEAR_) do { \
        _Pragma("unroll") for (int r = 0; r < 16; ++r) { S1_[r] = __builtin_amdgcn_exp2f(S1_[r]); S2_[r] = __builtin_amdgcn_exp2f(S2_[r]); } \
        _Pragma("unroll") for (int r = 0; r < 16; r += 4) { L1 += (f32x4){S1_[r], S1_[r + 1], S1_[r + 2], S1_[r + 3]}; L2 += (f32x4){S2_[r], S2_[r + 1], S2_[r + 2], S2_[r + 3]}; } } while (0)
#define ATT_VLOAD(Vf_, sub_) do { _Pragma("unroll") for (int s = 0; s < 2; ++s) _Pragma("unroll") for (int vt = 0; vt < 2; ++vt) { const LAS bf16_t* vp = VL + (32 * (sub_) + 16 * s) * AV_STR + 32 * vt + vlane; \
            const v4i16_t lo = __builtin_amdgcn_ds_read_tr16_b64_v4i16((LAS v4i16_t*)vp), hi4 = __builtin_amdgcn_ds_read_tr16_b64_v4i16((LAS v4i16_t*)(vp + 8 * AV_STR)); \
            Vf_[s][vt] = (bf16x8){lo[0], lo[1], lo[2], lo[3], hi4[0], hi4[1], hi4[2], hi4[3]}; } } while (0)
#define ATT_PV(S1_, S2_, Vf_) do { _Pragma("unroll") for (int s = 0; s < 2; ++s) { const bf16x8 PA1 = pack8r(S1_, s), PA2 = pack8r(S2_, s); \
            _Pragma("unroll") for (int vt = 0; vt < 2; ++vt) { O1[vt] = MFMA32(PA1, Vf_[s][vt], O1[vt]); O2[vt] = MFMA32(PA2, Vf_[s][vt], O2[vt]); } } } while (0)
#define ATT_ITER(k0_, k1_, v0_, v1_, p_, NEAR_) do { const int p = (p_); ATT_T(ta_); \
        if (kh == 0 && p + 1 < npairs) { ATT_WRITE(k0_, k1_, v0_, v1_, (p + 1) & 1); }     \
        if (!(NEAR_) && prefetch_next && p + 2 == qi && tid == 0) nxq_ = xb_add(F.ctl + CW_Q + 64 * (2 * l), 1u);     \
        if (kh == 0 && p + 2 < npairs) { ATT_LOAD(k0_, k1_, v0_, v1_, p + 2); } \
        ATT_TW(tb_); \
        const int k0 = 128 * p + 64 * kh; \
        if (!(NEAR_) || k0 <= q0 + 32 * qq + 31) { \
            const LAS bf16_t* KL = (const LAS bf16_t*)(F.lds + (p & 1) * ATT_BUF) + 64 * kh * AK_STR; const LAS bf16_t* VL = (const LAS bf16_t*)(F.lds + (p & 1) * ATT_BUF + ATT_KB) + 64 * kh * AV_STR; \
            f32x16 SA1, SA2, SB1, SB2, CA = cinit, CB = cinit; \
            if (NEAR_) { const LAS float* tb_ = TAB + (qrow - 4 * hi - k0 + 101);     \
                _Pragma("unroll") for (int r = 0; r < 16; ++r) { CA[r] = tb_[27 - ((r & 3) + 8 * (r >> 2))]; CB[r] = tb_[27 - 32 - ((r & 3) + 8 * (r >> 2))]; } } \
            {   const bf16x8 Q00 = ld_l8(qlp), Q01 = ld_l8(qlp + 16), Q10 = ld_l8(qlp + 32), Q11 = ld_l8(qlp + 48); \
                const LAS bf16_t* kp = KL + r32 * AK_STR + 8 * hi; \
                const bf16x8 a10 = ld_l8(kp), a11 = ld_l8(kp + 16), a20 = ld_l8(kp + 32), a21 = ld_l8(kp + 48); \
                const bf16x8 b10 = ld_l8(kp + 32 * AK_STR), b11 = ld_l8(kp + 32 * AK_STR + 16), b20 = ld_l8(kp + 32 * AK_STR + 32), b21 = ld_l8(kp + 32 * AK_STR + 48); \
                SA1 = MFMA32(a10, Q00, CA); SA2 = MFMA32(a20, Q10, CA); SA1 = MFMA32(a11, Q01, SA1); SA2 = MFMA32(a21, Q11, SA2); \
                SB1 = MFMA32(b10, Q00, CB); SB2 = MFMA32(b20, Q10, CB); SB1 = MFMA32(b11, Q01, SB1); SB2 = MFMA32(b21, Q11, SB2); } \
            bf16x8 Vf[2][2], Vg[2][2]; \
            ATT_VLOAD(Vf, 0); ATT_VLOAD(Vg, 1); \
            ATT_EXP(SA1, SA2, 0, NEAR_); \
            ATT_PV(SA1, SA2, Vf); \
            ATT_EXP(SB1, SB2, 1, NEAR_); \
            ATT_PV(SB1, SB2, Vg); \
            {   \
                __builtin_amdgcn_sched_group_barrier(0x8, 4, 0); \
                _Pragma("unroll") for (int g_ = 0; g_ < 4; ++g_) { __builtin_amdgcn_sched_group_barrier(0x8, 1, 0); __builtin_amdgcn_sched_group_barrier(0x400, 8, 0); } \
                __builtin_amdgcn_sched_group_barrier(0x2, 24, 0); \
                _Pragma("unroll") for (int g_ = 0; g_ < 8; ++g_) { __builtin_amdgcn_sched_group_barrier(0x8, 1, 0); __builtin_amdgcn_sched_group_barrier(0x400, 4, 0); __builtin_amdgcn_sched_group_barrier(0x2, 2, 0); } } \
        } \
        ATT_T(tc_); \
        if (kh == 1 && p + 1 < npairs) { ATT_WRITE(k0_, k1_, v0_, v1_, (p + 1) & 1); } \
        if (kh == 1 && p + 2 < npairs) { ATT_LOAD(k0_, k1_, v0_, v1_, p + 2); } \
        LDS_BARRIER(); ATT_T(td_); ATT_TACC(); } while (0)
#ifdef PROBE_A
    if (lane == 0) atomicMax(F.ctl + 32768 + 64 * (11 + 16 * l), (unsigned)(__builtin_amdgcn_s_memrealtime() - tp0_));
#endif
    int pp = 0;
    for (; pp + 1 < qi; ++pp) ATT_ITER(ka0, ka1, va0, va1, pp, 0);
    for (; pp < npairs; ++pp) ATT_ITER(ka0, ka1, va0, va1, pp, 1);
    if (prefetch_next && tid == 0) F.MISC[17] = nxq_;
#undef ATT_EXP
#undef ATT_VLOAD
#undef ATT_PV
#undef ATT_ITER
#ifdef PROBE_SECTIONS
    if (qi == 31 && lane == 0) { atomicMax(F.ctl + 32768 + 64 * (8 + 16 * l), (unsigned)(dA_ / 32) * 10u); atomicMax(F.ctl + 32768 + 64 * (9 + 16 * l), (unsigned)(dB_ / 32) * 10u); atomicMax(F.ctl + 32768 + 64 * (10 + 16 * l), (unsigned)(dC_ / 32) * 10u); }
#endif
#undef ATT_WRITE
#undef ATT_LOAD
    float l1 = (L1.x + L1.y) + (L1.z + L1.w), l2 = (L2.x + L2.y) + (L2.z + L2.w);
    epilogue_attn(F, l, bh, qi, O1, O2, l1, l2);
}
__device__ __forceinline__ void epilogue_attn(Frame& F, int l, int bh, int qi, f32x16 (&O1)[2], f32x16 (&O2)[2], float l1, float l2) {
    int t3 = threadIdx.x; asm volatile("" : "+v"(t3));
    const int lane = t3 & 63, w = __builtin_amdgcn_readfirstlane(t3 >> 6), r32 = lane & 31, hi = lane >> 5, qq = w & 3, kh = w >> 2, b = bh >> 2, h = bh & 3;
    bf16_t* Y = (bf16_t*)(F.ws + WS_PROJ) + PX;
    const size_t row0 = (size_t)b * SEQ; const int q0 = qi * 128;
    LAS float* XCH = (LAS float*)F.lds + (size_t)qq * 66 * 64 + lane;
    if (kh == 1) {
#pragma unroll
        for (int vt = 0; vt < 2; ++vt)
#pragma unroll
            for (int r = 0; r < 16; ++r) { XCH[(vt * 16 + r) * 64] = O1[vt][r]; XCH[(32 + vt * 16 + r) * 64] = O2[vt][r]; }
        XCH[64 * 64] = l1; XCH[65 * 64] = l2;
    }
    __syncthreads();
    if (kh == 0) {
        const float* lm = F.in[17] + (size_t)l * 128;
        float d1 = (lane < 32) ? lm[lane] * lm[32 + lane] : 0.f, d2 = (lane < 32) ? lm[64 + lane] * lm[96 + lane] : 0.f;
        d1 = wave_sum(d1); d2 = wave_sum(d2);
        int lq = l; asm volatile("" : "+s"(lq));
        const float lam_init = (lq == 0) ? 0.2f : 0.35550906759f;
        const float lam = __int_as_float(__builtin_amdgcn_readfirstlane(__float_as_int(fast_exp(d1) - fast_exp(d2) + lam_init)));
#pragma unroll
        for (int vt = 0; vt < 2; ++vt)
#pragma unroll
            for (int r = 0; r < 16; ++r) { O1[vt][r] += XCH[(vt * 16 + r) * 64]; O2[vt][r] += XCH[(32 + vt * 16 + r) * 64]; }
        l1 += XCH[64 * 64]; l2 += XCH[65 * 64];
        l1 += __shfl_xor(l1, 32); l2 += __shfl_xor(l2, 32);
        const float i1 = fast_rcp(l1), i2 = lam * fast_rcp(l2);
        const float* sw = F.in[18] + (size_t)l * 64; const float osc = 1.0f - lam_init;
        const float sw0 = sw[r32], sw1 = sw[32 + r32];
#pragma unroll
        for (int r = 0; r < 16; ++r) {
            const int qr = crow16(r, hi);
            const float a1 = __shfl(i1, qr), a2 = __shfl(i2, qr);
            const float o0 = O1[0][r] * a1 - O2[0][r] * a2, o1 = O1[1][r] * a1 - O2[1][r] * a2;
            float s = o0 * o0 + o1 * o1;
            s += __shfl_xor(s, 1); s += __shfl_xor(s, 2); s += __shfl_xor(s, 4); s += __shfl_xor(s, 8); s += __shfl_xor(s, 16);
            const float rs = rsqrtf(s * (1.0f / 64.0f) + NORM_EPS) * osc;
            const size_t row = row0 + q0 + 32 * qq + qr;
            Y[row * PLD + 768 + h * 64 + r32] = f2bf(o0 * rs * sw0); Y[row * PLD + 768 + h * 64 + 32 + r32] = f2bf(o1 * rs * sw1);
        }
    }
}

constexpr int SSD_STR = 136;
constexpr int SX_P = 72, SB_P = 136, SS_BUF = 128 * SX_P * 2 + 128 * SB_P * 2;
__device__ __forceinline__ void ssd_state_item(Frame& F, int l, int bhh) {
    const int b = bhh >> 3, hh = bhh & 7, g = hh >> 2, w = F.wave, lane = F.lane, fr = lane & 15, fq = lane >> 4, tid = F.tid;
    LAS float* XS = (LAS float*)(F.lds + 2 * SS_BUF); LAS float* CD = XS + 4096;
    const bf16_t* XACT = (const bf16_t*)F.in[25]; const float* GATES = (const float*)(F.ws + WS_GATES); bf16_t* SST = (bf16_t*)(F.ws + WS_SST);
    const float Ah = -expf(F.in[12][l * 8 + hh]);
    {   float d0v[4], d1v[4];
#pragma unroll
        for (int i = 0; i < 4; ++i) { const size_t r0 = (size_t)b * SEQ + 128 * (w + 8 * i); d0v[i] = GATES[(r0 + lane) * 16 + 8 + hh]; d1v[i] = GATES[(r0 + 64 + lane) * 16 + 8 + hh]; }
#pragma unroll
        for (int i = 0; i < 4; ++i) { const int c = w + 8 * i; const float dt0 = d0v[i], dt1 = d1v[i];
            const float s0 = wave_scan_incl(dt0 * Ah, lane); const float t0 = __shfl(s0, 63);
            const float s1 = wave_scan_incl(dt1 * Ah, lane) + t0; const float last = __shfl(s1, 63);
            XS[128 * c + lane] = dt0 * fast_exp(last - s0); XS[128 * c + 64 + lane] = dt1 * fast_exp(last - s1);
            if (lane == 0) CD[c] = fast_exp(last); }
    }
    const int pt = w & 3, nh = w >> 2;
    f32x4 acc[4];
#pragma unroll
    for (int j = 0; j < 4; ++j) acc[j] = (f32x4){0.f, 0.f, 0.f, 0.f};
    const bf16_t* xg = XACT + ((size_t)b * SEQ + (tid >> 3)) * 1024 + hh * 64 + 8 * (tid & 7);
    const bf16_t* bg = XACT + ((size_t)b * SEQ + (tid >> 4)) * 1024 + 512 + g * 128 + 8 * (tid & 15);
    u32x4 xa[2], ba[4], xb[2], bb[4], xc[2], bc[4];
#define SS_LOAD(xr, br, c_) do { const size_t o_ = (size_t)(c_) * 128 * 1024; xr[0] = *(const u32x4*)(xg + o_); xr[1] = *(const u32x4*)(xg + o_ + 64 * 1024); \
        _Pragma("unroll") for (int i_ = 0; i_ < 4; ++i_) br[i_] = *(const u32x4*)(bg + o_ + (size_t)i_ * 32 * 1024); } while (0)
#define SS_WRITE(xr, br, c_) do { LAS bf16_t* XL_ = (LAS bf16_t*)(F.lds + ((c_) & 1) * SS_BUF); LAS bf16_t* BL_ = XL_ + 128 * SX_P; \
        _Pragma("unroll") for (int i_ = 0; i_ < 2; ++i_) { const int s_ = (tid >> 3) + 64 * i_; const float sc_ = XS[128 * (c_) + s_]; u32x4 o_; \
            _Pragma("unroll") for (int e_ = 0; e_ < 4; ++e_) o_[e_] = cvtpk(sc_ * bflo(xr[i_][e_]), sc_ * bfhi(xr[i_][e_])); \
            *(LAS u32x4*)(XL_ + s_ * SX_P + 8 * (tid & 7)) = o_; } \
        _Pragma("unroll") for (int i_ = 0; i_ < 4; ++i_) *(LAS u32x4*)(BL_ + ((tid >> 4) + 32 * i_) * SB_P + 8 * (tid & 15)) = br[i_]; } while (0)
    LAS bf16_t* SSTG = (LAS bf16_t*)(F.lds + 2 * SS_BUF + 16384 + 128);
#define SS_STAGE(c_) do { LAS bf16_t* sg_ = SSTG + ((c_) & 1) * 8192; \
        _Pragma("unroll") for (int j = 0; j < 4; ++j) _Pragma("unroll") for (int r = 0; r < 4; ++r) sg_[(16 * pt + 4 * fq + r) * 128 + 16 * (4 * nh + j) + fr] = f2bf(acc[j][r]); } while (0)
    SS_LOAD(xa, ba, 0); SS_LOAD(xb, bb, 1); SS_LOAD(xc, bc, 2);
    __syncthreads();
    SS_WRITE(xa, ba, 0);
    SS_LOAD(xa, ba, 3);
    LDS_BARRIER();
#define SS_STEP(XW, BW, c_) do { const int cc_ = (c_); const size_t si = ((size_t)(b * 32 + cc_) * 8 + hh) * 8192; \
        _Pragma("unroll") for (int j = 0; j < 4; ++j) _Pragma("unroll") for (int r = 0; r < 4; ++r) SST[si + (16 * pt + 4 * fq + r) * 128 + 16 * (4 * nh + j) + fr] = f2bf(acc[j][r]); \
        asm volatile("" ::: "memory"); \
        if (cc_ + 1 < 32) { SS_WRITE(XW, BW, cc_ + 1); } \
        asm volatile("" ::: "memory"); \
        SS_LOAD(XW, BW, (cc_ + 4 < 32 ? cc_ + 4 : 31)); \
        asm volatile("" ::: "memory"); \
        const float cd = CD[cc_]; \
        _Pragma("unroll") for (int j = 0; j < 4; ++j) acc[j] = acc[j] * cd; \
        const LAS bf16_t* XL = (const LAS bf16_t*)(F.lds + (cc_ & 1) * SS_BUF); const LAS bf16_t* BL = XL + 128 * SX_P; \
        bf16x8 Af[4], Bf[4][4]; \
        _Pragma("unroll") for (int ks = 0; ks < 4; ++ks) { Af[ks] = ld_tr8(XL, SX_P, 32 * ks, 16 * pt, lane); \
            _Pragma("unroll") for (int j = 0; j < 4; ++j) Bf[ks][j] = ld_tr8(BL, SB_P, 32 * ks, 16 * (4 * nh + j), lane); } \
        asm volatile("s_waitcnt lgkmcnt(0)" ::: "memory"); __builtin_amdgcn_sched_barrier(0); \
        _Pragma("unroll") for (int ks = 0; ks < 4; ++ks) _Pragma("unroll") for (int j = 0; j < 4; ++j) acc[j] = MFMA16(Af[ks], Bf[ks][j], acc[j]); \
        LDS_BARRIER(); } while (0)
    for (int c = 0; c < 30; c += 3) { SS_STEP(xb, bb, c); SS_STEP(xc, bc, c + 1); SS_STEP(xa, ba, c + 2); }
    SS_STEP(xb, bb, 30); SS_STEP(xc, bc, 31);
#undef SS_STEP
#undef SS_STAGE
#undef SS_LOAD
#undef SS_WRITE
}

constexpr int SO_BP = 136, SO_XP = 72, SO_SP = 136, SO_YP = 264;
constexpr int SO_B_BYTES = 128 * SO_BP * 2, SO_H_BYTES = 128 * SO_XP * 2 + 64 * SO_SP * 2, SO_ACS_OFF = SO_B_BYTES + 2 * SO_H_BYTES;
__device__ __forceinline__ void ssd_out_item(Frame& F, int l, int it) {
    const int g = it & 1, c = (it >> 1) & 31, b = it >> 6, w = F.wave, lane = F.lane, fr = lane & 15, fq = lane >> 4, tid = F.tid;
    LAS bf16_t* BL = (LAS bf16_t*)F.lds;
    LAS float* ACS = (LAS float*)(F.lds + SO_ACS_OFF); LAS float* DTS = ACS + 512; LAS float* ETAB = DTS + 512; LAS float* REFS = ETAB + 512;
    const bf16_t* XACT = (const bf16_t*)F.in[25]; const float* GATES = (const float*)(F.ws + WS_GATES); const bf16_t* SST = (const bf16_t*)(F.ws + WS_SST);
    const bf16_t* PROJ = (const bf16_t*)(F.ws + WS_PROJ); bf16_t* Y = (bf16_t*)(F.ws + WS_PROJ) + PX;
    const size_t r0 = (size_t)b * SEQ + 128 * c;
    const float gdt0 = GATES[(r0 + lane) * 16 + 8 + g * 4 + (w & 3)], gdt1 = GATES[(r0 + 64 + lane) * 16 + 8 + g * 4 + (w & 3)];
    const bf16_t* bgp = XACT + (r0 + (tid >> 4)) * 1024 + 512 + g * 128 + 8 * (tid & 15);
    const bf16_t* xgp = XACT + (r0 + (tid >> 3)) * 1024 + g * 256 + 8 * (tid & 7);
    const bf16_t* sgp = SST + ((size_t)(b * 32 + c) * 8 + g * 4) * 8192 + (tid >> 4) * 128 + 8 * (tid & 15);
    u32x4 xr[2], sr[2];
#define SO_LOADH(hd_) do { xr[0] = *(const u32x4*)(xgp + (hd_) * 64); xr[1] = *(const u32x4*)(xgp + (hd_) * 64 + 64 * 1024); \
        sr[0] = *(const u32x4*)(sgp + (size_t)(hd_) * 8192); sr[1] = *(const u32x4*)(sgp + (size_t)(hd_) * 8192 + 32 * 128); } while (0)
#define SO_WRITEH(hd_) do { LAS bf16_t* XL_ = (LAS bf16_t*)(F.lds + SO_B_BYTES + ((hd_) & 1) * SO_H_BYTES); LAS bf16_t* SL_ = XL_ + 128 * SO_XP; \
        *(LAS u32x4*)(XL_ + (tid >> 3) * SO_XP + 8 * (tid & 7)) = xr[0]; *(LAS u32x4*)(XL_ + ((tid >> 3) + 64) * SO_XP + 8 * (tid & 7)) = xr[1]; \
        *(LAS u32x4*)(SL_ + (tid >> 4) * SO_SP + 8 * (tid & 15)) = sr[0]; *(LAS u32x4*)(SL_ + ((tid >> 4) + 32) * SO_SP + 8 * (tid & 15)) = sr[1]; } while (0)
    {   u32x4 br[4];
#pragma unroll
        for (int i = 0; i < 4; ++i) br[i] = *(const u32x4*)(bgp + (size_t)i * 32 * 1024);
        SO_LOADH(0);
#pragma unroll
        for (int i = 0; i < 4; ++i) *(LAS u32x4*)(BL + ((tid >> 4) + 32 * i) * SO_BP + 8 * (tid & 15)) = br[i];
        SO_WRITEH(0);
    }
    if (w < 4) {
        const int hh = g * 4 + w; const float Ah = -expf(F.in[12][l * 8 + hh]);
        const float dt0 = gdt0, dt1 = gdt1;
        const float s0 = wave_scan_incl(dt0 * Ah, lane); const float t0 = __shfl(s0, 63);
        const float s1 = wave_scan_incl(dt1 * Ah, lane) + t0;
        ACS[128 * w + lane] = s0; ACS[128 * w + 64 + lane] = s1; DTS[128 * w + lane] = dt0; DTS[128 * w + 64 + lane] = dt1;
        const float e0 = __shfl(s0, 31), e2 = __shfl(s1, 31), e3 = __shfl(s1, 63);
        ETAB[128 * w + lane] = fast_exp((lane < 32 ? e0 : t0) - s0) * dt0; ETAB[128 * w + 64 + lane] = fast_exp((lane < 32 ? e2 : e3) - s1) * dt1;
        if (lane == 0) { REFS[4 * w + 0] = e0; REFS[4 * w + 1] = t0; REFS[4 * w + 2] = e2; REFS[4 * w + 3] = e3; }
    }
    SO_LOADH(1);
    const int lrow = 16 * w + fr, nkk = (w >> 1) + 1;
    bf16x8 Cf[4];
#pragma unroll
    for (int ks = 0; ks < 4; ++ks) Cf[ks] = ld_g8(XACT + (r0 + lrow) * 1024 + 768 + g * 128 + 32 * ks + 8 * fq);
    asm volatile("" : "+v"(Cf[0]), "+v"(Cf[1]), "+v"(Cf[2]), "+v"(Cf[3]));
    LDS_BARRIER();
    f32x4 G[4][2];
#pragma unroll
    for (int kk = 0; kk < 4; ++kk) { G[kk][0] = (f32x4){0.f, 0.f, 0.f, 0.f}; G[kk][1] = (f32x4){0.f, 0.f, 0.f, 0.f};
        if (kk < nkk) {
            bf16x8 b0[4], b1[4];
#pragma unroll
            for (int ks = 0; ks < 4; ++ks) { b0[ks] = ld_l8(BL + (32 * kk + fr) * SO_BP + 32 * ks + 8 * fq); b1[ks] = ld_l8(BL + (32 * kk + 16 + fr) * SO_BP + 32 * ks + 8 * fq); }
#pragma unroll
            for (int ks = 0; ks < 4; ++ks) { G[kk][0] = MFMA16(b0[ks], Cf[ks], G[kk][0]); G[kk][1] = MFMA16(b1[ks], Cf[ks], G[kk][1]); } } }
    const float* Dk = F.in[13] + l * 8 + g * 4;
    f32x4 yacc[4][4];
#pragma unroll
    for (int hd = 0; hd < 4; ++hd) {
        const LAS bf16_t* XL = (const LAS bf16_t*)(F.lds + SO_B_BYTES + (hd & 1) * SO_H_BYTES); const LAS bf16_t* SL = XL + 128 * SO_XP;
        bf16x8 Sf[4][4];
#pragma unroll
        for (int pt = 0; pt < 4; ++pt)
#pragma unroll
            for (int ks = 0; ks < 4; ++ks) Sf[pt][ks] = ld_l8(SL + (16 * pt + fr) * SO_SP + 32 * ks + 8 * fq);
        float ea[4], xv[4][4];
#pragma unroll
        for (int r = 0; r < 4; ++r) ea[r] = fast_exp(ACS[128 * hd + 16 * w + 4 * fq + r]);
#pragma unroll
        for (int pt = 0; pt < 4; ++pt)
#pragma unroll
            for (int r = 0; r < 4; ++r) xv[pt][r] = bf2f(XL[(16 * w + 4 * fq + r) * SO_XP + 16 * pt + fr]);
        const float dsk = Dk[hd];
#pragma unroll
        for (int pt = 0; pt < 4; ++pt) { f32x4 a = (f32x4){0.f, 0.f, 0.f, 0.f};
#pragma unroll
            for (int ks = 0; ks < 4; ++ks) a = MFMA16(Cf[ks], Sf[pt][ks], a);
#pragma unroll
            for (int r = 0; r < 4; ++r) a[r] = a[r] * ea[r] + dsk * xv[pt][r];
            yacc[hd][pt] = a; }
        const float al = ACS[128 * hd + lrow];
#pragma unroll
        for (int kk = 0; kk < 4; ++kk) if (kk < nkk) {
            f32x4 P0, P1;
            if (kk + 1 < nkk) {
                const float fk = fast_exp(al - REFS[4 * hd + kk]);
#pragma unroll
                for (int r = 0; r < 4; ++r) { const int s0 = 32 * kk + 4 * fq + r; P0[r] = G[kk][0][r] * fk * ETAB[128 * hd + s0]; P1[r] = G[kk][1][r] * fk * ETAB[128 * hd + s0 + 16]; }
            } else {
#pragma unroll
                for (int r = 0; r < 4; ++r) { const int s0 = 32 * kk + 4 * fq + r, s1 = s0 + 16;
                    P0[r] = (s0 <= lrow) ? G[kk][0][r] * fast_exp(al - ACS[128 * hd + s0]) * DTS[128 * hd + s0] : 0.f;
                    P1[r] = (s1 <= lrow) ? G[kk][1][r] * fast_exp(al - ACS[128 * hd + s1]) * DTS[128 * hd + s1] : 0.f; }
            }
            const bf16x8 PA = pack8(P0, P1);
            bf16x8 Bx[4];
#pragma unroll
            for (int pt = 0; pt < 4; ++pt) Bx[pt] = ld_tr8p(XL, SO_XP, 32 * kk, 16 * pt, lane);
#pragma unroll
            for (int pt = 0; pt < 4; ++pt) yacc[hd][pt] = MFMA16(PA, Bx[pt], yacc[hd][pt]);
        }
        if (hd + 1 < 4) { SO_WRITEH(hd + 1); if (hd + 2 < 4) SO_LOADH(hd + 2); }
        LDS_BARRIER();
    }
#undef SO_LOADH
#undef SO_WRITEH
    const float* nw = F.in[14] + (size_t)l * 512 + g * 256; const int ch8 = 8 * (tid & 31);
    const f32x4 nw0 = *(const f32x4*)(nw + ch8), nw1 = *(const f32x4*)(nw + ch8 + 4);
    u32x4 zv8[8];
#pragma unroll
    for (int i = 0; i < 8; ++i) zv8[i] = *(const u32x4*)(PROJ + (r0 + (tid >> 5) + 16 * i) * PLD + PZ + g * 256 + ch8);
    LAS bf16_t* YL = (LAS bf16_t*)F.lds;
#pragma unroll
    for (int hd = 0; hd < 4; ++hd)
#pragma unroll
        for (int pt = 0; pt < 4; ++pt)
#pragma unroll
            for (int r = 0; r < 4; ++r) YL[(16 * w + 4 * fq + r) * SO_YP + hd * 64 + 16 * pt + fr] = f2bf(yacc[hd][pt][r]);
    LDS_BARRIER();
#pragma unroll
    for (int i = 0; i < 8; ++i) {
        const int lr = (tid >> 5) + 16 * i; const size_t row = r0 + lr;
        const u32x4 yv = *(const LAS u32x4*)(YL + lr * SO_YP + ch8); const u32x4 zv = zv8[i];
        float v[8]; float ss = 0.f;
#pragma unroll
        for (int e = 0; e < 4; ++e) { v[2 * e] = bflo(yv[e]) * bflo(zv[e]); v[2 * e + 1] = bfhi(yv[e]) * bfhi(zv[e]); ss += v[2 * e] * v[2 * e] + v[2 * e + 1] * v[2 * e + 1]; }
        ss += __shfl_xor(ss, 1); ss += __shfl_xor(ss, 2); ss += __shfl_xor(ss, 4); ss += __shfl_xor(ss, 8); ss += __shfl_xor(ss, 16);
        const float rs = rsqrtf(ss * (1.0f / 256.0f) + NORM_EPS);
        u32x4 o; o.x = cvtpk(v[0] * rs * nw0.x, v[1] * rs * nw0.y); o.y = cvtpk(v[2] * rs * nw0.z, v[3] * rs * nw0.w); o.z = cvtpk(v[4] * rs * nw1.x, v[5] * rs * nw1.y); o.w = cvtpk(v[6] * rs * nw1.z, v[7] * rs * nw1.w);
        *(u32x4*)(Y + row * PLD + 256 + g * 256 + ch8) = o;
    }
}
#ifndef PH_EN
#define PH_EN 1023
#endif
#ifndef MK_N_LAUNCHES
#define MK_N_LAUNCHES 1
#endif
constexpr int N_PHASES = 1 + 9 * DEPTH;
constexpr int NA1 = 512;
constexpr int CW_STAT = 32768;
#ifdef PROBE_A
#define ITEM_T0() const unsigned long long it0_ = __builtin_amdgcn_s_memrealtime()
#define ITEM_T1(k_) do { __syncthreads(); if (threadIdx.x == 0) atomicMax(F.ctl + CW_STAT + 64 * ((k_) + 16 * l), (unsigned)(__builtin_amdgcn_s_memrealtime() - it0_)); } while (0)
#define ITEM_TSUM(k_) do { if (threadIdx.x == 0) atomicAdd(F.ctl + CW_STAT + 64 * ((k_) + 16 * l), (unsigned)(__builtin_amdgcn_s_memrealtime() - it0_)); } while (0)
#else
#define ITEM_T0() do {} while (0)
#define ITEM_T1(k_) do {} while (0)
#define ITEM_TSUM(k_) do {} while (0)
#endif

__global__ void __launch_bounds__(NTHREADS, 2) hyb_fwd(Args args) {
    extern __shared__ __attribute__((aligned(16))) unsigned char lds_raw[];
    {   const int t0 = threadIdx.x;
        for (int u = t0; u < (LDS_BYTES - LDSCTL_OFF) / 4; u += NTHREADS) ((LAS unsigned*)((LAS unsigned char*)lds_raw + LDSCTL_OFF))[u] = 0u; }
    __syncthreads();
    const int ph_lo = args.ph_lo, ph_hi = args.ph_hi;
    const bool one_launch = (ph_hi - ph_lo) > 1;
    if (one_launch) { XcdBarrier b0 = xcd_barrier_post((unsigned*)(args.ws + WS_CTL) + CW_BAR, (volatile LAS unsigned*)((LAS unsigned char*)lds_raw + MISC_OFF) + 8); (void)b0; }
#ifdef PROBE_A
    unsigned long long t_prev = __builtin_amdgcn_s_memrealtime();
#endif
    for (int ph = ph_lo; ph < ph_hi; ++ph) {
        int tid_ = threadIdx.x; asm volatile("" : "+v"(tid_));
        kinptr_t kin = (kinptr_t)__builtin_amdgcn_kernarg_segment_ptr(); asm volatile("" : "+s"(kin));
        Frame F;
        F.lds = (LAS unsigned char*)lds_raw; F.MISC = (volatile LAS unsigned*)(F.lds + MISC_OFF);
        F.tid = tid_; F.lane = tid_ & 63; F.wave = __builtin_amdgcn_readfirstlane(tid_ >> 6);
        F.G = gridDim.x; { const int bx = blockIdx.x; F.vcu = (F.G % 8 == 0) ? (bx % 8) * (F.G / 8) + bx / 8 : bx; }
        F.in = kin;
        float* const outp = (float*)kin[25]; unsigned char* ws = (unsigned char*)kin[26];
        F.ws = ws; F.ctl = (unsigned*)(ws + WS_CTL);
        bf16_t* XB = (bf16_t*)(ws + WS_XB); bf16_t* PROJ = (bf16_t*)(ws + WS_PROJ); float* SSQ = (float*)(ws + WS_SSQ); float* GATES = (float*)(ws + WS_GATES);
        if (ph == 0) { if (PH_EN & 1) p0_prologue(F); }
        else {
            const int l = (ph - 1) / 9, k = (ph - 1) % 9;
            const unsigned char* WL = ws + WS_W + (size_t)l * W_LAYER;
            if ((PH_EN & 2) && (k == 0 || k == 7)) {
                pg8::Gemm g{XB, (const bf16_t*)(WL + (k == 0 ? W_GU1 : W_GU2)), M_TOK, NGU, DM, DM}; pg8::StaticOrder S; S.init(M_TOK, NGU, F.G, (int)blockIdx.x);
                EpiSwiglu E{{}, PROJ, SSQ};
                pg8::gemm_phase<EpiSwiglu, true, true>(F.lds, g, S, E, F.tid);
                { int t2 = threadIdx.x; asm volatile("" : "+v"(t2)); F.tid = t2; F.lane = t2 & 63; F.wave = __builtin_amdgcn_readfirstlane(t2 >> 6); side_convert(F, l, k); }
            } else if ((PH_EN & 4) && (k == 1 || k == 8 || k == 6)) {
                pg8::Gemm g; float alpha = 0.5f;
                if (k == 6) { g = pg8::Gemm{PROJ + PX, (const bf16_t*)(WL + W_OUT), M_TOK, DM, DM, PLD}; alpha = 1.0f; }
                else { g = pg8::Gemm{PROJ, (const bf16_t*)(WL + (k == 1 ? W_D1 : W_D2)), M_TOK, DM, FF, FF}; }
                pg8::StaticOrder S; S.init(M_TOK, DM, F.G, (int)blockIdx.x);
                if (ph == N_PHASES - 1) { EpiResid<true> E{outp, XB, SSQ, alpha, 1.0f / alpha}; pg8::gemm_phase<EpiResid<true>, false, true>(F.lds, g, S, E, F.tid); }
                else { EpiResid<false> E{outp, XB, SSQ, alpha, 1.0f / alpha}; pg8::gemm_phase<EpiResid<false>, false, true>(F.lds, g, S, E, F.tid); }
            } else if ((PH_EN & 8) && k == 2) {
                pg8::Gemm g{XB, (const bf16_t*)(WL + W_IN), M_TOK, NIN, DM, DM}; pg8::StaticOrder S; S.init(M_TOK, NIN, F.G, (int)blockIdx.x);
                EpiInProj E{{}, PROJ, GATES, SSQ, kin[15] + l * 64, kin[16] + l * 64, kin[7] + l * 8, kin[11] + l * 8};
                pg8::gemm_phase<EpiInProj, true, true>(F.lds, g, S, E, F.tid);
                { int t2 = threadIdx.x; asm volatile("" : "+v"(t2)); F.tid = t2; F.lane = t2 & 63; F.wave = __builtin_amdgcn_readfirstlane(t2 >> 6); side_convert(F, l, k); }
            } else if ((PH_EN & 16) && k == 3) {
                conv_phase(F, l);
            } else if (k == 4) {
                const int qoff_ = (F.G == 256) ? 256 : 0;
                for (int it = (F.G == 256) ? (int)blockIdx.x : q_next(F, 2 * l);;) {
                    if (it >= 48 + NA1) break;
                    { int t2 = threadIdx.x; asm volatile("" : "+v"(t2)); F.tid = t2; F.lane = t2 & 63; F.wave = __builtin_amdgcn_readfirstlane(t2 >> 6); }
                    ITEM_T0();
                    if (it < 16) { if (PH_EN & 32) mlstm_state_item(F, it); ITEM_T1(0); it = q_next(F, 2 * l) + qoff_; }
                    else if (it < 48) { if (PH_EN & 64) ssd_state_item(F, l, it - 16); ITEM_T1(1); it = q_next(F, 2 * l) + qoff_; }
                    else { const int r = it - 48; attn_item(F, l, r & 15, 31 - (r >> 4), true); ITEM_T1(2); ITEM_TSUM(12);
                        __syncthreads(); it = (int)F.MISC[17] + qoff_; } }
#ifdef PROBE_A
                if (threadIdx.x == 0) atomicAdd(F.ctl + CW_STAT + 64 * (13 + 16 * l), (unsigned)(__builtin_amdgcn_s_memrealtime() - t_prev));
#endif
            } else if (k == 5 && NA1 == 512 && F.G == 256) {
                { int t2 = threadIdx.x; asm volatile("" : "+v"(t2)); F.tid = t2; F.lane = t2 & 63; F.wave = __builtin_amdgcn_readfirstlane(t2 >> 6); }
                ssd_out_item(F, l, F.vcu);
                __syncthreads();
                { int t2 = threadIdx.x; asm volatile("" : "+v"(t2)); F.tid = t2; F.lane = t2 & 63; F.wave = __builtin_amdgcn_readfirstlane(t2 >> 6); }
                mlstm_out_item(F, l, F.vcu);
            } else if (k == 5) {
                for (;;) { const int it = q_next(F, 2 * l + 1); if (it >= 512 + (512 - NA1)) break;
                    { int t2 = threadIdx.x; asm volatile("" : "+v"(t2)); F.tid = t2; F.lane = t2 & 63; F.wave = __builtin_amdgcn_readfirstlane(t2 >> 6); }
                    ITEM_T0();
                    if (it < 256) { if (PH_EN & 256) ssd_out_item(F, l, it); ITEM_T1(3); }
                    else if (it < 512) { if (PH_EN & 512) mlstm_out_item(F, l, it - 256); ITEM_T1(4); }
                    else { const int r = NA1 + it - 512; if (PH_EN & 128) attn_item(F, l, r & 15, 31 - (r >> 4), false); } }
            }
        }
#ifdef PROBE_A
        if (ph + 1 < ph_hi) { XcdBarrier bar; bar.bar = F.ctl + CW_BAR; bar.x = xb_xcc_id(); bar.st = F.MISC + 8; xcd_barrier(bar); }
        { const unsigned long long t_now = __builtin_amdgcn_s_memrealtime(); if (threadIdx.x == 0) F.MISC[24 + ph] += (unsigned)(t_now - t_prev); t_prev = t_now; }
        if (ph + 1 == ph_hi && blockIdx.x == 0) { __syncthreads();
            unsigned va = (PROBE_A < 32) ? F.MISC[24 + PROBE_A] : xb_ld(F.ctl + CW_STAT + 64 * (PROBE_A - 32)), vb = (PROBE_B < 32) ? F.MISC[24 + PROBE_B] : xb_ld(F.ctl + CW_STAT + 64 * (PROBE_B - 32));
            if (PROBE_A == 44 || PROBE_A == 45) va = va / 256u * 5u; if (PROBE_B == 44 || PROBE_B == 45) vb = vb / 256u * 5u;
            unsigned qa = (va + 500u) / 1000u, qb = (vb + 500u) / 1000u; if (qa > 63u) qa = 63u; if (qb > 63u) qb = 63u;
            const unsigned long long wait = (unsigned long long)(qa * 6400u + qb * 409600u); const unsigned long long t0 = __builtin_amdgcn_s_memrealtime();
            while (__builtin_amdgcn_s_memrealtime() - t0 < wait) __builtin_amdgcn_s_sleep(8); }
        continue;
#endif
        if (ph + 1 < ph_hi) { XcdBarrier bar; bar.bar = F.ctl + CW_BAR; bar.x = xb_xcc_id(); bar.st = F.MISC + 8; xcd_barrier(bar); }
    }
}

extern "C" void kernel_launch(void* const* d_in, const int* in_sizes, int n_in, void* d_out, int out_size, void* d_ws, size_t ws_size, hipStream_t stream) {
    static int grid = 0;
    if (grid == 0) {
        if (n_in != 25 || in_sizes[0] != M_TOK * DM || out_size != M_TOK * DM || ws_size < WS_END) { fprintf(stderr, "kernel_launch: unexpected shapes (n_in %d, in0 %d, out %d, ws %zu)\n", n_in, n_in > 0 ? in_sizes[0] : -1, out_size, ws_size); grid = -1; return; }
        int dev = 0, cus = 0, per_cu = 0;
        if (hipGetDevice(&dev) != hipSuccess || hipDeviceGetAttribute(&cus, hipDeviceAttributeMultiprocessorCount, dev) != hipSuccess) { grid = -1; return; }
        if (hipFuncSetAttribute((const void*)hyb_fwd, hipFuncAttributeMaxDynamicSharedMemorySize, LDS_BYTES) != hipSuccess) { fprintf(stderr, "kernel_launch: hipFuncSetAttribute failed\n"); grid = -1; return; }
        if (hipOccupancyMaxActiveBlocksPerMultiprocessor(&per_cu, (const void*)hyb_fwd, NTHREADS, LDS_BYTES) != hipSuccess || per_cu < 1)
            fprintf(stderr, "kernel_launch: note: occupancy query reports %d workgroups per CU\n", per_cu);
        (void)hipGetLastError();
        grid = cus;
    }
    if (grid < 0) return;
    if (hipMemsetAsync((char*)d_ws + WS_CTL, 0, CTL_ZERO_BYTES, stream) != hipSuccess) { fprintf(stderr, "kernel_launch: memset failed\n"); return; }
    Args a{};
    for (int i = 0; i < 25; ++i) a.in[i] = (const float*)d_in[i];
    a.out = (float*)d_out; a.ws = (unsigned char*)d_ws;
#if MK_N_LAUNCHES == 1
    a.ph_lo = 0; a.ph_hi = N_PHASES;
    hipLaunchKernelGGL(hyb_fwd, dim3(grid), dim3(NTHREADS), LDS_BYTES, stream, a);
#else
    for (int p = 0; p < N_PHASES; ++p) { a.ph_lo = p; a.ph_hi = p + 1; hipLaunchKernelGGL(hyb_fwd, dim3(grid), dim3(NTHREADS), LDS_BYTES, stream, a); }
#endif
    const hipError_t le = hipPeekAtLastError();
    if (le != hipSuccess) fprintf(stderr, "kernel_launch: launch failed: %s\n", hipGetErrorName(le));
}
```

```cpp
#include <hip/hip_runtime.h>
#include <cstdio>
#include <cstdint>

#define LAS __attribute__((address_space(3)))
#define GAS __attribute__((address_space(1)))
typedef unsigned short bf16_t;
typedef short bf16x8 __attribute__((ext_vector_type(8)));
typedef short bf16x4 __attribute__((ext_vector_type(4)));
typedef float f32x4 __attribute__((ext_vector_type(4)));
typedef float f32x2 __attribute__((ext_vector_type(2)));
typedef unsigned u32x4 __attribute__((ext_vector_type(4)));
typedef unsigned u32x2 __attribute__((ext_vector_type(2)));
typedef __bf16 bf16x2_t __attribute__((ext_vector_type(2)));

constexpr int M_TOK = 16384, SEQ = 4096, NBATCH = 4, DM = 1024, FF = 2816, NGU = 2 * FF, NIN = 3584, DEPTH = 2;
constexpr int PLD = 3328;
constexpr int PQ = 0, PK = 256, PV = 512, PO = 768, PZ = 1024, PX = 1536, PDQ = 2560, PDK = 2816, PDV = 3072;
constexpr float NORM_EPS = 1e-6f;
constexpr float LOG2E = 1.4426950408889634f;

__device__ __forceinline__ unsigned cvtpk(float lo, float hi) { f32x2 v = {lo, hi}; bf16x2_t b = __builtin_convertvector(v, bf16x2_t); return __builtin_bit_cast(unsigned, b); }
__device__ __forceinline__ bf16_t f2bf(float f) { return (bf16_t)(cvtpk(f, 0.f) & 0xffffu); }
__device__ __forceinline__ float bf2f(bf16_t h) { return __uint_as_float(((unsigned)h) << 16); }
__device__ __forceinline__ float bflo(unsigned w) { return __uint_as_float(w << 16); }
__device__ __forceinline__ float bfhi(unsigned w) { return __uint_as_float(w & 0xffff0000u); }
__device__ __forceinline__ float fast_exp(float x) { return __builtin_amdgcn_exp2f(x * LOG2E); }
__device__ __forceinline__ float fast_rcp(float x) { return __builtin_amdgcn_rcpf(x); }
__device__ __forceinline__ float fast_log1pexp(float x) { const float e = __builtin_amdgcn_exp2f(x * LOG2E); return __builtin_amdgcn_logf(1.0f + e) * 0.6931471805599453f; }
__device__ __forceinline__ float sigmoidf_(float x) { return fast_rcp(1.f + fast_exp(-x)); }
__device__ __forceinline__ float siluf_(float x) { return x * sigmoidf_(x); }

__device__ __forceinline__ void st16_wt(void* p, u32x4 v) { asm volatile("global_store_dwordx4 %0, %1, off sc1\n\ts_nop 1" :: "v"(p), "v"(v) : "memory"); }

namespace pg8 {
constexpr int BM = 256, BK = 64, HALF = 128, HTB = HALF * BK * 2, STAGE_BYTES = 8 * HTB, NXCD = 8, WGM = 8;
__host__ __device__ __forceinline__ int lds_byte(int r, int c) { const int st = (r >> 4) * 2 + (c >> 5), rr = r & 15, cc = c & 31, ob = rr * 64 + cc * 2; return st * 1024 + (ob ^ (((ob >> 9) & 1) << 5)); }
__host__ __device__ __forceinline__ void stage_rc(int b, int& R, int& C) { const int st = b / 1024, sb = b % 1024, swz = sb ^ (((sb >> 9) & 1) << 5); R = (st >> 1) * 16 + swz / 64; C = (st & 1) * 32 + (swz % 64) / 2; }
__host__ __device__ __forceinline__ int perm32(int rho) { const int n = rho >> 4, i = rho & 15; return 8 * (i >> 2) + 4 * n + (i & 3); }

struct Unit { int pm, pn; };
struct Gemm { const bf16_t* A; const bf16_t* Bt; int M, N, K, lda; };

struct StaticOrder {
    int nM, nN, nwg, G, c;
    __device__ void init(int M, int N, int G_, int c_) { nM = M / BM; nN = N / BM; nwg = nM * nN; G = G_; c = c_; }
    __device__ bool next(int i, Unit& u) const {
        const long L = (long)i * G + c; if (L >= nwg) return false;
        int wgid = (int)L; { const int q = nwg / NXCD, r = nwg % NXCD, xcd = wgid % NXCD, off = wgid / NXCD; wgid = (xcd < r ? xcd * (q + 1) : r * (q + 1) + (xcd - r) * q) + off; }
        const int nig = WGM * nN, gid = wgid / nig, fm = gid * WGM, gsz = (nM - fm) < WGM ? (nM - fm) : WGM;
        u.pm = fm + ((wgid % nig) % gsz); u.pn = (wgid % nig) / gsz; return true;
    }
};

template <class Epi, bool ALIGN_EPI, bool SP2>
__device__ __forceinline__ void gemm_phase(LAS unsigned char* lds, const Gemm g, const StaticOrder& S, const Epi& E, const int tid) {
    const int wid = __builtin_amdgcn_readfirstlane(tid >> 6), lane = tid & 63, wr = wid >> 2, wc = wid & 3, fr = lane & 15, fq = lane >> 4;
    const int K = g.K, nt = K / BK, lda = g.lda;
    unsigned voffA[2], voffB[2];
#pragma unroll
    for (int i = 0; i < 2; ++i) { int R, C; stage_rc(tid * 16 + i * 8192, R, C); const int Rb = (R & ~31) + perm32(R & 31);
        voffA[i] = (unsigned)(R * lda + C) * 2u; voffB[i] = (unsigned)(Rb * K + C) * 2u; }
    const size_t kstep = (size_t)(BK * 2);
    const size_t hstepA = (size_t)HALF * lda * 2, hstepB = (size_t)HALF * K * 2;
    const size_t tstepA = 2 * hstepA, tstepB = 2 * hstepB;
    const unsigned ldsw = (unsigned)wid * 1024u;
    const int aoff = lds_byte(wr * 64 + fr, fq * 8), boff = lds_byte(wc * 32 + fr, fq * 8);
#define PG8_SA(b, h) (((b) * 2 + (h)) * HTB)
#define PG8_SB(b, h) ((4 + (b) * 2 + (h)) * HTB)
#define PG8_STAGE(bufoff, gbase, voff) do { _Pragma("unroll") for (int _i = 0; _i < 2; ++_i) \
        __builtin_amdgcn_global_load_lds((const unsigned*)((const char*)(gbase) + (voff)[_i]), (LAS unsigned*)(lds + (bufoff) + ldsw + _i * 8192), 16, 0, 0); } while (0)
#define PG8_LDA(dst, b, h) do { _Pragma("unroll") for (int m = 0; m < 4; ++m) _Pragma("unroll") for (int k = 0; k < 2; ++k) dst[m][k] = *(const LAS bf16x8*)(lds + PG8_SA(b, h) + aoff + m * 2048 + k * 1024); } while (0)
#define PG8_LDB(dst, b, h) do { _Pragma("unroll") for (int n = 0; n < 2; ++n) _Pragma("unroll") for (int k = 0; k < 2; ++k) dst[n][k] = *(const LAS bf16x8*)(lds + PG8_SB(b, h) + boff + n * 2048 + k * 1024); } while (0)
#define PG8_MMA(ai, bj, At, Bt) do { __builtin_amdgcn_s_setprio(1); _Pragma("unroll") for (int m = 0; m < 4; ++m) _Pragma("unroll") for (int n = 0; n < 2; ++n) _Pragma("unroll") for (int k = 0; k < 2; ++k) \
        acc[ai][bj][m][n] = __builtin_amdgcn_mfma_f32_16x16x32_bf16(Bt[n][k], At[m][k], acc[ai][bj][m][n], 0, 0, 0); __builtin_amdgcn_s_setprio(0); } while (0)
#define PG8_WAIT_V(n) asm volatile("s_waitcnt vmcnt(" #n ")" ::: "memory")
#define PG8_WAIT_L(n) asm volatile("s_waitcnt lgkmcnt(" #n ")" ::: "memory")
#define PG8_BAR __builtin_amdgcn_s_barrier()
#define PG8_SCHED __builtin_amdgcn_sched_barrier(0)
    Unit cur, nxt; int ui = 0;
    if (!S.next(0, cur)) return;
    f32x4 acc[2][2][4][2];
    typename Epi::Raw raw; E.init_load(raw, cur, wr, wc, fr, fq);
    typename Epi::Pre pre; E.pre_load(pre, cur, wr, fr, fq);
    if constexpr (!Epi::HAS_INIT) {
#pragma unroll
    for (int a = 0; a < 2; ++a)
#pragma unroll
        for (int b = 0; b < 2; ++b)
#pragma unroll
            for (int m = 0; m < 4; ++m)
#pragma unroll
                for (int n = 0; n < 2; ++n) acc[a][b][m][n] = (f32x4){0.f, 0.f, 0.f, 0.f};
    }
    bf16x8 At[4][2], B0[2][2], B1[2][2];
    const char* cA = (const char*)g.A + (size_t)cur.pm * tstepA; const char* cB = (const char*)g.Bt + (size_t)cur.pn * tstepB;
    if constexpr (SP2) {
        PG8_STAGE(PG8_SB(0, 0), cB, voffB); PG8_STAGE(PG8_SB(0, 1), cB + hstepB, voffB); PG8_STAGE(PG8_SA(0, 0), cA, voffA); PG8_STAGE(PG8_SA(0, 1), cA + hstepA, voffA);
        if constexpr (Epi::HAS_INIT) E.init_finish(raw, acc);
        E.pre_finish(pre);
        if (wr == 1) PG8_BAR;
        PG8_WAIT_V(2); PG8_BAR;
        PG8_STAGE(PG8_SB(1, 0), cB + kstep, voffB); PG8_STAGE(PG8_SA(1, 0), cA + kstep, voffA); PG8_STAGE(PG8_SB(1, 1), cB + hstepB + kstep, voffB);
        PG8_WAIT_V(6); PG8_BAR;
    } else {
        PG8_STAGE(PG8_SB(0, 0), cB, voffB); PG8_STAGE(PG8_SA(0, 0), cA, voffA); PG8_STAGE(PG8_SB(0, 1), cB + hstepB, voffB); PG8_STAGE(PG8_SA(0, 1), cA + hstepA, voffA);
        E.pre_finish(pre);
        if (wr == 1) PG8_BAR;
        PG8_WAIT_V(4); PG8_BAR;
        PG8_STAGE(PG8_SB(1, 0), cB + kstep, voffB); PG8_STAGE(PG8_SA(1, 0), cA + kstep, voffA); PG8_STAGE(PG8_SB(1, 1), cB + hstepB + kstep, voffB);
        PG8_WAIT_V(6); PG8_BAR;
    }
    for (;;) {
        const bool has_next = S.next(ui + 1, nxt);
        const char* nA = has_next ? (const char*)g.A + (size_t)nxt.pm * tstepA : cA; const char* nB = has_next ? (const char*)g.Bt + (size_t)nxt.pn * tstepB : cB;
        for (int t = 0; t < nt; t += 2) {
            const bool last = (t == nt - 2);
            const char* a1 = cA + (size_t)(t + 1) * kstep;
            const char* a2 = last ? nA : cA + (size_t)(t + 2) * kstep; const char* b2 = last ? nB : cB + (size_t)(t + 2) * kstep;
            const char* a3 = a2 + kstep; const char* b3 = b2 + kstep;
            if constexpr (SP2) {
            PG8_LDB(B0, 0, 0); PG8_LDB(B1, 0, 1); PG8_SCHED; PG8_LDA(At, 0, 0); PG8_STAGE(PG8_SA(1, 1), a1 + hstepA, voffA);
            PG8_WAIT_V(8); PG8_WAIT_L(0); PG8_BAR; PG8_MMA(0, 0, At, B0); PG8_MMA(0, 1, At, B1); PG8_BAR; PG8_SCHED;
            PG8_LDA(At, 0, 1); PG8_STAGE(PG8_SB(0, 0), b2, voffB); PG8_STAGE(PG8_SB(0, 1), b2 + hstepB, voffB); PG8_STAGE(PG8_SA(0, 0), a2, voffA);
            PG8_WAIT_V(8); PG8_WAIT_L(0); PG8_BAR; PG8_MMA(1, 0, At, B0); PG8_MMA(1, 1, At, B1); PG8_BAR; PG8_SCHED;
            PG8_LDB(B0, 1, 0); PG8_LDB(B1, 1, 1); PG8_SCHED; PG8_LDA(At, 1, 0); PG8_STAGE(PG8_SA(0, 1), a2 + hstepA, voffA);
            PG8_WAIT_V(8); PG8_WAIT_L(0); PG8_BAR; PG8_MMA(0, 0, At, B0); PG8_MMA(0, 1, At, B1); PG8_BAR; PG8_SCHED;
            PG8_LDA(At, 1, 1); PG8_STAGE(PG8_SB(1, 0), b3, voffB); PG8_STAGE(PG8_SB(1, 1), b3 + hstepB, voffB); PG8_STAGE(PG8_SA(1, 0), a3, voffA);
            PG8_WAIT_V(8); PG8_WAIT_L(0); PG8_BAR; PG8_MMA(1, 0, At, B0); PG8_MMA(1, 1, At, B1); PG8_BAR; PG8_SCHED;
            } else {
            PG8_LDB(B0, 0, 0); PG8_SCHED; PG8_LDA(At, 0, 0); PG8_STAGE(PG8_SA(1, 1), a1 + hstepA, voffA);
            PG8_WAIT_L(8); PG8_BAR; PG8_WAIT_L(0); PG8_MMA(0, 0, At, B0); PG8_BAR; PG8_SCHED;
            PG8_LDB(B1, 0, 1); PG8_STAGE(PG8_SB(0, 0), b2, voffB);
            PG8_BAR; PG8_WAIT_L(0); PG8_MMA(0, 1, At, B1); PG8_BAR;
            PG8_LDA(At, 0, 1); PG8_STAGE(PG8_SA(0, 0), a2, voffA);
            PG8_BAR; PG8_WAIT_L(0); PG8_MMA(1, 0, At, B0); PG8_BAR; PG8_SCHED;
            PG8_STAGE(PG8_SB(0, 1), b2 + hstepB, voffB);
            PG8_WAIT_V(6); PG8_BAR; PG8_MMA(1, 1, At, B1); PG8_BAR;
            PG8_LDB(B0, 1, 0); PG8_SCHED; PG8_LDA(At, 1, 0); PG8_STAGE(PG8_SA(0, 1), a2 + hstepA, voffA);
            PG8_WAIT_L(8); PG8_BAR; PG8_WAIT_L(0); PG8_MMA(0, 0, At, B0); PG8_BAR; PG8_SCHED;
            PG8_LDB(B1, 1, 1); PG8_STAGE(PG8_SB(1, 0), b3, voffB);
            PG8_BAR; PG8_WAIT_L(0); PG8_MMA(0, 1, At, B1); PG8_BAR;
            PG8_LDA(At, 1, 1); PG8_STAGE(PG8_SA(1, 0), a3, voffA);
            PG8_BAR; PG8_WAIT_L(0); PG8_MMA(1, 0, At, B0); PG8_BAR; PG8_SCHED;
            PG8_STAGE(PG8_SB(1, 1), b3 + hstepB, voffB);
            PG8_WAIT_V(6); PG8_BAR; PG8_MMA(1, 1, At, B1); PG8_BAR;
            }
        }
        if constexpr (ALIGN_EPI) { if (wr == 0) PG8_BAR; }
        E(acc, cur, wr, wc, fr, fq, pre);
        if (!has_next) break;
#pragma unroll
        for (int a = 0; a < 2; ++a)
#pragma unroll
            for (int b = 0; b < 2; ++b)
#pragma unroll
                for (int m = 0; m < 4; ++m)
#pragma unroll
                    for (int n = 0; n < 2; ++n) acc[a][b][m][n] = (f32x4){0.f, 0.f, 0.f, 0.f};
        cur = nxt; cA = nA; cB = nB; ++ui;
        if constexpr (ALIGN_EPI) { if (wr == 1) PG8_BAR; }
    }
    PG8_WAIT_V(0);
    if constexpr (!ALIGN_EPI) { if (wr == 0) PG8_BAR; }
    PG8_BAR;
#undef PG8_SA
#undef PG8_SB
#undef PG8_STAGE
#undef PG8_LDA
#undef PG8_LDB
#undef PG8_MMA
#undef PG8_WAIT_V
#undef PG8_WAIT_L
#undef PG8_BAR
#undef PG8_SCHED
}
}
constexpr size_t MiB = 1u << 20;
constexpr size_t WS_CTL = 0, CTL_ZERO_BYTES = 1 * MiB;
constexpr size_t WS_SSQ = 1 * MiB;
constexpr size_t WS_GATES = 2 * MiB;
constexpr size_t WS_NST = 3 * MiB;
constexpr size_t WS_W = 4 * MiB;
constexpr size_t W_GU1 = 0, W_D1 = 11 * MiB, W_IN = W_D1 + 11 * MiB / 2, W_OUT = W_IN + 7 * MiB, W_GU2 = W_OUT + 2 * MiB, W_D2 = W_GU2 + 11 * MiB, W_LAYER = 42 * MiB;
static_assert(W_D2 + 11 * MiB / 2 == W_LAYER, "weights map");
constexpr size_t WS_XB = 88 * MiB;
constexpr size_t WS_CST = 120 * MiB;
constexpr size_t WS_SST = 128 * MiB;
constexpr size_t WS_PROJ = 144 * MiB;
constexpr size_t WS_END = 248 * MiB;
static_assert(WS_PROJ + (size_t)M_TOK * PLD * 2 <= WS_END, "ws map");

constexpr int CW_BAR = 4096;
constexpr int CW_Q = 16384;

constexpr int RING_BYTES = 131072;
constexpr int LDSCTL_OFF = RING_BYTES, MISC_OFF = LDSCTL_OFF + 320;
constexpr int LDS_BYTES = 147456;
constexpr int NWAVES = 8, NTHREADS = 512;

typedef GAS unsigned gu32;
#define RLX_AGENT __ATOMIC_RELAXED, __HIP_MEMORY_SCOPE_AGENT
#define LDS_WAIT() asm volatile("s_waitcnt lgkmcnt(0)" ::: "memory")
#define VM_WAIT() asm volatile("s_waitcnt vmcnt(0)" ::: "memory")

#define XB_TMO      128
#define XB_XCNT(j)  (256  + 64 * (j))
#define XB_XSUB(j)  (1280 + 64 * (j))
#define XB_XGEN(j)  (2304 + 64 * (j))
#define XB_TOP      3328
#define XB_TOPGEN   3392
#define XCD_BAR_WORDS 3456
#define XB_SPIN_CAP (1u << 22)
__device__ __forceinline__ unsigned xb_ld(unsigned* p)              { return __hip_atomic_load(p, __ATOMIC_RELAXED, __HIP_MEMORY_SCOPE_AGENT); }
__device__ __forceinline__ unsigned xb_add(unsigned* p, unsigned v) { return __hip_atomic_fetch_add(p, v, __ATOMIC_RELAXED, __HIP_MEMORY_SCOPE_AGENT); }
__device__ __forceinline__ unsigned xb_xcc_id() { return (unsigned)__builtin_amdgcn_s_getreg((3 << 11) | 20) & 0xFu; }
#define XB_SPIN(cond, bar) do { unsigned _sp = 0; while (cond) { __builtin_amdgcn_s_sleep(1); \
    if ((++_sp & 255u) == 0u) { if (xb_ld(&(bar)[XB_TMO])) break; if (_sp > XB_SPIN_CAP) { atomicAdd(&(bar)[XB_TMO], 1u); break; } } } } while (0)
struct XcdBarrier { unsigned* bar; unsigned x; volatile LAS unsigned* st; };
__device__ __forceinline__ XcdBarrier xcd_barrier_post(unsigned* bar, volatile LAS unsigned* st) {
    XcdBarrier b; b.bar = bar; b.x = xb_xcc_id(); b.st = st;
    if (threadIdx.x == 0) (void)xb_add(&bar[XB_XCNT(b.x)], 1u);
    return b;
}
__device__ __forceinline__ void xcd_barrier_complete(unsigned* bar, unsigned x, unsigned& nloc, unsigned& nx) {
    const unsigned G = gridDim.x * gridDim.y * gridDim.z;
    unsigned sum, cnt, mine, sp = 0u;
    for (;;) {
        sum = 0u; cnt = 0u; mine = 0u;
#pragma unroll
        for (unsigned j = 0; j < 16; ++j) { const unsigned c = xb_ld(&bar[XB_XCNT(j)]); sum += c; cnt += (c > 0u) ? 1u : 0u; mine = (j == x) ? c : mine; }
        if (sum == G) break;
        __builtin_amdgcn_s_sleep(1);
        if ((++sp & 255u) == 0u) { if (xb_ld(&bar[XB_TMO])) break; if (sp > XB_SPIN_CAP) { atomicAdd(&bar[XB_TMO], 1u); break; } }
    }
    nloc = mine > 0u ? mine : 1u; nx = cnt > 0u ? cnt : 1u;
}
__device__ __forceinline__ void xcd_barrier(const XcdBarrier& b) {
    asm volatile("s_waitcnt vmcnt(0)" ::: "memory");
    __syncthreads();
    if (threadIdx.x == 0) {
        unsigned* bar = b.bar;
        __builtin_amdgcn_s_waitcnt(0);
        unsigned nloc = b.st[0], nx = b.st[1];
        if (nloc == 0u) { xcd_barrier_complete(bar, b.x, nloc, nx); b.st[0] = nloc; b.st[1] = nx; }
        const unsigned old = xb_add(&bar[XB_XSUB(b.x)], 1u);
        const unsigned gen = old / nloc;
        if (old + 1u == (gen + 1u) * nloc) {
            __builtin_amdgcn_fence(__ATOMIC_RELEASE, "agent");
            asm volatile("s_waitcnt vmcnt(0)" ::: "memory");
            const unsigned og = xb_add(&bar[XB_TOP], 1u);
            const unsigned tg = og / nx;
            if (og + 1u == (tg + 1u) * nx) xb_add(&bar[XB_TOPGEN], 1u);
            else XB_SPIN(xb_ld(&bar[XB_TOPGEN]) == tg, bar);
            __builtin_amdgcn_fence(__ATOMIC_ACQUIRE, "agent");
            xb_add(&bar[XB_XGEN(b.x)], 1u);
            asm volatile("s_waitcnt vmcnt(0)" ::: "memory");
        } else {
            XB_SPIN(xb_ld(&bar[XB_XGEN(b.x)]) == gen, bar);
            __builtin_amdgcn_fence(__ATOMIC_ACQUIRE, "agent");
            asm volatile("s_waitcnt vmcnt(0)" ::: "memory");
        }
    }
    __syncthreads();
}

struct Args { const float* in[25]; float* out; unsigned char* ws; int ph_lo, ph_hi; };
typedef const float* fptr_t; typedef __attribute__((address_space(4))) const fptr_t* kinptr_t;
struct ArgView { kinptr_t in; };
struct Frame {
    LAS unsigned char* lds;
    volatile LAS unsigned* MISC;
    unsigned* ctl;
    int tid, lane, wave, vcu, G;
    kinptr_t in;
    unsigned char* ws;
};
__device__ __forceinline__ float wave_sum(float v) {
#pragma unroll
    for (int o = 1; o < 64; o <<= 1) v += __shfl_xor(v, o);
    return v;
}
__device__ __forceinline__ int q_next(Frame& F, int q) {
    __syncthreads();
    if (F.tid == 0) F.MISC[16] = xb_add(F.ctl + CW_Q + 64 * q, 1u);
    __syncthreads();
    return (int)F.MISC[16];
}

struct MapPlain { __device__ __forceinline__ int row(int n) const { return n; } __device__ __forceinline__ float scale(int) const { return 1.f; } };
struct MapGU { int off; __device__ __forceinline__ int row(int n) const { return 256 * (n >> 7) + off + (n & 127); } __device__ __forceinline__ float scale(int) const { return 1.f; } };
struct MapIn {
    __device__ __forceinline__ int row(int n) const {
        if (n < 1024) return n;
        if (n < 1032) return 13 * 256 + (n - 1024);
        if (n < 1544) return 4 * 256 + (n - 1032);
        if (n < 2568) return 6 * 256 + (n - 1544);
        if (n < 2576) return 13 * 256 + 8 + (n - 2568);
        return 10 * 256 + (n - 2576);
    }
    __device__ __forceinline__ float scale(int n) const { return (n >= 256 && n < 512) ? 0.125f : 1.f; }
};
template <class Map>
__device__ __forceinline__ void p0_transpose_item(const float* W, int K, int N, bf16_t* WT, int item, int lane, const float* gain, const Map map) {
    const int nblk = (N + 63) / 64, kb = item / nblk, nb = item % nblk, k0 = 64 * kb, n = 64 * nb + lane;
    if (n >= N) return;
    const float* src = W + (size_t)k0 * N + n;
    float v[64];
#pragma unroll
    for (int i = 0; i < 64; ++i) v[i] = src[(size_t)i * N];
    const float sc = map.scale(n);
    if (gain) {
#pragma unroll
        for (int i = 0; i < 64; i += 4) { const f32x4 g = *(const f32x4*)(gain + k0 + i); v[i] *= g.x; v[i + 1] *= g.y; v[i + 2] *= g.z; v[i + 3] *= g.w; }
    }
    u32x4* dst = (u32x4*)(WT + (size_t)map.row(n) * K + k0);
#pragma unroll
    for (int c = 0; c < 8; ++c) { u32x4 o; o.x = cvtpk(v[8 * c] * sc, v[8 * c + 1] * sc); o.y = cvtpk(v[8 * c + 2] * sc, v[8 * c + 3] * sc); o.z = cvtpk(v[8 * c + 4] * sc, v[8 * c + 5] * sc); o.w = cvtpk(v[8 * c + 6] * sc, v[8 * c + 7] * sc); dst[c] = o; }
}
constexpr int I_G = (DM / 64) * (FF / 64), I_D = (FF / 64) * (DM / 64), I_IN = (DM / 64) * ((3344 + 63) / 64), I_OUT = (DM / 64) * (DM / 64);
constexpr int R_GU1 = 0, R_D1 = 2 * I_G, R_IN = R_D1 + I_D, R_OUT = R_IN + I_IN, R_GU2 = R_OUT + I_OUT, R_D2 = R_GU2 + 2 * I_G, R_END = R_D2 + I_D;
__device__ __forceinline__ void convert_items(Frame& F, int l, int r_lo, int r_hi, int gw, int NGW) {
    bf16_t* WL = (bf16_t*)(F.ws + WS_W + (size_t)l * W_LAYER);
    for (int it = r_lo + gw; it < r_hi; it += NGW) {
        int r = it;
        if (r < I_G) { p0_transpose_item(F.in[2] + (size_t)l * DM * FF, DM, FF, (bf16_t*)((char*)WL + W_GU1), r, F.lane, F.in[1] + l * DM, MapGU{0}); continue; } r -= I_G;
        if (r < I_G) { p0_transpose_item(F.in[3] + (size_t)l * DM * FF, DM, FF, (bf16_t*)((char*)WL + W_GU1), r, F.lane, F.in[1] + l * DM, MapGU{128}); continue; } r -= I_G;
        if (r < I_D) { p0_transpose_item(F.in[4] + (size_t)l * FF * DM, FF, DM, (bf16_t*)((char*)WL + W_D1), r, F.lane, nullptr, MapPlain{}); continue; } r -= I_D;
        if (r < I_IN) { p0_transpose_item(F.in[6] + (size_t)l * DM * 3344, DM, 3344, (bf16_t*)((char*)WL + W_IN), r, F.lane, F.in[5] + l * DM, MapIn{}); continue; } r -= I_IN;
        if (r < I_OUT) { p0_transpose_item(F.in[20] + (size_t)l * DM * DM, DM, DM, (bf16_t*)((char*)WL + W_OUT), r, F.lane, nullptr, MapPlain{}); continue; } r -= I_OUT;
        if (r < I_G) { p0_transpose_item(F.in[22] + (size_t)l * DM * FF, DM, FF, (bf16_t*)((char*)WL + W_GU2), r, F.lane, F.in[21] + l * DM, MapGU{0}); continue; } r -= I_G;
        if (r < I_G) { p0_transpose_item(F.in[23] + (size_t)l * DM * FF, DM, FF, (bf16_t*)((char*)WL + W_GU2), r, F.lane, F.in[21] + l * DM, MapGU{128}); continue; } r -= I_G;
        p0_transpose_item(F.in[24] + (size_t)l * FF * DM, FF, DM, (bf16_t*)((char*)WL + W_D2), r, F.lane, nullptr, MapPlain{});
    }
    if (r_lo <= R_IN && R_IN < r_hi) {
        u32x4* z = (u32x4*)(F.ws + WS_W + (size_t)l * W_LAYER + W_IN + (size_t)(13 * 256 + 16) * DM * 2);
        const int n16 = 240 * DM * 2 / 16;
        unsigned z0 = 0u; asm volatile("" : "+v"(z0));
        for (int i = gw * 64 + F.lane; i < n16; i += NGW * 64) z[i] = (u32x4){z0, z0, z0, z0};
    }
}
__device__ __forceinline__ void side_convert(Frame& F, int l, int k) {
    if (F.G != 256) return;
    constexpr int R_SPLIT3 = R_END - (R_END - R_OUT) / 6;
    if ((int)blockIdx.x < 128) { if (l == 0 && k == 2) convert_items(F, 0, R_SPLIT3, R_END, (int)blockIdx.x * NWAVES + F.wave, 128 * NWAVES); return; }
    const int gw = ((int)blockIdx.x - 128) * NWAVES + F.wave, NGW = 128 * NWAVES;
    if (l == 0 && k == 0) convert_items(F, 0, R_D1, R_OUT, gw, NGW);
    else if (l == 0 && k == 2) convert_items(F, 0, R_OUT, R_SPLIT3, gw, NGW);
    else if (l == 0 && k == 7) convert_items(F, 1, R_GU1, R_D1, gw, NGW);
    else if (l == 1 && k == 0) convert_items(F, 1, R_D1, R_GU2, gw, NGW);
    else if (l == 1 && k == 2) convert_items(F, 1, R_GU2, R_D2, gw, NGW);
    else if (l == 1 && k == 7) convert_items(F, 1, R_D2, R_END, gw, NGW);
}
__device__ __forceinline__ void p0_prologue(Frame& F) {
    const int gw = F.vcu * NWAVES + F.wave, NGW = F.G * NWAVES;
    if (F.G == 256) convert_items(F, 0, R_GU1, R_D1, gw, NGW);
    else { convert_items(F, 0, 0, R_END, gw, NGW); convert_items(F, 1, 0, R_END, gw, NGW); }
    const float* x = F.in[0]; bf16_t* XB = (bf16_t*)(F.ws + WS_XB); float* SSQ = (float*)(F.ws + WS_SSQ);
    for (int m = gw; m < M_TOK; m += NGW) {
        const f32x4* xr = (const f32x4*)(x + (size_t)m * DM) + F.lane; float s = 0.f; f32x4 v[4];
#pragma unroll
        for (int j = 0; j < 4; ++j) { v[j] = xr[64 * j]; s += (v[j].x * v[j].x + v[j].y * v[j].y) + (v[j].z * v[j].z + v[j].w * v[j].w); }
        s = wave_sum(s);
        u32x2* o8 = (u32x2*)(XB + (size_t)m * DM) + F.lane;
#pragma unroll
        for (int j = 0; j < 4; ++j) o8[64 * j] = (u32x2){cvtpk(v[j].x, v[j].y), cvtpk(v[j].z, v[j].w)};
        if (F.lane < 16) SSQ[(size_t)m * 16 + F.lane] = (F.lane == 0) ? s : 0.f;
    }
}

__device__ __forceinline__ void rows_rs(const float* ssq, int rowbase, int fr, int fq, float (&rs)[8]) {
    f32x4 p[8];
#pragma unroll
    for (int i = 0; i < 8; ++i) { const int row = rowbase + (i >> 2) * 128 + (i & 3) * 16 + fr; p[i] = *(const f32x4*)(ssq + (size_t)row * 16 + 4 * fq); }
#pragma unroll
    for (int i = 0; i < 8; ++i) { float s = (p[i].x + p[i].y) + (p[i].z + p[i].w); s += __shfl_xor(s, 16); s += __shfl_xor(s, 32); rs[i] = rsqrtf(s * (1.0f / DM) + NORM_EPS); }
}
struct RowScale { f32x4 p[8]; float rs[8]; int pm; };
__device__ __forceinline__ void rowscale_load(RowScale& R, const float* ssq, const pg8::Unit& u, int wr, int fr, int fq) {
    R.pm = u.pm;
#pragma unroll
    for (int i = 0; i < 8; ++i) { const int row = u.pm * 256 + wr * 64 + (i >> 2) * 128 + (i & 3) * 16 + fr; R.p[i] = *(const f32x4*)(ssq + (size_t)row * 16 + 4 * fq); }
}
__device__ __forceinline__ void rowscale_finish(RowScale& R) {
#pragma unroll
    for (int i = 0; i < 8; ++i) { float s = (R.p[i].x + R.p[i].y) + (R.p[i].z + R.p[i].w); s += __shfl_xor(s, 16); s += __shfl_xor(s, 32); R.rs[i] = rsqrtf(s * (1.0f / DM) + NORM_EPS); asm volatile("" : "+v"(R.rs[i])); }
}
struct EpiNoInit { struct Raw {}; static constexpr bool HAS_INIT = false; __device__ __forceinline__ void init_load(Raw&, const pg8::Unit&, int, int, int, int) const {}
    struct Pre {}; __device__ __forceinline__ void pre_load(Pre&, const pg8::Unit&, int, int, int) const {} __device__ __forceinline__ void pre_finish(Pre&) const {} };
struct EpiSwiglu : EpiNoInit {
    bf16_t* H; const float* ssq;
    typedef RowScale Pre;
    __device__ __forceinline__ void pre_load(Pre& R, const pg8::Unit& u, int wr, int fr, int fq) const { rowscale_load(R, ssq, u, wr, fr, fq); }
    __device__ __forceinline__ void pre_finish(Pre& R) const { rowscale_finish(R); }
    __device__ __forceinline__ void operator()(const f32x4 (&acc)[2][2][4][2], const pg8::Unit& u, int wr, int wc, int fr, int fq, Pre& R) const {
        asm volatile("" : "+v"(fr), "+v"(fq));
        const int col0 = u.pn * 128 + wc * 32 + 8 * fq;
        if (u.pm != R.pm) { rowscale_load(R, ssq, u, wr, fr, fq); rowscale_finish(R); }
        const float (&rs)[8] = R.rs;
#pragma unroll
        for (int ai = 0; ai < 2; ++ai)
#pragma unroll
            for (int m = 0; m < 4; ++m) {
                const int row = u.pm * 256 + ai * 128 + wr * 64 + m * 16 + fr; const float r = rs[ai * 4 + m];
                float hv[8];
#pragma unroll
                for (int n = 0; n < 2; ++n)
#pragma unroll
                    for (int j = 0; j < 4; ++j) { const float g = acc[ai][0][m][n][j] * r, up = acc[ai][1][m][n][j] * r; hv[4 * n + j] = siluf_(g) * up; }
                u32x4 w; w.x = cvtpk(hv[0], hv[1]); w.y = cvtpk(hv[2], hv[3]); w.z = cvtpk(hv[4], hv[5]); w.w = cvtpk(hv[6], hv[7]);
                st16_wt(H + (size_t)row * FF + col0, w);
                if (m & 1) asm volatile("" ::: "memory");
            }
    }
};
template <bool FINAL>
struct EpiResid {
    struct Raw { u32x4 r[2][4][2]; };
    static constexpr bool HAS_INIT = true;
    struct Pre {}; __device__ __forceinline__ void pre_load(Pre&, const pg8::Unit&, int, int, int) const {} __device__ __forceinline__ void pre_finish(Pre&) const {}
    float* xout; bf16_t* XB; float* ssq; float alpha, ralpha;
    __device__ __forceinline__ void init_load(Raw& raw, const pg8::Unit& u, int wr, int wc, int fr, int fq) const {
        const int col0 = u.pn * 256 + wc * 32 + 8 * fq;
#pragma unroll
        for (int ai = 0; ai < 2; ++ai)
#pragma unroll
            for (int m = 0; m < 4; ++m) { const int row = u.pm * 256 + ai * 128 + wr * 64 + m * 16 + fr;
#pragma unroll
                for (int bj = 0; bj < 2; ++bj) raw.r[ai][m][bj] = *(const u32x4*)(XB + (size_t)row * DM + col0 + bj * 128); }
    }
    __device__ __forceinline__ void init_finish(const Raw& raw, f32x4 (&acc)[2][2][4][2]) const {
#pragma unroll
        for (int ai = 0; ai < 2; ++ai)
#pragma unroll
            for (int m = 0; m < 4; ++m)
#pragma unroll
                for (int bj = 0; bj < 2; ++bj) { const u32x4 w = raw.r[ai][m][bj];
                    acc[ai][bj][m][0] = (f32x4){bflo(w.x), bfhi(w.x), bflo(w.y), bfhi(w.y)} * ralpha; acc[ai][bj][m][1] = (f32x4){bflo(w.z), bfhi(w.z), bflo(w.w), bfhi(w.w)} * ralpha; }
    }
    __device__ __forceinline__ void operator()(const f32x4 (&acc)[2][2][4][2], const pg8::Unit& u, int wr, int wc, int fr, int fq, Pre&) const {
        asm volatile("" : "+v"(fr), "+v"(fq));
        const int col0 = u.pn * 256 + wc * 32 + 8 * fq;
#pragma unroll
        for (int ai = 0; ai < 2; ++ai)
#pragma unroll
            for (int m = 0; m < 4; ++m) {
                const int row = u.pm * 256 + ai * 128 + wr * 64 + m * 16 + fr; float ss = 0.f;
#pragma unroll
                for (int bj = 0; bj < 2; ++bj) {
                    const size_t off = (size_t)row * DM + col0 + bj * 128;
                    const f32x4 y0 = acc[ai][bj][m][0] * alpha, y1 = acc[ai][bj][m][1] * alpha;
                    if (FINAL) { *(f32x4*)(xout + off) = y0; *(f32x4*)(xout + off + 4) = y1; }
                    else {
                        ss += (y0.x * y0.x + y0.y * y0.y) + (y0.z * y0.z + y0.w * y0.w) + (y1.x * y1.x + y1.y * y1.y) + (y1.z * y1.z + y1.w * y1.w);
                        u32x4 w; w.x = cvtpk(y0.x, y0.y); w.y = cvtpk(y0.z, y0.w); w.z = cvtpk(y1.x, y1.y); w.w = cvtpk(y1.z, y1.w);
                        st16_wt(XB + off, w); }
                }
                if (!FINAL) { ss += __shfl_xor(ss, 16); ss += __shfl_xor(ss, 32);
                    if (fq == 0) ssq[(size_t)row * 16 + u.pn * 4 + wc] = ss; }
                if (m & 1) asm volatile("" ::: "memory");
            }
    }
};
struct EpiInProj : EpiNoInit {
    bf16_t* PROJ; float* GATES; const float* ssq; const float* qnw; const float* knw; const float* gbias; const float* dtb;
    template <int KIND>
    __device__ __forceinline__ void body(const f32x4 (&acc)[2][2][4][2], const pg8::Unit& u, int wr, int wc, int fr, int fq, const float (&rs)[8]) const {
        const int t = u.pn, colw = wc * 32 + 8 * fq;
        float nw[8];
        if (KIND == 3) { const float* w = (t == 10 ? qnw : knw) + (wc & 1) * 32 + 8 * fq; const float sc = (t == 10) ? (0.17677669529663687f * LOG2E) : 1.f;
#pragma unroll
            for (int i = 0; i < 8; ++i) nw[i] = w[i] * sc; }
#pragma unroll
        for (int ai = 0; ai < 2; ++ai)
#pragma unroll
            for (int m = 0; m < 4; ++m) {
                const int row = u.pm * 256 + ai * 128 + wr * 64 + m * 16 + fr; const float r = rs[ai * 4 + m];
#pragma unroll
                for (int bj = 0; bj < 2; ++bj) {
                    float v[8];
#pragma unroll
                    for (int n = 0; n < 2; ++n)
#pragma unroll
                        for (int j = 0; j < 4; ++j) v[4 * n + j] = acc[ai][bj][m][n][j] * r;
                    if (KIND == 1) {
#pragma unroll
                        for (int i = 0; i < 8; ++i) v[i] = sigmoidf_(v[i]);
                    } else if (KIND == 2) {
#pragma unroll
                        for (int i = 0; i < 8; ++i) v[i] = siluf_(v[i]);
                    } else if (KIND == 3) {
                        float ss = 0.f;
#pragma unroll
                        for (int i = 0; i < 8; ++i) ss += v[i] * v[i];
                        ss += __shfl_xor(ss, 16); ss += __shfl_xor(ss, 32);
                        const float q = rsqrtf(ss * (1.0f / 32.0f) + NORM_EPS);
#pragma unroll
                        for (int i = 0; i < 8; ++i) v[i] = v[i] * q * nw[i];
                    }
                    u32x4 w; w.x = cvtpk(v[0], v[1]); w.y = cvtpk(v[2], v[3]); w.z = cvtpk(v[4], v[5]); w.w = cvtpk(v[6], v[7]);
                    st16_wt(PROJ + (size_t)row * PLD + t * 256 + bj * 128 + colw, w);
                }
                if (m & 1) asm volatile("" ::: "memory");
            }
    }
    __device__ __forceinline__ void gates(const f32x4 (&acc)[2][2][4][2], const pg8::Unit& u, int wr, int wc, int fr, int fq, const float (&rs)[8]) const {
        if (wc != 0 || fq >= 2) return;
#pragma unroll
        for (int ai = 0; ai < 2; ++ai)
#pragma unroll
            for (int m = 0; m < 4; ++m) {
                const int row = u.pm * 256 + ai * 128 + wr * 64 + m * 16 + fr; const float r = rs[ai * 4 + m];
                float v[8], o[8];
#pragma unroll
                for (int n = 0; n < 2; ++n)
#pragma unroll
                    for (int j = 0; j < 4; ++j) v[4 * n + j] = acc[ai][0][m][n][j] * r;
                if (fq == 0) {
#pragma unroll
                    for (int j = 0; j < 4; ++j) { o[j] = v[j] + gbias[j]; const float z = v[4 + j] + gbias[4 + j]; o[4 + j] = fminf(z, 0.f) - fast_log1pexp(-fabsf(z)); }
                } else {
#pragma unroll
                    for (int j = 0; j < 8; ++j) { const float z = v[j] + dtb[j]; o[j] = fmaxf(z, 0.f) + fast_log1pexp(-fabsf(z)); }
                }
                float* gp = GATES + (size_t)row * 16 + 8 * fq;
                *(f32x4*)gp = (f32x4){o[0], o[1], o[2], o[3]}; *(f32x4*)(gp + 4) = (f32x4){o[4], o[5], o[6], o[7]};
                asm volatile("" ::: "memory");
            }
    }
    typedef RowScale Pre;
    __device__ __forceinline__ void pre_load(Pre& R, const pg8::Unit& u, int wr, int fr, int fq) const { rowscale_load(R, ssq, u, wr, fr, fq); }
    __device__ __forceinline__ void pre_finish(Pre& R) const { rowscale_finish(R); }
    __device__ __forceinline__ void operator()(const f32x4 (&acc)[2][2][4][2], const pg8::Unit& u, int wr, int wc, int fr, int fq, Pre& R) const {
        asm volatile("" : "+v"(fr), "+v"(fq));
        if (u.pm != R.pm) { rowscale_load(R, ssq, u, wr, fr, fq); rowscale_finish(R); }
        const float (&rs)[8] = R.rs;
        const int t = u.pn;
        if (t == 13) gates(acc, u, wr, wc, fr, fq, rs);
        else if (t == 3) body<1>(acc, u, wr, wc, fr, fq, rs);
        else if (t == 4 || t == 5) body<2>(acc, u, wr, wc, fr, fq, rs);
        else if (t == 10 || t == 11) body<3>(acc, u, wr, wc, fr, fq, rs);
        else body<0>(acc, u, wr, wc, fr, fq, rs);
    }
};
#define MFMA16(a, b, c) __builtin_amdgcn_mfma_f32_16x16x32_bf16((a), (b), (c), 0, 0, 0)
#define WAVE_SYNC() do { asm volatile("s_waitcnt lgkmcnt(0)" ::: "memory"); __builtin_amdgcn_wave_barrier(); } while (0)
#define LDS_BARRIER() do { asm volatile("s_waitcnt lgkmcnt(0)" ::: "memory"); __builtin_amdgcn_s_barrier(); asm volatile("" ::: "memory"); } while (0)
__device__ __forceinline__ bf16x8 ld_g8(const bf16_t* p) { return *(const bf16x8*)p; }
__device__ __forceinline__ bf16x8 ld_l8(const LAS bf16_t* p) { return *(const LAS bf16x8*)p; }
__device__ __forceinline__ bf16x8 ld_l44(const LAS bf16_t* p0, const LAS bf16_t* p1) { const bf16x4 a = *(const LAS bf16x4*)p0, b = *(const LAS bf16x4*)p1; return (bf16x8){a[0], a[1], a[2], a[3], b[0], b[1], b[2], b[3]}; }
__device__ __forceinline__ bf16x8 pack8(const f32x4 a, const f32x4 b) { u32x4 w; w.x = cvtpk(a[0], a[1]); w.y = cvtpk(a[2], a[3]); w.z = cvtpk(b[0], b[1]); w.w = cvtpk(b[2], b[3]); return __builtin_bit_cast(bf16x8, w); }
__device__ __forceinline__ float wave_scan_incl(float v, int lane) {
#pragma unroll
    for (int o = 1; o < 64; o <<= 1) { const float t = __shfl_up(v, o); if (lane >= o) v += t; }
    return v;
}

typedef short v4i16_t __attribute__((ext_vector_type(4)));
__device__ __forceinline__ bf16x8 ld_tr8(const LAS bf16_t* T, int pitch, int k0, int c0, int lane) {
    const int i = lane & 15, fq = lane >> 4;
    const LAS bf16_t* p = T + (k0 + 8 * fq + (i >> 2)) * pitch + c0 + 4 * (i & 3);
    const v4i16_t lo = __builtin_amdgcn_ds_read_tr16_b64_v4i16((LAS v4i16_t*)p), hi = __builtin_amdgcn_ds_read_tr16_b64_v4i16((LAS v4i16_t*)(p + 4 * pitch));
    return (bf16x8){lo[0], lo[1], lo[2], lo[3], hi[0], hi[1], hi[2], hi[3]};
}
__device__ __forceinline__ bf16x8 ld_tr8p(const LAS bf16_t* T, int pitch, int k0, int c0, int lane) {
    const int i = lane & 15, fq = lane >> 4;
    const LAS bf16_t* p = T + (k0 + 4 * fq + (i >> 2)) * pitch + c0 + 4 * (i & 3);
    const v4i16_t lo = __builtin_amdgcn_ds_read_tr16_b64_v4i16((LAS v4i16_t*)p), hi = __builtin_amdgcn_ds_read_tr16_b64_v4i16((LAS v4i16_t*)(p + 16 * pitch));
    return (bf16x8){lo[0], lo[1], lo[2], lo[3], hi[0], hi[1], hi[2], hi[3]};
}

__device__ __forceinline__ void conv_phase(Frame& F, int l) {
    const bf16_t* PROJ = (const bf16_t*)(F.ws + WS_PROJ); bf16_t* XACT = (bf16_t*)F.in[25];
    const float* cw = F.in[9] + (size_t)l * 4 * 1024; const float* cb = F.in[10] + (size_t)l * 1024;
    for (int g = F.vcu * NTHREADS + F.tid; g < 1024 * 128; g += F.G * NTHREADS) {
        const int cg = g & 127, rb = g >> 7, ch0 = cg * 8, row0 = rb * 16;
        float w[4][8], bs[8];
#pragma unroll
        for (int j = 0; j < 4; ++j) { const f32x4 a = *(const f32x4*)(cw + j * 1024 + ch0), b = *(const f32x4*)(cw + j * 1024 + ch0 + 4);
            w[j][0] = a.x; w[j][1] = a.y; w[j][2] = a.z; w[j][3] = a.w; w[j][4] = b.x; w[j][5] = b.y; w[j][6] = b.z; w[j][7] = b.w; }
        { const f32x4 a = *(const f32x4*)(cb + ch0), b = *(const f32x4*)(cb + ch0 + 4); bs[0] = a.x; bs[1] = a.y; bs[2] = a.z; bs[3] = a.w; bs[4] = b.x; bs[5] = b.y; bs[6] = b.z; bs[7] = b.w; }
        float h3[8], h2[8], h1[8];
        const bool first = (row0 % SEQ) == 0;
        const bf16_t* src = PROJ + (size_t)row0 * PLD + PX + ch0;
        if (first) {
#pragma unroll
            for (int e = 0; e < 8; ++e) { h3[e] = 0.f; h2[e] = 0.f; h1[e] = 0.f; }
        } else {
            const u32x4 a = *(const u32x4*)(src - 3 * (size_t)PLD), b = *(const u32x4*)(src - 2 * (size_t)PLD), c = *(const u32x4*)(src - (size_t)PLD);
#pragma unroll
            for (int e = 0; e < 4; ++e) { h3[2 * e] = bflo(a[e]); h3[2 * e + 1] = bfhi(a[e]); h2[2 * e] = bflo(b[e]); h2[2 * e + 1] = bfhi(b[e]); h1[2 * e] = bflo(c[e]); h1[2 * e + 1] = bfhi(c[e]); }
        }
        u32x4 dr[16];
#pragma unroll
        for (int i = 0; i < 16; ++i) dr[i] = *(const u32x4*)(src + (size_t)i * PLD);
#pragma unroll
        for (int i = 0; i < 16; ++i) {
            const u32x4 d = dr[i]; float cur[8], o[8];
#pragma unroll
            for (int e = 0; e < 4; ++e) { cur[2 * e] = bflo(d[e]); cur[2 * e + 1] = bfhi(d[e]); }
#pragma unroll
            for (int e = 0; e < 8; ++e) { const float s = bs[e] + w[0][e] * h3[e] + w[1][e] * h2[e] + w[2][e] * h1[e] + w[3][e] * cur[e]; o[e] = siluf_(s); h3[e] = h2[e]; h2[e] = h1[e]; h1[e] = cur[e]; }
            u32x4 ow; ow.x = cvtpk(o[0], o[1]); ow.y = cvtpk(o[2], o[3]); ow.z = cvtpk(o[4], o[5]); ow.w = cvtpk(o[6], o[7]);
            *(u32x4*)(XACT + (size_t)(row0 + i) * 1024 + ch0) = ow;
        }
    }
}

__device__ __forceinline__ void mlstm_state_item(Frame& F, int bh) {
    const int b = bh >> 2, h = bh & 3, w = F.wave, vq = w & 3, dh = w >> 2, lane = F.lane, fr = lane & 15, fq = lane >> 4, tid = F.tid;
    constexpr int MP = 72, MBUF = 2 * 64 * MP * 2 + 128;
    LAS float* WG = (LAS float*)(F.lds + 2 * MBUF); LAS float* DEC = WG + 4096;
    const bf16_t* PROJ = (const bf16_t*)(F.ws + WS_PROJ); const float* GATES = (const float*)(F.ws + WS_GATES);
    bf16_t* CST = (bf16_t*)(F.ws + WS_CST); float* NST = (float*)(F.ws + WS_NST);
    const size_t rowb = (size_t)b * SEQ;
    {
        float igv[8], lfv[8];
#pragma unroll
        for (int i = 0; i < 8; ++i) { const float* gq = GATES + (rowb + 64 * (w + 8 * i) + lane) * 16 + h; igv[i] = gq[0]; lfv[i] = gq[4]; }
#pragma unroll
        for (int i = 0; i < 8; ++i) { const int c = w + 8 * i;
            const float bs = wave_scan_incl(lfv[i], lane); const float bl = __shfl(bs, 63);
            WG[64 * c + lane] = fast_exp(bl - bs + igv[i]); if (lane == 0) DEC[c] = fast_exp(bl); }
    }
    f32x4 acc[2], nacc[2];
    acc[0] = acc[1] = nacc[0] = nacc[1] = (f32x4){0.f, 0.f, 0.f, 0.f};
    const int ls = tid >> 3, lc = tid & 7;
    const bf16_t* kp = PROJ + (rowb + ls) * PLD + PK + h * 64 + 8 * lc; const bf16_t* vp = PROJ + (rowb + ls) * PLD + PV + h * 64 + 8 * lc;
    u32x4 k0, v0, k1, v1, k2, v2;
#define ML_LOAD(kr_, vr_, c_) do { const size_t o_ = (size_t)(c_) * 64 * PLD; kr_ = *(const u32x4*)(kp + o_); vr_ = *(const u32x4*)(vp + o_); } while (0)
#define ML_WRITE(kr_, vr_, c_) do { LAS bf16_t* KL_ = (LAS bf16_t*)(F.lds + ((c_) & 1) * MBUF); LAS bf16_t* VL_ = KL_ + 64 * MP; const float wg_ = WG[64 * (c_) + ls]; \
        *(LAS u32x4*)(KL_ + ls * MP + 8 * lc) = kr_; u32x4 o_; _Pragma("unroll") for (int e_ = 0; e_ < 4; ++e_) o_[e_] = cvtpk(wg_ * bflo(vr_[e_]), wg_ * bfhi(vr_[e_])); \
        *(LAS u32x4*)(VL_ + ls * MP + 8 * lc) = o_; if (lc == 0) (VL_ + 64 * MP)[ls] = f2bf(wg_); } while (0)
    LAS bf16_t* STG = (LAS bf16_t*)(F.lds + 2 * MBUF + 16384 + 256); LAS float* NSTG = (LAS float*)(STG + 2 * 4096);
#define ML_STAGE(c_) do { LAS bf16_t* sg_ = STG + ((c_) & 1) * 4096; \
        _Pragma("unroll") for (int dt = 0; dt < 2; ++dt) _Pragma("unroll") for (int r = 0; r < 4; ++r) sg_[(vq * 16 + 4 * fq + r) * 64 + dh * 32 + dt * 16 + fr] = f2bf(acc[dt][r]); \
        if (vq == 0 && fq == 0) { NSTG[((c_) & 1) * 64 + dh * 32 + fr] = nacc[0][0]; NSTG[((c_) & 1) * 64 + dh * 32 + 16 + fr] = nacc[1][0]; } } while (0)
    ML_LOAD(k0, v0, 0); ML_LOAD(k1, v1, 1); ML_LOAD(k2, v2, 2);
    __syncthreads();
    ML_WRITE(k0, v0, 0);
    ML_STAGE(0);
    LDS_BARRIER();
#define ML_STEP(KW, VW, KN, VN, c_) do { const int cc_ = (c_); const size_t ci = (size_t)bh * 64 + cc_; \
          \
        { const u32x4 st_ = *(const LAS u32x4*)(STG + ((cc_) & 1) * 4096 + tid * 8); *(u32x4*)(CST + ci * 4096 + tid * 8) = st_; \
          NST[ci * 64 + (tid & 63)] = NSTG[((cc_) & 1) * 64 + (tid & 63)]; }     \
        asm volatile("" ::: "memory"); \
        if (cc_ + 1 < 64) ML_WRITE(KW, VW, cc_ + 1); \
        asm volatile("" ::: "memory"); \
        ML_LOAD(KN, VN, (cc_ + 3 < 64 ? cc_ + 3 : 63)); \
        asm volatile("" ::: "memory"); \
        const float decay = DEC[cc_]; \
        const LAS bf16_t* KL = (const LAS bf16_t*)(F.lds + (cc_ & 1) * MBUF); const LAS bf16_t* VL = KL + 64 * MP; const LAS bf16_t* WV = VL + 64 * MP; \
        _Pragma("unroll") for (int dt = 0; dt < 2; ++dt) { acc[dt] = acc[dt] * decay; nacc[dt] = nacc[dt] * decay; } \
        _Pragma("unroll") for (int ks = 0; ks < 2; ++ks) { \
            const bf16x8 A = ld_tr8(VL, MP, 32 * ks, 16 * vq, lane); \
            bf16x8 An = ld_l8(WV + 32 * ks + 8 * fq); if (fr != 0) An = (bf16x8){0, 0, 0, 0, 0, 0, 0, 0}; \
            _Pragma("unroll") for (int dt = 0; dt < 2; ++dt) { const bf16x8 B = ld_tr8(KL, MP, 32 * ks, 32 * dh + 16 * dt, lane); \
                acc[dt] = MFMA16(A, B, acc[dt]); if (vq == 0) nacc[dt] = MFMA16(An, B, nacc[dt]); } } \
        ML_STAGE(cc_ + 1); \
        LDS_BARRIER(); } while (0)
    for (int c = 0; c < 63; c += 3) { ML_STEP(k1, v1, k0, v0, c); ML_STEP(k2, v2, k1, v1, c + 1); ML_STEP(k0, v0, k2, v2, c + 2); }
    ML_STEP(k1, v1, k0, v0, 63);
#undef ML_STEP
#undef ML_LOAD
#undef ML_WRITE
#undef ML_STAGE
}

template <int TH>
__device__ __forceinline__ void mlstm_out_wave(Frame& F, int l, int bc, int h) {
    const int b = bc >> 6, c = bc & 63, w = F.wave, lane = F.lane, fr = lane & 15, fq = lane >> 4;
    constexpr int VP = 72;
    LAS bf16_t* VL = (LAS bf16_t*)(F.lds + w * 12288); LAS float* BT_ = (LAS float*)(F.lds + w * 12288 + 9216); LAS float* GS = BT_ + 64;
    LAS bf16_t* YS = VL;
    const bf16_t* PROJ = (const bf16_t*)(F.ws + WS_PROJ); const float* GATES = (const float*)(F.ws + WS_GATES);
    const bf16_t* CST = (const bf16_t*)(F.ws + WS_CST); const float* NST = (const float*)(F.ws + WS_NST);
    bf16_t* Y = (bf16_t*)(F.ws + WS_PROJ) + PX;
    const size_t row0 = (size_t)b * SEQ + 64 * c; const size_t ci = (size_t)(b * 4 + h) * 64 + c;
    constexpr int NST_ = 2 * TH + 2, NKK = TH + 1;
    {
        const size_t row = row0 + lane;
        const float ig = GATES[row * 16 + h], lf = GATES[row * 16 + 4 + h];
        const bf16_t* vp = PROJ + row * PLD + PV + h * 64;
        u32x4 vr[8];
#pragma unroll
        for (int i = 0; i < 8; ++i) vr[i] = *(const u32x4*)(vp + 8 * i);
        const float bs = wave_scan_incl(lf, lane);
        BT_[lane] = bs; GS[lane] = ig - bs;
#pragma unroll
        for (int i = 0; i < 8; ++i) *(LAS u32x4*)(VL + lane * VP + 8 * i) = vr[i];
    }
    bf16x8 Qf[2][2], Kf[NST_][2];
#pragma unroll
    for (int tt = 0; tt < 2; ++tt)
#pragma unroll
        for (int ks = 0; ks < 2; ++ks) Qf[tt][ks] = ld_g8(PROJ + (row0 + 32 * TH + 16 * tt + fr) * PLD + PQ + h * 64 + 32 * ks + 8 * fq);
#pragma unroll
    for (int st = 0; st < NST_; ++st)
#pragma unroll
        for (int ks = 0; ks < 2; ++ks) Kf[st][ks] = ld_g8(PROJ + (row0 + 16 * st + fr) * PLD + PK + h * 64 + 32 * ks + 8 * fq);
    bf16x8 Cf[4][2];
#pragma unroll
    for (int vt = 0; vt < 4; ++vt)
#pragma unroll
        for (int ks = 0; ks < 2; ++ks) Cf[vt][ks] = ld_g8(CST + ci * 4096 + (16 * vt + fr) * 64 + 32 * ks + 8 * fq);
    u32x4 ogv[4];
#pragma unroll
    for (int i = 0; i < 4; ++i) ogv[i] = *(const u32x4*)(PROJ + (row0 + 32 * TH + (lane >> 3) + 8 * i) * PLD + PO + h * 64 + 8 * (lane & 7));
    f32x4 nv[2][2];
#pragma unroll
    for (int ks = 0; ks < 2; ++ks) { nv[ks][0] = *(const f32x4*)(NST + ci * 64 + 32 * ks + 8 * fq); nv[ks][1] = *(const f32x4*)(NST + ci * 64 + 32 * ks + 8 * fq + 4); }
    WAVE_SYNC();
    f32x4 P[2][NST_]; float den[2];
#pragma unroll
    for (int tt = 0; tt < 2; ++tt) {
        const int t = 32 * TH + 16 * tt + fr; const float bt = BT_[t]; float d1 = 0.f;
#pragma unroll
        for (int st = 0; st < NST_; ++st) {
            f32x4 s = (f32x4){0.f, 0.f, 0.f, 0.f};
#pragma unroll
            for (int ks = 0; ks < 2; ++ks) s = MFMA16(Kf[st][ks], Qf[tt][ks], s);
#pragma unroll
            for (int r = 0; r < 4; ++r) { const int sidx = 16 * st + 4 * fq + r; const float wv = (sidx <= t) ? s[r] * fast_exp(bt + GS[sidx]) : 0.f; s[r] = wv; d1 += wv; }
            P[tt][st] = s;
        }
        d1 += __shfl_xor(d1, 16); d1 += __shfl_xor(d1, 32);
        float d2 = 0.f;
#pragma unroll
        for (int ks = 0; ks < 2; ++ks) { const f32x4 n0 = nv[ks][0], n1 = nv[ks][1];
            const u32x4 qw = __builtin_bit_cast(u32x4, Qf[tt][ks]);
            d2 += bflo(qw.x) * n0.x + bfhi(qw.x) * n0.y + bflo(qw.y) * n0.z + bfhi(qw.y) * n0.w + bflo(qw.z) * n1.x + bfhi(qw.z) * n1.y + bflo(qw.w) * n1.z + bfhi(qw.w) * n1.w; }
        d2 += __shfl_xor(d2, 16); d2 += __shfl_xor(d2, 32);
        den[tt] = d1 + fast_exp(bt) * d2;
    }
    const float* nw = F.in[8] + (size_t)l * 256 + h * 64;
    f32x4 acc[2][4];
#pragma unroll
    for (int tt = 0; tt < 2; ++tt) {
#pragma unroll
        for (int vt = 0; vt < 4; ++vt) { acc[tt][vt] = (f32x4){0.f, 0.f, 0.f, 0.f};
#pragma unroll
            for (int ks = 0; ks < 2; ++ks) acc[tt][vt] = MFMA16(Qf[tt][ks], Cf[vt][ks], acc[tt][vt]); }
        float eb[4], dr[4];
#pragma unroll
        for (int r = 0; r < 4; ++r) { eb[r] = fast_exp(BT_[32 * TH + 16 * tt + 4 * fq + r]); dr[r] = __shfl(den[tt], 4 * fq + r); }
#pragma unroll
        for (int vt = 0; vt < 4; ++vt)
#pragma unroll
            for (int r = 0; r < 4; ++r) acc[tt][vt][r] *= eb[r];
#pragma unroll
        for (int kk = 0; kk < NKK; ++kk) { const bf16x8 PA = pack8(P[tt][2 * kk], P[tt][2 * kk + 1]);
            bf16x8 Bv[4];
#pragma unroll
            for (int vt = 0; vt < 4; ++vt) Bv[vt] = ld_tr8p(VL, VP, 32 * kk, 16 * vt, lane);
#pragma unroll
            for (int vt = 0; vt < 4; ++vt) acc[tt][vt] = MFMA16(PA, Bv[vt], acc[tt][vt]); }
#pragma unroll
        for (int r = 0; r < 4; ++r) { const float inv = fast_rcp(fmaxf(fabsf(dr[r]), 1.0f)); float s = 0.f;
#pragma unroll
            for (int vt = 0; vt < 4; ++vt) { acc[tt][vt][r] *= inv; s += acc[tt][vt][r] * acc[tt][vt][r]; }
            s += __shfl_xor(s, 1); s += __shfl_xor(s, 2); s += __shfl_xor(s, 4); s += __shfl_xor(s, 8); const float rs = rsqrtf(s * (1.0f / 64.0f) + NORM_EPS);
#pragma unroll
            for (int vt = 0; vt < 4; ++vt) acc[tt][vt][r] *= rs * nw[16 * vt + fr]; }
    }
    WAVE_SYNC();
#pragma unroll
    for (int tt = 0; tt < 2; ++tt)
#pragma unroll
        for (int vt = 0; vt < 4; ++vt)
#pragma unroll
            for (int r = 0; r < 4; ++r) YS[(16 * tt + 4 * fq + r) * VP + 16 * vt + fr] = f2bf(acc[tt][vt][r]);
    WAVE_SYNC();
#pragma unroll
    for (int i = 0; i < 4; ++i) { const int tr_ = (lane >> 3) + 8 * i, ch = lane & 7; const size_t row = row0 + 32 * TH + tr_;
        const u32x4 yv = *(const LAS u32x4*)(YS + tr_ * VP + 8 * ch); const u32x4 gv = ogv[i]; u32x4 o;
#pragma unroll
        for (int e = 0; e < 4; ++e) o[e] = cvtpk(bflo(yv[e]) * bflo(gv[e]), bfhi(yv[e]) * bfhi(gv[e]));
        *(u32x4*)(Y + row * PLD + h * 64 + 8 * ch) = o; }
    WAVE_SYNC();
}
__device__ __forceinline__ void mlstm_out_item(Frame& F, int l, int bc) {
    const int h = F.wave >> 1;
    if (F.wave & 1) mlstm_out_wave<1>(F, l, bc, h); else mlstm_out_wave<0>(F, l, bc, h);
}
typedef float f32x16 __attribute__((ext_vector_type(16)));
#define MFMA32(a, b, c) __builtin_amdgcn_mfma_f32_32x32x16_bf16((a), (b), (c), 0, 0, 0)
constexpr int AK_STR = 72, AV_STR = 96;
constexpr int ATT_KB = 128 * AK_STR * 2, ATT_VB = 128 * AV_STR * 2, ATT_BUF = ATT_KB + ATT_VB;
constexpr int ATT_TAB_OFF = 2 * ATT_BUF;
__device__ __forceinline__ int t5_bucket(int n) {
    if (n < 16) return n;
    int bk = 16;
    bk += (n >= 19); bk += (n >= 21); bk += (n >= 24); bk += (n >= 27); bk += (n >= 31); bk += (n >= 35); bk += (n >= 40); bk += (n >= 46);
    bk += (n >= 52); bk += (n >= 59); bk += (n >= 67); bk += (n >= 77); bk += (n >= 87); bk += (n >= 99); bk += (n >= 113);
    return bk;
}
__device__ __forceinline__ int crow16(int reg, int hi) { return (reg & 3) + 8 * (reg >> 2) + 4 * hi; }
__device__ __forceinline__ bf16x8 pack8r(const f32x16& p, const int s) { u32x4 w; w.x = cvtpk(p[8 * s], p[8 * s + 1]); w.y = cvtpk(p[8 * s + 2], p[8 * s + 3]); w.z = cvtpk(p[8 * s + 4], p[8 * s + 5]); w.w = cvtpk(p[8 * s + 6], p[8 * s + 7]); return __builtin_bit_cast(bf16x8, w); }
__device__ __forceinline__ void epilogue_attn(Frame& F, int l, int bh, int qi, f32x16 (&O1)[2], f32x16 (&O2)[2], float l1, float l2);
__device__ __forceinline__ void attn_item(Frame& F, int l, int bh, int qi, const bool prefetch_next) {
    const int b = bh >> 2, h = bh & 3, w = F.wave, lane = F.lane, tid = F.tid, r32 = lane & 31, hi = lane >> 5, qq = w & 3, kh = w >> 2;
#ifdef PROBE_A
    const unsigned long long tp0_ = __builtin_amdgcn_s_memrealtime();
#endif
    const bf16_t* PROJ = (const bf16_t*)(F.ws + WS_PROJ); bf16_t* Y = (bf16_t*)(F.ws + WS_PROJ) + PX;
    LAS float* TAB = (LAS float*)(F.lds + ATT_TAB_OFF);
    LAS bf16_t* QL = (LAS bf16_t*)(F.lds + ATT_TAB_OFF + 2048);
    const size_t row0 = (size_t)b * SEQ; const int q0 = qi * 128;
    unsigned nxq_ = 0u; if (prefetch_next && qi < 2 && tid == 0) nxq_ = xb_add(F.ctl + CW_Q + 64 * (2 * l), 1u);
    if (tid < 384) { const int rel = tid - 128; const float cf = F.in[19][31 * 4 + h]; TAB[tid] = rel < 0 ? -1e30f : (F.in[19][t5_bucket(rel) * 4 + h] - cf) * LOG2E; }
    const int npairs = qi + 1;
    const int lk = tid >> 3, lc = tid & 7;
    const bf16_t* kg = PROJ + (row0 + lk) * PLD + PDK + h * 64 + 8 * lc; const bf16_t* vg = PROJ + (row0 + lk) * PLD + PDV + h * 64 + 8 * lc;
    u32x4 ka0, ka1, va0, va1;
#define ATT_WRITE(k0_, k1_, v0_, v1_, buf) do { LAS bf16_t* KL_ = (LAS bf16_t*)(F.lds + (buf) * ATT_BUF); LAS bf16_t* VL_ = (LAS bf16_t*)(F.lds + (buf) * ATT_BUF + ATT_KB); \
        *(LAS u32x4*)(KL_ + lk * AK_STR + 8 * lc) = k0_; *(LAS u32x4*)(KL_ + (lk + 64) * AK_STR + 8 * lc) = k1_; \
        *(LAS u32x4*)(VL_ + lk * AV_STR + 8 * lc) = v0_; *(LAS u32x4*)(VL_ + (lk + 64) * AV_STR + 8 * lc) = v1_; } while (0)
#define ATT_LOAD(k0_, k1_, v0_, v1_, p) do { const size_t o_ = (size_t)(p) * 128 * PLD; k0_ = *(const u32x4*)(kg + o_); k1_ = *(const u32x4*)(kg + o_ + (size_t)64 * PLD); v0_ = *(const u32x4*)(vg + o_); v1_ = *(const u32x4*)(vg + o_ + (size_t)64 * PLD); } while (0)
    ATT_LOAD(ka0, ka1, va0, va1, 0);
    {
        const bf16_t* qg = PROJ + (row0 + q0 + lk) * PLD + PDQ + h * 64 + 8 * lc;
        const u32x4 q0r = *(const u32x4*)qg, q1r = *(const u32x4*)(qg + (size_t)64 * PLD);
        *(LAS u32x4*)(QL + lk * AK_STR + 8 * lc) = q0r; *(LAS u32x4*)(QL + (lk + 64) * AK_STR + 8 * lc) = q1r; }
    ATT_WRITE(ka0, ka1, va0, va1, 0);
    if (npairs > 1) ATT_LOAD(ka0, ka1, va0, va1, 1);
    const int qrow = q0 + 32 * qq + r32;
    f32x16 O1[2], O2[2];
#pragma unroll
    for (int i = 0; i < 16; ++i) { O1[0][i] = 0.f; O1[1][i] = 0.f; O2[0][i] = 0.f; O2[1][i] = 0.f; }
    f32x4 L1 = {0.f, 0.f, 0.f, 0.f}, L2 = {0.f, 0.f, 0.f, 0.f};
    __syncthreads();
    const f32x16 cinit = {0.f, 0.f, 0.f, 0.f, 0.f, 0.f, 0.f, 0.f, 0.f, 0.f, 0.f, 0.f, 0.f, 0.f, 0.f, 0.f};
    const int vlane = (4 * hi + ((lane & 15) >> 2)) * AV_STR + 16 * ((lane >> 4) & 1) + 4 * (lane & 3);
    const LAS bf16_t* qlp = QL + (32 * qq + r32) * AK_STR + 8 * hi;
#ifdef PROBE_SECTIONS
    unsigned long long dA_ = 0, dB_ = 0, dC_ = 0;
#define ATT_T(x_) const unsigned long long x_ = __builtin_amdgcn_s_memtime()
#define ATT_TW(x_) asm volatile("s_waitcnt lgkmcnt(0)" ::: "memory"); const unsigned long long x_ = __builtin_amdgcn_s_memtime()
#define ATT_TACC() do { dA_ += tb_ - ta_; dB_ += tc_ - tb_; dC_ += td_ - tc_; } while (0)
#else
#define ATT_T(x_) do {} while (0)
#define ATT_TW(x_) do {} while (0)
#define ATT_TACC() do {} while (0)
#endif
#define ATT_EXP(S1_, S2_, sub_, NEAR_) do { \
        _Pragma("unroll") for (int r = 0; r < 16; ++r) { S1_[r] = __builtin_amdgcn_exp2f(S1_[r]); S2_[r] = __builtin_amdgcn_exp2f(S2_[r]); } \
        _Pragma("unroll") for (int r = 0; r < 16; r += 4) { L1 += (f32x4){S1_[r], S1_[r + 1], S1_[r + 2], S1_[r + 3]}; L2 += (f32x4){S2_[r], S2_[r + 1], S2_[r + 2], S2_[r + 3]}; } } while (0)
#define ATT_VLOAD(Vf_, sub_) do { _Pragma("unroll") for (int s = 0; s < 2; ++s) _Pragma("unroll") for (int vt = 0; vt < 2; ++vt) { const LAS bf16_t* vp = VL + (32 * (sub_) + 16 * s) * AV_STR + 32 * vt + vlane; \
            const v4i16_t lo = __builtin_amdgcn_ds_read_tr16_b64_v4i16((LAS v4i16_t*)vp), hi4 = __builtin_amdgcn_ds_read_tr16_b64_v4i16((LAS v4i16_t*)(vp + 8 * AV_STR)); \
            Vf_[s][vt] = (bf16x8){lo[0], lo[1], lo[2], lo[3], hi4[0], hi4[1], hi4[2], hi4[3]}; } } while (0)
#define ATT_PV(S1_, S2_, Vf_) do { _Pragma("unroll") for (int s = 0; s < 2; ++s) { const bf16x8 PA1 = pack8r(S1_, s), PA2 = pack8r(S2_, s); \
            _Pragma("unroll") for (int vt = 0; vt < 2; ++vt) { O1[vt] = MFMA32(PA1, Vf_[s][vt], O1[vt]); O2[vt] = MFMA32(PA2, Vf_[s][vt], O2[vt]); } } } while (0)
#define ATT_ITER(k0_, k1_, v0_, v1_, p_, NEAR_) do { const int p = (p_); ATT_T(ta_); \
        if (kh == 0 && p + 1 < npairs) { ATT_WRITE(k0_, k1_, v0_, v1_, (p + 1) & 1); }     \
        if (!(NEAR_) && prefetch_next && p + 2 == qi && tid == 0) nxq_ = xb_add(F.ctl + CW_Q + 64 * (2 * l), 1u);     \
        if (kh == 0 && p + 2 < npairs) { ATT_LOAD(k0_, k1_, v0_, v1_, p + 2); } \
        ATT_TW(tb_); \
        const int k0 = 128 * p + 64 * kh; \
        if (!(NEAR_) || k0 <= q0 + 32 * qq + 31) { \
            const LAS bf16_t* KL = (const LAS bf16_t*)(F.lds + (p & 1) * ATT_BUF) + 64 * kh * AK_STR; const LAS bf16_t* VL = (const LAS bf16_t*)(F.lds + (p & 1) * ATT_BUF + ATT_KB) + 64 * kh * AV_STR; \
            f32x16 SA1, SA2, SB1, SB2, CA = cinit, CB = cinit; \
            if (NEAR_) { const LAS float* tb_ = TAB + (qrow - 4 * hi - k0 + 101);     \
                _Pragma("unroll") for (int r = 0; r < 16; ++r) { CA[r] = tb_[27 - ((r & 3) + 8 * (r >> 2))]; CB[r] = tb_[27 - 32 - ((r & 3) + 8 * (r >> 2))]; } } \
            {   const bf16x8 Q00 = ld_l8(qlp), Q01 = ld_l8(qlp + 16), Q10 = ld_l8(qlp + 32), Q11 = ld_l8(qlp + 48); \
                const LAS bf16_t* kp = KL + r32 * AK_STR + 8 * hi; \
                const bf16x8 a10 = ld_l8(kp), a11 = ld_l8(kp + 16), a20 = ld_l8(kp + 32), a21 = ld_l8(kp + 48); \
                const bf16x8 b10 = ld_l8(kp + 32 * AK_STR), b11 = ld_l8(kp + 32 * AK_STR + 16), b20 = ld_l8(kp + 32 * AK_STR + 32), b21 = ld_l8(kp + 32 * AK_STR + 48); \
                SA1 = MFMA32(a10, Q00, CA); SA2 = MFMA32(a20, Q10, CA); SA1 = MFMA32(a11, Q01, SA1); SA2 = MFMA32(a21, Q11, SA2); \
                SB1 = MFMA32(b10, Q00, CB); SB2 = MFMA32(b20, Q10, CB); SB1 = MFMA32(b11, Q01, SB1); SB2 = MFMA32(b21, Q11, SB2); } \
            bf16x8 Vf[2][2], Vg[2][2]; \
            ATT_VLOAD(Vf, 0); ATT_VLOAD(Vg, 1); \
            ATT_EXP(SA1, SA2, 0, NEAR_); \
            ATT_PV(SA1, SA2, Vf); \
            ATT_EXP(SB1, SB2, 1, NEAR_); \
            ATT_PV(SB1, SB2, Vg); \
            {   \
                __builtin_amdgcn_sched_group_barrier(0x8, 4, 0); \
                _Pragma("unroll") for (int g_ = 0; g_ < 4; ++g_) { __builtin_amdgcn_sched_group_barrier(0x8, 1, 0); __builtin_amdgcn_sched_group_barrier(0x400, 8, 0); } \
                __builtin_amdgcn_sched_group_barrier(0x2, 24, 0); \
                _Pragma("unroll") for (int g_ = 0; g_ < 8; ++g_) { __builtin_amdgcn_sched_group_barrier(0x8, 1, 0); __builtin_amdgcn_sched_group_barrier(0x400, 4, 0); __builtin_amdgcn_sched_group_barrier(0x2, 2, 0); } } \
        } \
        ATT_T(tc_); \
        if (kh == 1 && p + 1 < npairs) { ATT_WRITE(k0_, k1_, v0_, v1_, (p + 1) & 1); } \
        if (kh == 1 && p + 2 < npairs) { ATT_LOAD(k0_, k1_, v0_, v1_, p + 2); } \
        LDS_BARRIER(); ATT_T(td_); ATT_TACC(); } while (0)
#ifdef PROBE_A
    if (lane == 0) atomicMax(F.ctl + 32768 + 64 * (11 + 16 * l), (unsigned)(__builtin_amdgcn_s_memrealtime() - tp0_));
#endif
    int pp = 0;
    for (; pp + 1 < qi; ++pp) ATT_ITER(ka0, ka1, va0, va1, pp, 0);
    for (; pp < npairs; ++pp) ATT_ITER(ka0, ka1, va0, va1, pp, 1);
    if (prefetch_next && tid == 0) F.MISC[17] = nxq_;
#undef ATT_EXP
#undef ATT_VLOAD
#undef ATT_PV
#undef ATT_ITER
#ifdef PROBE_SECTIONS
    if (qi == 31 && lane == 0) { atomicMax(F.ctl + 32768 + 64 * (8 + 16 * l), (unsigned)(dA_ / 32) * 10u); atomicMax(F.ctl + 32768 + 64 * (9 + 16 * l), (unsigned)(dB_ / 32) * 10u); atomicMax(F.ctl + 32768 + 64 * (10 + 16 * l), (unsigned)(dC_ / 32) * 10u); }
#endif
#undef ATT_WRITE
#undef ATT_LOAD
    float l1 = (L1.x + L1.y) + (L1.z + L1.w), l2 = (L2.x + L2.y) + (L2.z + L2.w);
    epilogue_attn(F, l, bh, qi, O1, O2, l1, l2);
}
__device__ __forceinline__ void epilogue_attn(Frame& F, int l, int bh, int qi, f32x16 (&O1)[2], f32x16 (&O2)[2], float l1, float l2) {
    int t3 = threadIdx.x; asm volatile("" : "+v"(t3));
    const int lane = t3 & 63, w = __builtin_amdgcn_readfirstlane(t3 >> 6), r32 = lane & 31, hi = lane >> 5, qq = w & 3, kh = w >> 2, b = bh >> 2, h = bh & 3;
    bf16_t* Y = (bf16_t*)(F.ws + WS_PROJ) + PX;
    const size_t row0 = (size_t)b * SEQ; const int q0 = qi * 128;
    LAS float* XCH = (LAS float*)F.lds + (size_t)qq * 66 * 64 + lane;
    if (kh == 1) {
#pragma unroll
        for (int vt = 0; vt < 2; ++vt)
#pragma unroll
            for (int r = 0; r < 16; ++r) { XCH[(vt * 16 + r) * 64] = O1[vt][r]; XCH[(32 + vt * 16 + r) * 64] = O2[vt][r]; }
        XCH[64 * 64] = l1; XCH[65 * 64] = l2;
    }
    __syncthreads();
    if (kh == 0) {
        const float* lm = F.in[17] + (size_t)l * 128;
        float d1 = (lane < 32) ? lm[lane] * lm[32 + lane] : 0.f, d2 = (lane < 32) ? lm[64 + lane] * lm[96 + lane] : 0.f;
        d1 = wave_sum(d1); d2 = wave_sum(d2);
        int lq = l; asm volatile("" : "+s"(lq));
        const float lam_init = (lq == 0) ? 0.2f : 0.35550906759f;
        const float lam = __int_as_float(__builtin_amdgcn_readfirstlane(__float_as_int(fast_exp(d1) - fast_exp(d2) + lam_init)));
#pragma unroll
        for (int vt = 0; vt < 2; ++vt)
#pragma unroll
            for (int r = 0; r < 16; ++r) { O1[vt][r] += XCH[(vt * 16 + r) * 64]; O2[vt][r] += XCH[(32 + vt * 16 + r) * 64]; }
        l1 += XCH[64 * 64]; l2 += XCH[65 * 64];
        l1 += __shfl_xor(l1, 32); l2 += __shfl_xor(l2, 32);
        const float i1 = fast_rcp(l1), i2 = lam * fast_rcp(l2);
        const float* sw = F.in[18] + (size_t)l * 64; const float osc = 1.0f - lam_init;
        const float sw0 = sw[r32], sw1 = sw[32 + r32];
#pragma unroll
        for (int r = 0; r < 16; ++r) {
            const int qr = crow16(r, hi);
            const float a1 = __shfl(i1, qr), a2 = __shfl(i2, qr);
            const float o0 = O1[0][r] * a1 - O2[0][r] * a2, o1 = O1[1][r] * a1 - O2[1][r] * a2;
            float s = o0 * o0 + o1 * o1;
            s += __shfl_xor(s, 1); s += __shfl_xor(s, 2); s += __shfl_xor(s, 4); s += __shfl_xor(s, 8); s += __shfl_xor(s, 16);
            const float rs = rsqrtf(s * (1.0f / 64.0f) + NORM_EPS) * osc;
            const size_t row = row0 + q0 + 32 * qq + qr;
            Y[row * PLD + 768 + h * 64 + r32] = f2bf(o0 * rs * sw0); Y[row * PLD + 768 + h * 64 + 32 + r32] = f2bf(o1 * rs * sw1);
        }
    }
}

constexpr int SSD_STR = 136;
constexpr int SX_P = 72, SB_P = 136, SS_BUF = 128 * SX_P * 2 + 128 * SB_P * 2;
__device__ __forceinline__ void ssd_state_item(Frame& F, int l, int bhh) {
    const int b = bhh >> 3, hh = bhh & 7, g = hh >> 2, w = F.wave, lane = F.lane, fr = lane & 15, fq = lane >> 4, tid = F.tid;
    LAS float* XS = (LAS float*)(F.lds + 2 * SS_BUF); LAS float* CD = XS + 4096;
    const bf16_t* XACT = (const bf16_t*)F.in[25]; const float* GATES = (const float*)(F.ws + WS_GATES); bf16_t* SST = (bf16_t*)(F.ws + WS_SST);
    const float Ah = -expf(F.in[12][l * 8 + hh]);
    {   float d0v[4], d1v[4];
#pragma unroll
        for (int i = 0; i < 4; ++i) { const size_t r0 = (size_t)b * SEQ + 128 * (w + 8 * i); d0v[i] = GATES[(r0 + lane) * 16 + 8 + hh]; d1v[i] = GATES[(r0 + 64 + lane) * 16 + 8 + hh]; }
#pragma unroll
        for (int i = 0; i < 4; ++i) { const int c = w + 8 * i; const float dt0 = d0v[i], dt1 = d1v[i];
            const float s0 = wave_scan_incl(dt0 * Ah, lane); const float t0 = __shfl(s0, 63);
            const float s1 = wave_scan_incl(dt1 * Ah, lane) + t0; const float last = __shfl(s1, 63);
            XS[128 * c + lane] = dt0 * fast_exp(last - s0); XS[128 * c + 64 + lane] = dt1 * fast_exp(last - s1);
            if (lane == 0) CD[c] = fast_exp(last); }
    }
    const int pt = w & 3, nh = w >> 2;
    f32x4 acc[4];
#pragma unroll
    for (int j = 0; j < 4; ++j) acc[j] = (f32x4){0.f, 0.f, 0.f, 0.f};
    const bf16_t* xg = XACT + ((size_t)b * SEQ + (tid >> 3)) * 1024 + hh * 64 + 8 * (tid & 7);
    const bf16_t* bg = XACT + ((size_t)b * SEQ + (tid >> 4)) * 1024 + 512 + g * 128 + 8 * (tid & 15);
    u32x4 xa[2], ba[4], xb[2], bb[4], xc[2], bc[4];
#define SS_LOAD(xr, br, c_) do { const size_t o_ = (size_t)(c_) * 128 * 1024; xr[0] = *(const u32x4*)(xg + o_); xr[1] = *(const u32x4*)(xg + o_ + 64 * 1024); \
        _Pragma("unroll") for (int i_ = 0; i_ < 4; ++i_) br[i_] = *(const u32x4*)(bg + o_ + (size_t)i_ * 32 * 1024); } while (0)
#define SS_WRITE(xr, br, c_) do { LAS bf16_t* XL_ = (LAS bf16_t*)(F.lds + ((c_) & 1) * SS_BUF); LAS bf16_t* BL_ = XL_ + 128 * SX_P; \
        _Pragma("unroll") for (int i_ = 0; i_ < 2; ++i_) { const int s_ = (tid >> 3) + 64 * i_; const float sc_ = XS[128 * (c_) + s_]; u32x4 o_; \
            _Pragma("unroll") for (int e_ = 0; e_ < 4; ++e_) o_[e_] = cvtpk(sc_ * bflo(xr[i_][e_]), sc_ * bfhi(xr[i_][e_])); \
            *(LAS u32x4*)(XL_ + s_ * SX_P + 8 * (tid & 7)) = o_; } \
        _Pragma("unroll") for (int i_ = 0; i_ < 4; ++i_) *(LAS u32x4*)(BL_ + ((tid >> 4) + 32 * i_) * SB_P + 8 * (tid & 15)) = br[i_]; } while (0)
    LAS bf16_t* SSTG = (LAS bf16_t*)(F.lds + 2 * SS_BUF + 16384 + 128);
#define SS_STAGE(c_) do { LAS bf16_t* sg_ = SSTG + ((c_) & 1) * 8192; \
        _Pragma("unroll") for (int j = 0; j < 4; ++j) _Pragma("unroll") for (int r = 0; r < 4; ++r) sg_[(16 * pt + 4 * fq + r) * 128 + 16 * (4 * nh + j) + fr] = f2bf(acc[j][r]); } while (0)
    SS_LOAD(xa, ba, 0); SS_LOAD(xb, bb, 1); SS_LOAD(xc, bc, 2);
    __syncthreads();
    SS_WRITE(xa, ba, 0);
    SS_LOAD(xa, ba, 3);
    LDS_BARRIER();
#define SS_STEP(XW, BW, c_) do { const int cc_ = (c_); const size_t si = ((size_t)(b * 32 + cc_) * 8 + hh) * 8192; \
        _Pragma("unroll") for (int j = 0; j < 4; ++j) _Pragma("unroll") for (int r = 0; r < 4; ++r) SST[si + (16 * pt + 4 * fq + r) * 128 + 16 * (4 * nh + j) + fr] = f2bf(acc[j][r]); \
        asm volatile("" ::: "memory"); \
        if (cc_ + 1 < 32) { SS_WRITE(XW, BW, cc_ + 1); } \
        asm volatile("" ::: "memory"); \
        SS_LOAD(XW, BW, (cc_ + 4 < 32 ? cc_ + 4 : 31)); \
        asm volatile("" ::: "memory"); \
        const float cd = CD[cc_]; \
        _Pragma("unroll") for (int j = 0; j < 4; ++j) acc[j] = acc[j] * cd; \
        const LAS bf16_t* XL = (const LAS bf16_t*)(F.lds + (cc_ & 1) * SS_BUF); const LAS bf16_t* BL = XL + 128 * SX_P; \
        bf16x8 Af[4], Bf[4][4]; \
        _Pragma("unroll") for (int ks = 0; ks < 4; ++ks) { Af[ks] = ld_tr8(XL, SX_P, 32 * ks, 16 * pt, lane); \
            _Pragma("unroll") for (int j = 0; j < 4; ++j) Bf[ks][j] = ld_tr8(BL, SB_P, 32 * ks, 16 * (4 * nh + j), lane); } \
        asm volatile("s_waitcnt lgkmcnt(0)" ::: "memory"); __builtin_amdgcn_sched_barrier(0); \
        _Pragma("unroll") for (int ks = 0; ks < 4; ++ks) _Pragma("unroll") for (int j = 0; j < 4; ++j) acc[j] = MFMA16(Af[ks], Bf[ks][j], acc[j]); \
        LDS_BARRIER(); } while (0)
    for (int c = 0; c < 30; c += 3) { SS_STEP(xb, bb, c); SS_STEP(xc, bc, c + 1); SS_STEP(xa, ba, c + 2); }
    SS_STEP(xb, bb, 30); SS_STEP(xc, bc, 31);
#undef SS_STEP
#undef SS_STAGE
#undef SS_LOAD
#undef SS_WRITE
}

constexpr int SO_BP = 136, SO_XP = 72, SO_SP = 136, SO_YP = 264;
constexpr int SO_B_BYTES = 128 * SO_BP * 2, SO_H_BYTES = 128 * SO_XP * 2 + 64 * SO_SP * 2, SO_ACS_OFF = SO_B_BYTES + 2 * SO_H_BYTES;
__device__ __forceinline__ void ssd_out_item(Frame& F, int l, int it) {
    const int g = it & 1, c = (it >> 1) & 31, b = it >> 6, w = F.wave, lane = F.lane, fr = lane & 15, fq = lane >> 4, tid = F.tid;
    LAS bf16_t* BL = (LAS bf16_t*)F.lds;
    LAS float* ACS = (LAS float*)(F.lds + SO_ACS_OFF); LAS float* DTS = ACS + 512; LAS float* ETAB = DTS + 512; LAS float* REFS = ETAB + 512;
    const bf16_t* XACT = (const bf16_t*)F.in[25]; const float* GATES = (const float*)(F.ws + WS_GATES); const bf16_t* SST = (const bf16_t*)(F.ws + WS_SST);
    const bf16_t* PROJ = (const bf16_t*)(F.ws + WS_PROJ); bf16_t* Y = (bf16_t*)(F.ws + WS_PROJ) + PX;
    const size_t r0 = (size_t)b * SEQ + 128 * c;
    const float gdt0 = GATES[(r0 + lane) * 16 + 8 + g * 4 + (w & 3)], gdt1 = GATES[(r0 + 64 + lane) * 16 + 8 + g * 4 + (w & 3)];
    const bf16_t* bgp = XACT + (r0 + (tid >> 4)) * 1024 + 512 + g * 128 + 8 * (tid & 15);
    const bf16_t* xgp = XACT + (r0 + (tid >> 3)) * 1024 + g * 256 + 8 * (tid & 7);
    const bf16_t* sgp = SST + ((size_t)(b * 32 + c) * 8 + g * 4) * 8192 + (tid >> 4) * 128 + 8 * (tid & 15);
    u32x4 xr[2], sr[2];
#define SO_LOADH(hd_) do { xr[0] = *(const u32x4*)(xgp + (hd_) * 64); xr[1] = *(const u32x4*)(xgp + (hd_) * 64 + 64 * 1024); \
        sr[0] = *(const u32x4*)(sgp + (size_t)(hd_) * 8192); sr[1] = *(const u32x4*)(sgp + (size_t)(hd_) * 8192 + 32 * 128); } while (0)
#define SO_WRITEH(hd_) do { LAS bf16_t* XL_ = (LAS bf16_t*)(F.lds + SO_B_BYTES + ((hd_) & 1) * SO_H_BYTES); LAS bf16_t* SL_ = XL_ + 128 * SO_XP; \
        *(LAS u32x4*)(XL_ + (tid >> 3) * SO_XP + 8 * (tid & 7)) = xr[0]; *(LAS u32x4*)(XL_ + ((tid >> 3) + 64) * SO_XP + 8 * (tid & 7)) = xr[1]; \
        *(LAS u32x4*)(SL_ + (tid >> 4) * SO_SP + 8 * (tid & 15)) = sr[0]; *(LAS u32x4*)(SL_ + ((tid >> 4) + 32) * SO_SP + 8 * (tid & 15)) = sr[1]; } while (0)
    {   u32x4 br[4];
#pragma unroll
        for (int i = 0; i < 4; ++i) br[i] = *(const u32x4*)(bgp + (size_t)i * 32 * 1024);
        SO_LOADH(0);
#pragma unroll
        for (int i = 0; i < 4; ++i) *(LAS u32x4*)(BL + ((tid >> 4) + 32 * i) * SO_BP + 8 * (tid & 15)) = br[i];
        SO_WRITEH(0);
    }
    if (w < 4) {
        const int hh = g * 4 + w; const float Ah = -expf(F.in[12][l * 8 + hh]);
        const float dt0 = gdt0, dt1 = gdt1;
        const float s0 = wave_scan_incl(dt0 * Ah, lane); const float t0 = __shfl(s0, 63);
        const float s1 = wave_scan_incl(dt1 * Ah, lane) + t0;
        ACS[128 * w + lane] = s0; ACS[128 * w + 64 + lane] = s1; DTS[128 * w + lane] = dt0; DTS[128 * w + 64 + lane] = dt1;
        const float e0 = __shfl(s0, 31), e2 = __shfl(s1, 31), e3 = __shfl(s1, 63);
        ETAB[128 * w + lane] = fast_exp((lane < 32 ? e0 : t0) - s0) * dt0; ETAB[128 * w + 64 + lane] = fast_exp((lane < 32 ? e2 : e3) - s1) * dt1;
        if (lane == 0) { REFS[4 * w + 0] = e0; REFS[4 * w + 1] = t0; REFS[4 * w + 2] = e2; REFS[4 * w + 3] = e3; }
    }
    SO_LOADH(1);
    const int lrow = 16 * w + fr, nkk = (w >> 1) + 1;
    bf16x8 Cf[4];
#pragma unroll
    for (int ks = 0; ks < 4; ++ks) Cf[ks] = ld_g8(XACT + (r0 + lrow) * 1024 + 768 + g * 128 + 32 * ks + 8 * fq);
    asm volatile("" : "+v"(Cf[0]), "+v"(Cf[1]), "+v"(Cf[2]), "+v"(Cf[3]));
    LDS_BARRIER();
    f32x4 G[4][2];
#pragma unroll
    for (int kk = 0; kk < 4; ++kk) { G[kk][0] = (f32x4){0.f, 0.f, 0.f, 0.f}; G[kk][1] = (f32x4){0.f, 0.f, 0.f, 0.f};
        if (kk < nkk) {
            bf16x8 b0[4], b1[4];
#pragma unroll
            for (int ks = 0; ks < 4; ++ks) { b0[ks] = ld_l8(BL + (32 * kk + fr) * SO_BP + 32 * ks + 8 * fq); b1[ks] = ld_l8(BL + (32 * kk + 16 + fr) * SO_BP + 32 * ks + 8 * fq); }
#pragma unroll
            for (int ks = 0; ks < 4; ++ks) { G[kk][0] = MFMA16(b0[ks], Cf[ks], G[kk][0]); G[kk][1] = MFMA16(b1[ks], Cf[ks], G[kk][1]); } } }
    const float* Dk = F.in[13] + l * 8 + g * 4;
    f32x4 yacc[4][4];
#pragma unroll
    for (int hd = 0; hd < 4; ++hd) {
        const LAS bf16_t* XL = (const LAS bf16_t*)(F.lds + SO_B_BYTES + (hd & 1) * SO_H_BYTES); const LAS bf16_t* SL = XL + 128 * SO_XP;
        bf16x8 Sf[4][4];
#pragma unroll
        for (int pt = 0; pt < 4; ++pt)
#pragma unroll
            for (int ks = 0; ks < 4; ++ks) Sf[pt][ks] = ld_l8(SL + (16 * pt + fr) * SO_SP + 32 * ks + 8 * fq);
        float ea[4], xv[4][4];
#pragma unroll
        for (int r = 0; r < 4; ++r) ea[r] = fast_exp(ACS[128 * hd + 16 * w + 4 * fq + r]);
#pragma unroll
        for (int pt = 0; pt < 4; ++pt)
#pragma unroll
            for (int r = 0; r < 4; ++r) xv[pt][r] = bf2f(XL[(16 * w + 4 * fq + r) * SO_XP + 16 * pt + fr]);
        const float dsk = Dk[hd];
#pragma unroll
        for (int pt = 0; pt < 4; ++pt) { f32x4 a = (f32x4){0.f, 0.f, 0.f, 0.f};
#pragma unroll
            for (int ks = 0; ks < 4; ++ks) a = MFMA16(Cf[ks], Sf[pt][ks], a);
#pragma unroll
            for (int r = 0; r < 4; ++r) a[r] = a[r] * ea[r] + dsk * xv[pt][r];
            yacc[hd][pt] = a; }
        const float al = ACS[128 * hd + lrow];
#pragma unroll
        for (int kk = 0; kk < 4; ++kk) if (kk < nkk) {
            f32x4 P0, P1;
            if (kk + 1 < nkk) {
                const float fk = fast_exp(al - REFS[4 * hd + kk]);
#pragma unroll
                for (int r = 0; r < 4; ++r) { const int s0 = 32 * kk + 4 * fq + r; P0[r] = G[kk][0][r] * fk * ETAB[128 * hd + s0]; P1[r] = G[kk][1][r] * fk * ETAB[128 * hd + s0 + 16]; }
            } else {
#pragma unroll
                for (int r = 0; r < 4; ++r) { const int s0 = 32 * kk + 4 * fq + r, s1 = s0 + 16;
                    P0[r] = (s0 <= lrow) ? G[kk][0][r] * fast_exp(al - ACS[128 * hd + s0]) * DTS[128 * hd + s0] : 0.f;
                    P1[r] = (s1 <= lrow) ? G[kk][1][r] * fast_exp(al - ACS[128 * hd + s1]) * DTS[128 * hd + s1] : 0.f; }
            }
            const bf16x8 PA = pack8(P0, P1);
            bf16x8 Bx[4];
#pragma unroll
            for (int pt = 0; pt < 4; ++pt) Bx[pt] = ld_tr8p(XL, SO_XP, 32 * kk, 16 * pt, lane);
#pragma unroll
            for (int pt = 0; pt < 4; ++pt) yacc[hd][pt] = MFMA16(PA, Bx[pt], yacc[hd][pt]);
        }
        if (hd + 1 < 4) { SO_WRITEH(hd + 1); if (hd + 2 < 4) SO_LOADH(hd + 2); }
        LDS_BARRIER();
    }
#undef SO_LOADH
#undef SO_WRITEH
    const float* nw = F.in[14] + (size_t)l * 512 + g * 256; const int ch8 = 8 * (tid & 31);
    const f32x4 nw0 = *(const f32x4*)(nw + ch8), nw1 = *(const f32x4*)(nw + ch8 + 4);
    u32x4 zv8[8];
#pragma unroll
    for (int i = 0; i < 8; ++i) zv8[i] = *(const u32x4*)(PROJ + (r0 + (tid >> 5) + 16 * i) * PLD + PZ + g * 256 + ch8);
    LAS bf16_t* YL = (LAS bf16_t*)F.lds;
#pragma unroll
    for (int hd = 0; hd < 4; ++hd)
#pragma unroll
        for (int pt = 0; pt < 4; ++pt)
#pragma unroll
            for (int r = 0; r < 4; ++r) YL[(16 * w + 4 * fq + r) * SO_YP + hd * 64 + 16 * pt + fr] = f2bf(yacc[hd][pt][r]);
    LDS_BARRIER();
#pragma unroll
    for (int i = 0; i < 8; ++i) {
        const int lr = (tid >> 5) + 16 * i; const size_t row = r0 + lr;
        const u32x4 yv = *(const LAS u32x4*)(YL + lr * SO_YP + ch8); const u32x4 zv = zv8[i];
        float v[8]; float ss = 0.f;
#pragma unroll
        for (int e = 0; e < 4; ++e) { v[2 * e] = bflo(yv[e]) * bflo(zv[e]); v[2 * e + 1] = bfhi(yv[e]) * bfhi(zv[e]); ss += v[2 * e] * v[2 * e] + v[2 * e + 1] * v[2 * e + 1]; }
        ss += __shfl_xor(ss, 1); ss += __shfl_xor(ss, 2); ss += __shfl_xor(ss, 4); ss += __shfl_xor(ss, 8); ss += __shfl_xor(ss, 16);
        const float rs = rsqrtf(ss * (1.0f / 256.0f) + NORM_EPS);
        u32x4 o; o.x = cvtpk(v[0] * rs * nw0.x, v[1] * rs * nw0.y); o.y = cvtpk(v[2] * rs * nw0.z, v[3] * rs * nw0.w); o.z = cvtpk(v[4] * rs * nw1.x, v[5] * rs * nw1.y); o.w = cvtpk(v[6] * rs * nw1.z, v[7] * rs * nw1.w);
        *(u32x4*)(Y + row * PLD + 256 + g * 256 + ch8) = o;
    }
}
#ifndef PH_EN
#define PH_EN 1023
#endif
#ifndef MK_N_LAUNCHES
#define MK_N_LAUNCHES 1
#endif
constexpr int N_PHASES = 1 + 9 * DEPTH;
constexpr int NA1 = 512;
constexpr int CW_STAT = 32768;
#ifdef PROBE_A
#define ITEM_T0() const unsigned long long it0_ = __builtin_amdgcn_s_memrealtime()
#define ITEM_T1(k_) do { __syncthreads(); if (threadIdx.x == 0) atomicMax(F.ctl + CW_STAT + 64 * ((k_) + 16 * l), (unsigned)(__builtin_amdgcn_s_memrealtime() - it0_)); } while (0)
#define ITEM_TSUM(k_) do { if (threadIdx.x == 0) atomicAdd(F.ctl + CW_STAT + 64 * ((k_) + 16 * l), (unsigned)(__builtin_amdgcn_s_memrealtime() - it0_)); } while (0)
#else
#define ITEM_T0() do {} while (0)
#define ITEM_T1(k_) do {} while (0)
#define ITEM_TSUM(k_) do {} while (0)
#endif

__global__ void __launch_bounds__(NTHREADS, 2) hyb_fwd(Args args) {
    extern __shared__ __attribute__((aligned(16))) unsigned char lds_raw[];
    {   const int t0 = threadIdx.x;
        for (int u = t0; u < (LDS_BYTES - LDSCTL_OFF) / 4; u += NTHREADS) ((LAS unsigned*)((LAS unsigned char*)lds_raw + LDSCTL_OFF))[u] = 0u; }
    __syncthreads();
    const int ph_lo = args.ph_lo, ph_hi = args.ph_hi;
    const bool one_launch = (ph_hi - ph_lo) > 1;
    if (one_launch) { XcdBarrier b0 = xcd_barrier_post((unsigned*)(args.ws + WS_CTL) + CW_BAR, (volatile LAS unsigned*)((LAS unsigned char*)lds_raw + MISC_OFF) + 8); (void)b0; }
#ifdef PROBE_A
    unsigned long long t_prev = __builtin_amdgcn_s_memrealtime();
#endif
    for (int ph = ph_lo; ph < ph_hi; ++ph) {
        int tid_ = threadIdx.x; asm volatile("" : "+v"(tid_));
        kinptr_t kin = (kinptr_t)__builtin_amdgcn_kernarg_segment_ptr(); asm volatile("" : "+s"(kin));
        Frame F;
        F.lds = (LAS unsigned char*)lds_raw; F.MISC = (volatile LAS unsigned*)(F.lds + MISC_OFF);
        F.tid = tid_; F.lane = tid_ & 63; F.wave = __builtin_amdgcn_readfirstlane(tid_ >> 6);
        F.G = gridDim.x; { const int bx = blockIdx.x; F.vcu = (F.G % 8 == 0) ? (bx % 8) * (F.G / 8) + bx / 8 : bx; }
        F.in = kin;
        float* const outp = (float*)kin[25]; unsigned char* ws = (unsigned char*)kin[26];
        F.ws = ws; F.ctl = (unsigned*)(ws + WS_CTL);
        bf16_t* XB = (bf16_t*)(ws + WS_XB); bf16_t* PROJ = (bf16_t*)(ws + WS_PROJ); float* SSQ = (float*)(ws + WS_SSQ); float* GATES = (float*)(ws + WS_GATES);
        if (ph == 0) { if (PH_EN & 1) p0_prologue(F); }
        else {
            const int l = (ph - 1) / 9, k = (ph - 1) % 9;
            const unsigned char* WL = ws + WS_W + (size_t)l * W_LAYER;
            if ((PH_EN & 2) && (k == 0 || k == 7)) {
                pg8::Gemm g{XB, (const bf16_t*)(WL + (k == 0 ? W_GU1 : W_GU2)), M_TOK, NGU, DM, DM}; pg8::StaticOrder S; S.init(M_TOK, NGU, F.G, (int)blockIdx.x);
                EpiSwiglu E{{}, PROJ, SSQ};
                pg8::gemm_phase<EpiSwiglu, true, true>(F.lds, g, S, E, F.tid);
                { int t2 = threadIdx.x; asm volatile("" : "+v"(t2)); F.tid = t2; F.lane = t2 & 63; F.wave = __builtin_amdgcn_readfirstlane(t2 >> 6); side_convert(F, l, k); }
            } else if ((PH_EN & 4) && (k == 1 || k == 8 || k == 6)) {
                pg8::Gemm g; float alpha = 0.5f;
                if (k == 6) { g = pg8::Gemm{PROJ + PX, (const bf16_t*)(WL + W_OUT), M_TOK, DM, DM, PLD}; alpha = 1.0f; }
                else { g = pg8::Gemm{PROJ, (const bf16_t*)(WL + (k == 1 ? W_D1 : W_D2)), M_TOK, DM, FF, FF}; }
                pg8::StaticOrder S; S.init(M_TOK, DM, F.G, (int)blockIdx.x);
                if (ph == N_PHASES - 1) { EpiResid<true> E{outp, XB, SSQ, alpha, 1.0f / alpha}; pg8::gemm_phase<EpiResid<true>, false, true>(F.lds, g, S, E, F.tid); }
                else { EpiResid<false> E{outp, XB, SSQ, alpha, 1.0f / alpha}; pg8::gemm_phase<EpiResid<false>, false, true>(F.lds, g, S, E, F.tid); }
            } else if ((PH_EN & 8) && k == 2) {
                pg8::Gemm g{XB, (const bf16_t*)(WL + W_IN), M_TOK, NIN, DM, DM}; pg8::StaticOrder S; S.init(M_TOK, NIN, F.G, (int)blockIdx.x);
                EpiInProj E{{}, PROJ, GATES, SSQ, kin[15] + l * 64, kin[16] + l * 64, kin[7] + l * 8, kin[11] + l * 8};
                pg8::gemm_phase<EpiInProj, true, true>(F.lds, g, S, E, F.tid);
                { int t2 = threadIdx.x; asm volatile("" : "+v"(t2)); F.tid = t2; F.lane = t2 & 63; F.wave = __builtin_amdgcn_readfirstlane(t2 >> 6); side_convert(F, l, k); }
            } else if ((PH_EN & 16) && k == 3) {
                conv_phase(F, l);
            } else if (k == 4) {
                const int qoff_ = (F.G == 256) ? 256 : 0;
                for (int it = (F.G == 256) ? (int)blockIdx.x : q_next(F, 2 * l);;) {
                    if (it >= 48 + NA1) break;
                    { int t2 = threadIdx.x; asm volatile("" : "+v"(t2)); F.tid = t2; F.lane = t2 & 63; F.wave = __builtin_amdgcn_readfirstlane(t2 >> 6); }
                    ITEM_T0();
                    if (it < 16) { if (PH_EN & 32) mlstm_state_item(F, it); ITEM_T1(0); it = q_next(F, 2 * l) + qoff_; }
                    else if (it < 48) { if (PH_EN & 64) ssd_state_item(F, l, it - 16); ITEM_T1(1); it = q_next(F, 2 * l) + qoff_; }
                    else { const int r = it - 48; attn_item(F, l, r & 15, 31 - (r >> 4), true); ITEM_T1(2); ITEM_TSUM(12);
                        __syncthreads(); it = (int)F.MISC[17] + qoff_; } }
#ifdef PROBE_A
                if (threadIdx.x == 0) atomicAdd(F.ctl + CW_STAT + 64 * (13 + 16 * l), (unsigned)(__builtin_amdgcn_s_memrealtime() - t_prev));
#endif
            } else if (k == 5 && NA1 == 512 && F.G == 256) {
                { int t2 = threadIdx.x; asm volatile("" : "+v"(t2)); F.tid = t2; F.lane = t2 & 63; F.wave = __builtin_amdgcn_readfirstlane(t2 >> 6); }
                ssd_out_item(F, l, F.vcu);
                __syncthreads();
                { int t2 = threadIdx.x; asm volatile("" : "+v"(t2)); F.tid = t2; F.lane = t2 & 63; F.wave = __builtin_amdgcn_readfirstlane(t2 >> 6); }
                mlstm_out_item(F, l, F.vcu);
            } else if (k == 5) {
                for (;;) { const int it = q_next(F, 2 * l + 1); if (it >= 512 + (512 - NA1)) break;
                    { int t2 = threadIdx.x; asm volatile("" : "+v"(t2)); F.tid = t2; F.lane = t2 & 63; F.wave = __builtin_amdgcn_readfirstlane(t2 >> 6); }
                    ITEM_T0();
                    if (it < 256) { if (PH_EN & 256) ssd_out_item(F, l, it); ITEM_T1(3); }
                    else if (it < 512) { if (PH_EN & 512) mlstm_out_item(F, l, it - 256); ITEM_T1(4); }
                    else { const int r = NA1 + it - 512; if (PH_EN & 128) attn_item(F, l, r & 15, 31 - (r >> 4), false); } }
            }
        }
#ifdef PROBE_A
        if (ph + 1 < ph_hi) { XcdBarrier bar; bar.bar = F.ctl + CW_BAR; bar.x = xb_xcc_id(); bar.st = F.MISC + 8; xcd_barrier(bar); }
        { const unsigned long long t_now = __builtin_amdgcn_s_memrealtime(); if (threadIdx.x == 0) F.MISC[24 + ph] += (unsigned)(t_now - t_prev); t_prev = t_now; }
        if (ph + 1 == ph_hi && blockIdx.x == 0) { __syncthreads();
            unsigned va = (PROBE_A < 32) ? F.MISC[24 + PROBE_A] : xb_ld(F.ctl + CW_STAT + 64 * (PROBE_A - 32)), vb = (PROBE_B < 32) ? F.MISC[24 + PROBE_B] : xb_ld(F.ctl + CW_STAT + 64 * (PROBE_B - 32));
            if (PROBE_A == 44 || PROBE_A == 45) va = va / 256u * 5u; if (PROBE_B == 44 || PROBE_B == 45) vb = vb / 256u * 5u;
            unsigned qa = (va + 500u) / 1000u, qb = (vb + 500u) / 1000u; if (qa > 63u) qa = 63u; if (qb > 63u) qb = 63u;
            const unsigned long long wait = (unsigned long long)(qa * 6400u + qb * 409600u); const unsigned long long t0 = __builtin_amdgcn_s_memrealtime();
            while (__builtin_amdgcn_s_memrealtime() - t0 < wait) __builtin_amdgcn_s_sleep(8); }
        continue;
#endif
        if (ph + 1 < ph_hi) { XcdBarrier bar; bar.bar = F.ctl + CW_BAR; bar.x = xb_xcc_id(); bar.st = F.MISC + 8; xcd_barrier(bar); }
    }
}

extern "C" void kernel_launch(void* const* d_in, const int* in_sizes, int n_in, void* d_out, int out_size, void* d_ws, size_t ws_size, hipStream_t stream) {
    static int grid = 0;
    if (grid == 0) {
        if (n_in != 25 || in_sizes[0] != M_TOK * DM || out_size != M_TOK * DM || ws_size < WS_END) { fprintf(stderr, "kernel_launch: unexpected shapes (n_in %d, in0 %d, out %d, ws %zu)\n", n_in, n_in > 0 ? in_sizes[0] : -1, out_size, ws_size); grid = -1; return; }
        int dev = 0, cus = 0, per_cu = 0;
        if (hipGetDevice(&dev) != hipSuccess || hipDeviceGetAttribute(&cus, hipDeviceAttributeMultiprocessorCount, dev) != hipSuccess) { grid = -1; return; }
        if (hipFuncSetAttribute((const void*)hyb_fwd, hipFuncAttributeMaxDynamicSharedMemorySize, LDS_BYTES) != hipSuccess) { fprintf(stderr, "kernel_launch: hipFuncSetAttribute failed\n"); grid = -1; return; }
        if (hipOccupancyMaxActiveBlocksPerMultiprocessor(&per_cu, (const void*)hyb_fwd, NTHREADS, LDS_BYTES) != hipSuccess || per_cu < 1)
            fprintf(stderr, "kernel_launch: note: occupancy query reports %d workgroups per CU\n", per_cu);
        (void)hipGetLastError();
        grid = cus;
    }
    if (grid < 0) return;
    if (hipMemsetAsync((char*)d_ws + WS_CTL, 0, CTL_ZERO_BYTES, stream) != hipSuccess) { fprintf(stderr, "kernel_launch: memset failed\n"); return; }
    Args a{};
    for (int i = 0; i < 25; ++i) a.in[i] = (const float*)d_in[i];
    a.out = (float*)d_out; a.ws = (unsigned char*)d_ws;
#if MK_N_LAUNCHES == 1
    a.ph_lo = 0; a.ph_hi = N_PHASES;
    hipLaunchKernelGGL(hyb_fwd, dim3(grid), dim3(NTHREADS), LDS_BYTES, stream, a);
#else
    for (int p = 0; p < N_PHASES; ++p) { a.ph_lo = p; a.ph_hi = p + 1; hipLaunchKernelGGL(hyb_fwd, dim3(grid), dim3(NTHREADS), LDS_BYTES, stream, a); }
#endif
    const hipError_t le = hipPeekAtLastError();
    if (le != hipSuccess) fprintf(stderr, "kernel_launch: launch failed: %s\n", hipGetErrorName(le));
}
```

```cpp
#include <hip/hip_runtime.h>
#include <cstdio>
#include <cstdint>

#define LAS __attribute__((address_space(3)))
#define GAS __attribute__((address_space(1)))
typedef unsigned short bf16_t;
typedef short bf16x8 __attribute__((ext_vector_type(8)));
typedef short bf16x4 __attribute__((ext_vector_type(4)));
typedef float f32x4 __attribute__((ext_vector_type(4)));
typedef float f32x2 __attribute__((ext_vector_type(2)));
typedef unsigned u32x4 __attribute__((ext_vector_type(4)));
typedef unsigned u32x2 __attribute__((ext_vector_type(2)));
typedef __bf16 bf16x2_t __attribute__((ext_vector_type(2)));

constexpr int M_TOK = 16384, SEQ = 4096, NBATCH = 4, DM = 1024, FF = 2816, NGU = 2 * FF, NIN = 3584, DEPTH = 2;
constexpr int PLD = 3328;
constexpr int PQ = 0, PK = 256, PV = 512, PO = 768, PZ = 1024, PX = 1536, PDQ = 2560, PDK = 2816, PDV = 3072;
constexpr float NORM_EPS = 1e-6f;
constexpr float LOG2E = 1.4426950408889634f;

__device__ __forceinline__ unsigned cvtpk(float lo, float hi) { f32x2 v = {lo, hi}; bf16x2_t b = __builtin_convertvector(v, bf16x2_t); return __builtin_bit_cast(unsigned, b); }
__device__ __forceinline__ bf16_t f2bf(float f) { return (bf16_t)(cvtpk(f, 0.f) & 0xffffu); }
__device__ __forceinline__ float bf2f(bf16_t h) { return __uint_as_float(((unsigned)h) << 16); }
__device__ __forceinline__ float bflo(unsigned w) { return __uint_as_float(w << 16); }
__device__ __forceinline__ float bfhi(unsigned w) { return __uint_as_float(w & 0xffff0000u); }
__device__ __forceinline__ float fast_exp(float x) { return __builtin_amdgcn_exp2f(x * LOG2E); }
__device__ __forceinline__ float fast_rcp(float x) { return __builtin_amdgcn_rcpf(x); }
__device__ __forceinline__ float fast_log1pexp(float x) { const float e = __builtin_amdgcn_exp2f(x * LOG2E); return __builtin_amdgcn_logf(1.0f + e) * 0.6931471805599453f; }
__device__ __forceinline__ float sigmoidf_(float x) { return fast_rcp(1.f + fast_exp(-x)); }
__device__ __forceinline__ float siluf_(float x) { return x * sigmoidf_(x); }

__device__ __forceinline__ void st16_wt(void* p, u32x4 v) { asm volatile("global_store_dwordx4 %0, %1, off sc1\n\ts_nop 1" :: "v"(p), "v"(v) : "memory"); }

namespace pg8 {
constexpr int BM = 256, BK = 64, HALF = 128, HTB = HALF * BK * 2, STAGE_BYTES = 8 * HTB, NXCD = 8, WGM = 8;
__host__ __device__ __forceinline__ int lds_byte(int r, int c) { const int st = (r >> 4) * 2 + (c >> 5), rr = r & 15, cc = c & 31, ob = rr * 64 + cc * 2; return st * 1024 + (ob ^ (((ob >> 9) & 1) << 5)); }
__host__ __device__ __forceinline__ void stage_rc(int b, int& R, int& C) { const int st = b / 1024, sb = b % 1024, swz = sb ^ (((sb >> 9) & 1) << 5); R = (st >> 1) * 16 + swz / 64; C = (st & 1) * 32 + (swz % 64) / 2; }
__host__ __device__ __forceinline__ int perm32(int rho) { const int n = rho >> 4, i = rho & 15; return 8 * (i >> 2) + 4 * n + (i & 3); }

struct Unit { int pm, pn; };
struct Gemm { const bf16_t* A; const bf16_t* Bt; int M, N, K, lda; };

struct StaticOrder {
    int nM, nN, nwg, G, c;
    __device__ void init(int M, int N, int G_, int c_) { nM = M / BM; nN = N / BM; nwg = nM * nN; G = G_; c = c_; }
    __device__ bool next(int i, Unit& u) const {
        const long L = (long)i * G + c; if (L >= nwg) return false;
        int wgid = (int)L; { const int q = nwg / NXCD, r = nwg % NXCD, xcd = wgid % NXCD, off = wgid / NXCD; wgid = (xcd < r ? xcd * (q + 1) : r * (q + 1) + (xcd - r) * q) + off; }
        const int nig = WGM * nN, gid = wgid / nig, fm = gid * WGM, gsz = (nM - fm) < WGM ? (nM - fm) : WGM;
        u.pm = fm + ((wgid % nig) % gsz); u.pn = (wgid % nig) / gsz; return true;
    }
};

template <class Epi, bool ALIGN_EPI, bool SP2>
__device__ __forceinline__ void gemm_phase(LAS unsigned char* lds, const Gemm g, const StaticOrder& S, const Epi& E, const int tid) {
    const int wid = __builtin_amdgcn_readfirstlane(tid >> 6), lane = tid & 63, wr = wid >> 2, wc = wid & 3, fr = lane & 15, fq = lane >> 4;
    const int K = g.K, nt = K / BK, lda = g.lda;
    unsigned voffA[2], voffB[2];
#pragma unroll
    for (int i = 0; i < 2; ++i) { int R, C; stage_rc(tid * 16 + i * 8192, R, C); const int Rb = (R & ~31) + perm32(R & 31);
        voffA[i] = (unsigned)(R * lda + C) * 2u; voffB[i] = (unsigned)(Rb * K + C) * 2u; }
    const size_t kstep = (size_t)(BK * 2);
    const size_t hstepA = (size_t)HALF * lda * 2, hstepB = (size_t)HALF * K * 2;
    const size_t tstepA = 2 * hstepA, tstepB = 2 * hstepB;
    const unsigned ldsw = (unsigned)wid * 1024u;
    const int aoff = lds_byte(wr * 64 + fr, fq * 8), boff = lds_byte(wc * 32 + fr, fq * 8);
#define PG8_SA(b, h) (((b) * 2 + (h)) * HTB)
#define PG8_SB(b, h) ((4 + (b) * 2 + (h)) * HTB)
#define PG8_STAGE(bufoff, gbase, voff) do { _Pragma("unroll") for (int _i = 0; _i < 2; ++_i) \
        __builtin_amdgcn_global_load_lds((const unsigned*)((const char*)(gbase) + (voff)[_i]), (LAS unsigned*)(lds + (bufoff) + ldsw + _i * 8192), 16, 0, 0); } while (0)
#define PG8_LDA(dst, b, h) do { _Pragma("unroll") for (int m = 0; m < 4; ++m) _Pragma("unroll") for (int k = 0; k < 2; ++k) dst[m][k] = *(const LAS bf16x8*)(lds + PG8_SA(b, h) + aoff + m * 2048 + k * 1024); } while (0)
#define PG8_LDB(dst, b, h) do { _Pragma("unroll") for (int n = 0; n < 2; ++n) _Pragma("unroll") for (int k = 0; k < 2; ++k) dst[n][k] = *(const LAS bf16x8*)(lds + PG8_SB(b, h) + boff + n * 2048 + k * 1024); } while (0)
#define PG8_MMA(ai, bj, At, Bt) do { __builtin_amdgcn_s_setprio(1); _Pragma("unroll") for (int m = 0; m < 4; ++m) _Pragma("unroll") for (int n = 0; n < 2; ++n) _Pragma("unroll") for (int k = 0; k < 2; ++k) \
        acc[ai][bj][m][n] = __builtin_amdgcn_mfma_f32_16x16x32_bf16(Bt[n][k], At[m][k], acc[ai][bj][m][n], 0, 0, 0); __builtin_amdgcn_s_setprio(0); } while (0)
#define PG8_WAIT_V(n) asm volatile("s_waitcnt vmcnt(" #n ")" ::: "memory")
#define PG8_WAIT_L(n) asm volatile("s_waitcnt lgkmcnt(" #n ")" ::: "memory")
#define PG8_BAR __builtin_amdgcn_s_barrier()
#define PG8_SCHED __builtin_amdgcn_sched_barrier(0)
    Unit cur, nxt; int ui = 0;
    if (!S.next(0, cur)) return;
    f32x4 acc[2][2][4][2];
    typename Epi::Raw raw; E.init_load(raw, cur, wr, wc, fr, fq);
    typename Epi::Pre pre; E.pre_load(pre, cur, wr, fr, fq);
    if constexpr (!Epi::HAS_INIT) {
#pragma unroll
    for (int a = 0; a < 2; ++a)
#pragma unroll
        for (int b = 0; b < 2; ++b)
#pragma unroll
            for (int m = 0; m < 4; ++m)
#pragma unroll
                for (int n = 0; n < 2; ++n) acc[a][b][m][n] = (f32x4){0.f, 0.f, 0.f, 0.f};
    }
    bf16x8 At[4][2], B0[2][2], B1[2][2];
    const char* cA = (const char*)g.A + (size_t)cur.pm * tstepA; const char* cB = (const char*)g.Bt + (size_t)cur.pn * tstepB;
    if constexpr (SP2) {
        PG8_STAGE(PG8_SB(0, 0), cB, voffB); PG8_STAGE(PG8_SB(0, 1), cB + hstepB, voffB); PG8_STAGE(PG8_SA(0, 0), cA, voffA); PG8_STAGE(PG8_SA(0, 1), cA + hstepA, voffA);
        if constexpr (Epi::HAS_INIT) E.init_finish(raw, acc);
        E.pre_finish(pre);
        if (wr == 1) PG8_BAR;
        PG8_WAIT_V(2); PG8_BAR;
        PG8_STAGE(PG8_SB(1, 0), cB + kstep, voffB); PG8_STAGE(PG8_SA(1, 0), cA + kstep, voffA); PG8_STAGE(PG8_SB(1, 1), cB + hstepB + kstep, voffB);
        PG8_WAIT_V(6); PG8_BAR;
    } else {
        PG8_STAGE(PG8_SB(0, 0), cB, voffB); PG8_STAGE(PG8_SA(0, 0), cA, voffA); PG8_STAGE(PG8_SB(0, 1), cB + hstepB, voffB); PG8_STAGE(PG8_SA(0, 1), cA + hstepA, voffA);
        E.pre_finish(pre);
        if (wr == 1) PG8_BAR;
        PG8_WAIT_V(4); PG8_BAR;
        PG8_STAGE(PG8_SB(1, 0), cB + kstep, voffB); PG8_STAGE(PG8_SA(1, 0), cA + kstep, voffA); PG8_STAGE(PG8_SB(1, 1), cB + hstepB + kstep, voffB);
        PG8_WAIT_V(6); PG8_BAR;
    }
    for (;;) {
        const bool has_next = S.next(ui + 1, nxt);
        const char* nA = has_next ? (const char*)g.A + (size_t)nxt.pm * tstepA : cA; const char* nB = has_next ? (const char*)g.Bt + (size_t)nxt.pn * tstepB : cB;
        for (int t = 0; t < nt; t += 2) {
            const bool last = (t == nt - 2);
            const char* a1 = cA + (size_t)(t + 1) * kstep;
            const char* a2 = last ? nA : cA + (size_t)(t + 2) * kstep; const char* b2 = last ? nB : cB + (size_t)(t + 2) * kstep;
            const char* a3 = a2 + kstep; const char* b3 = b2 + kstep;
            if constexpr (SP2) {
            PG8_LDB(B0, 0, 0); PG8_LDB(B1, 0, 1); PG8_SCHED; PG8_LDA(At, 0, 0); PG8_STAGE(PG8_SA(1, 1), a1 + hstepA, voffA);
            PG8_WAIT_V(8); PG8_WAIT_L(0); PG8_BAR; PG8_MMA(0, 0, At, B0); PG8_MMA(0, 1, At, B1); PG8_BAR; PG8_SCHED;
            PG8_LDA(At, 0, 1); PG8_STAGE(PG8_SB(0, 0), b2, voffB); PG8_STAGE(PG8_SB(0, 1), b2 + hstepB, voffB); PG8_STAGE(PG8_SA(0, 0), a2, voffA);
            PG8_WAIT_V(8); PG8_WAIT_L(0); PG8_BAR; PG8_MMA(1, 0, At, B0); PG8_MMA(1, 1, At, B1); PG8_BAR; PG8_SCHED;
            PG8_LDB(B0, 1, 0); PG8_LDB(B1, 1, 1); PG8_SCHED; PG8_LDA(At, 1, 0); PG8_STAGE(PG8_SA(0, 1), a2 + hstepA, voffA);
            PG8_WAIT_V(8); PG8_WAIT_L(0); PG8_BAR; PG8_MMA(0, 0, At, B0); PG8_MMA(0, 1, At, B1); PG8_BAR; PG8_SCHED;
            PG8_LDA(At, 1, 1); PG8_STAGE(PG8_SB(1, 0), b3, voffB); PG8_STAGE(PG8_SB(1, 1), b3 + hstepB, voffB); PG8_STAGE(PG8_SA(1, 0), a3, voffA);
            PG8_WAIT_V(8); PG8_WAIT_L(0); PG8_BAR; PG8_MMA(1, 0, At, B0); PG8_MMA(1, 1, At, B1); PG8_BAR; PG8_SCHED;
            } else {
            PG8_LDB(B0, 0, 0); PG8_SCHED; PG8_LDA(At, 0, 0); PG8_STAGE(PG8_SA(1, 1), a1 + hstepA, voffA);
            PG8_WAIT_L(8); PG8_BAR; PG8_WAIT_L(0); PG8_MMA(0, 0, At, B0); PG8_BAR; PG8_SCHED;
            PG8_LDB(B1, 0, 1); PG8_STAGE(PG8_SB(0, 0), b2, voffB);
            PG8_BAR; PG8_WAIT_L(0); PG8_MMA(0, 1, At, B1); PG8_BAR;
            PG8_LDA(At, 0, 1); PG8_STAGE(PG8_SA(0, 0), a2, voffA);
            PG8_BAR; PG8_WAIT_L(0); PG8_MMA(1, 0, At, B0); PG8_BAR; PG8_SCHED;
            PG8_STAGE(PG8_SB(0, 1), b2 + hstepB, voffB);
            PG8_WAIT_V(6); PG8_BAR; PG8_MMA(1, 1, At, B1); PG8_BAR;
            PG8_LDB(B0, 1, 0); PG8_SCHED; PG8_LDA(At, 1, 0); PG8_STAGE(PG8_SA(0, 1), a2 + hstepA, voffA);
            PG8_WAIT_L(8); PG8_BAR; PG8_WAIT_L(0); PG8_MMA(0, 0, At, B0); PG8_BAR; PG8_SCHED;
            PG8_LDB(B1, 1, 1); PG8_STAGE(PG8_SB(1, 0), b3, voffB);
            PG8_BAR; PG8_WAIT_L(0); PG8_MMA(0, 1, At, B1); PG8_BAR;
            PG8_LDA(At, 1, 1); PG8_STAGE(PG8_SA(1, 0), a3, voffA);
            PG8_BAR; PG8_WAIT_L(0); PG8_MMA(1, 0, At, B0); PG8_BAR; PG8_SCHED;
            PG8_STAGE(PG8_SB(1, 1), b3 + hstepB, voffB);
            PG8_WAIT_V(6); PG8_BAR; PG8_MMA(1, 1, At, B1); PG8_BAR;
            }
        }
        if constexpr (ALIGN_EPI) { if (wr == 0) PG8_BAR; }
        E(acc, cur, wr, wc, fr, fq, pre);
        if (!has_next) break;
#pragma unroll
        for (int a = 0; a < 2; ++a)
#pragma unroll
            for (int b = 0; b < 2; ++b)
#pragma unroll
                for (int m = 0; m < 4; ++m)
#pragma unroll
                    for (int n = 0; n < 2; ++n) acc[a][b][m][n] = (f32x4){0.f, 0.f, 0.f, 0.f};
        cur = nxt; cA = nA; cB = nB; ++ui;
        if constexpr (ALIGN_EPI) { if (wr == 1) PG8_BAR; }
    }
    PG8_WAIT_V(0);
    if constexpr (!ALIGN_EPI) { if (wr == 0) PG8_BAR; }
    PG8_BAR;
#undef PG8_SA
#undef PG8_SB
#undef PG8_STAGE
#undef PG8_LDA
#undef PG8_LDB
#undef PG8_MMA
#undef PG8_WAIT_V
#undef PG8_WAIT_L
#undef PG8_BAR
#undef PG8_SCHED
}
}
constexpr size_t MiB = 1u << 20;
constexpr size_t WS_CTL = 0, CTL_ZERO_BYTES = 256 * 1024;
constexpr size_t WS_SSQ = 1 * MiB;
constexpr size_t WS_GATES = 2 * MiB;
constexpr size_t WS_NST = 3 * MiB;
constexpr size_t WS_W = 4 * MiB;
constexpr size_t W_GU1 = 0, W_D1 = 11 * MiB, W_IN = W_D1 + 11 * MiB / 2, W_OUT = W_IN + 7 * MiB, W_GU2 = W_OUT + 2 * MiB, W_D2 = W_GU2 + 11 * MiB, W_LAYER = 42 * MiB;
static_assert(W_D2 + 11 * MiB / 2 == W_LAYER, "weights map");
constexpr size_t WS_XB = 88 * MiB;
constexpr size_t WS_CST = 120 * MiB;
constexpr size_t WS_SST = 128 * MiB;
constexpr size_t WS_PROJ = 144 * MiB;
constexpr size_t WS_END = 248 * MiB;
static_assert(WS_PROJ + (size_t)M_TOK * PLD * 2 <= WS_END, "ws map");

constexpr int CW_BAR = 4096;
constexpr int CW_Q = 16384;

constexpr int RING_BYTES = 131072;
constexpr int LDSCTL_OFF = RING_BYTES, MISC_OFF = LDSCTL_OFF + 320;
constexpr int LDS_BYTES = 147456;
constexpr int NWAVES = 8, NTHREADS = 512;

typedef GAS unsigned gu32;
#define RLX_AGENT __ATOMIC_RELAXED, __HIP_MEMORY_SCOPE_AGENT
#define LDS_WAIT() asm volatile("s_waitcnt lgkmcnt(0)" ::: "memory")
#define VM_WAIT() asm volatile("s_waitcnt vmcnt(0)" ::: "memory")

#define XB_TMO      128
#define XB_XCNT(j)  (256  + 64 * (j))
#define XB_XSUB(j)  (1280 + 64 * (j))
#define XB_XGEN(j)  (2304 + 64 * (j))
#define XB_TOP      3328
#define XB_TOPGEN   3392
#define XCD_BAR_WORDS 3456
#define XB_SPIN_CAP (1u << 22)
__device__ __forceinline__ unsigned xb_ld(unsigned* p)              { return __hip_atomic_load(p, __ATOMIC_RELAXED, __HIP_MEMORY_SCOPE_AGENT); }
__device__ __forceinline__ unsigned xb_add(unsigned* p, unsigned v) { return __hip_atomic_fetch_add(p, v, __ATOMIC_RELAXED, __HIP_MEMORY_SCOPE_AGENT); }
__device__ __forceinline__ unsigned xb_xcc_id() { return (unsigned)__builtin_amdgcn_s_getreg((3 << 11) | 20) & 0xFu; }
#define XB_SPIN(cond, bar) do { unsigned _sp = 0; while (cond) { __builtin_amdgcn_s_sleep(1); \
    if ((++_sp & 255u) == 0u) { if (xb_ld(&(bar)[XB_TMO])) break; if (_sp > XB_SPIN_CAP) { atomicAdd(&(bar)[XB_TMO], 1u); break; } } } } while (0)
struct XcdBarrier { unsigned* bar; unsigned x; volatile LAS unsigned* st; };
__device__ __forceinline__ XcdBarrier xcd_barrier_post(unsigned* bar, volatile LAS unsigned* st) {
    XcdBarrier b; b.bar = bar; b.x = xb_xcc_id(); b.st = st;
    if (threadIdx.x == 0) (void)xb_add(&bar[XB_XCNT(b.x)], 1u);
    return b;
}
__device__ __forceinline__ void xcd_barrier_complete(unsigned* bar, unsigned x, unsigned& nloc, unsigned& nx) {
    const unsigned G = gridDim.x * gridDim.y * gridDim.z;
    unsigned sum, cnt, mine, sp = 0u;
    for (;;) {
        sum = 0u; cnt = 0u; mine = 0u;
#pragma unroll
        for (unsigned j = 0; j < 16; ++j) { const unsigned c = xb_ld(&bar[XB_XCNT(j)]); sum += c; cnt += (c > 0u) ? 1u : 0u; mine = (j == x) ? c : mine; }
        if (sum == G) break;
        __builtin_amdgcn_s_sleep(1);
        if ((++sp & 255u) == 0u) { if (xb_ld(&bar[XB_TMO])) break; if (sp > XB_SPIN_CAP) { atomicAdd(&bar[XB_TMO], 1u); break; } }
    }
    nloc = mine > 0u ? mine : 1u; nx = cnt > 0u ? cnt : 1u;
}
__device__ __forceinline__ void xcd_barrier(const XcdBarrier& b) {
    asm volatile("s_waitcnt vmcnt(0)" ::: "memory");
    __syncthreads();
    if (threadIdx.x == 0) {
        unsigned* bar = b.bar;
        __builtin_amdgcn_s_waitcnt(0);
        unsigned nloc = b.st[0], nx = b.st[1];
        if (nloc == 0u) { xcd_barrier_complete(bar, b.x, nloc, nx); b.st[0] = nloc; b.st[1] = nx; }
        const unsigned old = xb_add(&bar[XB_XSUB(b.x)], 1u);
        const unsigned gen = old / nloc;
        if (old + 1u == (gen + 1u) * nloc) {
            __builtin_amdgcn_fence(__ATOMIC_RELEASE, "agent");
            asm volatile("s_waitcnt vmcnt(0)" ::: "memory");
            const unsigned og = xb_add(&bar[XB_TOP], 1u);
            const unsigned tg = og / nx;
            if (og + 1u == (tg + 1u) * nx) xb_add(&bar[XB_TOPGEN], 1u);
            else XB_SPIN(xb_ld(&bar[XB_TOPGEN]) == tg, bar);
            __builtin_amdgcn_fence(__ATOMIC_ACQUIRE, "agent");
            xb_add(&bar[XB_XGEN(b.x)], 1u);
            asm volatile("s_waitcnt vmcnt(0)" ::: "memory");
        } else {
            XB_SPIN(xb_ld(&bar[XB_XGEN(b.x)]) == gen, bar);
            __builtin_amdgcn_fence(__ATOMIC_ACQUIRE, "agent");
            asm volatile("s_waitcnt vmcnt(0)" ::: "memory");
        }
    }
    __syncthreads();
}

struct Args { const float* in[25]; float* out; unsigned char* ws; int ph_lo, ph_hi; };
typedef const float* fptr_t; typedef __attribute__((address_space(4))) const fptr_t* kinptr_t;
struct ArgView { kinptr_t in; };
struct Frame {
    LAS unsigned char* lds;
    volatile LAS unsigned* MISC;
    unsigned* ctl;
    int tid, lane, wave, vcu, G;
    kinptr_t in;
    unsigned char* ws;
};
__device__ __forceinline__ float wave_sum(float v) {
#pragma unroll
    for (int o = 1; o < 64; o <<= 1) v += __shfl_xor(v, o);
    return v;
}
__device__ __forceinline__ int q_next(Frame& F, int q) {
    __syncthreads();
    if (F.tid == 0) F.MISC[16] = xb_add(F.ctl + CW_Q + 64 * q, 1u);
    __syncthreads();
    return (int)F.MISC[16];
}

struct MapPlain { __device__ __forceinline__ int row(int n) const { return n; } __device__ __forceinline__ float scale(int) const { return 1.f; } };
struct MapGU { int off; __device__ __forceinline__ int row(int n) const { return 256 * (n >> 7) + off + (n & 127); } __device__ __forceinline__ float scale(int) const { return 1.f; } };
struct MapIn {
    __device__ __forceinline__ int row(int n) const {
        if (n < 1024) return n;
        if (n < 1032) return 13 * 256 + (n - 1024);
        if (n < 1544) return 4 * 256 + (n - 1032);
        if (n < 2568) return 6 * 256 + (n - 1544);
        if (n < 2576) return 13 * 256 + 8 + (n - 2568);
        return 10 * 256 + (n - 2576);
    }
    __device__ __forceinline__ float scale(int n) const { return (n >= 256 && n < 512) ? 0.125f : 1.f; }
};
#ifndef CONV_ST
#define CONV_ST(p_, v_) (*(p_) = (v_))
#endif
template <class Map>
__device__ __forceinline__ void p0_transpose_item(const float* W, int K, int N, bf16_t* WT, int item, int lane, const float* gain, const Map map, LAS unsigned char* stg) {
    const int nblk = (N + 63) / 64, kb = item / nblk, nb = item % nblk, k0 = 64 * kb, n = 64 * nb + lane;
    const int nc = n < N ? n : N - 1;
    const float* src = W + (size_t)k0 * N + nc;
    float v[64];
#pragma unroll
    for (int i = 0; i < 64; ++i) v[i] = __builtin_nontemporal_load(src + (size_t)i * N);
    const float sc = map.scale(nc);
    if (gain) {
#pragma unroll
        for (int i = 0; i < 64; i += 4) { const f32x4 g = *(const f32x4*)(gain + k0 + i); v[i] *= g.x; v[i + 1] *= g.y; v[i + 2] *= g.z; v[i + 3] *= g.w; }
    }
    LAS u32x4* srow = (LAS u32x4*)(stg + lane * 128);
#pragma unroll
    for (int c = 0; c < 8; ++c) { u32x4 o; o.x = cvtpk(v[8 * c] * sc, v[8 * c + 1] * sc); o.y = cvtpk(v[8 * c + 2] * sc, v[8 * c + 3] * sc); o.z = cvtpk(v[8 * c + 4] * sc, v[8 * c + 5] * sc); o.w = cvtpk(v[8 * c + 6] * sc, v[8 * c + 7] * sc); srow[c ^ (lane & 7)] = o; }
    asm volatile("s_waitcnt lgkmcnt(0)" ::: "memory"); __builtin_amdgcn_wave_barrier();
    const int rr = lane >> 3, cc = lane & 7;
#pragma unroll
    for (int j = 0; j < 8; ++j) { const int R = 8 * j + rr, nn = 64 * nb + R;
        const u32x4 o = *(const LAS u32x4*)(stg + R * 128 + 16 * (cc ^ rr));
        if (nn < N) CONV_ST((u32x4*)(WT + (size_t)map.row(nn) * K + k0 + 8 * cc), o); }
    asm volatile("s_waitcnt lgkmcnt(0)" ::: "memory"); __builtin_amdgcn_wave_barrier();
}
constexpr int I_G = (DM / 64) * (FF / 64), I_D = (FF / 64) * (DM / 64), I_IN = (DM / 64) * ((3344 + 63) / 64), I_OUT = (DM / 64) * (DM / 64);
constexpr int R_GU1 = 0, R_D1 = 2 * I_G, R_IN = R_D1 + I_D, R_OUT = R_IN + I_IN, R_GU2 = R_OUT + I_OUT, R_D2 = R_GU2 + 2 * I_G, R_END = R_D2 + I_D;
__device__ __forceinline__ void convert_items(Frame& F, int l, int r_lo, int r_hi, int gw, int NGW) {
    bf16_t* WL = (bf16_t*)(F.ws + WS_W + (size_t)l * W_LAYER);
    for (int it = r_lo + gw; it < r_hi; it += NGW) {
        int r = it;
        if (r < I_G) { p0_transpose_item(F.in[2] + (size_t)l * DM * FF, DM, FF, (bf16_t*)((char*)WL + W_GU1), r, F.lane, F.in[1] + l * DM, MapGU{0}, F.lds + F.wave * 8192); continue; } r -= I_G;
        if (r < I_G) { p0_transpose_item(F.in[3] + (size_t)l * DM * FF, DM, FF, (bf16_t*)((char*)WL + W_GU1), r, F.lane, F.in[1] + l * DM, MapGU{128}, F.lds + F.wave * 8192); continue; } r -= I_G;
        if (r < I_D) { p0_transpose_item(F.in[4] + (size_t)l * FF * DM, FF, DM, (bf16_t*)((char*)WL + W_D1), r, F.lane, nullptr, MapPlain{}, F.lds + F.wave * 8192); continue; } r -= I_D;
        if (r < I_IN) { p0_transpose_item(F.in[6] + (size_t)l * DM * 3344, DM, 3344, (bf16_t*)((char*)WL + W_IN), r, F.lane, F.in[5] + l * DM, MapIn{}, F.lds + F.wave * 8192); continue; } r -= I_IN;
        if (r < I_OUT) { p0_transpose_item(F.in[20] + (size_t)l * DM * DM, DM, DM, (bf16_t*)((char*)WL + W_OUT), r, F.lane, nullptr, MapPlain{}, F.lds + F.wave * 8192); continue; } r -= I_OUT;
        if (r < I_G) { p0_transpose_item(F.in[22] + (size_t)l * DM * FF, DM, FF, (bf16_t*)((char*)WL + W_GU2), r, F.lane, F.in[21] + l * DM, MapGU{0}, F.lds + F.wave * 8192); continue; } r -= I_G;
        if (r < I_G) { p0_transpose_item(F.in[23] + (size_t)l * DM * FF, DM, FF, (bf16_t*)((char*)WL + W_GU2), r, F.lane, F.in[21] + l * DM, MapGU{128}, F.lds + F.wave * 8192); continue; } r -= I_G;
        p0_transpose_item(F.in[24] + (size_t)l * FF * DM, FF, DM, (bf16_t*)((char*)WL + W_D2), r, F.lane, nullptr, MapPlain{}, F.lds + F.wave * 8192);
    }
    if (r_lo <= R_IN && R_IN < r_hi) {
        u32x4* z = (u32x4*)(F.ws + WS_W + (size_t)l * W_LAYER + W_IN + (size_t)(13 * 256 + 16) * DM * 2);
        const int n16 = 240 * DM * 2 / 16;
        unsigned z0 = 0u; asm volatile("" : "+v"(z0));
        for (int i = gw * 64 + F.lane; i < n16; i += NGW * 64) z[i] = (u32x4){z0, z0, z0, z0};
    }
}
__device__ __forceinline__ void side_convert(Frame& F, int l, int k) {
    if (F.G != 256) return;
    constexpr int R_SPLIT3 = R_END - (R_END - R_OUT) / 6;
    if ((int)blockIdx.x < 128) return;
    __syncthreads();
    const int gw = ((int)blockIdx.x - 128) * NWAVES + F.wave, NGW = 128 * NWAVES;
    if (l == 0 && k == 0) convert_items(F, 0, R_D1, R_OUT, gw, NGW);
    else if (l == 0 && k == 2) convert_items(F, 0, R_OUT, R_D2, gw, NGW);
    else if (l == 0 && k == 7) { convert_items(F, 0, R_D2, R_END, gw, NGW); convert_items(F, 1, R_GU1, R_D1, (gw + NGW - (R_END - R_D2) % NGW) % NGW, NGW); }
    else if (l == 1 && k == 0) convert_items(F, 1, R_D1, R_GU2, gw, NGW);
    else if (l == 1 && k == 2) convert_items(F, 1, R_GU2, R_D2, gw, NGW);
    else if (l == 1 && k == 7) convert_items(F, 1, R_D2, R_END, gw, NGW);
}
__device__ __forceinline__ void p0_prologue(Frame& F) {
    const int gw = F.vcu * NWAVES + F.wave, NGW = F.G * NWAVES;
    if (F.G == 256) convert_items(F, 0, R_GU1, R_D1, gw, NGW);
    else { convert_items(F, 0, 0, R_END, gw, NGW); convert_items(F, 1, 0, R_END, gw, NGW); }
    const float* x = F.in[0]; bf16_t* XB = (bf16_t*)(F.ws + WS_XB); float* SSQ = (float*)(F.ws + WS_SSQ);
    for (int m = gw; m < M_TOK; m += NGW) {
        const f32x4* xr = (const f32x4*)(x + (size_t)m * DM) + F.lane; float s = 0.f; f32x4 v[4];
#pragma unroll
        for (int j = 0; j < 4; ++j) { v[j] = xr[64 * j]; s += (v[j].x * v[j].x + v[j].y * v[j].y) + (v[j].z * v[j].z + v[j].w * v[j].w); }
        s = wave_sum(s);
        u32x2* o8 = (u32x2*)(XB + (size_t)m * DM) + F.lane;
#pragma unroll
        for (int j = 0; j < 4; ++j) o8[64 * j] = (u32x2){cvtpk(v[j].x, v[j].y), cvtpk(v[j].z, v[j].w)};
        if (F.lane < 16) SSQ[(size_t)m * 16 + F.lane] = (F.lane == 0) ? s : 0.f;
    }
}

__device__ __forceinline__ void rows_rs(const float* ssq, int rowbase, int fr, int fq, float (&rs)[8]) {
    f32x4 p[8];
#pragma unroll
    for (int i = 0; i < 8; ++i) { const int row = rowbase + (i >> 2) * 128 + (i & 3) * 16 + fr; p[i] = *(const f32x4*)(ssq + (size_t)row * 16 + 4 * fq); }
#pragma unroll
    for (int i = 0; i < 8; ++i) { float s = (p[i].x + p[i].y) + (p[i].z + p[i].w); s += __shfl_xor(s, 16); s += __shfl_xor(s, 32); rs[i] = rsqrtf(s * (1.0f / DM) + NORM_EPS); }
}
struct RowScale { f32x4 p[8]; float rs[8]; int pm; };
__device__ __forceinline__ void rowscale_load(RowScale& R, const float* ssq, const pg8::Unit& u, int wr, int fr, int fq) {
    R.pm = u.pm;
#pragma unroll
    for (int i = 0; i < 8; ++i) { const int row = u.pm * 256 + wr * 64 + (i >> 2) * 128 + (i & 3) * 16 + fr; R.p[i] = *(const f32x4*)(ssq + (size_t)row * 16 + 4 * fq); }
}
__device__ __forceinline__ void rowscale_finish(RowScale& R) {
#pragma unroll
    for (int i = 0; i < 8; ++i) { float s = (R.p[i].x + R.p[i].y) + (R.p[i].z + R.p[i].w); s += __shfl_xor(s, 16); s += __shfl_xor(s, 32); R.rs[i] = rsqrtf(s * (1.0f / DM) + NORM_EPS); asm volatile("" : "+v"(R.rs[i])); }
}
struct EpiNoInit { struct Raw {}; static constexpr bool HAS_INIT = false; __device__ __forceinline__ void init_load(Raw&, const pg8::Unit&, int, int, int, int) const {}
    struct Pre {}; __device__ __forceinline__ void pre_load(Pre&, const pg8::Unit&, int, int, int) const {} __device__ __forceinline__ void pre_finish(Pre&) const {} };
struct EpiSwiglu : EpiNoInit {
    bf16_t* H; const float* ssq;
    typedef RowScale Pre;
    __device__ __forceinline__ void pre_load(Pre& R, const pg8::Unit& u, int wr, int fr, int fq) const { rowscale_load(R, ssq, u, wr, fr, fq); }
    __device__ __forceinline__ void pre_finish(Pre& R) const { rowscale_finish(R); }
    __device__ __forceinline__ void operator()(const f32x4 (&acc)[2][2][4][2], const pg8::Unit& u, int wr, int wc, int fr, int fq, Pre& R) const {
        asm volatile("" : "+v"(fr), "+v"(fq));
        const int col0 = u.pn * 128 + wc * 32 + 8 * fq;
        if (u.pm != R.pm) { rowscale_load(R, ssq, u, wr, fr, fq); rowscale_finish(R); }
        const float (&rs)[8] = R.rs;
#pragma unroll
        for (int ai = 0; ai < 2; ++ai)
#pragma unroll
            for (int m = 0; m < 4; ++m) {
                const int row = u.pm * 256 + ai * 128 + wr * 64 + m * 16 + fr; const float r = rs[ai * 4 + m];
                float hv[8];
#pragma unroll
                for (int n = 0; n < 2; ++n)
#pragma unroll
                    for (int j = 0; j < 4; ++j) { const float g = acc[ai][0][m][n][j] * r, up = acc[ai][1][m][n][j] * r; hv[4 * n + j] = siluf_(g) * up; }
                u32x4 w; w.x = cvtpk(hv[0], hv[1]); w.y = cvtpk(hv[2], hv[3]); w.z = cvtpk(hv[4], hv[5]); w.w = cvtpk(hv[6], hv[7]);
                st16_wt(H + (size_t)row * FF + col0, w);
                if (m & 1) asm volatile("" ::: "memory");
            }
    }
};
template <bool FINAL>
struct EpiResid {
    struct Raw { u32x4 r[2][4][2]; };
    static constexpr bool HAS_INIT = true;
    struct Pre {}; __device__ __forceinline__ void pre_load(Pre&, const pg8::Unit&, int, int, int) const {} __device__ __forceinline__ void pre_finish(Pre&) const {}
    float* xout; bf16_t* XB; float* ssq; float alpha, ralpha;
    __device__ __forceinline__ void init_load(Raw& raw, const pg8::Unit& u, int wr, int wc, int fr, int fq) const {
        const int col0 = u.pn * 256 + wc * 32 + 8 * fq;
#pragma unroll
        for (int ai = 0; ai < 2; ++ai)
#pragma unroll
            for (int m = 0; m < 4; ++m) { const int row = u.pm * 256 + ai * 128 + wr * 64 + m * 16 + fr;
#pragma unroll
                for (int bj = 0; bj < 2; ++bj) raw.r[ai][m][bj] = *(const u32x4*)(XB + (size_t)row * DM + col0 + bj * 128); }
    }
    __device__ __forceinline__ void init_finish(const Raw& raw, f32x4 (&acc)[2][2][4][2]) const {
#pragma unroll
        for (int ai = 0; ai < 2; ++ai)
#pragma unroll
            for (int m = 0; m < 4; ++m)
#pragma unroll
                for (int bj = 0; bj < 2; ++bj) { const u32x4 w = raw.r[ai][m][bj];
                    acc[ai][bj][m][0] = (f32x4){bflo(w.x), bfhi(w.x), bflo(w.y), bfhi(w.y)} * ralpha; acc[ai][bj][m][1] = (f32x4){bflo(w.z), bfhi(w.z), bflo(w.w), bfhi(w.w)} * ralpha; }
    }
    __device__ __forceinline__ void operator()(const f32x4 (&acc)[2][2][4][2], const pg8::Unit& u, int wr, int wc, int fr, int fq, Pre&) const {
        asm volatile("" : "+v"(fr), "+v"(fq));
        const int col0 = u.pn * 256 + wc * 32 + 8 * fq;
#pragma unroll
        for (int ai = 0; ai < 2; ++ai)
#pragma unroll
            for (int m = 0; m < 4; ++m) {
                const int row = u.pm * 256 + ai * 128 + wr * 64 + m * 16 + fr; float ss = 0.f;
#pragma unroll
                for (int bj = 0; bj < 2; ++bj) {
                    const size_t off = (size_t)row * DM + col0 + bj * 128;
                    const f32x4 y0 = acc[ai][bj][m][0] * alpha, y1 = acc[ai][bj][m][1] * alpha;
                    if (FINAL) { *(f32x4*)(xout + off) = y0; *(f32x4*)(xout + off + 4) = y1; }
                    else {
                        ss += (y0.x * y0.x + y0.y * y0.y) + (y0.z * y0.z + y0.w * y0.w) + (y1.x * y1.x + y1.y * y1.y) + (y1.z * y1.z + y1.w * y1.w);
                        u32x4 w; w.x = cvtpk(y0.x, y0.y); w.y = cvtpk(y0.z, y0.w); w.z = cvtpk(y1.x, y1.y); w.w = cvtpk(y1.z, y1.w);
                        st16_wt(XB + off, w); }
                }
                if (!FINAL) { ss += __shfl_xor(ss, 16); ss += __shfl_xor(ss, 32);
                    if (fq == 0) ssq[(size_t)row * 16 + u.pn * 4 + wc] = ss; }
                if (m & 1) asm volatile("" ::: "memory");
            }
    }
};
struct EpiInProj : EpiNoInit {
    bf16_t* PROJ; float* GATES; const float* ssq; const float* qnw; const float* knw; const float* gbias; const float* dtb;
    template <int KIND>
    __device__ __forceinline__ void body(const f32x4 (&acc)[2][2][4][2], const pg8::Unit& u, int wr, int wc, int fr, int fq, const float (&rs)[8]) const {
        const int t = u.pn, colw = wc * 32 + 8 * fq;
        float nw[8];
        if (KIND == 3) { const float* w = (t == 10 ? qnw : knw) + (wc & 1) * 32 + 8 * fq; const float sc = (t == 10) ? (0.17677669529663687f * LOG2E) : 1.f;
#pragma unroll
            for (int i = 0; i < 8; ++i) nw[i] = w[i] * sc; }
#pragma unroll
        for (int ai = 0; ai < 2; ++ai)
#pragma unroll
            for (int m = 0; m < 4; ++m) {
                const int row = u.pm * 256 + ai * 128 + wr * 64 + m * 16 + fr; const float r = rs[ai * 4 + m];
#pragma unroll
                for (int bj = 0; bj < 2; ++bj) {
                    float v[8];
#pragma unroll
                    for (int n = 0; n < 2; ++n)
#pragma unroll
                        for (int j = 0; j < 4; ++j) v[4 * n + j] = acc[ai][bj][m][n][j] * r;
                    if (KIND == 1) {
#pragma unroll
                        for (int i = 0; i < 8; ++i) v[i] = sigmoidf_(v[i]);
                    } else if (KIND == 2) {
#pragma unroll
                        for (int i = 0; i < 8; ++i) v[i] = siluf_(v[i]);
                    } else if (KIND == 3) {
                        float ss = 0.f;
#pragma unroll
                        for (int i = 0; i < 8; ++i) ss += v[i] * v[i];
                        ss += __shfl_xor(ss, 16); ss += __shfl_xor(ss, 32);
                        const float q = rsqrtf(ss * (1.0f / 32.0f) + NORM_EPS);
#pragma unroll
                        for (int i = 0; i < 8; ++i) v[i] = v[i] * q * nw[i];
                    }
                    u32x4 w; w.x = cvtpk(v[0], v[1]); w.y = cvtpk(v[2], v[3]); w.z = cvtpk(v[4], v[5]); w.w = cvtpk(v[6], v[7]);
                    st16_wt(PROJ + (size_t)row * PLD + t * 256 + bj * 128 + colw, w);
                }
                if (m & 1) asm volatile("" ::: "memory");
            }
    }
    __device__ __forceinline__ void gates(const f32x4 (&acc)[2][2][4][2], const pg8::Unit& u, int wr, int wc, int fr, int fq, const float (&rs)[8]) const {
        if (wc != 0 || fq >= 2) return;
#pragma unroll
        for (int ai = 0; ai < 2; ++ai)
#pragma unroll
            for (int m = 0; m < 4; ++m) {
                const int row = u.pm * 256 + ai * 128 + wr * 64 + m * 16 + fr; const float r = rs[ai * 4 + m];
                float v[8], o[8];
#pragma unroll
                for (int n = 0; n < 2; ++n)
#pragma unroll
                    for (int j = 0; j < 4; ++j) v[4 * n + j] = acc[ai][0][m][n][j] * r;
                if (fq == 0) {
#pragma unroll
                    for (int j = 0; j < 4; ++j) { o[j] = v[j] + gbias[j]; const float z = v[4 + j] + gbias[4 + j]; o[4 + j] = fminf(z, 0.f) - fast_log1pexp(-fabsf(z)); }
                } else {
#pragma unroll
                    for (int j = 0; j < 8; ++j) { const float z = v[j] + dtb[j]; o[j] = fmaxf(z, 0.f) + fast_log1pexp(-fabsf(z)); }
                }
                float* gp = GATES + (size_t)row * 16 + 8 * fq;
                *(f32x4*)gp = (f32x4){o[0], o[1], o[2], o[3]}; *(f32x4*)(gp + 4) = (f32x4){o[4], o[5], o[6], o[7]};
                asm volatile("" ::: "memory");
            }
    }
    typedef RowScale Pre;
    __device__ __forceinline__ void pre_load(Pre& R, const pg8::Unit& u, int wr, int fr, int fq) const { rowscale_load(R, ssq, u, wr, fr, fq); }
    __device__ __forceinline__ void pre_finish(Pre& R) const { rowscale_finish(R); }
    __device__ __forceinline__ void operator()(const f32x4 (&acc)[2][2][4][2], const pg8::Unit& u, int wr, int wc, int fr, int fq, Pre& R) const {
        asm volatile("" : "+v"(fr), "+v"(fq));
        if (u.pm != R.pm) { rowscale_load(R, ssq, u, wr, fr, fq); rowscale_finish(R); }
        const float (&rs)[8] = R.rs;
        const int t = u.pn;
        if (t == 13) gates(acc, u, wr, wc, fr, fq, rs);
        else if (t == 3) body<1>(acc, u, wr, wc, fr, fq, rs);
        else if (t == 4 || t == 5) body<2>(acc, u, wr, wc, fr, fq, rs);
        else if (t == 10 || t == 11) body<3>(acc, u, wr, wc, fr, fq, rs);
        else body<0>(acc, u, wr, wc, fr, fq, rs);
    }
};
#define MFMA16(a, b, c) __builtin_amdgcn_mfma_f32_16x16x32_bf16((a), (b), (c), 0, 0, 0)
#define WAVE_SYNC() do { asm volatile("s_waitcnt lgkmcnt(0)" ::: "memory"); __builtin_amdgcn_wave_barrier(); } while (0)
#define LDS_BARRIER() do { asm volatile("s_waitcnt lgkmcnt(0)" ::: "memory"); __builtin_amdgcn_s_barrier(); asm volatile("" ::: "memory"); } while (0)
__device__ __forceinline__ bf16x8 ld_g8(const bf16_t* p) { return *(const bf16x8*)p; }
__device__ __forceinline__ bf16x8 ld_l8(const LAS bf16_t* p) { return *(const LAS bf16x8*)p; }
__device__ __forceinline__ bf16x8 ld_l44(const LAS bf16_t* p0, const LAS bf16_t* p1) { const bf16x4 a = *(const LAS bf16x4*)p0, b = *(const LAS bf16x4*)p1; return (bf16x8){a[0], a[1], a[2], a[3], b[0], b[1], b[2], b[3]}; }
__device__ __forceinline__ bf16x8 pack8(const f32x4 a, const f32x4 b) { u32x4 w; w.x = cvtpk(a[0], a[1]); w.y = cvtpk(a[2], a[3]); w.z = cvtpk(b[0], b[1]); w.w = cvtpk(b[2], b[3]); return __builtin_bit_cast(bf16x8, w); }
__device__ __forceinline__ float wave_scan_incl(float v, int lane) {
#pragma unroll
    for (int o = 1; o < 64; o <<= 1) { const float t = __shfl_up(v, o); if (lane >= o) v += t; }
    return v;
}

typedef short v4i16_t __attribute__((ext_vector_type(4)));
__device__ __forceinline__ bf16x8 ld_tr8(const LAS bf16_t* T, int pitch, int k0, int c0, int lane) {
    const int i = lane & 15, fq = lane >> 4;
    const LAS bf16_t* p = T + (k0 + 8 * fq + (i >> 2)) * pitch + c0 + 4 * (i & 3);
    const v4i16_t lo = __builtin_amdgcn_ds_read_tr16_b64_v4i16((LAS v4i16_t*)p), hi = __builtin_amdgcn_ds_read_tr16_b64_v4i16((LAS v4i16_t*)(p + 4 * pitch));
    return (bf16x8){lo[0], lo[1], lo[2], lo[3], hi[0], hi[1], hi[2], hi[3]};
}
__device__ __forceinline__ bf16x8 ld_tr8p(const LAS bf16_t* T, int pitch, int k0, int c0, int lane) {
    const int i = lane & 15, fq = lane >> 4;
    const LAS bf16_t* p = T + (k0 + 4 * fq + (i >> 2)) * pitch + c0 + 4 * (i & 3);
    const v4i16_t lo = __builtin_amdgcn_ds_read_tr16_b64_v4i16((LAS v4i16_t*)p), hi = __builtin_amdgcn_ds_read_tr16_b64_v4i16((LAS v4i16_t*)(p + 16 * pitch));
    return (bf16x8){lo[0], lo[1], lo[2], lo[3], hi[0], hi[1], hi[2], hi[3]};
}

__device__ __forceinline__ void conv_phase(Frame& F, int l) {
    const bf16_t* PROJ = (const bf16_t*)(F.ws + WS_PROJ); bf16_t* XACT = (bf16_t*)F.in[25];
    const float* cw = F.in[9] + (size_t)l * 4 * 1024; const float* cb = F.in[10] + (size_t)l * 1024;
    for (int g = F.vcu * NTHREADS + F.tid; g < 1024 * 128; g += F.G * NTHREADS) {
        const int cg = g & 127, rb = g >> 7, ch0 = cg * 8, row0 = rb * 16;
        float w[4][8], bs[8];
#pragma unroll
        for (int j = 0; j < 4; ++j) { const f32x4 a = *(const f32x4*)(cw + j * 1024 + ch0), b = *(const f32x4*)(cw + j * 1024 + ch0 + 4);
            w[j][0] = a.x; w[j][1] = a.y; w[j][2] = a.z; w[j][3] = a.w; w[j][4] = b.x; w[j][5] = b.y; w[j][6] = b.z; w[j][7] = b.w; }
        { const f32x4 a = *(const f32x4*)(cb + ch0), b = *(const f32x4*)(cb + ch0 + 4); bs[0] = a.x; bs[1] = a.y; bs[2] = a.z; bs[3] = a.w; bs[4] = b.x; bs[5] = b.y; bs[6] = b.z; bs[7] = b.w; }
        float h3[8], h2[8], h1[8];
        const bool first = (row0 % SEQ) == 0;
        const bf16_t* src = PROJ + (size_t)row0 * PLD + PX + ch0;
        if (first) {
#pragma unroll
            for (int e = 0; e < 8; ++e) { h3[e] = 0.f; h2[e] = 0.f; h1[e] = 0.f; }
        } else {
            const u32x4 a = *(const u32x4*)(src - 3 * (size_t)PLD), b = *(const u32x4*)(src - 2 * (size_t)PLD), c = *(const u32x4*)(src - (size_t)PLD);
#pragma unroll
            for (int e = 0; e < 4; ++e) { h3[2 * e] = bflo(a[e]); h3[2 * e + 1] = bfhi(a[e]); h2[2 * e] = bflo(b[e]); h2[2 * e + 1] = bfhi(b[e]); h1[2 * e] = bflo(c[e]); h1[2 * e + 1] = bfhi(c[e]); }
        }
        u32x4 dr[16];
#pragma unroll
        for (int i = 0; i < 16; ++i) dr[i] = *(const u32x4*)(src + (size_t)i * PLD);
#pragma unroll
        for (int i = 0; i < 16; ++i) {
            const u32x4 d = dr[i]; float cur[8], o[8];
#pragma unroll
            for (int e = 0; e < 4; ++e) { cur[2 * e] = bflo(d[e]); cur[2 * e + 1] = bfhi(d[e]); }
#pragma unroll
            for (int e = 0; e < 8; ++e) { const float s = bs[e] + w[0][e] * h3[e] + w[1][e] * h2[e] + w[2][e] * h1[e] + w[3][e] * cur[e]; o[e] = siluf_(s); h3[e] = h2[e]; h2[e] = h1[e]; h1[e] = cur[e]; }
            u32x4 ow; ow.x = cvtpk(o[0], o[1]); ow.y = cvtpk(o[2], o[3]); ow.z = cvtpk(o[4], o[5]); ow.w = cvtpk(o[6], o[7]);
            *(u32x4*)(XACT + (size_t)(row0 + i) * 1024 + ch0) = ow;
        }
    }
}

__device__ __forceinline__ void mlstm_state_item(Frame& F, int bh) {
    const int b = bh >> 2, h = bh & 3, w = F.wave, vq = w & 3, dh = w >> 2, lane = F.lane, fr = lane & 15, fq = lane >> 4, tid = F.tid;
    constexpr int MP = 72, MBUF = 2 * 64 * MP * 2 + 128;
    LAS float* WG = (LAS float*)(F.lds + 2 * MBUF); LAS float* DEC = WG + 4096;
    const bf16_t* PROJ = (const bf16_t*)(F.ws + WS_PROJ); const float* GATES = (const float*)(F.ws + WS_GATES);
    bf16_t* CST = (bf16_t*)(F.ws + WS_CST); float* NST = (float*)(F.ws + WS_NST);
    const size_t rowb = (size_t)b * SEQ;
    {
        float igv[8], lfv[8];
#pragma unroll
        for (int i = 0; i < 8; ++i) { const float* gq = GATES + (rowb + 64 * (w + 8 * i) + lane) * 16 + h; igv[i] = gq[0]; lfv[i] = gq[4]; }
#pragma unroll
        for (int i = 0; i < 8; ++i) { const int c = w + 8 * i;
            const float bs = wave_scan_incl(lfv[i], lane); const float bl = __shfl(bs, 63);
            WG[64 * c + lane] = fast_exp(bl - bs + igv[i]); if (lane == 0) DEC[c] = fast_exp(bl); }
    }
    f32x4 acc[2], nacc[2];
    acc[0] = acc[1] = nacc[0] = nacc[1] = (f32x4){0.f, 0.f, 0.f, 0.f};
    const int ls = tid >> 3, lc = tid & 7;
    const bf16_t* kp = PROJ + (rowb + ls) * PLD + PK + h * 64 + 8 * lc; const bf16_t* vp = PROJ + (rowb + ls) * PLD + PV + h * 64 + 8 * lc;
    u32x4 k0, v0, k1, v1, k2, v2;
#define ML_LOAD(kr_, vr_, c_) do { const size_t o_ = (size_t)(c_) * 64 * PLD; kr_ = *(const u32x4*)(kp + o_); vr_ = *(const u32x4*)(vp + o_); } while (0)
#define ML_WRITE(kr_, vr_, c_) do { LAS bf16_t* KL_ = (LAS bf16_t*)(F.lds + ((c_) & 1) * MBUF); LAS bf16_t* VL_ = KL_ + 64 * MP; const float wg_ = WG[64 * (c_) + ls]; \
        *(LAS u32x4*)(KL_ + ls * MP + 8 * lc) = kr_; u32x4 o_; _Pragma("unroll") for (int e_ = 0; e_ < 4; ++e_) o_[e_] = cvtpk(wg_ * bflo(vr_[e_]), wg_ * bfhi(vr_[e_])); \
        *(LAS u32x4*)(VL_ + ls * MP + 8 * lc) = o_; if (lc == 0) (VL_ + 64 * MP)[ls] = f2bf(wg_); } while (0)
    LAS bf16_t* STG = (LAS bf16_t*)(F.lds + 2 * MBUF + 16384 + 256); LAS float* NSTG = (LAS float*)(STG + 2 * 4096);
#define ML_STAGE(c_) do { LAS bf16_t* sg_ = STG + ((c_) & 1) * 4096; \
        _Pragma("unroll") for (int dt = 0; dt < 2; ++dt) _Pragma("unroll") for (int r = 0; r < 4; ++r) sg_[(vq * 16 + 4 * fq + r) * 64 + dh * 32 + dt * 16 + fr] = f2bf(acc[dt][r]); \
        if (vq == 0 && fq == 0) { NSTG[((c_) & 1) * 64 + dh * 32 + fr] = nacc[0][0]; NSTG[((c_) & 1) * 64 + dh * 32 + 16 + fr] = nacc[1][0]; } } while (0)
    ML_LOAD(k0, v0, 0); ML_LOAD(k1, v1, 1); ML_LOAD(k2, v2, 2);
    __syncthreads();
    ML_WRITE(k0, v0, 0);
    ML_STAGE(0);
    LDS_BARRIER();
#define ML_STEP(KW, VW, KN, VN, c_) do { const int cc_ = (c_); const size_t ci = (size_t)bh * 64 + cc_; \
          \
        { const u32x4 st_ = *(const LAS u32x4*)(STG + ((cc_) & 1) * 4096 + tid * 8); *(u32x4*)(CST + ci * 4096 + tid * 8) = st_; \
          NST[ci * 64 + (tid & 63)] = NSTG[((cc_) & 1) * 64 + (tid & 63)]; }     \
        asm volatile("" ::: "memory"); \
        if (cc_ + 1 < 64) ML_WRITE(KW, VW, cc_ + 1); \
        asm volatile("" ::: "memory"); \
        ML_LOAD(KN, VN, (cc_ + 3 < 64 ? cc_ + 3 : 63)); \
        asm volatile("" ::: "memory"); \
        const float decay = DEC[cc_]; \
        const LAS bf16_t* KL = (const LAS bf16_t*)(F.lds + (cc_ & 1) * MBUF); const LAS bf16_t* VL = KL + 64 * MP; const LAS bf16_t* WV = VL + 64 * MP; \
        _Pragma("unroll") for (int dt = 0; dt < 2; ++dt) { acc[dt] = acc[dt] * decay; nacc[dt] = nacc[dt] * decay; } \
        _Pragma("unroll") for (int ks = 0; ks < 2; ++ks) { \
            const bf16x8 A = ld_tr8(VL, MP, 32 * ks, 16 * vq, lane); \
            bf16x8 An = ld_l8(WV + 32 * ks + 8 * fq); if (fr != 0) An = (bf16x8){0, 0, 0, 0, 0, 0, 0, 0}; \
            _Pragma("unroll") for (int dt = 0; dt < 2; ++dt) { const bf16x8 B = ld_tr8(KL, MP, 32 * ks, 32 * dh + 16 * dt, lane); \
                acc[dt] = MFMA16(A, B, acc[dt]); if (vq == 0) nacc[dt] = MFMA16(An, B, nacc[dt]); } } \
        ML_STAGE(cc_ + 1); \
        LDS_BARRIER(); } while (0)
    for (int c = 0; c < 63; c += 3) { ML_STEP(k1, v1, k0, v0, c); ML_STEP(k2, v2, k1, v1, c + 1); ML_STEP(k0, v0, k2, v2, c + 2); }
    ML_STEP(k1, v1, k0, v0, 63);
#undef ML_STEP
#undef ML_LOAD
#undef ML_WRITE
#undef ML_STAGE
}

template <int TH>
__device__ __forceinline__ void mlstm_out_wave(Frame& F, int l, int bc, int h) {
    const int b = bc >> 6, c = bc & 63, w = F.wave, lane = F.lane, fr = lane & 15, fq = lane >> 4;
    constexpr int VP = 72;
    LAS bf16_t* VL = (LAS bf16_t*)(F.lds + w * 12288); LAS float* BT_ = (LAS float*)(F.lds + w * 12288 + 9216); LAS float* GS = BT_ + 64;
    LAS bf16_t* YS = VL;
    const bf16_t* PROJ = (const bf16_t*)(F.ws + WS_PROJ); const float* GATES = (const float*)(F.ws + WS_GATES);
    const bf16_t* CST = (const bf16_t*)(F.ws + WS_CST); const float* NST = (const float*)(F.ws + WS_NST);
    bf16_t* Y = (bf16_t*)(F.ws + WS_PROJ) + PX;
    const size_t row0 = (size_t)b * SEQ + 64 * c; const size_t ci = (size_t)(b * 4 + h) * 64 + c;
    constexpr int NST_ = 2 * TH + 2, NKK = TH + 1;
    {
        const size_t row = row0 + lane;
        const float ig = GATES[row * 16 + h], lf = GATES[row * 16 + 4 + h];
        const bf16_t* vp = PROJ + row * PLD + PV + h * 64;
        u32x4 vr[8];
#pragma unroll
        for (int i = 0; i < 8; ++i) vr[i] = *(const u32x4*)(vp + 8 * i);
        const float bs = wave_scan_incl(lf, lane);
        BT_[lane] = bs; GS[lane] = ig - bs;
#pragma unroll
        for (int i = 0; i < 8; ++i) *(LAS u32x4*)(VL + lane * VP + 8 * i) = vr[i];
    }
    bf16x8 Qf[2][2], Kf[NST_][2];
#pragma unroll
    for (int tt = 0; tt < 2; ++tt)
#pragma unroll
        for (int ks = 0; ks < 2; ++ks) Qf[tt][ks] = ld_g8(PROJ + (row0 + 32 * TH + 16 * tt + fr) * PLD + PQ + h * 64 + 32 * ks + 8 * fq);
#pragma unroll
    for (int st = 0; st < NST_; ++st)
#pragma unroll
        for (int ks = 0; ks < 2; ++ks) Kf[st][ks] = ld_g8(PROJ + (row0 + 16 * st + fr) * PLD + PK + h * 64 + 32 * ks + 8 * fq);
    bf16x8 Cf[4][2];
#pragma unroll
    for (int vt = 0; vt < 4; ++vt)
#pragma unroll
        for (int ks = 0; ks < 2; ++ks) Cf[vt][ks] = ld_g8(CST + ci * 4096 + (16 * vt + fr) * 64 + 32 * ks + 8 * fq);
    u32x4 ogv[4];
#pragma unroll
    for (int i = 0; i < 4; ++i) ogv[i] = *(const u32x4*)(PROJ + (row0 + 32 * TH + (lane >> 3) + 8 * i) * PLD + PO + h * 64 + 8 * (lane & 7));
    f32x4 nv[2][2];
#pragma unroll
    for (int ks = 0; ks < 2; ++ks) { nv[ks][0] = *(const f32x4*)(NST + ci * 64 + 32 * ks + 8 * fq); nv[ks][1] = *(const f32x4*)(NST + ci * 64 + 32 * ks + 8 * fq + 4); }
    WAVE_SYNC();
    f32x4 P[2][NST_]; float den[2];
#pragma unroll
    for (int tt = 0; tt < 2; ++tt) {
        const int t = 32 * TH + 16 * tt + fr; const float bt = BT_[t]; float d1 = 0.f;
#pragma unroll
        for (int st = 0; st < NST_; ++st) {
            f32x4 s = (f32x4){0.f, 0.f, 0.f, 0.f};
#pragma unroll
            for (int ks = 0; ks < 2; ++ks) s = MFMA16(Kf[st][ks], Qf[tt][ks], s);
#pragma unroll
            for (int r = 0; r < 4; ++r) { const int sidx = 16 * st + 4 * fq + r; const float wv = (sidx <= t) ? s[r] * fast_exp(bt + GS[sidx]) : 0.f; s[r] = wv; d1 += wv; }
            P[tt][st] = s;
        }
        d1 += __shfl_xor(d1, 16); d1 += __shfl_xor(d1, 32);
        float d2 = 0.f;
#pragma unroll
        for (int ks = 0; ks < 2; ++ks) { const f32x4 n0 = nv[ks][0], n1 = nv[ks][1];
            const u32x4 qw = __builtin_bit_cast(u32x4, Qf[tt][ks]);
            d2 += bflo(qw.x) * n0.x + bfhi(qw.x) * n0.y + bflo(qw.y) * n0.z + bfhi(qw.y) * n0.w + bflo(qw.z) * n1.x + bfhi(qw.z) * n1.y + bflo(qw.w) * n1.z + bfhi(qw.w) * n1.w; }
        d2 += __shfl_xor(d2, 16); d2 += __shfl_xor(d2, 32);
        den[tt] = d1 + fast_exp(bt) * d2;
    }
    const float* nw = F.in[8] + (size_t)l * 256 + h * 64;
    f32x4 acc[2][4];
#pragma unroll
    for (int tt = 0; tt < 2; ++tt) {
#pragma unroll
        for (int vt = 0; vt < 4; ++vt) { acc[tt][vt] = (f32x4){0.f, 0.f, 0.f, 0.f};
#pragma unroll
            for (int ks = 0; ks < 2; ++ks) acc[tt][vt] = MFMA16(Qf[tt][ks], Cf[vt][ks], acc[tt][vt]); }
        float eb[4], dr[4];
#pragma unroll
        for (int r = 0; r < 4; ++r) { eb[r] = fast_exp(BT_[32 * TH + 16 * tt + 4 * fq + r]); dr[r] = __shfl(den[tt], 4 * fq + r); }
#pragma unroll
        for (int vt = 0; vt < 4; ++vt)
#pragma unroll
            for (int r = 0; r < 4; ++r) acc[tt][vt][r] *= eb[r];
#pragma unroll
        for (int kk = 0; kk < NKK; ++kk) { const bf16x8 PA = pack8(P[tt][2 * kk], P[tt][2 * kk + 1]);
            bf16x8 Bv[4];
#pragma unroll
            for (int vt = 0; vt < 4; ++vt) Bv[vt] = ld_tr8p(VL, VP, 32 * kk, 16 * vt, lane);
#pragma unroll
            for (int vt = 0; vt < 4; ++vt) acc[tt][vt] = MFMA16(PA, Bv[vt], acc[tt][vt]); }
#pragma unroll
        for (int r = 0; r < 4; ++r) { const float inv = fast_rcp(fmaxf(fabsf(dr[r]), 1.0f)); float s = 0.f;
#pragma unroll
            for (int vt = 0; vt < 4; ++vt) { acc[tt][vt][r] *= inv; s += acc[tt][vt][r] * acc[tt][vt][r]; }
            s += __shfl_xor(s, 1); s += __shfl_xor(s, 2); s += __shfl_xor(s, 4); s += __shfl_xor(s, 8); const float rs = rsqrtf(s * (1.0f / 64.0f) + NORM_EPS);
#pragma unroll
            for (int vt = 0; vt < 4; ++vt) acc[tt][vt][r] *= rs * nw[16 * vt + fr]; }
    }
    WAVE_SYNC();
#pragma unroll
    for (int tt = 0; tt < 2; ++tt)
#pragma unroll
        for (int vt = 0; vt < 4; ++vt)
#pragma unroll
            for (int r = 0; r < 4; ++r) YS[(16 * tt + 4 * fq + r) * VP + 16 * vt + fr] = f2bf(acc[tt][vt][r]);
    WAVE_SYNC();
#pragma unroll
    for (int i = 0; i < 4; ++i) { const int tr_ = (lane >> 3) + 8 * i, ch = lane & 7; const size_t row = row0 + 32 * TH + tr_;
        const u32x4 yv = *(const LAS u32x4*)(YS + tr_ * VP + 8 * ch); const u32x4 gv = ogv[i]; u32x4 o;
#pragma unroll
        for (int e = 0; e < 4; ++e) o[e] = cvtpk(bflo(yv[e]) * bflo(gv[e]), bfhi(yv[e]) * bfhi(gv[e]));
        *(u32x4*)(Y + row * PLD + h * 64 + 8 * ch) = o; }
    WAVE_SYNC();
}
__device__ __forceinline__ void mlstm_out_item(Frame& F, int l, int bc) {
    const int h = F.wave >> 1;
    if (F.wave & 1) mlstm_out_wave<1>(F, l, bc, h); else mlstm_out_wave<0>(F, l, bc, h);
}
typedef float f32x16 __attribute__((ext_vector_type(16)));
#define MFMA32(a, b, c) __builtin_amdgcn_mfma_f32_32x32x16_bf16((a), (b), (c), 0, 0, 0)
constexpr int AK_STR = 72, AV_STR = 96;
constexpr int ATT_KB = 128 * AK_STR * 2, ATT_VB = 128 * AV_STR * 2, ATT_BUF = ATT_KB + ATT_VB;
constexpr int ATT_TAB_OFF = 2 * ATT_BUF;
__device__ __forceinline__ int t5_bucket(int n) {
    if (n < 16) return n;
    int bk = 16;
    bk += (n >= 19); bk += (n >= 21); bk += (n >= 24); bk += (n >= 27); bk += (n >= 31); bk += (n >= 35); bk += (n >= 40); bk += (n >= 46);
    bk += (n >= 52); bk += (n >= 59); bk += (n >= 67); bk += (n >= 77); bk += (n >= 87); bk += (n >= 99); bk += (n >= 113);
    return bk;
}
__device__ __forceinline__ int crow16(int reg, int hi) { return (reg & 3) + 8 * (reg >> 2) + 4 * hi; }
__device__ __forceinline__ bf16x8 pack8r(const f32x16& p, const int s) { u32x4 w; w.x = cvtpk(p[8 * s], p[8 * s + 1]); w.y = cvtpk(p[8 * s + 2], p[8 * s + 3]); w.z = cvtpk(p[8 * s + 4], p[8 * s + 5]); w.w = cvtpk(p[8 * s + 6], p[8 * s + 7]); return __builtin_bit_cast(bf16x8, w); }
__device__ __forceinline__ void epilogue_attn(Frame& F, int l, int bh, int qi, f32x16 (&O1)[2], f32x16 (&O2)[2], float l1, float l2);
__device__ __forceinline__ void attn_item(Frame& F, int l, int bh, int qi, const bool prefetch_next) {
    const int b = bh >> 2, h = bh & 3, w = F.wave, lane = F.lane, tid = F.tid, r32 = lane & 31, hi = lane >> 5, qq = w & 3, kh = w >> 2;
#ifdef PROBE_A
    const unsigned long long tp0_ = __builtin_amdgcn_s_memrealtime();
#endif
    const bf16_t* PROJ = (const bf16_t*)(F.ws + WS_PROJ); bf16_t* Y = (bf16_t*)(F.ws + WS_PROJ) + PX;
    LAS float* TAB = (LAS float*)(F.lds + ATT_TAB_OFF);
    LAS bf16_t* QL = (LAS bf16_t*)(F.lds + ATT_TAB_OFF + 2048);
    const size_t row0 = (size_t)b * SEQ; const int q0 = qi * 128;
    unsigned nxq_ = 0u; if (prefetch_next && qi < 2 && tid == 0) nxq_ = xb_add(F.ctl + CW_Q + 64 * (2 * l), 1u);
    if (tid < 384) { const int rel = tid - 128; const float cf = F.in[19][31 * 4 + h]; TAB[tid] = rel < 0 ? -1e30f : (F.in[19][t5_bucket(rel) * 4 + h] - cf) * LOG2E; }
    const int npairs = qi + 1;
    const int lk = tid >> 3, lc = tid & 7;
    const bf16_t* kg = PROJ + (row0 + lk) * PLD + PDK + h * 64 + 8 * lc; const bf16_t* vg = PROJ + (row0 + lk) * PLD + PDV + h * 64 + 8 * lc;
    u32x4 ka0, ka1, va0, va1;
#define ATT_WRITE(k0_, k1_, v0_, v1_, buf) do { LAS bf16_t* KL_ = (LAS bf16_t*)(F.lds + (buf) * ATT_BUF); LAS bf16_t* VL_ = (LAS bf16_t*)(F.lds + (buf) * ATT_BUF + ATT_KB); \
        *(LAS u32x4*)(KL_ + lk * AK_STR + 8 * lc) = k0_; *(LAS u32x4*)(KL_ + (lk + 64) * AK_STR + 8 * lc) = k1_; \
        *(LAS u32x4*)(VL_ + lk * AV_STR + 8 * lc) = v0_; *(LAS u32x4*)(VL_ + (lk + 64) * AV_STR + 8 * lc) = v1_; } while (0)
#define ATT_LOAD(k0_, k1_, v0_, v1_, p) do { const size_t o_ = (size_t)(p) * 128 * PLD; k0_ = *(const u32x4*)(kg + o_); k1_ = *(const u32x4*)(kg + o_ + (size_t)64 * PLD); v0_ = *(const u32x4*)(vg + o_); v1_ = *(const u32x4*)(vg + o_ + (size_t)64 * PLD); } while (0)
    ATT_LOAD(ka0, ka1, va0, va1, 0);
    {
        const bf16_t* qg = PROJ + (row0 + q0 + lk) * PLD + PDQ + h * 64 + 8 * lc;
        const u32x4 q0r = *(const u32x4*)qg, q1r = *(const u32x4*)(qg + (size_t)64 * PLD);
        *(LAS u32x4*)(QL + lk * AK_STR + 8 * lc) = q0r; *(LAS u32x4*)(QL + (lk + 64) * AK_STR + 8 * lc) = q1r; }
    ATT_WRITE(ka0, ka1, va0, va1, 0);
    if (npairs > 1) ATT_LOAD(ka0, ka1, va0, va1, 1);
    const int qrow = q0 + 32 * qq + r32;
    f32x16 O1[2], O2[2];
#pragma unroll
    for (int i = 0; i < 16; ++i) { O1[0][i] = 0.f; O1[1][i] = 0.f; O2[0][i] = 0.f; O2[1][i] = 0.f; }
    f32x4 L1 = {0.f, 0.f, 0.f, 0.f}, L2 = {0.f, 0.f, 0.f, 0.f};
    __syncthreads();
    const f32x16 cinit = {0.f, 0.f, 0.f, 0.f, 0.f, 0.f, 0.f, 0.f, 0.f, 0.f, 0.f, 0.f, 0.f, 0.f, 0.f, 0.f};
    const int vlane = (4 * hi + ((lane & 15) >> 2)) * AV_STR + 16 * ((lane >> 4) & 1) + 4 * (lane & 3);
    const LAS bf16_t* qlp = QL + (32 * qq + r32) * AK_STR + 8 * hi;
#ifdef PROBE_SECTIONS
    unsigned long long dA_ = 0, dB_ = 0, dC_ = 0;
#define ATT_T(x_) const unsigned long long x_ = __builtin_amdgcn_s_memtime()
#define ATT_TW(x_) asm volatile("s_waitcnt lgkmcnt(0)" ::: "memory"); const unsigned long long x_ = __builtin_amdgcn_s_memtime()
#define ATT_TACC() do { dA_ += tb_ - ta_; dB_ += tc_ - tb_; dC_ += td_ - tc_; } while (0)
#else
#define ATT_T(x_) do {} while (0)
#define ATT_TW(x_) do {} while (0)
#define ATT_TACC() do {} while (0)
#endif
#define ATT_EXP(S1_, S2_, sub_, NEAR_) do { \
        _Pragma("unroll") for (int r = 0; r < 16; ++r) { S1_[r] = __builtin_amdgcn_exp2f(S1_[r]); S2_[r] = __builtin_amdgcn_exp2f(S2_[r]); } \
        _Pragma("unroll") for (int r = 0; r < 16; r += 4) { L1 += (f32x4){S1_[r], S1_[r + 1], S1_[r + 2], S1_[r + 3]}; L2 += (f32x4){S2_[r], S2_[r + 1], S2_[r + 2], S2_[r + 3]}; } } while (0)
#define ATT_VLOAD(Vf_, sub_) do { _Pragma("unroll") for (int s = 0; s < 2; ++s) _Pragma("unroll") for (int vt = 0; vt < 2; ++vt) { const LAS bf16_t* vp = VL + (32 * (sub_) + 16 * s) * AV_STR + 32 * vt + vlane; \
            const v4i16_t lo = __builtin_amdgcn_ds_read_tr16_b64_v4i16((LAS v4i16_t*)vp), hi4 = __builtin_amdgcn_ds_read_tr16_b64_v4i16((LAS v4i16_t*)(vp + 8 * AV_STR)); \
            Vf_[s][vt] = (bf16x8){lo[0], lo[1], lo[2], lo[3], hi4[0], hi4[1], hi4[2], hi4[3]}; } } while (0)
#define ATT_PV(S1_, S2_, Vf_) do { _Pragma("unroll") for (int s = 0; s < 2; ++s) { const bf16x8 PA1 = pack8r(S1_, s), PA2 = pack8r(S2_, s); \
            _Pragma("unroll") for (int vt = 0; vt < 2; ++vt) { O1[vt] = MFMA32(PA1, Vf_[s][vt], O1[vt]); O2[vt] = MFMA32(PA2, Vf_[s][vt], O2[vt]); } } } while (0)
#define ATT_ITER(k0_, k1_, v0_, v1_, p_, NEAR_) do { const int p = (p_); ATT_T(ta_); \
        if (kh == 0 && p + 1 < npairs) { ATT_WRITE(k0_, k1_, v0_, v1_, (p + 1) & 1); }     \
        if (!(NEAR_) && prefetch_next && p + 2 == qi && tid == 0) nxq_ = xb_add(F.ctl + CW_Q + 64 * (2 * l), 1u);     \
        if (kh == 0 && p + 2 < npairs) { ATT_LOAD(k0_, k1_, v0_, v1_, p + 2); } \
        ATT_TW(tb_); \
        const int k0 = 128 * p + 64 * kh; \
        if (!(NEAR_) || k0 <= q0 + 32 * qq + 31) { \
            const LAS bf16_t* KL = (const LAS bf16_t*)(F.lds + (p & 1) * ATT_BUF) + 64 * kh * AK_STR; const LAS bf16_t* VL = (const LAS bf16_t*)(F.lds + (p & 1) * ATT_BUF + ATT_KB) + 64 * kh * AV_STR; \
            f32x16 SA1, SA2, SB1, SB2, CA = cinit, CB = cinit; \
            if (NEAR_) { const LAS float* tb_ = TAB + (qrow - 4 * hi - k0 + 101);     \
                _Pragma("unroll") for (int r = 0; r < 16; ++r) { CA[r] = tb_[27 - ((r & 3) + 8 * (r >> 2))]; CB[r] = tb_[27 - 32 - ((r & 3) + 8 * (r >> 2))]; } } \
            {   const bf16x8 Q00 = ld_l8(qlp), Q01 = ld_l8(qlp + 16), Q10 = ld_l8(qlp + 32), Q11 = ld_l8(qlp + 48); \
                const LAS bf16_t* kp = KL + r32 * AK_STR + 8 * hi; \
                const bf16x8 a10 = ld_l8(kp), a11 = ld_l8(kp + 16), a20 = ld_l8(kp + 32), a21 = ld_l8(kp + 48); \
                const bf16x8 b10 = ld_l8(kp + 32 * AK_STR), b11 = ld_l8(kp + 32 * AK_STR + 16), b20 = ld_l8(kp + 32 * AK_STR + 32), b21 = ld_l8(kp + 32 * AK_STR + 48); \
                SA1 = MFMA32(a10, Q00, CA); SA2 = MFMA32(a20, Q10, CA); SA1 = MFMA32(a11, Q01, SA1); SA2 = MFMA32(a21, Q11, SA2); \
                SB1 = MFMA32(b10, Q00, CB); SB2 = MFMA32(b20, Q10, CB); SB1 = MFMA32(b11, Q01, SB1); SB2 = MFMA32(b21, Q11, SB2); } \
            bf16x8 Vf[2][2], Vg[2][2]; \
            ATT_VLOAD(Vf, 0); ATT_VLOAD(Vg, 1); \
            ATT_EXP(SA1, SA2, 0, NEAR_); \
            ATT_PV(SA1, SA2, Vf); \
            ATT_EXP(SB1, SB2, 1, NEAR_); \
            ATT_PV(SB1, SB2, Vg); \
            {   \
                __builtin_amdgcn_sched_group_barrier(0x8, 4, 0); \
                _Pragma("unroll") for (int g_ = 0; g_ < 4; ++g_) { __builtin_amdgcn_sched_group_barrier(0x8, 1, 0); __builtin_amdgcn_sched_group_barrier(0x400, 8, 0); } \
                __builtin_amdgcn_sched_group_barrier(0x2, 24, 0); \
                _Pragma("unroll") for (int g_ = 0; g_ < 8; ++g_) { __builtin_amdgcn_sched_group_barrier(0x8, 1, 0); __builtin_amdgcn_sched_group_barrier(0x400, 4, 0); __builtin_amdgcn_sched_group_barrier(0x2, 2, 0); } } \
        } \
        ATT_T(tc_); \
        if (kh == 1 && p + 1 < npairs) { ATT_WRITE(k0_, k1_, v0_, v1_, (p + 1) & 1); } \
        if (kh == 1 && p + 2 < npairs) { ATT_LOAD(k0_, k1_, v0_, v1_, p + 2); } \
        LDS_BARRIER(); ATT_T(td_); ATT_TACC(); } while (0)
#ifdef PROBE_A
    if (lane == 0) atomicMax(F.ctl + 32768 + 64 * (11 + 16 * l), (unsigned)(__builtin_amdgcn_s_memrealtime() - tp0_));
#endif
    int pp = 0;
    for (; pp + 1 < qi; ++pp) ATT_ITER(ka0, ka1, va0, va1, pp, 0);
    for (; pp < npairs; ++pp) ATT_ITER(ka0, ka1, va0, va1, pp, 1);
    if (prefetch_next && tid == 0) F.MISC[17] = nxq_;
#undef ATT_EXP
#undef ATT_VLOAD
#undef ATT_PV
#undef ATT_ITER
#ifdef PROBE_SECTIONS
    if (qi == 31 && lane == 0) { atomicMax(F.ctl + 32768 + 64 * (8 + 16 * l), (unsigned)(dA_ / 32) * 10u); atomicMax(F.ctl + 32768 + 64 * (9 + 16 * l), (unsigned)(dB_ / 32) * 10u); atomicMax(F.ctl + 32768 + 64 * (10 + 16 * l), (unsigned)(dC_ / 32) * 10u); }
#endif
#undef ATT_WRITE
#undef ATT_LOAD
    float l1 = (L1.x + L1.y) + (L1.z + L1.w), l2 = (L2.x + L2.y) + (L2.z + L2.w);
    epilogue_attn(F, l, bh, qi, O1, O2, l1, l2);
}
__device__ __forceinline__ void epilogue_attn(Frame& F, int l, int bh, int qi, f32x16 (&O1)[2], f32x16 (&O2)[2], float l1, float l2) {
    int t3 = threadIdx.x; asm volatile("" : "+v"(t3));
    const int lane = t3 & 63, w = __builtin_amdgcn_readfirstlane(t3 >> 6), r32 = lane & 31, hi = lane >> 5, qq = w & 3, kh = w >> 2, b = bh >> 2, h = bh & 3;
    bf16_t* Y = (bf16_t*)(F.ws + WS_PROJ) + PX;
    const size_t row0 = (size_t)b * SEQ; const int q0 = qi * 128;
    LAS float* XCH = (LAS float*)F.lds + (size_t)qq * 66 * 64 + lane;
    if (kh == 1) {
#pragma unroll
        for (int vt = 0; vt < 2; ++vt)
#pragma unroll
            for (int r = 0; r < 16; ++r) { XCH[(vt * 16 + r) * 64] = O1[vt][r]; XCH[(32 + vt * 16 + r) * 64] = O2[vt][r]; }
        XCH[64 * 64] = l1; XCH[65 * 64] = l2;
    }
    __syncthreads();
    if (kh == 0) {
        const float* lm = F.in[17] + (size_t)l * 128;
        float d1 = (lane < 32) ? lm[lane] * lm[32 + lane] : 0.f, d2 = (lane < 32) ? lm[64 + lane] * lm[96 + lane] : 0.f;
        d1 = wave_sum(d1); d2 = wave_sum(d2);
        int lq = l; asm volatile("" : "+s"(lq));
        const float lam_init = (lq == 0) ? 0.2f : 0.35550906759f;
        const float lam = __int_as_float(__builtin_amdgcn_readfirstlane(__float_as_int(fast_exp(d1) - fast_exp(d2) + lam_init)));
#pragma unroll
        for (int vt = 0; vt < 2; ++vt)
#pragma unroll
            for (int r = 0; r < 16; ++r) { O1[vt][r] += XCH[(vt * 16 + r) * 64]; O2[vt][r] += XCH[(32 + vt * 16 + r) * 64]; }
        l1 += XCH[64 * 64]; l2 += XCH[65 * 64];
        l1 += __shfl_xor(l1, 32); l2 += __shfl_xor(l2, 32);
        const float i1 = fast_rcp(l1), i2 = lam * fast_rcp(l2);
        const float* sw = F.in[18] + (size_t)l * 64; const float osc = 1.0f - lam_init;
        const float sw0 = sw[r32], sw1 = sw[32 + r32];
#pragma unroll
        for (int r = 0; r < 16; ++r) {
            const int qr = crow16(r, hi);
            const float a1 = __shfl(i1, qr), a2 = __shfl(i2, qr);
            const float o0 = O1[0][r] * a1 - O2[0][r] * a2, o1 = O1[1][r] * a1 - O2[1][r] * a2;
            float s = o0 * o0 + o1 * o1;
            s += __shfl_xor(s, 1); s += __shfl_xor(s, 2); s += __shfl_xor(s, 4); s += __shfl_xor(s, 8); s += __shfl_xor(s, 16);
            const float rs = rsqrtf(s * (1.0f / 64.0f) + NORM_EPS) * osc;
            const size_t row = row0 + q0 + 32 * qq + qr;
            Y[row * PLD + 768 + h * 64 + r32] = f2bf(o0 * rs * sw0); Y[row * PLD + 768 + h * 64 + 32 + r32] = f2bf(o1 * rs * sw1);
        }
    }
}

constexpr int SSD_STR = 136;
constexpr int SX_P = 72, SB_P = 136, SS_BUF = 128 * SX_P * 2 + 128 * SB_P * 2;
__device__ __forceinline__ void ssd_state_item(Frame& F, int l, int bhh) {
    const int b = bhh >> 3, hh = bhh & 7, g = hh >> 2, w = F.wave, lane = F.lane, fr = lane & 15, fq = lane >> 4, tid = F.tid;
    LAS float* XS = (LAS float*)(F.lds + 2 * SS_BUF); LAS float* CD = XS + 4096;
    const bf16_t* XACT = (const bf16_t*)F.in[25]; const float* GATES = (const float*)(F.ws + WS_GATES); bf16_t* SST = (bf16_t*)(F.ws + WS_SST);
    const float Ah = -expf(F.in[12][l * 8 + hh]);
    {   float d0v[4], d1v[4];
#pragma unroll
        for (int i = 0; i < 4; ++i) { const size_t r0 = (size_t)b * SEQ + 128 * (w + 8 * i); d0v[i] = GATES[(r0 + lane) * 16 + 8 + hh]; d1v[i] = GATES[(r0 + 64 + lane) * 16 + 8 + hh]; }
#pragma unroll
        for (int i = 0; i < 4; ++i) { const int c = w + 8 * i; const float dt0 = d0v[i], dt1 = d1v[i];
            const float s0 = wave_scan_incl(dt0 * Ah, lane); const float t0 = __shfl(s0, 63);
            const float s1 = wave_scan_incl(dt1 * Ah, lane) + t0; const float last = __shfl(s1, 63);
            XS[128 * c + lane] = dt0 * fast_exp(last - s0); XS[128 * c + 64 + lane] = dt1 * fast_exp(last - s1);
            if (lane == 0) CD[c] = fast_exp(last); }
    }
    const int pt = w & 3, nh = w >> 2;
    f32x4 acc[4];
#pragma unroll
    for (int j = 0; j < 4; ++j) acc[j] = (f32x4){0.f, 0.f, 0.f, 0.f};
    const bf16_t* xg = XACT + ((size_t)b * SEQ + (tid >> 3)) * 1024 + hh * 64 + 8 * (tid & 7);
    const bf16_t* bg = XACT + ((size_t)b * SEQ + (tid >> 4)) * 1024 + 512 + g * 128 + 8 * (tid & 15);
    u32x4 xa[2], ba[4], xb[2], bb[4], xc[2], bc[4];
#define SS_LOAD(xr, br, c_) do { const size_t o_ = (size_t)(c_) * 128 * 1024; xr[0] = *(const u32x4*)(xg + o_); xr[1] = *(const u32x4*)(xg + o_ + 64 * 1024); \
        _Pragma("unroll") for (int i_ = 0; i_ < 4; ++i_) br[i_] = *(const u32x4*)(bg + o_ + (size_t)i_ * 32 * 1024); } while (0)
#define SS_WRITE(xr, br, c_) do { LAS bf16_t* XL_ = (LAS bf16_t*)(F.lds + ((c_) & 1) * SS_BUF); LAS bf16_t* BL_ = XL_ + 128 * SX_P; \
        _Pragma("unroll") for (int i_ = 0; i_ < 2; ++i_) { const int s_ = (tid >> 3) + 64 * i_; const float sc_ = XS[128 * (c_) + s_]; u32x4 o_; \
            _Pragma("unroll") for (int e_ = 0; e_ < 4; ++e_) o_[e_] = cvtpk(sc_ * bflo(xr[i_][e_]), sc_ * bfhi(xr[i_][e_])); \
            *(LAS u32x4*)(XL_ + s_ * SX_P + 8 * (tid & 7)) = o_; } \
        _Pragma("unroll") for (int i_ = 0; i_ < 4; ++i_) *(LAS u32x4*)(BL_ + ((tid >> 4) + 32 * i_) * SB_P + 8 * (tid & 15)) = br[i_]; } while (0)
    LAS bf16_t* SSTG = (LAS bf16_t*)(F.lds + 2 * SS_BUF + 16384 + 128);
#define SS_STAGE(c_) do { LAS bf16_t* sg_ = SSTG + ((c_) & 1) * 8192; \
        _Pragma("unroll") for (int j = 0; j < 4; ++j) _Pragma("unroll") for (int r = 0; r < 4; ++r) sg_[(16 * pt + 4 * fq + r) * 128 + 16 * (4 * nh + j) + fr] = f2bf(acc[j][r]); } while (0)
    SS_LOAD(xa, ba, 0); SS_LOAD(xb, bb, 1); SS_LOAD(xc, bc, 2);
    __syncthreads();
    SS_WRITE(xa, ba, 0);
    SS_LOAD(xa, ba, 3);
    LDS_BARRIER();
#define SS_STEP(XW, BW, c_) do { const int cc_ = (c_); const size_t si = ((size_t)(b * 32 + cc_) * 8 + hh) * 8192; \
        _Pragma("unroll") for (int j = 0; j < 4; ++j) _Pragma("unroll") for (int r = 0; r < 4; ++r) SST[si + (16 * pt + 4 * fq + r) * 128 + 16 * (4 * nh + j) + fr] = f2bf(acc[j][r]); \
        asm volatile("" ::: "memory"); \
        if (cc_ + 1 < 32) { SS_WRITE(XW, BW, cc_ + 1); } \
        asm volatile("" ::: "memory"); \
        SS_LOAD(XW, BW, (cc_ + 4 < 32 ? cc_ + 4 : 31)); \
        asm volatile("" ::: "memory"); \
        const float cd = CD[cc_]; \
        _Pragma("unroll") for (int j = 0; j < 4; ++j) acc[j] = acc[j] * cd; \
        const LAS bf16_t* XL = (const LAS bf16_t*)(F.lds + (cc_ & 1) * SS_BUF); const LAS bf16_t* BL = XL + 128 * SX_P; \
        bf16x8 Af[4], Bf[4][4]; \
        _Pragma("unroll") for (int ks = 0; ks < 4; ++ks) { Af[ks] = ld_tr8(XL, SX_P, 32 * ks, 16 * pt, lane); \
            _Pragma("unroll") for (int j = 0; j < 4; ++j) Bf[ks][j] = ld_tr8(BL, SB_P, 32 * ks, 16 * (4 * nh + j), lane); } \
        asm volatile("s_waitcnt lgkmcnt(0)" ::: "memory"); __builtin_amdgcn_sched_barrier(0); \
        _Pragma("unroll") for (int ks = 0; ks < 4; ++ks) _Pragma("unroll") for (int j = 0; j < 4; ++j) acc[j] = MFMA16(Af[ks], Bf[ks][j], acc[j]); \
        LDS_BARRIER(); } while (0)
    for (int c = 0; c < 30; c += 3) { SS_STEP(xb, bb, c); SS_STEP(xc, bc, c + 1); SS_STEP(xa, ba, c + 2); }
    SS_STEP(xb, bb, 30); SS_STEP(xc, bc, 31);
#undef SS_STEP
#undef SS_STAGE
#undef SS_LOAD
#undef SS_WRITE
}

constexpr int SO_BP = 136, SO_XP = 72, SO_SP = 136, SO_YP = 264;
constexpr int SO_B_BYTES = 128 * SO_BP * 2, SO_H_BYTES = 128 * SO_XP * 2 + 64 * SO_SP * 2, SO_ACS_OFF = SO_B_BYTES + 2 * SO_H_BYTES;
__device__ __forceinline__ void ssd_out_item(Frame& F, int l, int it) {
    const int g = it & 1, c = (it >> 1) & 31, b = it >> 6, w = F.wave, lane = F.lane, fr = lane & 15, fq = lane >> 4, tid = F.tid;
    LAS bf16_t* BL = (LAS bf16_t*)F.lds;
    LAS float* ACS = (LAS float*)(F.lds + SO_ACS_OFF); LAS float* DTS = ACS + 512; LAS float* ETAB = DTS + 512; LAS float* REFS = ETAB + 512;
    const bf16_t* XACT = (const bf16_t*)F.in[25]; const float* GATES = (const float*)(F.ws + WS_GATES); const bf16_t* SST = (const bf16_t*)(F.ws + WS_SST);
    const bf16_t* PROJ = (const bf16_t*)(F.ws + WS_PROJ); bf16_t* Y = (bf16_t*)(F.ws + WS_PROJ) + PX;
    const size_t r0 = (size_t)b * SEQ + 128 * c;
    const float gdt0 = GATES[(r0 + lane) * 16 + 8 + g * 4 + (w & 3)], gdt1 = GATES[(r0 + 64 + lane) * 16 + 8 + g * 4 + (w & 3)];
    const bf16_t* bgp = XACT + (r0 + (tid >> 4)) * 1024 + 512 + g * 128 + 8 * (tid & 15);
    const bf16_t* xgp = XACT + (r0 + (tid >> 3)) * 1024 + g * 256 + 8 * (tid & 7);
    const bf16_t* sgp = SST + ((size_t)(b * 32 + c) * 8 + g * 4) * 8192 + (tid >> 4) * 128 + 8 * (tid & 15);
    u32x4 xr[2], sr[2];
#define SO_LOADH(hd_) do { xr[0] = *(const u32x4*)(xgp + (hd_) * 64); xr[1] = *(const u32x4*)(xgp + (hd_) * 64 + 64 * 1024); \
        sr[0] = *(const u32x4*)(sgp + (size_t)(hd_) * 8192); sr[1] = *(const u32x4*)(sgp + (size_t)(hd_) * 8192 + 32 * 128); } while (0)
#define SO_WRITEH(hd_) do { LAS bf16_t* XL_ = (LAS bf16_t*)(F.lds + SO_B_BYTES + ((hd_) & 1) * SO_H_BYTES); LAS bf16_t* SL_ = XL_ + 128 * SO_XP; \
        *(LAS u32x4*)(XL_ + (tid >> 3) * SO_XP + 8 * (tid & 7)) = xr[0]; *(LAS u32x4*)(XL_ + ((tid >> 3) + 64) * SO_XP + 8 * (tid & 7)) = xr[1]; \
        *(LAS u32x4*)(SL_ + (tid >> 4) * SO_SP + 8 * (tid & 15)) = sr[0]; *(LAS u32x4*)(SL_ + ((tid >> 4) + 32) * SO_SP + 8 * (tid & 15)) = sr[1]; } while (0)
    {   u32x4 br[4];
#pragma unroll
        for (int i = 0; i < 4; ++i) br[i] = *(const u32x4*)(bgp + (size_t)i * 32 * 1024);
        SO_LOADH(0);
#pragma unroll
        for (int i = 0; i < 4; ++i) *(LAS u32x4*)(BL + ((tid >> 4) + 32 * i) * SO_BP + 8 * (tid & 15)) = br[i];
        SO_WRITEH(0);
    }
    if (w < 4) {
        const int hh = g * 4 + w; const float Ah = -expf(F.in[12][l * 8 + hh]);
        const float dt0 = gdt0, dt1 = gdt1;
        const float s0 = wave_scan_incl(dt0 * Ah, lane); const float t0 = __shfl(s0, 63);
        const float s1 = wave_scan_incl(dt1 * Ah, lane) + t0;
        ACS[128 * w + lane] = s0; ACS[128 * w + 64 + lane] = s1; DTS[128 * w + lane] = dt0; DTS[128 * w + 64 + lane] = dt1;
        const float e0 = __shfl(s0, 31), e2 = __shfl(s1, 31), e3 = __shfl(s1, 63);
        ETAB[128 * w + lane] = fast_exp((lane < 32 ? e0 : t0) - s0) * dt0; ETAB[128 * w + 64 + lane] = fast_exp((lane < 32 ? e2 : e3) - s1) * dt1;
        if (lane == 0) { REFS[4 * w + 0] = e0; REFS[4 * w + 1] = t0; REFS[4 * w + 2] = e2; REFS[4 * w + 3] = e3; }
    }
    SO_LOADH(1);
    const int lrow = 16 * w + fr, nkk = (w >> 1) + 1;
    bf16x8 Cf[4];
#pragma unroll
    for (int ks = 0; ks < 4; ++ks) Cf[ks] = ld_g8(XACT + (r0 + lrow) * 1024 + 768 + g * 128 + 32 * ks + 8 * fq);
    asm volatile("" : "+v"(Cf[0]), "+v"(Cf[1]), "+v"(Cf[2]), "+v"(Cf[3]));
    LDS_BARRIER();
    f32x4 G[4][2];
#pragma unroll
    for (int kk = 0; kk < 4; ++kk) { G[kk][0] = (f32x4){0.f, 0.f, 0.f, 0.f}; G[kk][1] = (f32x4){0.f, 0.f, 0.f, 0.f};
        if (kk < nkk) {
            bf16x8 b0[4], b1[4];
#pragma unroll
            for (int ks = 0; ks < 4; ++ks) { b0[ks] = ld_l8(BL + (32 * kk + fr) * SO_BP + 32 * ks + 8 * fq); b1[ks] = ld_l8(BL + (32 * kk + 16 + fr) * SO_BP + 32 * ks + 8 * fq); }
#pragma unroll
            for (int ks = 0; ks < 4; ++ks) { G[kk][0] = MFMA16(b0[ks], Cf[ks], G[kk][0]); G[kk][1] = MFMA16(b1[ks], Cf[ks], G[kk][1]); } } }
    const float* Dk = F.in[13] + l * 8 + g * 4;
    f32x4 yacc[4][4];
#pragma unroll
    for (int hd = 0; hd < 4; ++hd) {
        const LAS bf16_t* XL = (const LAS bf16_t*)(F.lds + SO_B_BYTES + (hd & 1) * SO_H_BYTES); const LAS bf16_t* SL = XL + 128 * SO_XP;
        bf16x8 Sf[4][4];
#pragma unroll
        for (int pt = 0; pt < 4; ++pt)
#pragma unroll
            for (int ks = 0; ks < 4; ++ks) Sf[pt][ks] = ld_l8(SL + (16 * pt + fr) * SO_SP + 32 * ks + 8 * fq);
        float ea[4], xv[4][4];
#pragma unroll
        for (int r = 0; r < 4; ++r) ea[r] = fast_exp(ACS[128 * hd + 16 * w + 4 * fq + r]);
#pragma unroll
        for (int pt = 0; pt < 4; ++pt)
#pragma unroll
            for (int r = 0; r < 4; ++r) xv[pt][r] = bf2f(XL[(16 * w + 4 * fq + r) * SO_XP + 16 * pt + fr]);
        const float dsk = Dk[hd];
#pragma unroll
        for (int pt = 0; pt < 4; ++pt) { f32x4 a = (f32x4){0.f, 0.f, 0.f, 0.f};
#pragma unroll
            for (int ks = 0; ks < 4; ++ks) a = MFMA16(Cf[ks], Sf[pt][ks], a);
#pragma unroll
            for (int r = 0; r < 4; ++r) a[r] = a[r] * ea[r] + dsk * xv[pt][r];
            yacc[hd][pt] = a; }
        const float al = ACS[128 * hd + lrow];
#pragma unroll
        for (int kk = 0; kk < 4; ++kk) if (kk < nkk) {
            f32x4 P0, P1;
            if (kk + 1 < nkk) {
                const float fk = fast_exp(al - REFS[4 * hd + kk]);
#pragma unroll
                for (int r = 0; r < 4; ++r) { const int s0 = 32 * kk + 4 * fq + r; P0[r] = G[kk][0][r] * fk * ETAB[128 * hd + s0]; P1[r] = G[kk][1][r] * fk * ETAB[128 * hd + s0 + 16]; }
            } else {
#pragma unroll
                for (int r = 0; r < 4; ++r) { const int s0 = 32 * kk + 4 * fq + r, s1 = s0 + 16;
                    P0[r] = (s0 <= lrow) ? G[kk][0][r] * fast_exp(al - ACS[128 * hd + s0]) * DTS[128 * hd + s0] : 0.f;
                    P1[r] = (s1 <= lrow) ? G[kk][1][r] * fast_exp(al - ACS[128 * hd + s1]) * DTS[128 * hd + s1] : 0.f; }
            }
            const bf16x8 PA = pack8(P0, P1);
            bf16x8 Bx[4];
#pragma unroll
            for (int pt = 0; pt < 4; ++pt) Bx[pt] = ld_tr8p(XL, SO_XP, 32 * kk, 16 * pt, lane);
#pragma unroll
            for (int pt = 0; pt < 4; ++pt) yacc[hd][pt] = MFMA16(PA, Bx[pt], yacc[hd][pt]);
        }
        if (hd + 1 < 4) { SO_WRITEH(hd + 1); if (hd + 2 < 4) SO_LOADH(hd + 2); }
        LDS_BARRIER();
    }
#undef SO_LOADH
#undef SO_WRITEH
    const float* nw = F.in[14] + (size_t)l * 512 + g * 256; const int ch8 = 8 * (tid & 31);
    const f32x4 nw0 = *(const f32x4*)(nw + ch8), nw1 = *(const f32x4*)(nw + ch8 + 4);
    u32x4 zv8[8];
#pragma unroll
    for (int i = 0; i < 8; ++i) zv8[i] = *(const u32x4*)(PROJ + (r0 + (tid >> 5) + 16 * i) * PLD + PZ + g * 256 + ch8);
    LAS bf16_t* YL = (LAS bf16_t*)F.lds;
#pragma unroll
    for (int hd = 0; hd < 4; ++hd)
#pragma unroll
        for (int pt = 0; pt < 4; ++pt)
#pragma unroll
            for (int r = 0; r < 4; ++r) YL[(16 * w + 4 * fq + r) * SO_YP + hd * 64 + 16 * pt + fr] = f2bf(yacc[hd][pt][r]);
    LDS_BARRIER();
#pragma unroll
    for (int i = 0; i < 8; ++i) {
        const int lr = (tid >> 5) + 16 * i; const size_t row = r0 + lr;
        const u32x4 yv = *(const LAS u32x4*)(YL + lr * SO_YP + ch8); const u32x4 zv = zv8[i];
        float v[8]; float ss = 0.f;
#pragma unroll
        for (int e = 0; e < 4; ++e) { v[2 * e] = bflo(yv[e]) * bflo(zv[e]); v[2 * e + 1] = bfhi(yv[e]) * bfhi(zv[e]); ss += v[2 * e] * v[2 * e] + v[2 * e + 1] * v[2 * e + 1]; }
        ss += __shfl_xor(ss, 1); ss += __shfl_xor(ss, 2); ss += __shfl_xor(ss, 4); ss += __shfl_xor(ss, 8); ss += __shfl_xor(ss, 16);
        const float rs = rsqrtf(ss * (1.0f / 256.0f) + NORM_EPS);
        u32x4 o; o.x = cvtpk(v[0] * rs * nw0.x, v[1] * rs * nw0.y); o.y = cvtpk(v[2] * rs * nw0.z, v[3] * rs * nw0.w); o.z = cvtpk(v[4] * rs * nw1.x, v[5] * rs * nw1.y); o.w = cvtpk(v[6] * rs * nw1.z, v[7] * rs * nw1.w);
        *(u32x4*)(Y + row * PLD + 256 + g * 256 + ch8) = o;
    }
}
#ifndef PH_EN
#define PH_EN 1023
#endif
#ifndef MK_N_LAUNCHES
#define MK_N_LAUNCHES 1
#endif
constexpr int N_PHASES = 1 + 9 * DEPTH;
constexpr int NA1 = 512;
constexpr int CW_STAT = 32768;
#ifdef PROBE_A
#define ITEM_T0() const unsigned long long it0_ = __builtin_amdgcn_s_memrealtime()
#define ITEM_T1(k_) do { __syncthreads(); if (threadIdx.x == 0) atomicMax(F.ctl + CW_STAT + 64 * ((k_) + 16 * l), (unsigned)(__builtin_amdgcn_s_memrealtime() - it0_)); } while (0)
#define ITEM_TSUM(k_) do { if (threadIdx.x == 0) atomicAdd(F.ctl + CW_STAT + 64 * ((k_) + 16 * l), (unsigned)(__builtin_amdgcn_s_memrealtime() - it0_)); } while (0)
#else
#define ITEM_T0() do {} while (0)
#define ITEM_T1(k_) do {} while (0)
#define ITEM_TSUM(k_) do {} while (0)
#endif

__global__ void __launch_bounds__(NTHREADS, 2) hyb_fwd(Args args) {
    extern __shared__ __attribute__((aligned(16))) unsigned char lds_raw[];
    {   const int t0 = threadIdx.x;
        for (int u = t0; u < (LDS_BYTES - LDSCTL_OFF) / 4; u += NTHREADS) ((LAS unsigned*)((LAS unsigned char*)lds_raw + LDSCTL_OFF))[u] = 0u; }
    __syncthreads();
    const int ph_lo = args.ph_lo, ph_hi = args.ph_hi;
    const bool one_launch = (ph_hi - ph_lo) > 1;
    if (one_launch) { XcdBarrier b0 = xcd_barrier_post((unsigned*)(args.ws + WS_CTL) + CW_BAR, (volatile LAS unsigned*)((LAS unsigned char*)lds_raw + MISC_OFF) + 8); (void)b0; }
#ifdef PROBE_A
    unsigned long long t_prev = __builtin_amdgcn_s_memrealtime();
#endif
    for (int ph = ph_lo; ph < ph_hi; ++ph) {
        int tid_ = threadIdx.x; asm volatile("" : "+v"(tid_));
        kinptr_t kin = (kinptr_t)__builtin_amdgcn_kernarg_segment_ptr(); asm volatile("" : "+s"(kin));
        Frame F;
        F.lds = (LAS unsigned char*)lds_raw; F.MISC = (volatile LAS unsigned*)(F.lds + MISC_OFF);
        F.tid = tid_; F.lane = tid_ & 63; F.wave = __builtin_amdgcn_readfirstlane(tid_ >> 6);
        F.G = gridDim.x; { const int bx = blockIdx.x; F.vcu = (F.G % 8 == 0) ? (bx % 8) * (F.G / 8) + bx / 8 : bx; }
        F.in = kin;
        float* const outp = (float*)kin[25]; unsigned char* ws = (unsigned char*)kin[26];
        F.ws = ws; F.ctl = (unsigned*)(ws + WS_CTL);
        bf16_t* XB = (bf16_t*)(ws + WS_XB); bf16_t* PROJ = (bf16_t*)(ws + WS_PROJ); float* SSQ = (float*)(ws + WS_SSQ); float* GATES = (float*)(ws + WS_GATES);
        if (ph == 0) { if (PH_EN & 1) p0_prologue(F); }
        else {
            const int l = (ph - 1) / 9, k = (ph - 1) % 9;
            const unsigned char* WL = ws + WS_W + (size_t)l * W_LAYER;
            if ((PH_EN & 2) && (k == 0 || k == 7)) {
                pg8::Gemm g{XB, (const bf16_t*)(WL + (k == 0 ? W_GU1 : W_GU2)), M_TOK, NGU, DM, DM}; pg8::StaticOrder S; S.init(M_TOK, NGU, F.G, (int)blockIdx.x);
                EpiSwiglu E{{}, PROJ, SSQ};
                pg8::gemm_phase<EpiSwiglu, true, true>(F.lds, g, S, E, F.tid);
                { int t2 = threadIdx.x; asm volatile("" : "+v"(t2)); F.tid = t2; F.lane = t2 & 63; F.wave = __builtin_amdgcn_readfirstlane(t2 >> 6); side_convert(F, l, k); }
            } else if ((PH_EN & 4) && (k == 1 || k == 8 || k == 6)) {
                pg8::Gemm g; float alpha = 0.5f;
                if (k == 6) { g = pg8::Gemm{PROJ + PX, (const bf16_t*)(WL + W_OUT), M_TOK, DM, DM, PLD}; alpha = 1.0f; }
                else { g = pg8::Gemm{PROJ, (const bf16_t*)(WL + (k == 1 ? W_D1 : W_D2)), M_TOK, DM, FF, FF}; }
                pg8::StaticOrder S; S.init(M_TOK, DM, F.G, (int)blockIdx.x);
                if (ph == N_PHASES - 1) { EpiResid<true> E{outp, XB, SSQ, alpha, 1.0f / alpha}; pg8::gemm_phase<EpiResid<true>, false, true>(F.lds, g, S, E, F.tid); }
                else { EpiResid<false> E{outp, XB, SSQ, alpha, 1.0f / alpha}; pg8::gemm_phase<EpiResid<false>, false, true>(F.lds, g, S, E, F.tid); }
            } else if ((PH_EN & 8) && k == 2) {
                pg8::Gemm g{XB, (const bf16_t*)(WL + W_IN), M_TOK, NIN, DM, DM}; pg8::StaticOrder S; S.init(M_TOK, NIN, F.G, (int)blockIdx.x);
                EpiInProj E{{}, PROJ, GATES, SSQ, kin[15] + l * 64, kin[16] + l * 64, kin[7] + l * 8, kin[11] + l * 8};
                pg8::gemm_phase<EpiInProj, true, true>(F.lds, g, S, E, F.tid);
                { int t2 = threadIdx.x; asm volatile("" : "+v"(t2)); F.tid = t2; F.lane = t2 & 63; F.wave = __builtin_amdgcn_readfirstlane(t2 >> 6); side_convert(F, l, k); }
            } else if ((PH_EN & 16) && k == 3) {
                conv_phase(F, l);
            } else if (k == 4) {
                const int qoff_ = (F.G == 256) ? 256 : 0;
                for (int it = (F.G == 256) ? (int)blockIdx.x : q_next(F, 2 * l);;) {
                    if (it >= 48 + NA1) break;
                    { int t2 = threadIdx.x; asm volatile("" : "+v"(t2)); F.tid = t2; F.lane = t2 & 63; F.wave = __builtin_amdgcn_readfirstlane(t2 >> 6); }
                    ITEM_T0();
                    if (it < 48) {
                        if (it < 16) { if (PH_EN & 32) mlstm_state_item(F, it); ITEM_T1(0); } else { if (PH_EN & 64) ssd_state_item(F, l, it - 16); ITEM_T1(1); }
                        __syncthreads();
                        if (threadIdx.x == 0) { __builtin_amdgcn_fence(__ATOMIC_RELEASE, "agent"); asm volatile("s_waitcnt vmcnt(0)" ::: "memory"); (void)xb_add(F.ctl + CW_Q + 64 * (8 + l), 1u); }
                        it = q_next(F, 2 * l) + qoff_; }
                    else { const int r = it - 48; attn_item(F, l, r & 15, 31 - (r >> 4), true); ITEM_T1(2); ITEM_TSUM(12);
                        __syncthreads(); it = (int)F.MISC[17] + qoff_; } }
#ifdef PROBE_A
                if (threadIdx.x == 0) atomicAdd(F.ctl + CW_STAT + 64 * (13 + 16 * l), (unsigned)(__builtin_amdgcn_s_memrealtime() - t_prev));
#endif
                if (threadIdx.x == 0) { unsigned sp_ = 0u; while (xb_ld(F.ctl + CW_Q + 64 * (8 + l)) < 48u) { __builtin_amdgcn_s_sleep(2); if (++sp_ > (1u << 24)) break; }
                    __builtin_amdgcn_fence(__ATOMIC_ACQUIRE, "agent"); asm volatile("s_waitcnt vmcnt(0)" ::: "memory"); }
                for (;;) { const int it = q_next(F, 2 * l + 1); if (it >= 512) break;
                    { int t2 = threadIdx.x; asm volatile("" : "+v"(t2)); F.tid = t2; F.lane = t2 & 63; F.wave = __builtin_amdgcn_readfirstlane(t2 >> 6); }
                    if (it < 256) ssd_out_item(F, l, it); else mlstm_out_item(F, l, it - 256); }
            } else if (k == 5) {
            } else if (k == 5 && NA1 == 512 && F.G == 256) {
                { int t2 = threadIdx.x; asm volatile("" : "+v"(t2)); F.tid = t2; F.lane = t2 & 63; F.wave = __builtin_amdgcn_readfirstlane(t2 >> 6); }
                ssd_out_item(F, l, F.vcu);
                __syncthreads();
                { int t2 = threadIdx.x; asm volatile("" : "+v"(t2)); F.tid = t2; F.lane = t2 & 63; F.wave = __builtin_amdgcn_readfirstlane(t2 >> 6); }
                mlstm_out_item(F, l, F.vcu);
            } else if (k == 5) {
                for (;;) { const int it = q_next(F, 2 * l + 1); if (it >= 512 + (512 - NA1)) break;
                    { int t2 = threadIdx.x; asm volatile("" : "+v"(t2)); F.tid = t2; F.lane = t2 & 63; F.wave = __builtin_amdgcn_readfirstlane(t2 >> 6); }
                    ITEM_T0();
                    if (it < 256) { if (PH_EN & 256) ssd_out_item(F, l, it); ITEM_T1(3); }
                    else if (it < 512) { if (PH_EN & 512) mlstm_out_item(F, l, it - 256); ITEM_T1(4); }
                    else { const int r = NA1 + it - 512; if (PH_EN & 128) attn_item(F, l, r & 15, 31 - (r >> 4), false); } }
            }
        }
#ifdef PROBE_A
        if (ph + 1 < ph_hi) { XcdBarrier bar; bar.bar = F.ctl + CW_BAR; bar.x = xb_xcc_id(); bar.st = F.MISC + 8; xcd_barrier(bar); }
        { const unsigned long long t_now = __builtin_amdgcn_s_memrealtime(); if (threadIdx.x == 0) F.MISC[24 + ph] += (unsigned)(t_now - t_prev); t_prev = t_now; }
        if (ph + 1 == ph_hi && blockIdx.x == 0) { __syncthreads();
            unsigned va = (PROBE_A < 32) ? F.MISC[24 + PROBE_A] : xb_ld(F.ctl + CW_STAT + 64 * (PROBE_A - 32)), vb = (PROBE_B < 32) ? F.MISC[24 + PROBE_B] : xb_ld(F.ctl + CW_STAT + 64 * (PROBE_B - 32));
            if (PROBE_A == 44 || PROBE_A == 45) va = va / 256u * 5u; if (PROBE_B == 44 || PROBE_B == 45) vb = vb / 256u * 5u;
            unsigned qa = (va + 500u) / 1000u, qb = (vb + 500u) / 1000u; if (qa > 63u) qa = 63u; if (qb > 63u) qb = 63u;
            const unsigned long long wait = (unsigned long long)(qa * 6400u + qb * 409600u); const unsigned long long t0 = __builtin_amdgcn_s_memrealtime();
            while (__builtin_amdgcn_s_memrealtime() - t0 < wait) __builtin_amdgcn_s_sleep(8); }
        continue;
#endif
        if (ph + 1 < ph_hi && !(ph > 0 && (ph - 1) % 9 == 5)) { XcdBarrier bar; bar.bar = F.ctl + CW_BAR; bar.x = xb_xcc_id(); bar.st = F.MISC + 8; xcd_barrier(bar); }
    }
}

extern "C" void kernel_launch(void* const* d_in, const int* in_sizes, int n_in, void* d_out, int out_size, void* d_ws, size_t ws_size, hipStream_t stream) {
    static int grid = 0;
    if (grid == 0) {
        if (n_in != 25 || in_sizes[0] != M_TOK * DM || out_size != M_TOK * DM || ws_size < WS_END) { fprintf(stderr, "kernel_launch: unexpected shapes (n_in %d, in0 %d, out %d, ws %zu)\n", n_in, n_in > 0 ? in_sizes[0] : -1, out_size, ws_size); grid = -1; return; }
        int dev = 0, cus = 0, per_cu = 0;
        if (hipGetDevice(&dev) != hipSuccess || hipDeviceGetAttribute(&cus, hipDeviceAttributeMultiprocessorCount, dev) != hipSuccess) { grid = -1; return; }
        if (hipFuncSetAttribute((const void*)hyb_fwd, hipFuncAttributeMaxDynamicSharedMemorySize, LDS_BYTES) != hipSuccess) { fprintf(stderr, "kernel_launch: hipFuncSetAttribute failed\n"); grid = -1; return; }
        if (hipOccupancyMaxActiveBlocksPerMultiprocessor(&per_cu, (const void*)hyb_fwd, NTHREADS, LDS_BYTES) != hipSuccess || per_cu < 1)
            fprintf(stderr, "kernel_launch: note: occupancy query reports %d workgroups per CU\n", per_cu);
        (void)hipGetLastError();
        grid = cus;
    }
    if (grid < 0) return;
    if (hipMemsetAsync((char*)d_ws + WS_CTL, 0, CTL_ZERO_BYTES, stream) != hipSuccess) { fprintf(stderr, "kernel_launch: memset failed\n"); return; }
    Args a{};
    for (int i = 0; i < 25; ++i) a.in[i] = (const float*)d_in[i];
    a.out = (float*)d_out; a.ws = (unsigned char*)d_ws;
#if MK_N_LAUNCHES == 1
    a.ph_lo = 0; a.ph_hi = N_PHASES;
    hipLaunchKernelGGL(hyb_fwd, dim3(grid), dim3(NTHREADS), LDS_BYTES, stream, a);
#else
    for (int p = 0; p < N_PHASES; ++p) { a.ph_lo = p; a.ph_hi = p + 1; hipLaunchKernelGGL(hyb_fwd, dim3(grid), dim3(NTHREADS), LDS_BYTES, stream, a); }
#endif
    const hipError_t le = hipPeekAtLastError();
    if (le != hipSuccess) fprintf(stderr, "kernel_launch: launch failed: %s\n", hipGetErrorName(le));
}
```
